# Optimizing an MI355X kernel written in HIP

```python
import jax, jax.numpy as jnp
from jax import lax
import numpy as np

D_MODEL = 2048
BATCH = 4
SEQ = 4096
DEPTH = 2

GRID_W = 64
CTX_LEN = 256
EPS = 1e-6

HEAD_DIM = 128
RET_HEADS = (D_MODEL // 2) // HEAD_DIM
RET_WIDTH = RET_HEADS * HEAD_DIM
RET_CHUNK = 128
QK_SCALE = HEAD_DIM ** -0.5
ROPE_BASE = 10000.0

SGU_CHUNK = 128
SGU_GROUPS = 8
SGU_GROUP_DIM = (D_MODEL // 2) // SGU_GROUPS
SGU_WIDTH = SGU_GROUPS * SGU_GROUP_DIM

AB_IN_WIDTH = 4 * RET_WIDTH + 2 * SGU_WIDTH
AB_OUT_WIDTH = RET_WIDTH + SGU_WIDTH

CONV_WIDTH = D_MODEL
CONV_K = 3

N_GROUPS = 4
EXPERTS_PER_GROUP = 4
N_EXPERTS = N_GROUPS * EXPERTS_PER_GROUP
TOP_K_INNER = 2
D_EXPERT = D_MODEL // 2

N_EVEN = (DEPTH + 1) // 2
N_ODD = DEPTH // 2

kernel_name = "hybrid_retention_sgu_shortconv_hmoe_dit"


def rmsnorm(x, g):
    x32 = x.astype(jnp.float32)
    y = x32 * lax.rsqrt(jnp.mean(x32 * x32, axis=-1, keepdims=True) + EPS)
    return (y * g.astype(jnp.float32)).astype(x.dtype)


def modulate(x, g, shift, scale):
    return rmsnorm(x, g) * (1 + scale) + shift


def head_groupnorm(y):
    y32 = y.astype(jnp.float32)
    mu = jnp.mean(y32, axis=-1, keepdims=True)
    var = jnp.mean(jnp.square(y32 - mu), axis=-1, keepdims=True)
    return (y32 - mu) * lax.rsqrt(var + EPS)


def axial_rope_tables(n_tokens):
    t = jnp.arange(n_tokens)
    row = (t // GRID_W).astype(jnp.float32)
    col = (t % GRID_W).astype(jnp.float32)
    n_freq = HEAD_DIM // 4
    inv = ROPE_BASE ** (-jnp.arange(n_freq, dtype=jnp.float32) / n_freq)
    ang = jnp.concatenate([row[:, None] * inv, col[:, None] * inv], axis=-1)
    return jnp.cos(ang), jnp.sin(ang)


def apply_rope(x, cos, sin):
    x1, x2 = jnp.split(x, 2, axis=-1)
    cos = cos.astype(x.dtype)
    sin = sin.astype(x.dtype)
    return jnp.concatenate([x1 * cos - x2 * sin, x1 * sin + x2 * cos], axis=-1)


def retention_chunkwise(q, k, v, log_gamma, s0, include_diag):
    B, H, T, d = q.shape
    C = RET_CHUNK
    N = T // C
    qc = q.reshape(B, H, N, C, d)
    kc = k.reshape(B, H, N, C, d)
    vc = v.reshape(B, H, N, C, d)
    lg = log_gamma.astype(jnp.float32)
    i = jnp.arange(C, dtype=jnp.float32)
    diff = i[:, None] - i[None, :]
    mask = (diff >= 0) if include_diag else (diff > 0)
    decay = jnp.exp(jnp.where(mask[None], diff[None] * lg[:, None, None], -jnp.inf))
    scores = jnp.einsum('bhnid,bhnjd->bhnij', qc, kc) * decay[None, :, None].astype(q.dtype)
    y_intra = jnp.einsum('bhnij,bhnjd->bhnid', scores, vc)
    q_decay = jnp.exp((i + 1.0)[None, :] * lg[:, None])
    k_decay = jnp.exp((C - 1.0 - i)[None, :] * lg[:, None])
    chunk_decay = jnp.exp(C * lg)
    u = jnp.einsum('bhnjd,bhnje->nbhde', kc * k_decay[None, :, None, :, None].astype(k.dtype), vc)
    u = u.astype(jnp.float32)

    def step(s, u_n):
        return chunk_decay[None, :, None, None] * s + u_n, s

    s_final, s_prev = lax.scan(step, s0, u)
    y_cross = jnp.einsum('bhnid,nbhde->bhnie', qc, s_prev) * q_decay[None, :, None, :, None]
    y = (y_intra + y_cross).reshape(B, H, T, d)
    return y, s_final


def bidir_retention(q, k, v, lg_fwd, lg_bwd, s0_fwd, s0_bwd):
    flip = lambda t: jnp.flip(t, axis=2)
    y_f, s_f = retention_chunkwise(q, k, v, lg_fwd, s0_fwd, True)
    y_b, s_b = retention_chunkwise(flip(q), flip(k), flip(v), lg_bwd, s0_bwd, False)
    return y_f + flip(y_b), s_f, s_b


def spatial_gating(u, v, w_s, b_s):
    B, T, _ = u.shape
    n = T // SGU_CHUNK
    v = v.reshape(B, n, SGU_CHUNK, SGU_GROUPS, SGU_GROUP_DIM)
    v32 = v.astype(jnp.float32)
    mu = jnp.mean(v32, axis=-1, keepdims=True)
    var = jnp.mean(jnp.square(v32 - mu), axis=-1, keepdims=True)
    vn = ((v32 - mu) * lax.rsqrt(var + EPS)).astype(v.dtype)
    s = jnp.einsum('gpq,bnqgc->bnpgc', w_s, vn) + b_s.T[None, None, :, :, None]
    return u * s.reshape(B, T, SGU_WIDTH)


def mixer_ab(a_lat, a_ctx, w_in, w_out, decay_logit, w_s, b_s, cos, sin, with_ctx):
    lg_f = jax.nn.log_sigmoid(decay_logit[0].astype(jnp.float32))
    lg_b = jax.nn.log_sigmoid(decay_logit[1].astype(jnp.float32))
    split_at = [RET_WIDTH, 2 * RET_WIDTH, 3 * RET_WIDTH, 4 * RET_WIDTH, 4 * RET_WIDTH + SGU_WIDTH]

    def heads(t):
        B, T, _ = t.shape
        return t.reshape(B, T, RET_HEADS, HEAD_DIM).transpose(0, 2, 1, 3)

    def unheads(t):
        B, H, T, d = t.shape
        return t.transpose(0, 2, 1, 3).reshape(B, T, H * d)

    def finish(z_g, y_ret, z_u, z_v):
        r = jax.nn.silu(z_g) * unheads(head_groupnorm(y_ret)).astype(z_g.dtype)
        s = spatial_gating(jax.nn.gelu(z_u), jax.nn.gelu(z_v), w_s, b_s)
        return jnp.concatenate([r, s], axis=-1) @ w_out

    z_c = a_ctx @ w_in
    q_c, k_c, v_c, g_c, u_c, vs_c = jnp.split(z_c, split_at, axis=-1)
    zeros = jnp.zeros((a_ctx.shape[0], RET_HEADS, HEAD_DIM, HEAD_DIM), jnp.float32)
    y_c, s_f, s_b = bidir_retention(heads(q_c) * QK_SCALE, heads(k_c), heads(v_c), lg_f, lg_b, zeros, zeros)
    out_c = finish(g_c, y_c, u_c, vs_c) if with_ctx else None

    z_l = a_lat @ w_in
    q_l, k_l, v_l, g_l, u_l, vs_l = jnp.split(z_l, split_at, axis=-1)
    q_l = apply_rope(heads(q_l), cos, sin) * QK_SCALE
    k_l = apply_rope(heads(k_l), cos, sin)
    y_l, _, _ = bidir_retention(q_l, k_l, heads(v_l), lg_f, lg_b, s_f, s_b)
    out_l = finish(g_l, y_l, u_l, vs_l)
    return out_l, out_c


def conv3_centred(h, w, b, axis):
    n = h.shape[axis]
    half = CONV_K // 2
    pad = [(0, 0)] * h.ndim
    pad[axis] = (half, half)
    hp = jnp.pad(h, pad)
    y = b
    for j in range(CONV_K):
        y = y + lax.slice_in_dim(hp, j, j + n, axis=axis) * w[j]
    return y


def mixer_c(h, w_in, conv_w, conv_b, w_out, rows):
    z = h @ w_in
    gate_b, gate_c, hv = jnp.split(z, 3, axis=-1)
    xg = gate_c * hv
    if rows is None:
        y = conv3_centred(xg, conv_w, conv_b, axis=1)
    else:
        B, T, W = xg.shape
        y = conv3_centred(xg.reshape(B, rows, GRID_W, W), conv_w, conv_b, axis=2).reshape(B, T, W)
    return (gate_b * y) @ w_out


def hier_moe(h, w_r1, b_r1, w_r2, b_r2, w1, w3, w2):
    logit1 = (h @ w_r1 + b_r1).astype(jnp.float32)
    p1 = jax.nn.softmax(logit1, axis=-1)
    grp = jnp.argmax(logit1, axis=-1)
    p_grp = jnp.take_along_axis(p1, grp[:, None], axis=-1)
    logit2 = (jnp.einsum('nd,gde->nge', h, w_r2) + b_r2).astype(jnp.float32)
    logit2 = jnp.take_along_axis(logit2, grp[:, None, None], axis=1)[:, 0]
    top_v, top_i = lax.top_k(logit2, TOP_K_INNER)
    w_sel = jax.nn.softmax(top_v, axis=-1) * p_grp
    expert_idx = grp[:, None] * EXPERTS_PER_GROUP + top_i
    comb = jnp.sum(jax.nn.one_hot(expert_idx, N_EXPERTS, dtype=jnp.float32) * w_sel[..., None], axis=1)
    comb = comb.astype(h.dtype)
    y = jnp.zeros_like(h)
    for e in range(N_EXPERTS):
        a = jax.nn.silu(h @ w1[e]) * (h @ w3[e])
        y = y + comb[:, e:e + 1] * (a @ w2[e])
    return y


def setup_inputs(seed: int = 0) -> dict:
    key = jax.random.key(seed)
    ks = jax.random.split(key, 26)
    f32 = jnp.float32
    D = D_MODEL

    def nrm(k, shape, scale):
        return jax.random.normal(k, shape, f32) * scale

    decay_base = jnp.asarray(np.log(2.0 ** (5 + np.arange(RET_HEADS)) - 1.0), f32)
    return {
        "x": nrm(ks[0], (BATCH, SEQ, D), 1.0),
        "c": nrm(ks[1], (BATCH, D), 1.0),
        "ctx": nrm(ks[2], (BATCH, CTX_LEN, D), 1.0),
        "c_ctx": nrm(ks[3], (D,), 1.0),
        "w_mod": nrm(ks[4], (DEPTH, D, 6 * D), 0.5 * D ** -0.5),
        "b_mod": nrm(ks[5], (DEPTH, 6 * D), 0.02),
        "g_mix": 1.0 + nrm(ks[6], (DEPTH, D), 0.02),
        "g_ffn": 1.0 + nrm(ks[7], (DEPTH, D), 0.02),
        "ab_w_in": nrm(ks[8], (N_EVEN, D, AB_IN_WIDTH), D ** -0.5),
        "ab_w_out": nrm(ks[9], (N_EVEN, AB_OUT_WIDTH, D), AB_OUT_WIDTH ** -0.5),
        "ret_decay_logit": decay_base[None, None, :] + nrm(ks[10], (N_EVEN, 2, RET_HEADS), 0.1),
        "sgu_w_s": nrm(ks[11], (N_EVEN, SGU_GROUPS, SGU_CHUNK, SGU_CHUNK), 0.5 * SGU_CHUNK ** -0.5),
        "sgu_b_s": 1.0 + nrm(ks[12], (N_EVEN, SGU_GROUPS, SGU_CHUNK), 0.02),
        "cv_w_in": nrm(ks[13], (N_ODD, D, 3 * CONV_WIDTH), D ** -0.5),
        "cv_conv_w": nrm(ks[14], (N_ODD, CONV_K, CONV_WIDTH), CONV_K ** -0.5),
        "cv_conv_b": nrm(ks[15], (N_ODD, CONV_WIDTH), 0.02),
        "cv_w_out": nrm(ks[16], (N_ODD, CONV_WIDTH, D), CONV_WIDTH ** -0.5),
        "moe_w_r1": nrm(ks[17], (DEPTH, D, N_GROUPS), D ** -0.5),
        "moe_b_r1": nrm(ks[18], (DEPTH, N_GROUPS), 0.01),
        "moe_w_r2": nrm(ks[19], (DEPTH, N_GROUPS, D, EXPERTS_PER_GROUP), D ** -0.5),
        "moe_b_r2": nrm(ks[20], (DEPTH, N_GROUPS, EXPERTS_PER_GROUP), 0.01),
        "moe_w1": nrm(ks[21], (DEPTH, N_EXPERTS, D, D_EXPERT), D ** -0.5),
        "moe_w3": nrm(ks[22], (DEPTH, N_EXPERTS, D, D_EXPERT), D ** -0.5),
        "moe_w2": nrm(ks[23], (DEPTH, N_EXPERTS, D_EXPERT, D), D_EXPERT ** -0.5),
        "g_final": 1.0 + nrm(ks[24], (D,), 0.02),
    }


def reference(x, c, ctx, c_ctx, w_mod, b_mod, g_mix, g_ffn,
              ab_w_in, ab_w_out, ret_decay_logit, sgu_w_s, sgu_b_s,
              cv_w_in, cv_conv_w, cv_conv_b, cv_w_out,
              moe_w_r1, moe_b_r1, moe_w_r2, moe_b_r2, moe_w1, moe_w3, moe_w2,
              g_final):
    B, T, D = x.shape
    rows = T // GRID_W
    cos, sin = axial_rope_tables(T)
    for i in range(DEPTH):
        last = i == DEPTH - 1
        even = i % 2 == 0
        use_ctx = even or not last
        mod = jax.nn.silu(c) @ w_mod[i] + b_mod[i]
        sh1, sc1, gt1, sh2, sc2, gt2 = jnp.split(mod[:, None, :], 6, axis=-1)
        a_lat = modulate(x, g_mix[i], sh1, sc1)
        if use_ctx:
            cmod = jax.nn.silu(c_ctx) @ w_mod[i] + b_mod[i]
            csh1, csc1, cgt1, csh2, csc2, cgt2 = jnp.split(cmod, 6)
            a_ctx = modulate(ctx, g_mix[i], csh1, csc1)
        j = i // 2
        if even:
            m_lat, m_ctx = mixer_ab(a_lat, a_ctx, ab_w_in[j], ab_w_out[j], ret_decay_logit[j],
                                    sgu_w_s[j], sgu_b_s[j], cos, sin, not last)
        else:
            m_lat = mixer_c(a_lat, cv_w_in[j], cv_conv_w[j], cv_conv_b[j], cv_w_out[j], rows)
            m_ctx = None if last else mixer_c(a_ctx, cv_w_in[j], cv_conv_w[j], cv_conv_b[j], cv_w_out[j], None)
        x = x + gt1 * m_lat
        f_lat = modulate(x, g_ffn[i], sh2, sc2).reshape(-1, D)
        if last:
            y = hier_moe(f_lat, moe_w_r1[i], moe_b_r1[i], moe_w_r2[i], moe_b_r2[i],
                         moe_w1[i], moe_w3[i], moe_w2[i])
            x = x + gt2 * y.reshape(B, T, D)
        else:
            ctx = ctx + cgt1 * m_ctx
            f_ctx = modulate(ctx, g_ffn[i], csh2, csc2).reshape(-1, D)
            y = hier_moe(jnp.concatenate([f_lat, f_ctx], axis=0), moe_w_r1[i], moe_b_r1[i],
                         moe_w_r2[i], moe_b_r2[i], moe_w1[i], moe_w3[i], moe_w2[i])
            x = x + gt2 * y[:B * T].reshape(B, T, D)
            ctx = ctx + cgt2 * y[B * T:].reshape(ctx.shape)
    return rmsnorm(x, g_final)
```

```cpp
#include <hip/hip_runtime.h>
#include <cstdio>
#include <cstdint>

#ifndef MK_SPLIT
#define MK_SPLIT 0
#endif
#ifndef DBG_STOP
#define DBG_STOP 0
#endif

#define LAS __attribute__((address_space(3)))
#define GAS __attribute__((address_space(1)))
typedef unsigned short bf16;
typedef short bf16x8 __attribute__((ext_vector_type(8)));
typedef short s16x4 __attribute__((ext_vector_type(4)));
typedef float f32x4 __attribute__((ext_vector_type(4)));
typedef float f32x2 __attribute__((ext_vector_type(2)));
typedef unsigned u32x4 __attribute__((ext_vector_type(4)));
typedef unsigned u32x2 __attribute__((ext_vector_type(2)));
typedef int i32x4 __attribute__((ext_vector_type(4)));
typedef int i32x2 __attribute__((ext_vector_type(2)));

constexpr int D = 2048, NB = 4, TL = 4096, TCX = 256;
constexpr int NLAT = NB * TL;
constexpr int NCTX = NB * TCX;
constexpr int NTOK = NLAT + NCTX;
constexpr int HD = 128, NH = 8, RW = 1024;
constexpr int NSLOT = 34;
constexpr int NUNIT = NB * NH * NSLOT;
constexpr int DE = 1024, NE = 16;
constexpr int PCAP = 2 * NTOK + NE * 256;
constexpr float EPSN = 1e-6f;
constexpr float QK_SCALE = 0.08838834764831845f;
constexpr int MODW = 6 * D;

constexpr size_t MiB = 1u << 20;
constexpr size_t WS_CTL = 0, CTL_BYTES = 1 * MiB;
constexpr size_t WS_MOD = 1 * MiB;
constexpr size_t WS_ROPE = 1 * MiB + 512 * 1024;
constexpr size_t WS_WR = 2 * MiB;
constexpr size_t WS_RIDX = 3 * MiB;
constexpr size_t WS_RWT = 4 * MiB;
constexpr size_t WS_RDST = 4 * MiB + 512 * 1024;
constexpr size_t WS_WAB_IN = 8 * MiB, WS_WAB_OUT = 32 * MiB, WS_WCV_IN = 40 * MiB, WS_WCV_OUT = 64 * MiB;
constexpr size_t WS_W13 = 72 * MiB;
constexpr size_t WS_W2 = 328 * MiB;
constexpr size_t WS_XB = 456 * MiB;
constexpr size_t WS_A = 592 * MiB;
constexpr size_t WS_R1 = 660 * MiB;
constexpr size_t WS_R2 = 864 * MiB;
constexpr size_t WS_R3 = 1016 * MiB;
constexpr size_t WS_END = 1092 * MiB;
constexpr size_t ZSEC = (size_t)NTOK * 1024;
constexpr int CW_BAR = 4096;
constexpr int CW_CNT = 1024;

constexpr int SCR_BYTES = 147456;
constexpr int MISC_OFF = SCR_BYTES;
constexpr int LDS_BYTES = SCR_BYTES + 2048;
constexpr int MI_LCNT = 16, MI_GBASE = 32, MI_TB = 64, MI_TEXP = 96;

__device__ __forceinline__ unsigned cvt_pk_bf16(float lo, float hi) { unsigned r; asm("v_cvt_pk_bf16_f32 %0, %1, %2" : "=v"(r) : "v"(lo), "v"(hi)); return r; }
__device__ __forceinline__ float bf2f(unsigned b) { return __uint_as_float(b << 16); }
__device__ __forceinline__ float wave_sum(float v) {
#pragma unroll
    for (int o = 1; o < 64; o <<= 1) v += __shfl_xor(v, o);
    return v;
}
__device__ __forceinline__ float silu_f(float x) { return x / (1.0f + __expf(-x)); }
__device__ __forceinline__ float gelu_tanh_f(float x) { const float z = 1.5957691216057308f * (x + 0.044715f * x * x * x); return x / (1.0f + __expf(-z)); }
__device__ __forceinline__ u32x4 pack8(f32x4 a, f32x4 b) { u32x4 w; w.x = cvt_pk_bf16(a[0], a[1]); w.y = cvt_pk_bf16(a[2], a[3]); w.z = cvt_pk_bf16(b[0], b[1]); w.w = cvt_pk_bf16(b[2], b[3]); return w; }
__device__ __forceinline__ float logsig(float x) { return -log1pf(expf(-x)); }
#define LOG2E 1.4426950408889634f

namespace pg8 {
constexpr int BM = 256, BK = 64, HALF = 128, HTB = HALF * BK * 2, STAGE_BYTES = 8 * HTB, NXCD = 8, WGM = 8;
__host__ __device__ __forceinline__ int lds_byte(int r, int c) { const int st = (r >> 4) * 2 + (c >> 5), rr = r & 15, cc = c & 31, ob = rr * 64 + cc * 2; return st * 1024 + (ob ^ (((ob >> 9) & 1) << 5)); }
__host__ __device__ __forceinline__ void stage_rc(int b, int& R, int& C) { const int st = b / 1024, sb = b % 1024, swz = sb ^ (((sb >> 9) & 1) << 5); R = (st >> 1) * 16 + swz / 64; C = (st & 1) * 32 + (swz % 64) / 2; }

struct Unit { int pm, pn; long boff; };
struct Gemm { const bf16* A; const bf16* Bt; int K; };

struct StaticOrder {
    int nM, nN, nwg, G, c;
    __device__ void init(int nM_, int nN_, int G_, int c_) { nM = nM_; nN = nN_; nwg = nM * nN; G = G_; c = c_; }
    __device__ bool map(int i, int& pm, int& pn) const {
        const long L = (long)i * G + c; if (L >= nwg) return false;
        int wgid = (int)L; { const int q = nwg / NXCD, r = nwg % NXCD, xcd = wgid % NXCD, off = wgid / NXCD; wgid = (xcd < r ? xcd * (q + 1) : r * (q + 1) + (xcd - r) * q) + off; }
        const int nig = WGM * nN, gid = wgid / nig, fm = gid * WGM, gsz = (nM - fm) < WGM ? (nM - fm) : WGM;
        pm = fm + ((wgid % nig) % gsz); pn = (wgid % nig) / gsz; return true;
    }
    __device__ bool next(int i, Unit& u) const { u.boff = 0; return map(i, u.pm, u.pn); }
};
struct MoeOrder : StaticOrder {
    const volatile LAS int* texp; long bstride;
    __device__ bool next(int i, Unit& u) const { if (!map(i, u.pm, u.pn)) return false; u.boff = (long)texp[u.pm] * bstride; return true; }
};

template <class Epi, class Sched, bool ALIGN_EPI, bool SP2>
__device__ __forceinline__ void gemm_phase(LAS unsigned char* lds, const Gemm g, const Sched& S, const Epi& E) {
    const int tid = threadIdx.x, wid = __builtin_amdgcn_readfirstlane(tid >> 6), lane = tid & 63, wr = wid >> 2, wc = wid & 3, fr = lane & 15, fq = lane >> 4;
    const int K = g.K, nt = K / BK;
    unsigned voffA[2];
#pragma unroll
    for (int i = 0; i < 2; ++i) { int R, C; stage_rc(tid * 16 + i * 8192, R, C); voffA[i] = (unsigned)(R * K + C) * 2u; }
    const size_t kstep = (size_t)(BK * 2);
    const size_t hstep = (size_t)HALF * K * 2;
    const size_t tstep = 2 * hstep;
    const unsigned ldsw = (unsigned)wid * 1024u;
    const int aoff = lds_byte(wr * 64 + fr, fq * 8), boff = lds_byte(wc * 32 + fr, fq * 8);
#define PG8_SA(b, h) (((b) * 2 + (h)) * HTB)
#define PG8_SB(b, h) ((4 + (b) * 2 + (h)) * HTB)
#define PG8_STAGE(bufoff, gbase) do { _Pragma("unroll") for (int _i = 0; _i < 2; ++_i) \
        __builtin_amdgcn_global_load_lds((const unsigned*)((const char*)(gbase) + voffA[_i]), (LAS unsigned*)(lds + (bufoff) + ldsw + _i * 8192), 16, 0, 0); } while (0)
#define PG8_LDA(dst, b, h) do { _Pragma("unroll") for (int m = 0; m < 4; ++m) _Pragma("unroll") for (int k = 0; k < 2; ++k) dst[m][k] = *(const LAS bf16x8*)(lds + PG8_SA(b, h) + aoff + m * 2048 + k * 1024); } while (0)
#define PG8_LDB(dst, b, h) do { _Pragma("unroll") for (int n = 0; n < 2; ++n) _Pragma("unroll") for (int k = 0; k < 2; ++k) dst[n][k] = *(const LAS bf16x8*)(lds + PG8_SB(b, h) + boff + n * 2048 + k * 1024); } while (0)
#define PG8_MMA(ai, bj, At, Bt) do { __builtin_amdgcn_s_setprio(1); _Pragma("unroll") for (int m = 0; m < 4; ++m) _Pragma("unroll") for (int n = 0; n < 2; ++n) _Pragma("unroll") for (int k = 0; k < 2; ++k) \
        acc[ai][bj][m][n] = __builtin_amdgcn_mfma_f32_16x16x32_bf16(Bt[n][k], At[m][k], acc[ai][bj][m][n], 0, 0, 0); __builtin_amdgcn_s_setprio(0); } while (0)
#define PG8_WAIT_V(n) asm volatile("s_waitcnt vmcnt(" #n ")" ::: "memory")
#define PG8_WAIT_L(n) asm volatile("s_waitcnt lgkmcnt(" #n ")" ::: "memory")
#define PG8_BAR __builtin_amdgcn_s_barrier()
#define PG8_SCHED __builtin_amdgcn_sched_barrier(0)
    Unit cur, nxt; int ui = 0;
    if (!S.next(0, cur)) return;
    f32x4 acc[2][2][4][2];
#pragma unroll
    for (int a = 0; a < 2; ++a)
#pragma unroll
        for (int b = 0; b < 2; ++b)
#pragma unroll
            for (int m = 0; m < 4; ++m)
#pragma unroll
                for (int n = 0; n < 2; ++n) acc[a][b][m][n] = (f32x4){0.f, 0.f, 0.f, 0.f};
    bf16x8 At[4][2], B0[2][2], B1[2][2];
    const char* cA = (const char*)g.A + (size_t)cur.pm * tstep; const char* cB = (const char*)g.Bt + cur.boff + (size_t)cur.pn * tstep;
    if constexpr (SP2) {
        PG8_STAGE(PG8_SB(0, 0), cB); PG8_STAGE(PG8_SB(0, 1), cB + hstep); PG8_STAGE(PG8_SA(0, 0), cA); PG8_STAGE(PG8_SA(0, 1), cA + hstep);
        if (wr == 1) PG8_BAR;
        PG8_WAIT_V(2); PG8_BAR;
        PG8_STAGE(PG8_SB(1, 0), cB + kstep); PG8_STAGE(PG8_SA(1, 0), cA + kstep); PG8_STAGE(PG8_SB(1, 1), cB + hstep + kstep);
        PG8_WAIT_V(6); PG8_BAR;
    } else {
        PG8_STAGE(PG8_SB(0, 0), cB); PG8_STAGE(PG8_SA(0, 0), cA); PG8_STAGE(PG8_SB(0, 1), cB + hstep); PG8_STAGE(PG8_SA(0, 1), cA + hstep);
        if (wr == 1) PG8_BAR;
        PG8_WAIT_V(4); PG8_BAR;
        PG8_STAGE(PG8_SB(1, 0), cB + kstep); PG8_STAGE(PG8_SA(1, 0), cA + kstep); PG8_STAGE(PG8_SB(1, 1), cB + hstep + kstep);
        PG8_WAIT_V(6); PG8_BAR;
    }
    for (;;) {
        const bool has_next = S.next(ui + 1, nxt);
        const char* nA = has_next ? (const char*)g.A + (size_t)nxt.pm * tstep : cA; const char* nB = has_next ? (const char*)g.Bt + nxt.boff + (size_t)nxt.pn * tstep : cB;
        for (int t = 0; t < nt; t += 2) {
            const bool last = (t == nt - 2);
            const char* a1 = cA + (size_t)(t + 1) * kstep;
            const char* a2 = last ? nA : cA + (size_t)(t + 2) * kstep; const char* b2 = last ? nB : cB + (size_t)(t + 2) * kstep;
            const char* a3 = a2 + kstep; const char* b3 = b2 + kstep;
            if constexpr (SP2) {
            PG8_LDB(B0, 0, 0); PG8_LDB(B1, 0, 1); PG8_SCHED; PG8_LDA(At, 0, 0); PG8_STAGE(PG8_SA(1, 1), a1 + hstep);
            PG8_WAIT_V(8); PG8_WAIT_L(0); PG8_BAR; PG8_MMA(0, 0, At, B0); PG8_MMA(0, 1, At, B1); PG8_BAR; PG8_SCHED;
            PG8_LDA(At, 0, 1); PG8_STAGE(PG8_SB(0, 0), b2); PG8_STAGE(PG8_SB(0, 1), b2 + hstep); PG8_STAGE(PG8_SA(0, 0), a2);
            PG8_WAIT_V(8); PG8_WAIT_L(0); PG8_BAR; PG8_MMA(1, 0, At, B0); PG8_MMA(1, 1, At, B1); PG8_BAR; PG8_SCHED;
            PG8_LDB(B0, 1, 0); PG8_LDB(B1, 1, 1); PG8_SCHED; PG8_LDA(At, 1, 0); PG8_STAGE(PG8_SA(0, 1), a2 + hstep);
            PG8_WAIT_V(8); PG8_WAIT_L(0); PG8_BAR; PG8_MMA(0, 0, At, B0); PG8_MMA(0, 1, At, B1); PG8_BAR; PG8_SCHED;
            PG8_LDA(At, 1, 1); PG8_STAGE(PG8_SB(1, 0), b3); PG8_STAGE(PG8_SB(1, 1), b3 + hstep); PG8_STAGE(PG8_SA(1, 0), a3);
            PG8_WAIT_V(8); PG8_WAIT_L(0); PG8_BAR; PG8_MMA(1, 0, At, B0); PG8_MMA(1, 1, At, B1); PG8_BAR; PG8_SCHED;
            } else {
            PG8_LDB(B0, 0, 0); PG8_SCHED; PG8_LDA(At, 0, 0); PG8_STAGE(PG8_SA(1, 1), a1 + hstep);
            PG8_WAIT_L(8); PG8_BAR; PG8_WAIT_L(0); PG8_MMA(0, 0, At, B0); PG8_BAR; PG8_SCHED;
            PG8_LDB(B1, 0, 1); PG8_STAGE(PG8_SB(0, 0), b2);
            PG8_BAR; PG8_WAIT_L(0); PG8_MMA(0, 1, At, B1); PG8_BAR;
            PG8_LDA(At, 0, 1); PG8_STAGE(PG8_SA(0, 0), a2);
            PG8_BAR; PG8_WAIT_L(0); PG8_MMA(1, 0, At, B0); PG8_BAR; PG8_SCHED;
            PG8_STAGE(PG8_SB(0, 1), b2 + hstep);
            PG8_WAIT_V(6); PG8_BAR; PG8_MMA(1, 1, At, B1); PG8_BAR;
            PG8_LDB(B0, 1, 0); PG8_SCHED; PG8_LDA(At, 1, 0); PG8_STAGE(PG8_SA(0, 1), a2 + hstep);
            PG8_WAIT_L(8); PG8_BAR; PG8_WAIT_L(0); PG8_MMA(0, 0, At, B0); PG8_BAR; PG8_SCHED;
            PG8_LDB(B1, 1, 1); PG8_STAGE(PG8_SB(1, 0), b3);
            PG8_BAR; PG8_WAIT_L(0); PG8_MMA(0, 1, At, B1); PG8_BAR;
            PG8_LDA(At, 1, 1); PG8_STAGE(PG8_SA(1, 0), a3);
            PG8_BAR; PG8_WAIT_L(0); PG8_MMA(1, 0, At, B0); PG8_BAR; PG8_SCHED;
            PG8_STAGE(PG8_SB(1, 1), b3 + hstep);
            PG8_WAIT_V(6); PG8_BAR; PG8_MMA(1, 1, At, B1); PG8_BAR;
            }
        }
        if constexpr (ALIGN_EPI) { if (wr == 0) PG8_BAR; }
        E(acc, cur, wr, wc, fr, fq);
        if (!has_next) break;
#pragma unroll
        for (int a = 0; a < 2; ++a)
#pragma unroll
            for (int b = 0; b < 2; ++b)
#pragma unroll
                for (int m = 0; m < 4; ++m)
#pragma unroll
                    for (int n = 0; n < 2; ++n) acc[a][b][m][n] = (f32x4){0.f, 0.f, 0.f, 0.f};
        cur = nxt; cA = nA; cB = nB; ++ui;
        if constexpr (ALIGN_EPI) { if (wr == 1) PG8_BAR; }
    }
    PG8_WAIT_V(0);
    if constexpr (!ALIGN_EPI) { if (wr == 0) PG8_BAR; }
    PG8_BAR;
#undef PG8_SA
#undef PG8_SB
#undef PG8_STAGE
#undef PG8_LDA
#undef PG8_LDB
#undef PG8_MMA
#undef PG8_WAIT_V
#undef PG8_WAIT_L
#undef PG8_BAR
#undef PG8_SCHED
}

typedef const f32x4 (&AccRef)[2][2][4][2];

struct EpiAB {
    bf16* Z; const float* cs;
    __device__ __forceinline__ void operator()(AccRef acc, const Unit& u, int wr, int wc, int fr, int fq) const {
        const int sec = u.pn >> 2, ct = u.pn & 3;
        bf16* base = Z + (size_t)sec * ZSEC;
#pragma unroll
        for (int ai = 0; ai < 2; ++ai)
#pragma unroll
            for (int m = 0; m < 4; ++m) {
                const int row = u.pm * BM + ai * HALF + wr * 64 + m * 16 + fr;
                if (sec < 2) {
                    const float sc = sec == 0 ? QK_SCALE : 1.0f;
                    const f32x4 x1a = acc[ai][0][m][0], x1b = acc[ai][0][m][1], x2a = acc[ai][1][m][0], x2b = acc[ai][1][m][1];
                    f32x4 o1a, o1b, o2a, o2b;
                    if (row < NLAT) {
                        const int t = row & (TL - 1); const int pos = (wc & 1) ? (t & 63) : (t >> 6);
                        const float* cp = cs + pos * 32 + 8 * fq;
                        const f32x4 c0 = *(const f32x4*)cp, c1 = *(const f32x4*)(cp + 4), s0 = *(const f32x4*)(cp + 2048), s1 = *(const f32x4*)(cp + 2052);
                        o1a = (x1a * c0 - x2a * s0) * sc; o1b = (x1b * c1 - x2b * s1) * sc; o2a = (x1a * s0 + x2a * c0) * sc; o2b = (x1b * s1 + x2b * c1) * sc;
                    } else { o1a = x1a * sc; o1b = x1b * sc; o2a = x2a * sc; o2b = x2b * sc; }
                    bf16* dst = base + (size_t)row * RW + (2 * ct + (wc >> 1)) * HD + 32 * (wc & 1) + 8 * fq;
                    *(u32x4*)dst = pack8(o1a, o1b); *(u32x4*)(dst + 64) = pack8(o2a, o2b);
                } else {
#pragma unroll
                    for (int bj = 0; bj < 2; ++bj) {
                        f32x4 v0 = acc[ai][bj][m][0], v1 = acc[ai][bj][m][1];
                        if (sec == 3) {
#pragma unroll
                            for (int j = 0; j < 4; ++j) { v0[j] = silu_f(v0[j]); v1[j] = silu_f(v1[j]); }
                        } else if (sec >= 4) {
#pragma unroll
                            for (int j = 0; j < 4; ++j) { v0[j] = gelu_tanh_f(v0[j]); v1[j] = gelu_tanh_f(v1[j]); }
                        }
                        *(u32x4*)(base + (size_t)row * RW + ct * 256 + bj * HALF + wc * 32 + 8 * fq) = pack8(v0, v1);
                    }
                }
            }
    }
};
struct EpiRes {
    float* X; const float* gate;
    __device__ __forceinline__ void operator()(AccRef acc, const Unit& u, int wr, int wc, int fr, int fq) const {
        const int r = u.pm < 64 ? (u.pm >> 4) : 4; const int col0 = u.pn * BM + wc * 32 + 8 * fq;
        const float* gp = gate + (size_t)r * MODW + col0;
        f32x4 g0[2], g1[2];
#pragma unroll
        for (int bj = 0; bj < 2; ++bj) { g0[bj] = *(const f32x4*)(gp + bj * HALF); g1[bj] = *(const f32x4*)(gp + bj * HALF + 4); }
#pragma unroll
        for (int ai = 0; ai < 2; ++ai)
#pragma unroll
            for (int m = 0; m < 4; ++m) { float* rowp = X + (size_t)(u.pm * BM + ai * HALF + wr * 64 + m * 16 + fr) * D + col0;
#pragma unroll
                for (int bj = 0; bj < 2; ++bj) { float* p = rowp + bj * HALF; f32x4 x0 = *(f32x4*)p, x1 = *(f32x4*)(p + 4);
                    x0 += g0[bj] * acc[ai][bj][m][0]; x1 += g1[bj] * acc[ai][bj][m][1]; *(f32x4*)p = x0; *(f32x4*)(p + 4) = x1; } }
    }
};
struct EpiCV {
    bf16* GB; bf16* XG;
    __device__ __forceinline__ void operator()(AccRef acc, const Unit& u, int wr, int wc, int fr, int fq) const {
#pragma unroll
        for (int ai = 0; ai < 2; ++ai)
#pragma unroll
            for (int m = 0; m < 4; ++m) { const size_t row = (size_t)(u.pm * BM + ai * HALF + wr * 64 + m * 16 + fr);
                if (u.pn < 8) {
#pragma unroll
                    for (int bj = 0; bj < 2; ++bj) *(u32x4*)(GB + row * D + u.pn * 256 + bj * HALF + wc * 32 + 8 * fq) = pack8(acc[ai][bj][m][0], acc[ai][bj][m][1]);
                } else {
                    *(u32x4*)(XG + row * D + (u.pn - 8) * HALF + wc * 32 + 8 * fq) = pack8(acc[ai][0][m][0] * acc[ai][1][m][0], acc[ai][0][m][1] * acc[ai][1][m][1]);
                } }
    }
};
struct EpiMoe1 {
    bf16* H;
    __device__ __forceinline__ void operator()(AccRef acc, const Unit& u, int wr, int wc, int fr, int fq) const {
#pragma unroll
        for (int ai = 0; ai < 2; ++ai)
#pragma unroll
            for (int m = 0; m < 4; ++m) { const size_t row = (size_t)(u.pm * BM + ai * HALF + wr * 64 + m * 16 + fr);
                f32x4 a0 = acc[ai][0][m][0], a1 = acc[ai][0][m][1];
#pragma unroll
                for (int j = 0; j < 4; ++j) { a0[j] = silu_f(a0[j]); a1[j] = silu_f(a1[j]); }
                *(u32x4*)(H + row * DE + u.pn * HALF + wc * 32 + 8 * fq) = pack8(a0 * acc[ai][1][m][0], a1 * acc[ai][1][m][1]); }
    }
};
struct EpiMoe2 {
    bf16* Y;
    __device__ __forceinline__ void operator()(AccRef acc, const Unit& u, int wr, int wc, int fr, int fq) const {
#pragma unroll
        for (int ai = 0; ai < 2; ++ai)
#pragma unroll
            for (int m = 0; m < 4; ++m) { const size_t row = (size_t)(u.pm * BM + ai * HALF + wr * 64 + m * 16 + fr);
#pragma unroll
                for (int bj = 0; bj < 2; ++bj) *(u32x4*)(Y + row * D + u.pn * 256 + bj * HALF + wc * 32 + 8 * fq) = pack8(acc[ai][bj][m][0], acc[ai][bj][m][1]); }
    }
};
}

#define XB_TMO      128
#define XB_XCNT(j)  (256  + 64 * (j))
#define XB_XSUB(j)  (1280 + 64 * (j))
#define XB_XGEN(j)  (2304 + 64 * (j))
#define XB_TOP      3328
#define XB_TOPGEN   3392
#define XCD_BAR_WORDS 3456
#define XB_SPIN_CAP (1u << 18)
__device__ __forceinline__ unsigned xb_ld(unsigned* p)              { return __hip_atomic_load(p, __ATOMIC_RELAXED, __HIP_MEMORY_SCOPE_AGENT); }
__device__ __forceinline__ unsigned xb_add(unsigned* p, unsigned v) { return __hip_atomic_fetch_add(p, v, __ATOMIC_RELAXED, __HIP_MEMORY_SCOPE_AGENT); }
__device__ __forceinline__ unsigned xb_xcc_id() { return (unsigned)__builtin_amdgcn_s_getreg((3 << 11) | 20) & 0xFu; }
#define XB_SPIN(cond, bar) do { unsigned _sp = 0; while (cond) { __builtin_amdgcn_s_sleep(1); \
    if ((++_sp & 255u) == 0u) { if (xb_ld(&(bar)[XB_TMO])) break; if (_sp > XB_SPIN_CAP) { atomicAdd(&(bar)[XB_TMO], 1u); break; } } } } while (0)
struct XcdBarrier { unsigned* bar; unsigned x; volatile LAS unsigned* st; };
__device__ __forceinline__ XcdBarrier xcd_barrier_post(unsigned* bar, volatile LAS unsigned* st) {
    XcdBarrier b; b.bar = bar; b.x = xb_xcc_id(); b.st = st;
    if (threadIdx.x == 0) (void)xb_add(&bar[XB_XCNT(b.x)], 1u);
    return b;
}
__device__ __forceinline__ void xcd_barrier_complete(unsigned* bar, unsigned x, unsigned& nloc, unsigned& nx) {
    const unsigned G = gridDim.x * gridDim.y * gridDim.z;
    unsigned sum, cnt, mine, sp = 0u;
    for (;;) {
        sum = 0u; cnt = 0u; mine = 0u;
#pragma unroll
        for (unsigned j = 0; j < 16; ++j) { const unsigned c = xb_ld(&bar[XB_XCNT(j)]); sum += c; cnt += (c > 0u) ? 1u : 0u; mine = (j == x) ? c : mine; }
        if (sum == G) break;
        __builtin_amdgcn_s_sleep(1);
        if ((++sp & 255u) == 0u) { if (xb_ld(&bar[XB_TMO])) break; if (sp > XB_SPIN_CAP) { atomicAdd(&bar[XB_TMO], 1u); break; } }
    }
    nloc = mine > 0u ? mine : 1u; nx = cnt > 0u ? cnt : 1u;
}
__device__ __forceinline__ void xcd_barrier(const XcdBarrier& b) {
    asm volatile("s_waitcnt vmcnt(0)" ::: "memory");
    __syncthreads();
    if (threadIdx.x == 0) {
        unsigned* bar = b.bar;
        __builtin_amdgcn_s_waitcnt(0);
        unsigned nloc = b.st[0], nx = b.st[1];
        if (nloc == 0u) { xcd_barrier_complete(bar, b.x, nloc, nx); b.st[0] = nloc; b.st[1] = nx; }
        const unsigned old = xb_add(&bar[XB_XSUB(b.x)], 1u);
        const unsigned gen = old / nloc;
        if (old + 1u == (gen + 1u) * nloc) {
            __builtin_amdgcn_fence(__ATOMIC_RELEASE, "agent");
            asm volatile("s_waitcnt vmcnt(0)" ::: "memory");
            const unsigned og = xb_add(&bar[XB_TOP], 1u);
            const unsigned tg = og / nx;
            if (og + 1u == (tg + 1u) * nx) xb_add(&bar[XB_TOPGEN], 1u);
            else XB_SPIN(xb_ld(&bar[XB_TOPGEN]) == tg, bar);
            __builtin_amdgcn_fence(__ATOMIC_ACQUIRE, "agent");
            xb_add(&bar[XB_XGEN(b.x)], 1u);
            asm volatile("s_waitcnt vmcnt(0)" ::: "memory");
        } else {
            XB_SPIN(xb_ld(&bar[XB_XGEN(b.x)]) == gen, bar);
            __builtin_amdgcn_fence(__ATOMIC_ACQUIRE, "agent");
            asm volatile("s_waitcnt vmcnt(0)" ::: "memory");
        }
    }
    __syncthreads();
}

struct Args {
    const float *x, *c, *ctx, *c_ctx, *w_mod, *b_mod, *g_mix, *g_ffn, *ab_w_in, *ab_w_out, *decay, *sgu_w, *sgu_b,
                *cv_w_in, *cv_cw, *cv_cb, *cv_w_out, *w_r1, *b_r1, *w_r2, *b_r2, *w1, *w3, *w2, *g_final;
    float* out; unsigned char* ws; int ph_lo, ph_hi;
};
struct Frame { LAS unsigned char* lds; volatile LAS unsigned* MISC; int tid, lane, wave, G, blk; };

enum { PH_PRO = 0, PH_L0 = 1, PH_PER_LAYER = 10, PH_FINAL = 21, NPHASE = 22 };
enum { K_PRE = 0, K_GIN = 1, K_MID1 = 2, K_MID2 = 3, K_MID3 = 4, K_GOUT = 5, K_ROUTE = 6, K_GATHER = 7, K_MOE1 = 8, K_MOE2 = 9 };

__device__ __forceinline__ int pos32(int x) { return 16 * ((x >> 2) & 1) + 4 * (x >> 3) + (x & 3); }
__device__ __forceinline__ void transpose_item(const float* W, int K, int N, bf16* WT, int kb, int nb, int dgrp, LAS float* scr, int lane) {
    const int k0 = 64 * kb, n0 = 32 * nb;
    const float* src = W + (size_t)(k0 + (lane >> 3)) * N + n0 + 4 * (lane & 7);
    f32x4 v[8];
#pragma unroll
    for (int i = 0; i < 8; ++i) v[i] = *(const f32x4*)(src + (size_t)(8 * i) * N);
#pragma unroll
    for (int i = 0; i < 8; ++i) { LAS float* d = scr + ((lane >> 3) + 8 * i) * 33 + 4 * (lane & 7); d[0] = v[i][0]; d[1] = v[i][1]; d[2] = v[i][2]; d[3] = v[i][3]; }
    asm volatile("s_waitcnt lgkmcnt(0)" ::: "memory");
    const int c = lane & 7;
#pragma unroll
    for (int j = 0; j < 4; ++j) { const int n = (lane >> 3) + 8 * j; const LAS float* s = scr + (8 * c) * 33 + n;
        u32x4 o; o.x = cvt_pk_bf16(s[0 * 33], s[1 * 33]); o.y = cvt_pk_bf16(s[2 * 33], s[3 * 33]); o.z = cvt_pk_bf16(s[4 * 33], s[5 * 33]); o.w = cvt_pk_bf16(s[6 * 33], s[7 * 33]);
        *(u32x4*)(WT + (size_t)(dgrp * 32 + pos32(n)) * K + k0 + 8 * c) = o; }
    asm volatile("s_waitcnt lgkmcnt(0)" ::: "memory");
}
__device__ __forceinline__ void phase_prologue(const Args& a, Frame& F) {
    unsigned char* ws = a.ws;
    {
        LAS float* S = (LAS float*)(F.lds + 69632);
        LAS float* red = (LAS float*)(F.lds + 110592);
        for (int i = F.tid; i < 5 * D; i += 512) { const int r = i / D, k = i % D; const float v = r < 4 ? a.c[r * D + k] : a.c_ctx[k]; S[i] = silu_f(v); }
        __syncthreads();
        if (F.blk < 256) {
            const int Lm = F.blk >> 7, strip = F.blk & 127;
            const int rsub = F.lane / 24, c4 = F.lane % 24;
            float acc[5][4];
#pragma unroll
            for (int r = 0; r < 5; ++r) { acc[r][0] = 0.f; acc[r][1] = 0.f; acc[r][2] = 0.f; acc[r][3] = 0.f; }
            if (rsub < 2) {
                const float* wp = a.w_mod + (size_t)Lm * D * MODW + (size_t)(256 * F.wave + rsub) * MODW + 96 * strip + 4 * c4;
#pragma unroll 8
                for (int it = 0; it < 128; ++it) {
                    const f32x4 w = *(const f32x4*)(wp + (size_t)(2 * it) * MODW);
                    const int k = 256 * F.wave + 2 * it + rsub;
#pragma unroll
                    for (int r = 0; r < 5; ++r) { const float s = S[r * D + k]; acc[r][0] += s * w[0]; acc[r][1] += s * w[1]; acc[r][2] += s * w[2]; acc[r][3] += s * w[3]; }
                }
#pragma unroll
                for (int r = 0; r < 5; ++r)
#pragma unroll
                    for (int j = 0; j < 4; ++j) red[(F.wave * 2 + rsub) * 480 + r * 96 + 4 * c4 + j] = acc[r][j];
            }
            __syncthreads();
            if (F.tid < 480) { float s = 0.f;
#pragma unroll
                for (int p = 0; p < 16; ++p) s += red[p * 480 + F.tid];
                const int r = F.tid / 96, cc = F.tid % 96; const int col = 96 * strip + cc;
                ((float*)(ws + WS_MOD))[(size_t)(Lm * 5 + r) * MODW + col] = s + a.b_mod[Lm * MODW + col]; }
        }
        __syncthreads();
    }
    {
        const int gt = F.blk * 512 + F.tid, NT = F.G * 512;
        float* cs = (float*)(ws + WS_ROPE);
        for (int i = gt; i < 2048; i += NT) { const int pos = i >> 5, f = i & 31; const float inv = powf(10000.0f, -(float)f / 32.0f); const float ang = (float)pos * inv; cs[i] = cosf(ang); cs[2048 + i] = sinf(ang); }
        float* wr = (float*)(ws + WS_WR);
        for (int i = gt; i < 2 * 20 * D; i += NT) { const int L = i / (20 * D), r = (i / D) % 20, k = i % D;
            float v; if (r < 4) v = a.w_r1[((size_t)L * D + k) * 4 + r]; else { const int g = (r - 4) >> 2, e = (r - 4) & 3; v = a.w_r2[(((size_t)L * 4 + g) * D + k) * 4 + e]; }
            wr[i] = v; }
    }
    {
        LAS float* scr = (LAS float*)(F.lds + F.wave * 8448);
        const int gw = F.blk * 8 + F.wave, NGW = F.G * 8;
        constexpr int I_IN = 32 * 192, I_OUT = 32 * 64, I_FIX = 2 * I_IN + 2 * I_OUT, I_EXP = 3072, NITEMS = I_FIX + 32 * I_EXP;
        for (int it = gw; it < NITEMS; it += NGW) {
            if (it < I_IN) {
                const int kb = it / 192, nb = it % 192; const int n = nb * 32, sec = n >> 10; int dg;
                if (sec < 2) { const int h = (n & 1023) >> 7, dgi = (n & 127) >> 5; dg = (sec * 4 + (h >> 1)) * 8 + (dgi >> 1) * 4 + (h & 1) * 2 + (dgi & 1); } else dg = nb;
                transpose_item(a.ab_w_in, D, 6144, (bf16*)(ws + WS_WAB_IN), kb, nb, dg, scr, F.lane);
            } else if (it < I_IN + I_OUT) { const int r = it - I_IN; transpose_item(a.ab_w_out, D, D, (bf16*)(ws + WS_WAB_OUT), r / 64, r % 64, r % 64, scr, F.lane);
            } else if (it < 2 * I_IN + I_OUT) {
                const int r = it - I_IN - I_OUT; const int kb = r / 192, nb = r % 192; const int n = nb * 32; int dg;
                if (n < 2048) dg = nb; else if (n < 4096) { const int cc = n - 2048; dg = (8 + (cc >> 7)) * 8 + ((cc & 127) >> 5); } else { const int cc = n - 4096; dg = (8 + (cc >> 7)) * 8 + 4 + ((cc & 127) >> 5); }
                transpose_item(a.cv_w_in, D, 6144, (bf16*)(ws + WS_WCV_IN), kb, nb, dg, scr, F.lane);
            } else if (it < I_FIX) { const int r = it - 2 * I_IN - I_OUT; transpose_item(a.cv_w_out, D, D, (bf16*)(ws + WS_WCV_OUT), r / 64, r % 64, r % 64, scr, F.lane);
            } else {
                const int idx = it - I_FIX; const int le = idx / I_EXP, r = idx % I_EXP, which = r >> 10, item = r & 1023;
                if (which < 2) {
                    const int kb = item >> 5, nb = item & 31; const int cc = nb * 32; const int dg = (cc >> 7) * 8 + which * 4 + ((cc & 127) >> 5);
                    transpose_item((which ? a.w3 : a.w1) + (size_t)le * D * DE, D, DE, (bf16*)(ws + WS_W13) + (size_t)le * D * D, kb, nb, dg, scr, F.lane);
                } else {
                    const int kb = item >> 6, nb = item & 63;
                    transpose_item(a.w2 + (size_t)le * DE * D, DE, D, (bf16*)(ws + WS_W2) + (size_t)le * D * DE, kb, nb, nb, scr, F.lane);
                }
            }
        }
    }
}

__device__ __forceinline__ void combine_row(f32x4 (&v)[8], const bf16* Y, const int* rdst, const float* rwt, const float* gate, int row, int lane) {
    const i32x2 d = *(const i32x2*)(rdst + 2 * (size_t)row); const f32x2 w = *(const f32x2*)(rwt + 2 * (size_t)row);
    const bf16* y0 = Y + (size_t)d.x * D + 4 * lane; const bf16* y1 = Y + (size_t)d.y * D + 4 * lane;
#pragma unroll
    for (int j = 0; j < 8; ++j) { const u32x2 p0 = *(const u32x2*)(y0 + 256 * j), p1 = *(const u32x2*)(y1 + 256 * j); const f32x4 g = *(const f32x4*)(gate + 4 * lane + 256 * j);
        v[j][0] += g[0] * (w.x * bf2f(p0.x & 0xffffu) + w.y * bf2f(p1.x & 0xffffu)); v[j][1] += g[1] * (w.x * bf2f(p0.x >> 16) + w.y * bf2f(p1.x >> 16));
        v[j][2] += g[2] * (w.x * bf2f(p0.y & 0xffffu) + w.y * bf2f(p1.y & 0xffffu)); v[j][3] += g[3] * (w.x * bf2f(p0.y >> 16) + w.y * bf2f(p1.y >> 16)); }
}
__device__ __forceinline__ float row_rstd(const f32x4 (&v)[8]) {
    float ss = 0.f;
#pragma unroll
    for (int j = 0; j < 8; ++j) ss += (v[j][0] * v[j][0] + v[j][1] * v[j][1]) + (v[j][2] * v[j][2] + v[j][3] * v[j][3]);
    return rsqrtf(wave_sum(ss) * (1.0f / D) + EPSN);
}
__device__ __forceinline__ void phase_pre(const Args& a, Frame& F, int L) {
    unsigned char* ws = a.ws; float* XB = (float*)(ws + WS_XB); bf16* A = (bf16*)(ws + WS_A);
    const float* MOD = (const float*)(ws + WS_MOD);
    const int nrows = (L == 0) ? NTOK : NLAT;
    const int gw = F.blk * 8 + F.wave, NGW = F.G * 8;
    for (int row = gw; row < nrows; row += NGW) {
        const int r = row < NLAT ? row >> 12 : 4;
        f32x4 v[8];
        if (L == 0) { const float* src = row < NLAT ? a.x + (size_t)row * D : a.ctx + (size_t)(row - NLAT) * D;
#pragma unroll
            for (int j = 0; j < 8; ++j) v[j] = *(const f32x4*)(src + 4 * F.lane + 256 * j);
        } else {
#pragma unroll
            for (int j = 0; j < 8; ++j) v[j] = *(const f32x4*)(XB + (size_t)row * D + 4 * F.lane + 256 * j);
            combine_row(v, (const bf16*)(ws + WS_R2), (const int*)(ws + WS_RDST) + (size_t)(L - 1) * NTOK * 2, (const float*)(ws + WS_RWT) + (size_t)(L - 1) * NTOK * 2,
                        MOD + (size_t)((L - 1) * 5 + r) * MODW + 5 * D, row, F.lane);
        }
#pragma unroll
        for (int j = 0; j < 8; ++j) *(f32x4*)(XB + (size_t)row * D + 4 * F.lane + 256 * j) = v[j];
        const float rstd = row_rstd(v);
        const float* mp = MOD + (size_t)(L * 5 + r) * MODW; const float* gm = a.g_mix + L * D;
#pragma unroll
        for (int j = 0; j < 8; ++j) { const int c = 4 * F.lane + 256 * j; const f32x4 g = *(const f32x4*)(gm + c), sh = *(const f32x4*)(mp + c), sc = *(const f32x4*)(mp + D + c);
            const f32x4 o = v[j] * rstd * g * (sc + 1.0f) + sh; u32x2 p; p.x = cvt_pk_bf16(o[0], o[1]); p.y = cvt_pk_bf16(o[2], o[3]); *(u32x2*)(A + (size_t)row * D + c) = p; }
    }
}

constexpr int LDP = 136;
constexpr int IMG = 128 * LDP * 2;
__device__ __forceinline__ int unit_row0(int b, int s) { return s < 2 ? NLAT + b * TCX + s * 128 : b * TL + (s - 2) * 128; }
__device__ __forceinline__ void piece_rc(int q, int& j, int& ch) { const int jr = q & 15, cq = (q >> 4) & 3, blk = q >> 6; j = 16 * (blk & 7) + jr; ch = 4 * (blk >> 3) + cq; }

__device__ __forceinline__ void ret_u_unit(const Args& a, Frame& F, int u) {
    unsigned char* ws = a.ws; const bf16* Z = (const bf16*)(ws + WS_R1);
    const int bh = u / NSLOT, s = u % NSLOT, b = bh >> 3, h = bh & 7; const int row0 = unit_row0(b, s);
    const bf16* Kp = Z + 1 * ZSEC + (size_t)row0 * RW + h * HD; const bf16* Vp = Z + 2 * ZSEC + (size_t)row0 * RW + h * HD;
    const float lgf2 = logsig(a.decay[h]) * LOG2E, lgb2 = logsig(a.decay[NH + h]) * LOG2E;
    LAS bf16* KTf = (LAS bf16*)(F.lds); LAS bf16* KTb = (LAS bf16*)(F.lds + IMG); LAS bf16* VT = (LAS bf16*)(F.lds + 2 * IMG);
#pragma unroll
    for (int k = 0; k < 4; ++k) { int j, ch; piece_rc(F.tid + 512 * k, j, ch);
        const u32x4 kv = *(const u32x4*)(Kp + (size_t)j * RW + 8 * ch), vv = *(const u32x4*)(Vp + (size_t)j * RW + 8 * ch);
        const float ff = exp2f((float)(127 - j) * lgf2), fb = exp2f((float)j * lgb2);
#pragma unroll
        for (int i = 0; i < 8; ++i) { const unsigned kw = (i & 1) ? (kv[i >> 1] >> 16) : (kv[i >> 1] & 0xffffu), vw = (i & 1) ? (vv[i >> 1] >> 16) : (vv[i >> 1] & 0xffffu);
            const float kf = bf2f(kw); const unsigned pf = cvt_pk_bf16(kf * ff, kf * fb);
            KTf[(8 * ch + i) * LDP + j] = (bf16)(pf & 0xffffu); KTb[(8 * ch + i) * LDP + j] = (bf16)(pf >> 16); VT[(8 * ch + i) * LDP + j] = (bf16)vw; } }
    __syncthreads();
    const int fr = F.lane & 15, g = F.lane >> 4, dt = F.wave;
    f32x4 accf[8], accb[8];
#pragma unroll
    for (int e = 0; e < 8; ++e) { accf[e] = (f32x4){0.f, 0.f, 0.f, 0.f}; accb[e] = (f32x4){0.f, 0.f, 0.f, 0.f}; }
#pragma unroll
    for (int sI = 0; sI < 4; ++sI) {
        const bf16x8 af = *(const LAS bf16x8*)(KTf + (16 * dt + fr) * LDP + 32 * sI + 8 * g), ab = *(const LAS bf16x8*)(KTb + (16 * dt + fr) * LDP + 32 * sI + 8 * g);
#pragma unroll
        for (int et = 0; et < 8; ++et) { const bf16x8 bv = *(const LAS bf16x8*)(VT + (16 * et + fr) * LDP + 32 * sI + 8 * g);
            accf[et] = __builtin_amdgcn_mfma_f32_16x16x32_bf16(af, bv, accf[et], 0, 0, 0); accb[et] = __builtin_amdgcn_mfma_f32_16x16x32_bf16(ab, bv, accb[et], 0, 0, 0); }
    }
    float* ST = (float*)(ws + WS_R2) + (size_t)u * 2 * 16384;
#pragma unroll
    for (int et = 0; et < 8; ++et) { *(f32x4*)(ST + (size_t)(16 * et + fr) * 128 + 16 * dt + 4 * g) = accf[et]; *(f32x4*)(ST + 16384 + (size_t)(16 * et + fr) * 128 + 16 * dt + 4 * g) = accb[et]; }
    __syncthreads();
}
__device__ __forceinline__ void sgu_unit(const Args& a, Frame& F, int u) {
    unsigned char* ws = a.ws; const bf16* Z = (const bf16*)(ws + WS_R1); bf16* RS = (bf16*)(ws + WS_R3);
    const int bg = u / NSLOT, s = u % NSLOT, b = bg >> 3, grp = bg & 7; const int row0 = unit_row0(b, s);
    const bf16* Up = Z + 4 * ZSEC + (size_t)row0 * RW + grp * HD; const bf16* Vp = Z + 5 * ZSEC + (size_t)row0 * RW + grp * HD;
    LAS bf16* WS_ = (LAS bf16*)(F.lds); LAS bf16* VT = (LAS bf16*)(F.lds + IMG);
    const float* wsrc = a.sgu_w + (size_t)grp * 16384;
#pragma unroll
    for (int k = 0; k < 8; ++k) { const int i4 = F.tid + 512 * k; const int p = i4 >> 5, q4 = (i4 & 31) * 4; const f32x4 w = *(const f32x4*)(wsrc + p * 128 + q4);
        u32x2 o; o.x = cvt_pk_bf16(w[0], w[1]); o.y = cvt_pk_bf16(w[2], w[3]); *(LAS u32x2*)(WS_ + p * LDP + q4) = o; }
    { const int q = F.tid >> 2, part = F.tid & 3; float x[32];
#pragma unroll
        for (int k = 0; k < 4; ++k) { const u32x4 vv = *(const u32x4*)(Vp + (size_t)q * RW + 32 * part + 8 * k);
#pragma unroll
            for (int i = 0; i < 4; ++i) { x[8 * k + 2 * i] = bf2f(vv[i] & 0xffffu); x[8 * k + 2 * i + 1] = bf2f(vv[i] >> 16); } }
        float sm = 0.f;
#pragma unroll
        for (int i = 0; i < 32; ++i) sm += x[i];
        sm += __shfl_xor(sm, 1); sm += __shfl_xor(sm, 2); const float mu = sm * (1.0f / 128.0f);
        float sq = 0.f;
#pragma unroll
        for (int i = 0; i < 32; ++i) { const float dlt = x[i] - mu; sq += dlt * dlt; }
        sq += __shfl_xor(sq, 1); sq += __shfl_xor(sq, 2); const float rstd = rsqrtf(sq * (1.0f / 128.0f) + EPSN);
#pragma unroll
        for (int i = 0; i < 32; i += 2) { const unsigned p2 = cvt_pk_bf16((x[i] - mu) * rstd, (x[i + 1] - mu) * rstd);
            VT[(32 * part + i) * LDP + q] = (bf16)(p2 & 0xffffu); VT[(32 * part + i + 1) * LDP + q] = (bf16)(p2 >> 16); } }
    __syncthreads();
    const int fr = F.lane & 15, g = F.lane >> 4, pt = F.wave;
    f32x4 acc[8];
#pragma unroll
    for (int c = 0; c < 8; ++c) acc[c] = (f32x4){0.f, 0.f, 0.f, 0.f};
#pragma unroll
    for (int sI = 0; sI < 4; ++sI) { const bf16x8 bw = *(const LAS bf16x8*)(WS_ + (16 * pt + fr) * LDP + 32 * sI + 8 * g);
#pragma unroll
        for (int ct = 0; ct < 8; ++ct) { const bf16x8 av = *(const LAS bf16x8*)(VT + (16 * ct + fr) * LDP + 32 * sI + 8 * g);
            acc[ct] = __builtin_amdgcn_mfma_f32_16x16x32_bf16(av, bw, acc[ct], 0, 0, 0); } }
    const int p = 16 * pt + fr; const float bs = a.sgu_b[grp * 128 + p];
#pragma unroll
    for (int ct = 0; ct < 8; ++ct) { const int c = 16 * ct + 4 * g; const u32x2 uu = *(const u32x2*)(Up + (size_t)p * RW + c);
        const float o0 = bf2f(uu.x & 0xffffu) * (acc[ct][0] + bs), o1 = bf2f(uu.x >> 16) * (acc[ct][1] + bs), o2 = bf2f(uu.y & 0xffffu) * (acc[ct][2] + bs), o3 = bf2f(uu.y >> 16) * (acc[ct][3] + bs);
        u32x2 o; o.x = cvt_pk_bf16(o0, o1); o.y = cvt_pk_bf16(o2, o3); *(u32x2*)(RS + (size_t)(row0 + p) * D + RW + grp * HD + c) = o; }
    __syncthreads();
}
__device__ __forceinline__ void phase_scan(const Args& a, Frame& F) {
    float* ST = (float*)(a.ws + WS_R2);
    const int NT = F.G * 512;
    for (int it = F.blk * 512 + F.tid; it < 32 * 2 * 4096; it += NT) {
        const int bh = it >> 13, dir = (it >> 12) & 1, e4 = it & 4095, h = bh & 7;
        const float cd = expf(128.0f * logsig(a.decay[dir * NH + h]));
        float* base = ST + ((size_t)bh * NSLOT * 2 + dir) * 16384 + (size_t)e4 * 4;
        f32x4 st = (f32x4){0.f, 0.f, 0.f, 0.f};
#pragma unroll 2
        for (int n = 0; n < NSLOT; ++n) { const int s = dir == 0 ? n : (n < 2 ? 1 - n : 35 - n);
            float* p = base + (size_t)s * 2 * 16384; const f32x4 tmp = *(const f32x4*)p; *(f32x4*)p = st; st = st * cd + tmp; }
    }
}
__device__ __forceinline__ void ret_y_unit(const Args& a, Frame& F, int u) {
    unsigned char* ws = a.ws; const bf16* Z = (const bf16*)(ws + WS_R1); bf16* RS = (bf16*)(ws + WS_R3);
    const int bh = u / NSLOT, s = u % NSLOT, b = bh >> 3, h = bh & 7; const int row0 = unit_row0(b, s);
    const bf16* Qp = Z + (size_t)row0 * RW + h * HD; const bf16* Kp = Z + 1 * ZSEC + (size_t)row0 * RW + h * HD; const bf16* Vp = Z + 2 * ZSEC + (size_t)row0 * RW + h * HD;
    const bf16* Gp = Z + 3 * ZSEC + (size_t)row0 * RW + h * HD;
    const float lgf2 = logsig(a.decay[h]) * LOG2E, lgb2 = logsig(a.decay[NH + h]) * LOG2E;
    LAS bf16* KN = (LAS bf16*)(F.lds); LAS bf16* VT = (LAS bf16*)(F.lds + IMG); LAS bf16* SF = (LAS bf16*)(F.lds + 2 * IMG); LAS bf16* SB = (LAS bf16*)(F.lds + 3 * IMG);
#pragma unroll
    for (int k = 0; k < 4; ++k) { int j, ch; piece_rc(F.tid + 512 * k, j, ch);
        const u32x4 kv = *(const u32x4*)(Kp + (size_t)j * RW + 8 * ch), vv = *(const u32x4*)(Vp + (size_t)j * RW + 8 * ch);
        *(LAS u32x4*)(KN + j * LDP + 8 * ch) = kv;
#pragma unroll
        for (int i = 0; i < 8; ++i) { const unsigned vw = (i & 1) ? (vv[i >> 1] >> 16) : (vv[i >> 1] & 0xffffu); VT[(8 * ch + i) * LDP + j] = (bf16)vw; } }
    { const float* ST = (const float*)(ws + WS_R2) + (size_t)u * 2 * 16384;
#pragma unroll
        for (int k = 0; k < 8; ++k) { const int i4 = F.tid + 512 * k; const int e = i4 >> 5, d4 = (i4 & 31) * 4; const f32x4 sf = *(const f32x4*)(ST + e * 128 + d4), sb = *(const f32x4*)(ST + 16384 + e * 128 + d4);
            u32x2 o; o.x = cvt_pk_bf16(sf[0], sf[1]); o.y = cvt_pk_bf16(sf[2], sf[3]); *(LAS u32x2*)(SF + e * LDP + d4) = o;
            o.x = cvt_pk_bf16(sb[0], sb[1]); o.y = cvt_pk_bf16(sb[2], sb[3]); *(LAS u32x2*)(SB + e * LDP + d4) = o; } }
    const int fr = F.lane & 15, g = F.lane >> 4, it_ = F.wave; const int i_abs = 16 * it_ + fr;
    bf16x8 qf[4];
#pragma unroll
    for (int sI = 0; sI < 4; ++sI) qf[sI] = *(const bf16x8*)(Qp + (size_t)i_abs * RW + 32 * sI + 8 * g);
    __syncthreads();
    bf16x8 pf[4];
#pragma unroll
    for (int ks = 0; ks < 4; ++ks) { f32x4 s0 = (f32x4){0.f, 0.f, 0.f, 0.f}, s1 = s0;
#pragma unroll
        for (int sI = 0; sI < 4; ++sI) { const bf16x8 k0 = *(const LAS bf16x8*)(KN + (32 * ks + fr) * LDP + 32 * sI + 8 * g), k1 = *(const LAS bf16x8*)(KN + (32 * ks + 16 + fr) * LDP + 32 * sI + 8 * g);
            s0 = __builtin_amdgcn_mfma_f32_16x16x32_bf16(k0, qf[sI], s0, 0, 0, 0); s1 = __builtin_amdgcn_mfma_f32_16x16x32_bf16(k1, qf[sI], s1, 0, 0, 0); }
        unsigned w[4];
#pragma unroll
        for (int r = 0; r < 4; r += 2) {
            const int j0 = 32 * ks + 4 * g + r, j1 = j0 + 1, j2 = j0 + 16, j3 = j2 + 1;
            const float d0 = (float)(i_abs - j0), d1 = (float)(i_abs - j1), d2 = (float)(i_abs - j2), d3 = (float)(i_abs - j3);
            const float m0 = d0 >= 0.f ? exp2f(d0 * lgf2) : exp2f(-d0 * lgb2), m1 = d1 >= 0.f ? exp2f(d1 * lgf2) : exp2f(-d1 * lgb2);
            const float m2 = d2 >= 0.f ? exp2f(d2 * lgf2) : exp2f(-d2 * lgb2), m3 = d3 >= 0.f ? exp2f(d3 * lgf2) : exp2f(-d3 * lgb2);
            w[r >> 1] = cvt_pk_bf16(s0[r] * m0, s0[r + 1] * m1); w[2 + (r >> 1)] = cvt_pk_bf16(s1[r] * m2, s1[r + 1] * m3);
        }
        u32x4 ww; ww.x = w[0]; ww.y = w[1]; ww.z = w[2]; ww.w = w[3]; pf[ks] = __builtin_bit_cast(bf16x8, ww);
    }
    const float qdf = exp2f((float)(i_abs + 1) * lgf2), qdb = exp2f((float)(128 - i_abs) * lgb2);
    f32x4 y[8];
#pragma unroll
    for (int et = 0; et < 8; ++et) {
        f32x4 ai = (f32x4){0.f, 0.f, 0.f, 0.f}, cf = ai, cb = ai;
#pragma unroll
        for (int ks = 0; ks < 4; ++ks) { const LAS bf16* vp = VT + (16 * et + fr) * LDP + 32 * ks + 4 * g; const u32x2 lo = *(const LAS u32x2*)vp, hi = *(const LAS u32x2*)(vp + 16);
            u32x4 av; av.x = lo.x; av.y = lo.y; av.z = hi.x; av.w = hi.y;
            ai = __builtin_amdgcn_mfma_f32_16x16x32_bf16(__builtin_bit_cast(bf16x8, av), pf[ks], ai, 0, 0, 0); }
#pragma unroll
        for (int sI = 0; sI < 4; ++sI) { const bf16x8 sf = *(const LAS bf16x8*)(SF + (16 * et + fr) * LDP + 32 * sI + 8 * g), sb = *(const LAS bf16x8*)(SB + (16 * et + fr) * LDP + 32 * sI + 8 * g);
            cf = __builtin_amdgcn_mfma_f32_16x16x32_bf16(sf, qf[sI], cf, 0, 0, 0); cb = __builtin_amdgcn_mfma_f32_16x16x32_bf16(sb, qf[sI], cb, 0, 0, 0); }
        y[et] = ai + cf * qdf + cb * qdb;
    }
    float sm = 0.f;
#pragma unroll
    for (int et = 0; et < 8; ++et) sm += (y[et][0] + y[et][1]) + (y[et][2] + y[et][3]);
    sm += __shfl_xor(sm, 16); sm += __shfl_xor(sm, 32); const float mu = sm * (1.0f / 128.0f);
    float sq = 0.f;
#pragma unroll
    for (int et = 0; et < 8; ++et) { const f32x4 dl = y[et] - mu; sq += (dl[0] * dl[0] + dl[1] * dl[1]) + (dl[2] * dl[2] + dl[3] * dl[3]); }
    sq += __shfl_xor(sq, 16); sq += __shfl_xor(sq, 32); const float rstd = rsqrtf(sq * (1.0f / 128.0f) + EPSN);
#pragma unroll
    for (int et = 0; et < 8; ++et) { const int e = 16 * et + 4 * g; const u32x2 gg = *(const u32x2*)(Gp + (size_t)i_abs * RW + e);
        const f32x4 o = (y[et] - mu) * rstd; u32x2 w2; w2.x = cvt_pk_bf16(o[0] * bf2f(gg.x & 0xffffu), o[1] * bf2f(gg.x >> 16)); w2.y = cvt_pk_bf16(o[2] * bf2f(gg.y & 0xffffu), o[3] * bf2f(gg.y >> 16));
        *(u32x2*)(RS + (size_t)(row0 + i_abs) * D + h * HD + e) = w2; }
    __syncthreads();
}

__device__ __forceinline__ void phase_conv(const Args& a, Frame& F) {
    unsigned char* ws = a.ws; const bf16* GB = (const bf16*)(ws + WS_R1); const bf16* XG = GB + (size_t)NLAT * D; bf16* A1 = (bf16*)(ws + WS_R3);
    const int NT = F.G * 512;
    for (int it = F.blk * 512 + F.tid; it < NLAT * 256; it += NT) {
        const int row = it >> 8, c = (it & 255) * 8; const int gc = row & 63;
        const u32x4 x1 = *(const u32x4*)(XG + (size_t)row * D + c), gb = *(const u32x4*)(GB + (size_t)row * D + c);
        u32x4 x0 = (u32x4){0u, 0u, 0u, 0u}, x2 = x0;
        if (gc > 0) x0 = *(const u32x4*)(XG + (size_t)(row - 1) * D + c);
        if (gc < 63) x2 = *(const u32x4*)(XG + (size_t)(row + 1) * D + c);
        float o[8];
#pragma unroll
        for (int i = 0; i < 8; ++i) { const int cc = c + i; const unsigned sh = (i & 1) ? 16u : 0u;
            const float f0 = bf2f((x0[i >> 1] >> sh) & 0xffffu), f1 = bf2f((x1[i >> 1] >> sh) & 0xffffu), f2 = bf2f((x2[i >> 1] >> sh) & 0xffffu), fg = bf2f((gb[i >> 1] >> sh) & 0xffffu);
            o[i] = fg * (a.cv_cb[cc] + a.cv_cw[cc] * f0 + a.cv_cw[D + cc] * f1 + a.cv_cw[2 * D + cc] * f2); }
        u32x4 w; w.x = cvt_pk_bf16(o[0], o[1]); w.y = cvt_pk_bf16(o[2], o[3]); w.z = cvt_pk_bf16(o[4], o[5]); w.w = cvt_pk_bf16(o[6], o[7]);
        *(u32x4*)(A1 + (size_t)row * D + c) = w;
    }
}

__device__ __forceinline__ void phase_route(const Args& a, Frame& F, int L) {
    unsigned char* ws = a.ws; const float* XB = (const float*)(ws + WS_XB); bf16* Fo = (bf16*)(ws + WS_A);
    const float* MOD = (const float*)(ws + WS_MOD); const float* WR = (const float*)(ws + WS_WR) + (size_t)L * 20 * D;
    const int nrows = (L == 0) ? NTOK : NLAT; const int RPB = (nrows + F.G - 1) / F.G;
    LAS int* rinfo = (LAS int*)F.lds;
    LAS float* rw = (LAS float*)(F.lds + 8192);
    volatile LAS unsigned* lcnt = F.MISC + MI_LCNT; volatile LAS unsigned* gbase = F.MISC + MI_GBASE;
    if (F.tid < 16) lcnt[F.tid] = 0u;
    __syncthreads();
    for (int i = F.wave; i < RPB; i += 8) {
        const int row = F.blk * RPB + i; if (row >= nrows) break;
        const int r = row < NLAT ? row >> 12 : 4;
        int ln4 = 4 * F.lane; asm volatile("" : "+v"(ln4));
        f32x4 v[8];
#pragma unroll
        for (int j = 0; j < 8; ++j) v[j] = *(const f32x4*)(XB + (size_t)row * D + ln4 + 256 * j);
        const float rstd = row_rstd(v);
        const float* mp = MOD + (size_t)(L * 5 + r) * MODW; const float* gf = a.g_ffn + L * D;
#pragma unroll
        for (int j = 0; j < 8; ++j) { const int c = ln4 + 256 * j; const f32x4 g = *(const f32x4*)(gf + c), sh = *(const f32x4*)(mp + 3 * D + c), sc = *(const f32x4*)(mp + 4 * D + c);
            v[j] = v[j] * rstd * g * (sc + 1.0f) + sh; u32x2 p; p.x = cvt_pk_bf16(v[j][0], v[j][1]); p.y = cvt_pk_bf16(v[j][2], v[j][3]); *(u32x2*)(Fo + (size_t)row * D + c) = p; }
        float l1[4];
#pragma unroll
        for (int g = 0; g < 4; ++g) { float s = 0.f;
#pragma unroll
            for (int j = 0; j < 8; ++j) { const f32x4 w = *(const f32x4*)(WR + (size_t)g * D + ln4 + 256 * j); s += (v[j][0] * w[0] + v[j][1] * w[1]) + (v[j][2] * w[2] + v[j][3] * w[3]); }
            l1[g] = wave_sum(s) + a.b_r1[L * 4 + g]; asm volatile("" ::: "memory"); }
        int grp = 0; float mx = l1[0];
#pragma unroll
        for (int g = 1; g < 4; ++g) if (l1[g] > mx) { mx = l1[g]; grp = g; }
        float den = 0.f;
#pragma unroll
        for (int g = 0; g < 4; ++g) den += expf(l1[g] - mx);
        const float pg = 1.0f / den;
        float l2[4];
#pragma unroll
        for (int e = 0; e < 4; ++e) { float s = 0.f; const float* wp = WR + (size_t)(4 + 4 * grp + e) * D;
#pragma unroll
            for (int j = 0; j < 8; ++j) { const f32x4 w = *(const f32x4*)(wp + ln4 + 256 * j); s += (v[j][0] * w[0] + v[j][1] * w[1]) + (v[j][2] * w[2] + v[j][3] * w[3]); }
            l2[e] = wave_sum(s) + a.b_r2[(L * 4 + grp) * 4 + e]; asm volatile("" ::: "memory"); }
        int i0 = 0; float v0 = l2[0];
#pragma unroll
        for (int e = 1; e < 4; ++e) if (l2[e] > v0) { v0 = l2[e]; i0 = e; }
        int i1 = -1; float v1 = -3.0e38f;
#pragma unroll
        for (int e = 0; e < 4; ++e) if (e != i0 && l2[e] > v1) { v1 = l2[e]; i1 = e; }
        const float ex = expf(v1 - v0); const float w0 = pg / (1.0f + ex), w1 = pg * ex / (1.0f + ex);
        if (F.lane == 0) { const int e0 = grp * 4 + i0, e1 = grp * 4 + i1;
            const int li0 = (int)__hip_atomic_fetch_add((LAS unsigned*)&lcnt[e0], 1u, __ATOMIC_RELAXED, __HIP_MEMORY_SCOPE_WORKGROUP);
            const int li1 = (int)__hip_atomic_fetch_add((LAS unsigned*)&lcnt[e1], 1u, __ATOMIC_RELAXED, __HIP_MEMORY_SCOPE_WORKGROUP);
            rinfo[4 * i] = e0; rinfo[4 * i + 1] = li0; rinfo[4 * i + 2] = e1; rinfo[4 * i + 3] = li1; rw[2 * i] = w0; rw[2 * i + 1] = w1; }
    }
    __syncthreads();
    if (F.tid < 16) gbase[F.tid] = xb_add((unsigned*)(ws + WS_CTL) + CW_CNT + L * 64 + F.tid, lcnt[F.tid]);
    __syncthreads();
    int* RIDX = (int*)(ws + WS_RIDX) + (size_t)L * NTOK * 4; float* RWT = (float*)(ws + WS_RWT) + (size_t)L * NTOK * 2;
    for (int i = F.tid; i < RPB; i += 512) { const int row = F.blk * RPB + i; if (row < nrows) {
        const int e0 = rinfo[4 * i], e1 = rinfo[4 * i + 2];
        i32x4 o; o.x = e0; o.y = (int)gbase[e0] + rinfo[4 * i + 1]; o.z = e1; o.w = (int)gbase[e1] + rinfo[4 * i + 3]; *(i32x4*)(RIDX + 4 * (size_t)row) = o;
        f32x2 w; w.x = rw[2 * i]; w.y = rw[2 * i + 1]; *(f32x2*)(RWT + 2 * (size_t)row) = w; } }
    __syncthreads();
}
__device__ __forceinline__ int moe_tables(const Args& a, Frame& F, int L) {
    volatile LAS int* tb = (volatile LAS int*)(F.MISC + MI_TB); volatile LAS int* texp = (volatile LAS int*)(F.MISC + MI_TEXP);
    __syncthreads();
    if (F.tid == 0) { unsigned* cnt = (unsigned*)(a.ws + WS_CTL) + CW_CNT + L * 64; int acc = 0;
        for (int e = 0; e < NE; ++e) { tb[e] = acc; const int n = ((int)xb_ld(cnt + e) + 255) >> 8; for (int t = 0; t < n && acc + t < 160; ++t) texp[acc + t] = e; acc += n; }
        tb[NE] = acc; }
    __syncthreads();
    return tb[NE];
}
__device__ __forceinline__ void phase_gather(const Args& a, Frame& F, int L) {
    unsigned char* ws = a.ws; const bf16* Fi = (const bf16*)(ws + WS_A); bf16* FG = (bf16*)(ws + WS_R1);
    (void)moe_tables(a, F, L);
    volatile LAS int* tb = (volatile LAS int*)(F.MISC + MI_TB);
    const int nrows = (L == 0) ? NTOK : NLAT;
    const int* RIDX = (const int*)(ws + WS_RIDX) + (size_t)L * NTOK * 4; int* RDST = (int*)(ws + WS_RDST) + (size_t)L * NTOK * 2;
    const int gw = F.blk * 8 + F.wave, NGW = F.G * 8;
    for (int row = gw; row < nrows; row += NGW) {
        const i32x4 ri = *(const i32x4*)(RIDX + 4 * (size_t)row);
        const int d0 = tb[ri.x] * 256 + ri.y, d1 = tb[ri.z] * 256 + ri.w;
        if (F.lane == 0) { i32x2 o; o.x = d0; o.y = d1; *(i32x2*)(RDST + 2 * (size_t)row) = o; }
        const u32x4* src = (const u32x4*)(Fi + (size_t)row * D); u32x4* p0 = (u32x4*)(FG + (size_t)d0 * D); u32x4* p1 = (u32x4*)(FG + (size_t)d1 * D);
#pragma unroll
        for (int j = 0; j < 4; ++j) { const u32x4 v = src[F.lane + 64 * j]; p0[F.lane + 64 * j] = v; p1[F.lane + 64 * j] = v; }
    }
}
__device__ __forceinline__ void phase_final(const Args& a, Frame& F, int Lc  ) {
    unsigned char* ws = a.ws; const float* XB = (const float*)(ws + WS_XB); const float* MOD = (const float*)(ws + WS_MOD);
    const int gw = F.blk * 8 + F.wave, NGW = F.G * 8;
    for (int row = gw; row < NLAT; row += NGW) {
        const int r = row >> 12;
        f32x4 v[8];
#pragma unroll
        for (int j = 0; j < 8; ++j) v[j] = *(const f32x4*)(XB + (size_t)row * D + 4 * F.lane + 256 * j);
        if (Lc >= 0) combine_row(v, (const bf16*)(ws + WS_R2), (const int*)(ws + WS_RDST) + (size_t)Lc * NTOK * 2, (const float*)(ws + WS_RWT) + (size_t)Lc * NTOK * 2,
                                 MOD + (size_t)(Lc * 5 + r) * MODW + 5 * D, row, F.lane);
        const float rstd = row_rstd(v);
#pragma unroll
        for (int j = 0; j < 8; ++j) { const int c = 4 * F.lane + 256 * j; const f32x4 g = *(const f32x4*)(a.g_final + c); *(f32x4*)(a.out + (size_t)row * D + c) = v[j] * rstd * g; }
    }
}

__global__ void __launch_bounds__(512, 2) fwd_kernel(Args a) {
    extern __shared__ __attribute__((aligned(16))) unsigned char lds_raw[];
    Frame F; F.lds = (LAS unsigned char*)lds_raw; F.MISC = (volatile LAS unsigned*)(F.lds + MISC_OFF);
    F.tid = threadIdx.x; F.lane = F.tid & 63; F.wave = __builtin_amdgcn_readfirstlane(F.tid >> 6); F.G = gridDim.x; F.blk = blockIdx.x;
    unsigned char* ws = a.ws;
    for (int u = F.tid; u < 512; u += 512) F.MISC[u] = 0u;
    __syncthreads();
#if MK_SPLIT
    #define GRID_BAR() do { } while (0)
#else
    XcdBarrier bar = xcd_barrier_post((unsigned*)(ws + WS_CTL) + CW_BAR, F.MISC);
    #define GRID_BAR() xcd_barrier(bar)
#endif
    const int lo = a.ph_lo, hi = a.ph_hi;
#define IN(k) (lo <= (k) && (k) < hi)
#define SEAM(k) do { if (IN((k) + 1)) GRID_BAR(); } while (0)

    if (IN(PH_PRO)) { phase_prologue(a, F); SEAM(PH_PRO); }
#define RUN_LAYER(L) do { \
        constexpr int P = PH_L0 + (L) * PH_PER_LAYER; \
        constexpr int nM = ((L) == 0) ? NTOK / 256 : NLAT / 256; \
        if (IN(P + K_PRE)) { phase_pre(a, F, (L)); SEAM(P + K_PRE); } \
        if (DBG_STOP == 1) break; \
        if (IN(P + K_GIN)) { \
            if ((L) == 0) { pg8::Gemm g{(const bf16*)(ws + WS_A), (const bf16*)(ws + WS_WAB_IN), D}; pg8::StaticOrder S; S.init(nM, 24, F.G, F.blk); \
                pg8::EpiAB E{(bf16*)(ws + WS_R1), (const float*)(ws + WS_ROPE)}; pg8::gemm_phase<pg8::EpiAB, pg8::StaticOrder, true, true>(F.lds, g, S, E); } \
            else { pg8::Gemm g{(const bf16*)(ws + WS_A), (const bf16*)(ws + WS_WCV_IN), D}; pg8::StaticOrder S; S.init(nM, 24, F.G, F.blk); \
                pg8::EpiCV E{(bf16*)(ws + WS_R1), (bf16*)(ws + WS_R1) + (size_t)NLAT * D}; pg8::gemm_phase<pg8::EpiCV, pg8::StaticOrder, true, true>(F.lds, g, S, E); } \
            SEAM(P + K_GIN); \
        } \
        if (IN(P + K_MID1)) { \
            if ((L) == 0) { for (int u = F.blk; u < NUNIT; u += F.G) ret_u_unit(a, F, u); for (int u = F.blk; u < NUNIT; u += F.G) sgu_unit(a, F, u); } \
            else phase_conv(a, F); \
            SEAM(P + K_MID1); \
        } \
        if ((L) == 0) { \
            if (IN(P + K_MID2)) { phase_scan(a, F); SEAM(P + K_MID2); } \
            if (IN(P + K_MID3)) { for (int u = F.blk; u < NUNIT; u += F.G) ret_y_unit(a, F, u); SEAM(P + K_MID3); } \
        } \
        if (IN(P + K_GOUT)) { \
            pg8::Gemm g{(const bf16*)(ws + WS_R3), (const bf16*)(ws + ((L) == 0 ? WS_WAB_OUT : WS_WCV_OUT)), D}; pg8::StaticOrder S; S.init(nM, 8, F.G, F.blk); \
            pg8::EpiRes E{(float*)(ws + WS_XB), (const float*)(ws + WS_MOD) + (size_t)(L) * 5 * MODW + 2 * D}; \
            pg8::gemm_phase<pg8::EpiRes, pg8::StaticOrder, true, true>(F.lds, g, S, E); \
            SEAM(P + K_GOUT); \
        } \
        if (DBG_STOP == 2 || (DBG_STOP == 4 && (L) == 1)) break; \
        if (IN(P + K_ROUTE)) { phase_route(a, F, (L)); SEAM(P + K_ROUTE); } \
        if (IN(P + K_GATHER)) { phase_gather(a, F, (L)); SEAM(P + K_GATHER); } \
        if (IN(P + K_MOE1)) { \
            const int TT = moe_tables(a, F, (L)); \
            pg8::Gemm g{(const bf16*)(ws + WS_R1), (const bf16*)(ws + WS_W13) + (size_t)(L) * NE * D * D, D}; \
            pg8::MoeOrder S; S.init(TT, 8, F.G, F.blk); S.texp = (const volatile LAS int*)(F.MISC + MI_TEXP); S.bstride = (long)D * D * 2; \
            pg8::EpiMoe1 E{(bf16*)(ws + WS_R3)}; pg8::gemm_phase<pg8::EpiMoe1, pg8::MoeOrder, true, true>(F.lds, g, S, E); \
            SEAM(P + K_MOE1); \
        } \
        if (IN(P + K_MOE2)) { \
            const int TT = moe_tables(a, F, (L)); \
            pg8::Gemm g{(const bf16*)(ws + WS_R3), (const bf16*)(ws + WS_W2) + (size_t)(L) * NE * D * DE, DE}; \
            pg8::MoeOrder S; S.init(TT, 8, F.G, F.blk); S.texp = (const volatile LAS int*)(F.MISC + MI_TEXP); S.bstride = (long)D * DE * 2; \
            pg8::EpiMoe2 E{(bf16*)(ws + WS_R2)}; pg8::gemm_phase<pg8::EpiMoe2, pg8::MoeOrder, true, true>(F.lds, g, S, E); \
            SEAM(P + K_MOE2); \
        } \
    } while (0)
    RUN_LAYER(0);
    if (DBG_STOP == 0 || DBG_STOP == 4) RUN_LAYER(1);
    if (IN(PH_FINAL)) phase_final(a, F, DBG_STOP == 0 ? 1 : (DBG_STOP == 3 ? 0 : -1));
#undef IN
#undef SEAM
}

extern "C" void kernel_launch(void* const* d_in, const int* in_sizes, int n_in, void* d_out, int out_size, void* d_ws, size_t ws_size, hipStream_t stream) {
    static int grid = 0;
    if (grid == 0) {
        if (n_in != 25 || in_sizes[0] != NLAT * D || out_size != NLAT * D || ws_size < WS_END) { fprintf(stderr, "kernel_launch: unexpected shapes (n_in %d, in0 %d, out %d, ws %zu)\n", n_in, n_in > 0 ? in_sizes[0] : -1, out_size, ws_size); grid = -1; return; }
        int dev = 0, cus = 0, per_cu = 0;
        if (hipGetDevice(&dev) != hipSuccess || hipDeviceGetAttribute(&cus, hipDeviceAttributeMultiprocessorCount, dev) != hipSuccess) { grid = -1; return; }
        if (hipFuncSetAttribute((const void*)fwd_kernel, hipFuncAttributeMaxDynamicSharedMemorySize, LDS_BYTES) != hipSuccess) { fprintf(stderr, "kernel_launch: hipFuncSetAttribute failed\n"); grid = -1; return; }
        if (hipOccupancyMaxActiveBlocksPerMultiprocessor(&per_cu, (const void*)fwd_kernel, 512, LDS_BYTES) != hipSuccess || per_cu < 1) fprintf(stderr, "kernel_launch: occupancy query reports %d\n", per_cu);
        (void)hipGetLastError();
        grid = cus;
    }
    if (grid < 0) return;
    (void)hipMemsetAsync((char*)d_ws + WS_CTL, 0, CTL_BYTES, stream);
    Args a{};
    const float** f = (const float**)&a;
    for (int i = 0; i < 25; ++i) f[i] = (const float*)d_in[i];
    a.out = (float*)d_out; a.ws = (unsigned char*)d_ws;
#if MK_SPLIT
    for (int ph = 0; ph < NPHASE; ++ph) { a.ph_lo = ph; a.ph_hi = ph + 1; hipLaunchKernelGGL(fwd_kernel, dim3(grid), dim3(512), LDS_BYTES, stream, a); }
#else
    a.ph_lo = 0; a.ph_hi = NPHASE; hipLaunchKernelGGL(fwd_kernel, dim3(grid), dim3(512), LDS_BYTES, stream, a);
#endif
}
```

```cpp
#include <hip/hip_runtime.h>
#include <cstdio>
#include <cstdint>

#ifndef MK_SPLIT
#define MK_SPLIT 0
#endif
#ifndef PROBE_MASK
#define PROBE_MASK 0u
#endif
#ifndef PROBE_MULT
#define PROBE_MULT 4
#endif
#ifndef DBG_STOP
#define DBG_STOP 0
#endif

#define LAS __attribute__((address_space(3)))
#define GAS __attribute__((address_space(1)))
typedef unsigned short bf16;
typedef short bf16x8 __attribute__((ext_vector_type(8)));
typedef short s16x4 __attribute__((ext_vector_type(4)));
typedef float f32x4 __attribute__((ext_vector_type(4)));
typedef float f32x2 __attribute__((ext_vector_type(2)));
typedef unsigned u32x4 __attribute__((ext_vector_type(4)));
typedef unsigned u32x2 __attribute__((ext_vector_type(2)));
typedef int i32x4 __attribute__((ext_vector_type(4)));
typedef int i32x8 __attribute__((ext_vector_type(8)));
typedef int i32x2 __attribute__((ext_vector_type(2)));

constexpr int D = 2048, NB = 4, TL = 4096, TCX = 256;
constexpr int NLAT = NB * TL;
constexpr int NCTX = NB * TCX;
constexpr int NTOK = NLAT + NCTX;
constexpr int HD = 128, NH = 8, RW = 1024;
constexpr int NSLOT = 34;
constexpr int NUNIT = NB * NH * NSLOT;
constexpr int DE = 1024, NE = 16;
constexpr int PCAP = 2 * NTOK + NE * 256;
constexpr float EPSN = 1e-6f;
constexpr float QK_SCALE = 0.08838834764831845f;
constexpr int MODW = 6 * D;

constexpr size_t MiB = 1u << 20;
constexpr size_t WS_CTL = 0, CTL_BYTES = 1 * MiB;
constexpr size_t WS_MOD = 1 * MiB;
constexpr size_t WS_ROPE = 1 * MiB + 512 * 1024;
constexpr size_t WS_WR = 2 * MiB;
constexpr size_t WS_RIDX = 3 * MiB;
constexpr size_t WS_RWT = 4 * MiB;
constexpr size_t WS_RDST = 4 * MiB + 512 * 1024;
constexpr size_t WS_WAB_IN = 8 * MiB, WS_WAB_OUT = 32 * MiB, WS_WCV_IN = 40 * MiB, WS_WCV_OUT = 64 * MiB;
constexpr size_t WS_W13 = 72 * MiB;
constexpr size_t WS_W2 = 328 * MiB;
constexpr size_t WS_XB = 456 * MiB;
constexpr size_t WS_A = 592 * MiB;
constexpr size_t WS_R1 = 660 * MiB;
constexpr size_t WS_R2 = 864 * MiB;
constexpr size_t WS_R3 = 1016 * MiB;
constexpr size_t WS_END = 1092 * MiB;
constexpr size_t ZSEC = (size_t)NTOK * 1024;
constexpr int CW_BAR = 4096;
constexpr int CW_CNT = 1024;

constexpr int SCR_BYTES = 147456;
constexpr int MISC_OFF = SCR_BYTES;
constexpr int LDS_BYTES = SCR_BYTES + 2048;
constexpr int MI_LCNT = 16, MI_GBASE = 32, MI_TB = 64, MI_TEXP = 96;

__device__ __forceinline__ unsigned cvt_pk_bf16(float lo, float hi) { unsigned r; asm("v_cvt_pk_bf16_f32 %0, %1, %2" : "=v"(r) : "v"(lo), "v"(hi)); return r; }
__device__ __forceinline__ int lane_id() { int l; asm volatile("v_mbcnt_lo_u32_b32 %0, -1, 0\n\tv_mbcnt_hi_u32_b32 %0, -1, %0" : "=v"(l)); return l; }
__device__ __forceinline__ float bf2f(unsigned b) { return __uint_as_float(b << 16); }
__device__ __forceinline__ float wave_sum(float v) {
#pragma unroll
    for (int o = 1; o < 64; o <<= 1) v += __shfl_xor(v, o);
    return v;
}
__device__ __forceinline__ float silu_f(float x) { return x / (1.0f + __expf(-x)); }
__device__ __forceinline__ float gelu_tanh_f(float x) { const float z = 1.5957691216057308f * (x + 0.044715f * x * x * x); return x / (1.0f + __expf(-z)); }
__device__ __forceinline__ u32x4 pack8(f32x4 a, f32x4 b) { u32x4 w; w.x = cvt_pk_bf16(a[0], a[1]); w.y = cvt_pk_bf16(a[2], a[3]); w.z = cvt_pk_bf16(b[0], b[1]); w.w = cvt_pk_bf16(b[2], b[3]); return w; }
__device__ __forceinline__ unsigned pk4_fp8(float a, float b, float c, float d) { int w = 0; w = __builtin_amdgcn_cvt_pk_fp8_f32(a, b, w, false); w = __builtin_amdgcn_cvt_pk_fp8_f32(c, d, w, true); return (unsigned)w; }
__device__ __forceinline__ u32x2 pack8_fp8(f32x4 a, f32x4 b) { u32x2 w; w.x = pk4_fp8(a[0], a[1], a[2], a[3]); w.y = pk4_fp8(b[0], b[1], b[2], b[3]); return w; }
#define W8_SCALE 64.0f
#define SCALE_W8 0x79797979
#define SCALE_ONE 0x7f7f7f7f
__device__ __forceinline__ float logsig(float x) { return -log1pf(expf(-x)); }
#define LOG2E 1.4426950408889634f

namespace pg8 {
constexpr int BM = 256, BK = 64, HALF = 128, HTB = HALF * BK * 2, STAGE_BYTES = 8 * HTB, NXCD = 8, WGM = 8;
__host__ __device__ __forceinline__ int lds_byte(int r, int c) { const int st = (r >> 4) * 2 + (c >> 5), rr = r & 15, cc = c & 31, ob = rr * 64 + cc * 2; return st * 1024 + (ob ^ (((ob >> 9) & 1) << 5)); }
__host__ __device__ __forceinline__ void stage_rc(int b, int& R, int& C) { const int st = b / 1024, sb = b % 1024, swz = sb ^ (((sb >> 9) & 1) << 5); R = (st >> 1) * 16 + swz / 64; C = (st & 1) * 32 + (swz % 64) / 2; }

struct Unit { int pm, pn; long boff; };
struct Gemm { const bf16* A; const bf16* Bt; int K; };

struct StaticOrder {
    int nM, nN, nwg, G, c;
    __device__ void init(int nM_, int nN_, int G_, int c_) { nM = nM_; nN = nN_; nwg = nM * nN; G = G_; c = c_; }
    __device__ bool map(int i, int& pm, int& pn) const {
        const long L = (long)i * G + c; if (L >= nwg) return false;
        int wgid = (int)L; { const int q = nwg / NXCD, r = nwg % NXCD, xcd = wgid % NXCD, off = wgid / NXCD; wgid = (xcd < r ? xcd * (q + 1) : r * (q + 1) + (xcd - r) * q) + off; }
        const int nig = WGM * nN, gid = wgid / nig, fm = gid * WGM, gsz = (nM - fm) < WGM ? (nM - fm) : WGM;
        pm = fm + ((wgid % nig) % gsz); pn = (wgid % nig) / gsz; return true;
    }
    __device__ bool next(int i, Unit& u) const { u.boff = 0; return map(i, u.pm, u.pn); }
};
struct MoeOrder : StaticOrder {
    const volatile LAS int* texp; long bstride;
    __device__ bool next(int i, Unit& u) const { if (!map(i, u.pm, u.pn)) return false; u.boff = (long)texp[u.pm] * bstride; return true; }
};

template <class Epi, class Sched, bool ALIGN_EPI, bool SP2, bool FP8 = false>
__device__ __forceinline__ void gemm_phase(LAS unsigned char* lds, const int wid, const Gemm g, const Sched& S, const Epi& E) {
    const int lane = lane_id(), tid = wid * 64 + lane, wr = wid >> 2, wc = wid & 3, fr = lane & 15, fq = lane >> 4;
    const int K = g.K, nt = K / BK;
    unsigned voffA[2];
#pragma unroll
    for (int i = 0; i < 2; ++i) { int R, C; stage_rc(tid * 16 + i * 8192, R, C); voffA[i] = (unsigned)(R * K + C) * 2u; }
    const size_t kstep = (size_t)(BK * 2);
    const size_t hstep = (size_t)HALF * K * 2;
    const size_t tstep = 2 * hstep;
    const unsigned ldsw = (unsigned)wid * 1024u;
    const int aoff = lds_byte(wr * 64 + fr, fq * 8), boff = lds_byte(wc * 32 + fr, fq * 8);
#define PG8_SA(b, h) (((b) * 2 + (h)) * HTB)
#define PG8_SB(b, h) ((4 + (b) * 2 + (h)) * HTB)
#define PG8_STAGE(bufoff, gbase) do { _Pragma("unroll") for (int _i = 0; _i < 2; ++_i) \
        __builtin_amdgcn_global_load_lds((const unsigned*)((const char*)(gbase) + voffA[_i]), (LAS unsigned*)(lds + (bufoff) + ldsw + _i * 8192), 16, 0, 0); } while (0)
#define PG8_CAT(lo, hi) __builtin_shufflevector(lo, hi, 0, 1, 2, 3, 4, 5, 6, 7)
#define PG8_LDA(dst, b, h) do { _Pragma("unroll") for (int m = 0; m < 4; ++m) dst[m] = PG8_CAT(*(const LAS i32x4*)(lds + PG8_SA(b, h) + aoff + m * 2048), *(const LAS i32x4*)(lds + PG8_SA(b, h) + aoff + m * 2048 + 1024)); } while (0)
#define PG8_LDB(dst, b, h) do { _Pragma("unroll") for (int n = 0; n < 2; ++n) dst[n] = PG8_CAT(*(const LAS i32x4*)(lds + PG8_SB(b, h) + boff + n * 2048), *(const LAS i32x4*)(lds + PG8_SB(b, h) + boff + n * 2048 + 1024)); } while (0)
#define PG8_LO(x) __builtin_bit_cast(bf16x8, __builtin_shufflevector(x, x, 0, 1, 2, 3))
#define PG8_HI(x) __builtin_bit_cast(bf16x8, __builtin_shufflevector(x, x, 4, 5, 6, 7))
#define PG8_MMA(ai, bj, At, Bt) do { __builtin_amdgcn_s_setprio(1); \
        if constexpr (FP8) { _Pragma("unroll") for (int m = 0; m < 4; ++m) _Pragma("unroll") for (int n = 0; n < 2; ++n) \
            asm volatile("v_mfma_scale_f32_16x16x128_f8f6f4 %0, %1, %2, %0, %3, %4 op_sel_hi:[0,0,0]" : "+v"(acc[ai][bj][m][n]) : "v"(Bt[n]), "v"(At[m]), "v"(scw), "v"(sca)); } \
        else { _Pragma("unroll") for (int m = 0; m < 4; ++m) _Pragma("unroll") for (int n = 0; n < 2; ++n) { \
            acc[ai][bj][m][n] = __builtin_amdgcn_mfma_f32_16x16x32_bf16(PG8_LO(Bt[n]), PG8_LO(At[m]), acc[ai][bj][m][n], 0, 0, 0); \
            acc[ai][bj][m][n] = __builtin_amdgcn_mfma_f32_16x16x32_bf16(PG8_HI(Bt[n]), PG8_HI(At[m]), acc[ai][bj][m][n], 0, 0, 0); } } \
        __builtin_amdgcn_s_setprio(0); } while (0)
#define PG8_WAIT_V(n) asm volatile("s_waitcnt vmcnt(" #n ")" ::: "memory")
#define PG8_WAIT_L(n) asm volatile("s_waitcnt lgkmcnt(" #n ")" ::: "memory")
#define PG8_BAR __builtin_amdgcn_s_barrier()
#define PG8_SCHED __builtin_amdgcn_sched_barrier(0)
    Unit cur, nxt; int ui = 0;
    if (!S.next(0, cur)) return;
    int scw = SCALE_W8, sca = SCALE_ONE; if constexpr (FP8) asm volatile("" : "+v"(scw), "+v"(sca));
    f32x4 acc[2][2][4][2];
#pragma unroll
    for (int a = 0; a < 2; ++a)
#pragma unroll
        for (int b = 0; b < 2; ++b)
#pragma unroll
            for (int m = 0; m < 4; ++m)
#pragma unroll
                for (int n = 0; n < 2; ++n) acc[a][b][m][n] = (f32x4){0.f, 0.f, 0.f, 0.f};
    i32x8 At[4], B0[2], B1[2];
    const char* cA = (const char*)g.A + (size_t)cur.pm * tstep; const char* cB = (const char*)g.Bt + cur.boff + (size_t)cur.pn * tstep;
    if constexpr (SP2) {
        PG8_STAGE(PG8_SB(0, 0), cB); PG8_STAGE(PG8_SB(0, 1), cB + hstep); PG8_STAGE(PG8_SA(0, 0), cA); PG8_STAGE(PG8_SA(0, 1), cA + hstep);
        if (wr == 1) PG8_BAR;
        PG8_WAIT_V(2); PG8_BAR;
        PG8_STAGE(PG8_SB(1, 0), cB + kstep); PG8_STAGE(PG8_SA(1, 0), cA + kstep); PG8_STAGE(PG8_SB(1, 1), cB + hstep + kstep);
        PG8_WAIT_V(6); PG8_BAR;
    } else {
        PG8_STAGE(PG8_SB(0, 0), cB); PG8_STAGE(PG8_SA(0, 0), cA); PG8_STAGE(PG8_SB(0, 1), cB + hstep); PG8_STAGE(PG8_SA(0, 1), cA + hstep);
        if (wr == 1) PG8_BAR;
        PG8_WAIT_V(4); PG8_BAR;
        PG8_STAGE(PG8_SB(1, 0), cB + kstep); PG8_STAGE(PG8_SA(1, 0), cA + kstep); PG8_STAGE(PG8_SB(1, 1), cB + hstep + kstep);
        PG8_WAIT_V(6); PG8_BAR;
    }
    for (;;) {
        const bool has_next = S.next(ui + 1, nxt);
        const char* nA = has_next ? (const char*)g.A + (size_t)nxt.pm * tstep : cA; const char* nB = has_next ? (const char*)g.Bt + nxt.boff + (size_t)nxt.pn * tstep : cB;
#pragma unroll 1
        for (int t = 0; t < nt; t += 2) {
            const bool last = (t == nt - 2);
            const char* a1 = cA + (size_t)(t + 1) * kstep;
            const char* a2 = last ? nA : cA + (size_t)(t + 2) * kstep; const char* b2 = last ? nB : cB + (size_t)(t + 2) * kstep;
            const char* a3 = a2 + kstep; const char* b3 = b2 + kstep;
            if constexpr (SP2) {
            PG8_LDB(B0, 0, 0); PG8_LDB(B1, 0, 1); PG8_SCHED; PG8_LDA(At, 0, 0); PG8_STAGE(PG8_SA(1, 1), a1 + hstep);
            PG8_WAIT_V(8); PG8_WAIT_L(0); PG8_BAR; PG8_MMA(0, 0, At, B0); PG8_MMA(0, 1, At, B1); PG8_BAR; PG8_SCHED;
            PG8_LDA(At, 0, 1); PG8_STAGE(PG8_SB(0, 0), b2); PG8_STAGE(PG8_SB(0, 1), b2 + hstep); PG8_STAGE(PG8_SA(0, 0), a2);
            PG8_WAIT_V(8); PG8_WAIT_L(0); PG8_BAR; PG8_MMA(1, 0, At, B0); PG8_MMA(1, 1, At, B1); PG8_BAR; PG8_SCHED;
            PG8_LDB(B0, 1, 0); PG8_LDB(B1, 1, 1); PG8_SCHED; PG8_LDA(At, 1, 0); PG8_STAGE(PG8_SA(0, 1), a2 + hstep);
            PG8_WAIT_V(8); PG8_WAIT_L(0); PG8_BAR; PG8_MMA(0, 0, At, B0); PG8_MMA(0, 1, At, B1); PG8_BAR; PG8_SCHED;
            PG8_LDA(At, 1, 1); PG8_STAGE(PG8_SB(1, 0), b3); PG8_STAGE(PG8_SB(1, 1), b3 + hstep); PG8_STAGE(PG8_SA(1, 0), a3);
            PG8_WAIT_V(8); PG8_WAIT_L(0); PG8_BAR; PG8_MMA(1, 0, At, B0); PG8_MMA(1, 1, At, B1); PG8_BAR; PG8_SCHED;
            } else {
            PG8_LDB(B0, 0, 0); PG8_SCHED; PG8_LDA(At, 0, 0); PG8_STAGE(PG8_SA(1, 1), a1 + hstep);
            PG8_WAIT_L(8); PG8_BAR; PG8_WAIT_L(0); PG8_MMA(0, 0, At, B0); PG8_BAR; PG8_SCHED;
            PG8_LDB(B1, 0, 1); PG8_STAGE(PG8_SB(0, 0), b2);
            PG8_BAR; PG8_WAIT_L(0); PG8_MMA(0, 1, At, B1); PG8_BAR;
            PG8_LDA(At, 0, 1); PG8_STAGE(PG8_SA(0, 0), a2);
            PG8_BAR; PG8_WAIT_L(0); PG8_MMA(1, 0, At, B0); PG8_BAR; PG8_SCHED;
            PG8_STAGE(PG8_SB(0, 1), b2 + hstep);
            PG8_WAIT_V(6); PG8_BAR; PG8_MMA(1, 1, At, B1); PG8_BAR;
            PG8_LDB(B0, 1, 0); PG8_SCHED; PG8_LDA(At, 1, 0); PG8_STAGE(PG8_SA(0, 1), a2 + hstep);
            PG8_WAIT_L(8); PG8_BAR; PG8_WAIT_L(0); PG8_MMA(0, 0, At, B0); PG8_BAR; PG8_SCHED;
            PG8_LDB(B1, 1, 1); PG8_STAGE(PG8_SB(1, 0), b3);
            PG8_BAR; PG8_WAIT_L(0); PG8_MMA(0, 1, At, B1); PG8_BAR;
            PG8_LDA(At, 1, 1); PG8_STAGE(PG8_SA(1, 0), a3);
            PG8_BAR; PG8_WAIT_L(0); PG8_MMA(1, 0, At, B0); PG8_BAR; PG8_SCHED;
            PG8_STAGE(PG8_SB(1, 1), b3 + hstep);
            PG8_WAIT_V(6); PG8_BAR; PG8_MMA(1, 1, At, B1); PG8_BAR;
            }
        }
        if constexpr (ALIGN_EPI) { if (wr == 0) PG8_BAR; }
        if constexpr (FP8) asm volatile("s_nop 15\n\ts_nop 15" ::: "memory");
        { int fr_ = fr, fq_ = fq; asm volatile("" : "+v"(fr_), "+v"(fq_)); E(acc, cur, wr, wc, fr_, fq_); }
        if (!has_next) break;
#pragma unroll
        for (int a = 0; a < 2; ++a)
#pragma unroll
            for (int b = 0; b < 2; ++b)
#pragma unroll
                for (int m = 0; m < 4; ++m)
#pragma unroll
                    for (int n = 0; n < 2; ++n) acc[a][b][m][n] = (f32x4){0.f, 0.f, 0.f, 0.f};
        cur = nxt; cA = nA; cB = nB; ++ui;
        if constexpr (ALIGN_EPI) { if (wr == 1) PG8_BAR; }
    }
    PG8_WAIT_V(0);
    if constexpr (!ALIGN_EPI) { if (wr == 0) PG8_BAR; }
    PG8_BAR;
#undef PG8_SA
#undef PG8_SB
#undef PG8_STAGE
#undef PG8_LDA
#undef PG8_LDB
#undef PG8_CAT
#undef PG8_LO
#undef PG8_HI
#undef PG8_MMA
#undef PG8_WAIT_V
#undef PG8_WAIT_L
#undef PG8_BAR
#undef PG8_SCHED
}

typedef const f32x4 (&AccRef)[2][2][4][2];

struct EpiAB {
    bf16* Z; const float* cs;
    __device__ __forceinline__ void operator()(AccRef acc, const Unit& u, int wr, int wc, int fr, int fq) const {
        const int sec = u.pn >> 2, ct = u.pn & 3;
        bf16* base = Z + (size_t)sec * ZSEC;
#pragma unroll
        for (int ai = 0; ai < 2; ++ai)
#pragma unroll
            for (int m = 0; m < 4; ++m) {
                const int row = u.pm * BM + ai * HALF + wr * 64 + m * 16 + fr;
                if (sec < 2) {
                    const float sc = sec == 0 ? QK_SCALE : 1.0f;
                    const f32x4 x1a = acc[ai][0][m][0], x1b = acc[ai][0][m][1], x2a = acc[ai][1][m][0], x2b = acc[ai][1][m][1];
                    f32x4 o1a, o1b, o2a, o2b;
                    if (row < NLAT) {
                        const int t = row & (TL - 1); const int pos = (wc & 1) ? (t & 63) : (t >> 6);
                        const float* cp = cs + pos * 32 + 8 * fq;
                        const f32x4 c0 = *(const f32x4*)cp, c1 = *(const f32x4*)(cp + 4), s0 = *(const f32x4*)(cp + 2048), s1 = *(const f32x4*)(cp + 2052);
                        o1a = (x1a * c0 - x2a * s0) * sc; o1b = (x1b * c1 - x2b * s1) * sc; o2a = (x1a * s0 + x2a * c0) * sc; o2b = (x1b * s1 + x2b * c1) * sc;
                    } else { o1a = x1a * sc; o1b = x1b * sc; o2a = x2a * sc; o2b = x2b * sc; }
                    bf16* dst = base + (size_t)row * RW + (2 * ct + (wc >> 1)) * HD + 32 * (wc & 1) + 8 * fq;
                    *(u32x4*)dst = pack8(o1a, o1b); *(u32x4*)(dst + 64) = pack8(o2a, o2b);
                } else {
#pragma unroll
                    for (int bj = 0; bj < 2; ++bj) {
                        f32x4 v0 = acc[ai][bj][m][0], v1 = acc[ai][bj][m][1];
                        if (sec == 3) {
#pragma unroll
                            for (int j = 0; j < 4; ++j) { v0[j] = silu_f(v0[j]); v1[j] = silu_f(v1[j]); }
                        } else if (sec >= 4) {
#pragma unroll
                            for (int j = 0; j < 4; ++j) { v0[j] = gelu_tanh_f(v0[j]); v1[j] = gelu_tanh_f(v1[j]); }
                        }
                        *(u32x4*)(base + (size_t)row * RW + ct * 256 + bj * HALF + wc * 32 + 8 * fq) = pack8(v0, v1);
                    }
                }
            }
    }
};
struct EpiRes {
    float* X; const float* gate;
    __device__ __forceinline__ void operator()(AccRef acc, const Unit& u, int wr, int wc, int fr, int fq) const {
        const int r = u.pm < 64 ? (u.pm >> 4) : 4; const int col0 = u.pn * BM + wc * 32 + 8 * fq;
        const float* gp = gate + (size_t)r * MODW + col0;
        f32x4 g0[2], g1[2];
#pragma unroll
        for (int bj = 0; bj < 2; ++bj) { g0[bj] = *(const f32x4*)(gp + bj * HALF); g1[bj] = *(const f32x4*)(gp + bj * HALF + 4); }
#pragma unroll
        for (int ai = 0; ai < 2; ++ai)
#pragma unroll
            for (int m = 0; m < 4; ++m) { float* rowp = X + (size_t)(u.pm * BM + ai * HALF + wr * 64 + m * 16 + fr) * D + col0;
#pragma unroll
                for (int bj = 0; bj < 2; ++bj) { float* p = rowp + bj * HALF; f32x4 x0 = *(f32x4*)p, x1 = *(f32x4*)(p + 4);
                    x0 += g0[bj] * acc[ai][bj][m][0]; x1 += g1[bj] * acc[ai][bj][m][1]; *(f32x4*)p = x0; *(f32x4*)(p + 4) = x1; } }
    }
};
struct EpiCV {
    bf16* GB; bf16* XG;
    __device__ __forceinline__ void operator()(AccRef acc, const Unit& u, int wr, int wc, int fr, int fq) const {
#pragma unroll
        for (int ai = 0; ai < 2; ++ai)
#pragma unroll
            for (int m = 0; m < 4; ++m) { const size_t row = (size_t)(u.pm * BM + ai * HALF + wr * 64 + m * 16 + fr);
                if (u.pn < 8) {
#pragma unroll
                    for (int bj = 0; bj < 2; ++bj) *(u32x4*)(GB + row * D + u.pn * 256 + bj * HALF + wc * 32 + 8 * fq) = pack8(acc[ai][bj][m][0], acc[ai][bj][m][1]);
                } else {
                    *(u32x4*)(XG + row * D + (u.pn - 8) * HALF + wc * 32 + 8 * fq) = pack8(acc[ai][0][m][0] * acc[ai][1][m][0], acc[ai][0][m][1] * acc[ai][1][m][1]);
                } }
    }
};
struct EpiMoe1 {
    unsigned char* H;
    __device__ __forceinline__ void operator()(AccRef acc, const Unit& u, int wr, int wc, int fr, int fq) const {
#pragma unroll
        for (int ai = 0; ai < 2; ++ai)
#pragma unroll
            for (int m = 0; m < 4; ++m) { const size_t row = (size_t)(u.pm * BM + ai * HALF + wr * 64 + m * 16 + fr);
                f32x4 a0 = acc[ai][0][m][0], a1 = acc[ai][0][m][1];
#pragma unroll
                for (int j = 0; j < 4; ++j) { a0[j] = silu_f(a0[j]); a1[j] = silu_f(a1[j]); }
                *(u32x2*)(H + row * DE + u.pn * HALF + wc * 32 + 8 * fq) = pack8_fp8(a0 * acc[ai][1][m][0], a1 * acc[ai][1][m][1]); }
    }
};
struct EpiMoe2 {
    bf16* Y;
    __device__ __forceinline__ void operator()(AccRef acc, const Unit& u, int wr, int wc, int fr, int fq) const {
#pragma unroll
        for (int ai = 0; ai < 2; ++ai)
#pragma unroll
            for (int m = 0; m < 4; ++m) { const size_t row = (size_t)(u.pm * BM + ai * HALF + wr * 64 + m * 16 + fr);
#pragma unroll
                for (int bj = 0; bj < 2; ++bj) *(u32x4*)(Y + row * D + u.pn * 256 + bj * HALF + wc * 32 + 8 * fq) = pack8(acc[ai][bj][m][0], acc[ai][bj][m][1]); }
    }
};
}

#define XB_TMO      128
#define XB_XCNT(j)  (256  + 64 * (j))
#define XB_XSUB(j)  (1280 + 64 * (j))
#define XB_XGEN(j)  (2304 + 64 * (j))
#define XB_TOP      3328
#define XB_TOPGEN   3392
#define XCD_BAR_WORDS 3456
#define XB_SPIN_CAP (1u << 18)
__device__ __forceinline__ unsigned xb_ld(unsigned* p)              { return __hip_atomic_load(p, __ATOMIC_RELAXED, __HIP_MEMORY_SCOPE_AGENT); }
__device__ __forceinline__ unsigned xb_add(unsigned* p, unsigned v) { return __hip_atomic_fetch_add(p, v, __ATOMIC_RELAXED, __HIP_MEMORY_SCOPE_AGENT); }
__device__ __forceinline__ unsigned xb_xcc_id() { return (unsigned)__builtin_amdgcn_s_getreg((3 << 11) | 20) & 0xFu; }
#define XB_SPIN(cond, bar) do { unsigned _sp = 0; while (cond) { __builtin_amdgcn_s_sleep(1); \
    if ((++_sp & 255u) == 0u) { if (xb_ld(&(bar)[XB_TMO])) break; if (_sp > XB_SPIN_CAP) { atomicAdd(&(bar)[XB_TMO], 1u); break; } } } } while (0)
struct XcdBarrier { unsigned* bar; unsigned x; volatile LAS unsigned* st; };
__device__ __forceinline__ XcdBarrier xcd_barrier_post(unsigned* bar, volatile LAS unsigned* st) {
    XcdBarrier b; b.bar = bar; b.x = xb_xcc_id(); b.st = st;
    if (threadIdx.x == 0) (void)xb_add(&bar[XB_XCNT(b.x)], 1u);
    return b;
}
__device__ __forceinline__ void xcd_barrier_complete(unsigned* bar, unsigned x, unsigned& nloc, unsigned& nx) {
    const unsigned G = gridDim.x * gridDim.y * gridDim.z;
    unsigned sum, cnt, mine, sp = 0u;
    for (;;) {
        sum = 0u; cnt = 0u; mine = 0u;
#pragma unroll
        for (unsigned j = 0; j < 16; ++j) { const unsigned c = xb_ld(&bar[XB_XCNT(j)]); sum += c; cnt += (c > 0u) ? 1u : 0u; mine = (j == x) ? c : mine; }
        if (sum == G) break;
        __builtin_amdgcn_s_sleep(1);
        if ((++sp & 255u) == 0u) { if (xb_ld(&bar[XB_TMO])) break; if (sp > XB_SPIN_CAP) { atomicAdd(&bar[XB_TMO], 1u); break; } }
    }
    nloc = mine > 0u ? mine : 1u; nx = cnt > 0u ? cnt : 1u;
}
__device__ __forceinline__ void xcd_barrier(const XcdBarrier& b) {
    asm volatile("s_waitcnt vmcnt(0)" ::: "memory");
    __syncthreads();
    if (threadIdx.x == 0) {
        unsigned* bar = b.bar;
        __builtin_amdgcn_s_waitcnt(0);
        unsigned nloc = b.st[0], nx = b.st[1];
        if (nloc == 0u) { xcd_barrier_complete(bar, b.x, nloc, nx); b.st[0] = nloc; b.st[1] = nx; }
        const unsigned old = xb_add(&bar[XB_XSUB(b.x)], 1u);
        const unsigned gen = old / nloc;
        if (old + 1u == (gen + 1u) * nloc) {
            __builtin_amdgcn_fence(__ATOMIC_RELEASE, "agent");
            asm volatile("s_waitcnt vmcnt(0)" ::: "memory");
            const unsigned og = xb_add(&bar[XB_TOP], 1u);
            const unsigned tg = og / nx;
            if (og + 1u == (tg + 1u) * nx) xb_add(&bar[XB_TOPGEN], 1u);
            else XB_SPIN(xb_ld(&bar[XB_TOPGEN]) == tg, bar);
            __builtin_amdgcn_fence(__ATOMIC_ACQUIRE, "agent");
            xb_add(&bar[XB_XGEN(b.x)], 1u);
            asm volatile("s_waitcnt vmcnt(0)" ::: "memory");
        } else {
            XB_SPIN(xb_ld(&bar[XB_XGEN(b.x)]) == gen, bar);
            __builtin_amdgcn_fence(__ATOMIC_ACQUIRE, "agent");
            asm volatile("s_waitcnt vmcnt(0)" ::: "memory");
        }
    }
    __syncthreads();
}

struct Args {
    const float *x, *c, *ctx, *c_ctx, *w_mod, *b_mod, *g_mix, *g_ffn, *ab_w_in, *ab_w_out, *decay, *sgu_w, *sgu_b,
                *cv_w_in, *cv_cw, *cv_cb, *cv_w_out, *w_r1, *b_r1, *w_r2, *b_r2, *w1, *w3, *w2, *g_final;
    float* out; unsigned char* ws; int ph_lo, ph_hi;
};
struct Frame { LAS unsigned char* lds; volatile LAS unsigned* MISC; int wave, G, blk; };
#define FR_LANE_TID const int lane_ = lane_id(); const int tid_ = F.wave * 64 + lane_

enum { PH_PRO = 0, PH_L0 = 1, PH_PER_LAYER = 10, PH_FINAL = 21, NPHASE = 22 };
enum { K_PRE = 0, K_GIN = 1, K_MID1 = 2, K_MID2 = 3, K_MID3 = 4, K_GOUT = 5, K_ROUTE = 6, K_GATHER = 7, K_MOE1 = 8, K_MOE2 = 9 };

__device__ __forceinline__ int pos32(int x) { return 16 * ((x >> 2) & 1) + 4 * (x >> 3) + (x & 3); }
__device__ __forceinline__ void transpose_item(const float* W, int K, int N, bf16* WT, int kb, int nb, int dgrp, LAS float* scr, int lane) {
    const int k0 = 64 * kb, n0 = 32 * nb;
    const float* src = W + (size_t)(k0 + (lane >> 3)) * N + n0 + 4 * (lane & 7);
    f32x4 v[8];
#pragma unroll
    for (int i = 0; i < 8; ++i) v[i] = *(const f32x4*)(src + (size_t)(8 * i) * N);
#pragma unroll
    for (int i = 0; i < 8; ++i) { LAS float* d = scr + ((lane >> 3) + 8 * i) * 33 + 4 * (lane & 7); d[0] = v[i][0]; d[1] = v[i][1]; d[2] = v[i][2]; d[3] = v[i][3]; }
    asm volatile("s_waitcnt lgkmcnt(0)" ::: "memory");
    const int c = lane & 7;
#pragma unroll
    for (int j = 0; j < 4; ++j) { const int n = (lane >> 3) + 8 * j; const LAS float* s = scr + (8 * c) * 33 + n;
        u32x4 o; o.x = cvt_pk_bf16(s[0 * 33], s[1 * 33]); o.y = cvt_pk_bf16(s[2 * 33], s[3 * 33]); o.z = cvt_pk_bf16(s[4 * 33], s[5 * 33]); o.w = cvt_pk_bf16(s[6 * 33], s[7 * 33]);
        *(u32x4*)(WT + (size_t)(dgrp * 32 + pos32(n)) * K + k0 + 8 * c) = o; }
    asm volatile("s_waitcnt lgkmcnt(0)" ::: "memory");
}
__device__ __forceinline__ void transpose_item_fp8(const float* W, int K, int N, unsigned char* WT, int kb, int nb, int dgrp, LAS float* scr, int lane) {
    const int k0 = 64 * kb, n0 = 32 * nb;
    const float* src = W + (size_t)(k0 + (lane >> 3)) * N + n0 + 4 * (lane & 7);
    f32x4 v[8];
#pragma unroll
    for (int i = 0; i < 8; ++i) v[i] = *(const f32x4*)(src + (size_t)(8 * i) * N);
#pragma unroll
    for (int i = 0; i < 8; ++i) { LAS float* d = scr + ((lane >> 3) + 8 * i) * 33 + 4 * (lane & 7); d[0] = v[i][0] * W8_SCALE; d[1] = v[i][1] * W8_SCALE; d[2] = v[i][2] * W8_SCALE; d[3] = v[i][3] * W8_SCALE; }
    asm volatile("s_waitcnt lgkmcnt(0)" ::: "memory");
    const int c = lane & 7;
#pragma unroll
    for (int j = 0; j < 4; ++j) { const int n = (lane >> 3) + 8 * j; const LAS float* s = scr + (8 * c) * 33 + n;
        u32x2 o; o.x = pk4_fp8(s[0 * 33], s[1 * 33], s[2 * 33], s[3 * 33]); o.y = pk4_fp8(s[4 * 33], s[5 * 33], s[6 * 33], s[7 * 33]);
        *(u32x2*)(WT + (size_t)(dgrp * 32 + pos32(n)) * K + k0 + 8 * c) = o; }
    asm volatile("s_waitcnt lgkmcnt(0)" ::: "memory");
}
__device__ __forceinline__ void phase_prologue(const Args& a, Frame& F) {
    FR_LANE_TID;
    unsigned char* ws = a.ws;
    {
        LAS float* S = (LAS float*)(F.lds + 69632);
        LAS float* red = (LAS float*)(F.lds + 110592);
        for (int i = tid_; i < 5 * D; i += 512) { const int r = i / D, k = i % D; const float v = r < 4 ? a.c[r * D + k] : a.c_ctx[k]; S[i] = silu_f(v); }
        __syncthreads();
        if (F.blk < 256) {
            const int Lm = F.blk >> 7, strip = F.blk & 127;
            const int rsub = lane_ / 24, c4 = lane_ % 24;
            float acc[5][4];
#pragma unroll
            for (int r = 0; r < 5; ++r) { acc[r][0] = 0.f; acc[r][1] = 0.f; acc[r][2] = 0.f; acc[r][3] = 0.f; }
            if (rsub < 2) {
                const float* wp = a.w_mod + (size_t)Lm * D * MODW + (size_t)(256 * F.wave + rsub) * MODW + 96 * strip + 4 * c4;
#pragma unroll 8
                for (int it = 0; it < 128; ++it) {
                    const f32x4 w = *(const f32x4*)(wp + (size_t)(2 * it) * MODW);
                    const int k = 256 * F.wave + 2 * it + rsub;
#pragma unroll
                    for (int r = 0; r < 5; ++r) { const float s = S[r * D + k]; acc[r][0] += s * w[0]; acc[r][1] += s * w[1]; acc[r][2] += s * w[2]; acc[r][3] += s * w[3]; }
                }
#pragma unroll
                for (int r = 0; r < 5; ++r)
#pragma unroll
                    for (int j = 0; j < 4; ++j) red[(F.wave * 2 + rsub) * 480 + r * 96 + 4 * c4 + j] = acc[r][j];
            }
            __syncthreads();
            if (tid_ < 480) { float s = 0.f;
#pragma unroll
                for (int p = 0; p < 16; ++p) s += red[p * 480 + tid_];
                const int r = tid_ / 96, cc = tid_ % 96; const int col = 96 * strip + cc;
                ((float*)(ws + WS_MOD))[(size_t)(Lm * 5 + r) * MODW + col] = s + a.b_mod[Lm * MODW + col]; }
        }
        __syncthreads();
    }
    {
        const int gt = F.blk * 512 + tid_, NT = F.G * 512;
        float* cs = (float*)(ws + WS_ROPE);
        for (int i = gt; i < 2048; i += NT) { const int pos = i >> 5, f = i & 31; const float inv = powf(10000.0f, -(float)f / 32.0f); const float ang = (float)pos * inv; cs[i] = cosf(ang); cs[2048 + i] = sinf(ang); }
        float* wr = (float*)(ws + WS_WR);
        for (int i = gt; i < 2 * 20 * D; i += NT) { const int L = i / (20 * D), r = (i / D) % 20, k = i % D;
            float v; if (r < 4) v = a.w_r1[((size_t)L * D + k) * 4 + r]; else { const int g = (r - 4) >> 2, e = (r - 4) & 3; v = a.w_r2[(((size_t)L * 4 + g) * D + k) * 4 + e]; }
            wr[i] = v; }
    }
    {
        LAS float* scr = (LAS float*)(F.lds + F.wave * 8448);
        const int gw = F.blk * 8 + F.wave, NGW = F.G * 8;
        constexpr int I_IN = 32 * 192, I_OUT = 32 * 64, I_FIX = 2 * I_IN + 2 * I_OUT, I_EXP = 3072, NITEMS = I_FIX + 32 * I_EXP;
        for (int it = gw; it < NITEMS; it += NGW) {
            if (it < I_IN) {
                const int kb = it / 192, nb = it % 192; const int n = nb * 32, sec = n >> 10; int dg;
                if (sec < 2) { const int h = (n & 1023) >> 7, dgi = (n & 127) >> 5; dg = (sec * 4 + (h >> 1)) * 8 + (dgi >> 1) * 4 + (h & 1) * 2 + (dgi & 1); } else dg = nb;
                transpose_item(a.ab_w_in, D, 6144, (bf16*)(ws + WS_WAB_IN), kb, nb, dg, scr, lane_);
            } else if (it < I_IN + I_OUT) { const int r = it - I_IN; transpose_item(a.ab_w_out, D, D, (bf16*)(ws + WS_WAB_OUT), r / 64, r % 64, r % 64, scr, lane_);
            } else if (it < 2 * I_IN + I_OUT) {
                const int r = it - I_IN - I_OUT; const int kb = r / 192, nb = r % 192; const int n = nb * 32; int dg;
                if (n < 2048) dg = nb; else if (n < 4096) { const int cc = n - 2048; dg = (8 + (cc >> 7)) * 8 + ((cc & 127) >> 5); } else { const int cc = n - 4096; dg = (8 + (cc >> 7)) * 8 + 4 + ((cc & 127) >> 5); }
                transpose_item(a.cv_w_in, D, 6144, (bf16*)(ws + WS_WCV_IN), kb, nb, dg, scr, lane_);
            } else if (it < I_FIX) { const int r = it - 2 * I_IN - I_OUT; transpose_item(a.cv_w_out, D, D, (bf16*)(ws + WS_WCV_OUT), r / 64, r % 64, r % 64, scr, lane_);
            } else {
                const int idx = it - I_FIX; const int le = idx / I_EXP, r = idx % I_EXP, which = r >> 10, item = r & 1023;
                if (which < 2) {
                    const int kb = item >> 5, nb = item & 31; const int cc = nb * 32; const int dg = (cc >> 7) * 8 + which * 4 + ((cc & 127) >> 5);
                    transpose_item_fp8((which ? a.w3 : a.w1) + (size_t)le * D * DE, D, DE, ws + WS_W13 + (size_t)le * D * D, kb, nb, dg, scr, lane_);
                } else {
                    const int kb = item >> 6, nb = item & 63;
                    transpose_item_fp8(a.w2 + (size_t)le * DE * D, DE, D, ws + WS_W2 + (size_t)le * D * DE, kb, nb, nb, scr, lane_);
                }
            }
        }
    }
}

__device__ __forceinline__ void combine_row(f32x4 (&v)[8], const bf16* Y, const int* rdst, const float* rwt, const float* gate, int row, int lane) {
    const i32x2 d = *(const i32x2*)(rdst + 2 * (size_t)row); const f32x2 w = *(const f32x2*)(rwt + 2 * (size_t)row);
    const bf16* y0 = Y + (size_t)d.x * D + 4 * lane; const bf16* y1 = Y + (size_t)d.y * D + 4 * lane;
#pragma unroll
    for (int j = 0; j < 8; ++j) { const u32x2 p0 = *(const u32x2*)(y0 + 256 * j), p1 = *(const u32x2*)(y1 + 256 * j); const f32x4 g = *(const f32x4*)(gate + 4 * lane + 256 * j);
        v[j][0] += g[0] * (w.x * bf2f(p0.x & 0xffffu) + w.y * bf2f(p1.x & 0xffffu)); v[j][1] += g[1] * (w.x * bf2f(p0.x >> 16) + w.y * bf2f(p1.x >> 16));
        v[j][2] += g[2] * (w.x * bf2f(p0.y & 0xffffu) + w.y * bf2f(p1.y & 0xffffu)); v[j][3] += g[3] * (w.x * bf2f(p0.y >> 16) + w.y * bf2f(p1.y >> 16)); }
}
__device__ __forceinline__ float row_rstd(const f32x4 (&v)[8]) {
    float ss = 0.f;
#pragma unroll
    for (int j = 0; j < 8; ++j) ss += (v[j][0] * v[j][0] + v[j][1] * v[j][1]) + (v[j][2] * v[j][2] + v[j][3] * v[j][3]);
    return rsqrtf(wave_sum(ss) * (1.0f / D) + EPSN);
}
__device__ __forceinline__ void phase_pre(const Args& a, Frame& F, int L) {
    FR_LANE_TID;
    unsigned char* ws = a.ws; float* XB = (float*)(ws + WS_XB); bf16* A = (bf16*)(ws + WS_A);
    const float* MOD = (const float*)(ws + WS_MOD);
    const int nrows = (L == 0) ? NTOK : NLAT;
    const int gw = F.blk * 8 + F.wave, NGW = F.G * 8;
    for (int row = gw; row < nrows; row += NGW) {
        const int r = row < NLAT ? row >> 12 : 4;
        f32x4 v[8];
        if (L == 0) { const float* src = row < NLAT ? a.x + (size_t)row * D : a.ctx + (size_t)(row - NLAT) * D;
#pragma unroll
            for (int j = 0; j < 8; ++j) v[j] = *(const f32x4*)(src + 4 * lane_ + 256 * j);
        } else {
#pragma unroll
            for (int j = 0; j < 8; ++j) v[j] = *(const f32x4*)(XB + (size_t)row * D + 4 * lane_ + 256 * j);
            combine_row(v, (const bf16*)(ws + WS_R2), (const int*)(ws + WS_RDST) + (size_t)(L - 1) * NTOK * 2, (const float*)(ws + WS_RWT) + (size_t)(L - 1) * NTOK * 2,
                        MOD + (size_t)((L - 1) * 5 + r) * MODW + 5 * D, row, lane_);
        }
#pragma unroll
        for (int j = 0; j < 8; ++j) *(f32x4*)(XB + (size_t)row * D + 4 * lane_ + 256 * j) = v[j];
        const float rstd = row_rstd(v);
        const float* mp = MOD + (size_t)(L * 5 + r) * MODW; const float* gm = a.g_mix + L * D;
#pragma unroll
        for (int j = 0; j < 8; ++j) { const int c = 4 * lane_ + 256 * j; const f32x4 g = *(const f32x4*)(gm + c), sh = *(const f32x4*)(mp + c), sc = *(const f32x4*)(mp + D + c);
            const f32x4 o = v[j] * rstd * g * (sc + 1.0f) + sh; u32x2 p; p.x = cvt_pk_bf16(o[0], o[1]); p.y = cvt_pk_bf16(o[2], o[3]); *(u32x2*)(A + (size_t)row * D + c) = p; }
    }
}

constexpr int LDP = 136;
constexpr int IMG = 128 * LDP * 2;
__device__ __forceinline__ int unit_row0(int b, int s) { return s < 2 ? NLAT + b * TCX + s * 128 : b * TL + (s - 2) * 128; }
__device__ __forceinline__ void piece_rc(int q, int& j, int& ch) { const int jr = q & 15, cq = (q >> 4) & 3, blk = q >> 6; j = 16 * (blk & 7) + jr; ch = 4 * (blk >> 3) + cq; }

__device__ __forceinline__ void ret_u_unit(const Args& a, Frame& F, int u) {
    FR_LANE_TID;
    unsigned char* ws = a.ws; const bf16* Z = (const bf16*)(ws + WS_R1);
    const int bh = u / NSLOT, s = u % NSLOT, b = bh >> 3, h = bh & 7; const int row0 = unit_row0(b, s);
    const bf16* Kp = Z + 1 * ZSEC + (size_t)row0 * RW + h * HD; const bf16* Vp = Z + 2 * ZSEC + (size_t)row0 * RW + h * HD;
    const float lgf2 = logsig(a.decay[h]) * LOG2E, lgb2 = logsig(a.decay[NH + h]) * LOG2E;
    LAS bf16* KTf = (LAS bf16*)(F.lds); LAS bf16* KTb = (LAS bf16*)(F.lds + IMG); LAS bf16* VT = (LAS bf16*)(F.lds + 2 * IMG);
#pragma unroll
    for (int k = 0; k < 4; ++k) { int j, ch; piece_rc(tid_ + 512 * k, j, ch);
        const u32x4 kv = *(const u32x4*)(Kp + (size_t)j * RW + 8 * ch), vv = *(const u32x4*)(Vp + (size_t)j * RW + 8 * ch);
        const float ff = exp2f((float)(127 - j) * lgf2), fb = exp2f((float)j * lgb2);
#pragma unroll
        for (int i = 0; i < 8; ++i) { const unsigned kw = (i & 1) ? (kv[i >> 1] >> 16) : (kv[i >> 1] & 0xffffu), vw = (i & 1) ? (vv[i >> 1] >> 16) : (vv[i >> 1] & 0xffffu);
            const float kf = bf2f(kw); const unsigned pf = cvt_pk_bf16(kf * ff, kf * fb);
            KTf[(8 * ch + i) * LDP + j] = (bf16)(pf & 0xffffu); KTb[(8 * ch + i) * LDP + j] = (bf16)(pf >> 16); VT[(8 * ch + i) * LDP + j] = (bf16)vw; } }
    __syncthreads();
    const int fr = lane_ & 15, g = lane_ >> 4, dt = F.wave;
    f32x4 accf[8], accb[8];
#pragma unroll
    for (int e = 0; e < 8; ++e) { accf[e] = (f32x4){0.f, 0.f, 0.f, 0.f}; accb[e] = (f32x4){0.f, 0.f, 0.f, 0.f}; }
#pragma unroll
    for (int sI = 0; sI < 4; ++sI) {
        const bf16x8 af = *(const LAS bf16x8*)(KTf + (16 * dt + fr) * LDP + 32 * sI + 8 * g), ab = *(const LAS bf16x8*)(KTb + (16 * dt + fr) * LDP + 32 * sI + 8 * g);
#pragma unroll
        for (int et = 0; et < 8; ++et) { const bf16x8 bv = *(const LAS bf16x8*)(VT + (16 * et + fr) * LDP + 32 * sI + 8 * g);
            accf[et] = __builtin_amdgcn_mfma_f32_16x16x32_bf16(af, bv, accf[et], 0, 0, 0); accb[et] = __builtin_amdgcn_mfma_f32_16x16x32_bf16(ab, bv, accb[et], 0, 0, 0); }
    }
    float* ST = (float*)(ws + WS_R2) + (size_t)u * 2 * 16384;
#pragma unroll
    for (int et = 0; et < 8; ++et) { *(f32x4*)(ST + (size_t)(16 * et + fr) * 128 + 16 * dt + 4 * g) = accf[et]; *(f32x4*)(ST + 16384 + (size_t)(16 * et + fr) * 128 + 16 * dt + 4 * g) = accb[et]; }
    __syncthreads();
}
__device__ __forceinline__ void sgu_unit(const Args& a, Frame& F, int u) {
    FR_LANE_TID;
    unsigned char* ws = a.ws; const bf16* Z = (const bf16*)(ws + WS_R1); bf16* RS = (bf16*)(ws + WS_R3);
    const int bg = u / NSLOT, s = u % NSLOT, b = bg >> 3, grp = bg & 7; const int row0 = unit_row0(b, s);
    const bf16* Up = Z + 4 * ZSEC + (size_t)row0 * RW + grp * HD; const bf16* Vp = Z + 5 * ZSEC + (size_t)row0 * RW + grp * HD;
    LAS bf16* WS_ = (LAS bf16*)(F.lds); LAS bf16* VT = (LAS bf16*)(F.lds + IMG);
    const float* wsrc = a.sgu_w + (size_t)grp * 16384;
#pragma unroll
    for (int k = 0; k < 8; ++k) { const int i4 = tid_ + 512 * k; const int p = i4 >> 5, q4 = (i4 & 31) * 4; const f32x4 w = *(const f32x4*)(wsrc + p * 128 + q4);
        u32x2 o; o.x = cvt_pk_bf16(w[0], w[1]); o.y = cvt_pk_bf16(w[2], w[3]); *(LAS u32x2*)(WS_ + p * LDP + q4) = o; }
    { const int q = tid_ >> 2, part = tid_ & 3; float x[32];
#pragma unroll
        for (int k = 0; k < 4; ++k) { const u32x4 vv = *(const u32x4*)(Vp + (size_t)q * RW + 32 * part + 8 * k);
#pragma unroll
            for (int i = 0; i < 4; ++i) { x[8 * k + 2 * i] = bf2f(vv[i] & 0xffffu); x[8 * k + 2 * i + 1] = bf2f(vv[i] >> 16); } }
        float sm = 0.f;
#pragma unroll
        for (int i = 0; i < 32; ++i) sm += x[i];
        sm += __shfl_xor(sm, 1); sm += __shfl_xor(sm, 2); const float mu = sm * (1.0f / 128.0f);
        float sq = 0.f;
#pragma unroll
        for (int i = 0; i < 32; ++i) { const float dlt = x[i] - mu; sq += dlt * dlt; }
        sq += __shfl_xor(sq, 1); sq += __shfl_xor(sq, 2); const float rstd = rsqrtf(sq * (1.0f / 128.0f) + EPSN);
#pragma unroll
        for (int i = 0; i < 32; i += 2) { const unsigned p2 = cvt_pk_bf16((x[i] - mu) * rstd, (x[i + 1] - mu) * rstd);
            VT[(32 * part + i) * LDP + q] = (bf16)(p2 & 0xffffu); VT[(32 * part + i + 1) * LDP + q] = (bf16)(p2 >> 16); } }
    __syncthreads();
    const int fr = lane_ & 15, g = lane_ >> 4, pt = F.wave;
    f32x4 acc[8];
#pragma unroll
    for (int c = 0; c < 8; ++c) acc[c] = (f32x4){0.f, 0.f, 0.f, 0.f};
#pragma unroll
    for (int sI = 0; sI < 4; ++sI) { const bf16x8 bw = *(const LAS bf16x8*)(WS_ + (16 * pt + fr) * LDP + 32 * sI + 8 * g);
#pragma unroll
        for (int ct = 0; ct < 8; ++ct) { const bf16x8 av = *(const LAS bf16x8*)(VT + (16 * ct + fr) * LDP + 32 * sI + 8 * g);
            acc[ct] = __builtin_amdgcn_mfma_f32_16x16x32_bf16(av, bw, acc[ct], 0, 0, 0); } }
    const int p = 16 * pt + fr; const float bs = a.sgu_b[grp * 128 + p];
#pragma unroll
    for (int ct = 0; ct < 8; ++ct) { const int c = 16 * ct + 4 * g; const u32x2 uu = *(const u32x2*)(Up + (size_t)p * RW + c);
        const float o0 = bf2f(uu.x & 0xffffu) * (acc[ct][0] + bs), o1 = bf2f(uu.x >> 16) * (acc[ct][1] + bs), o2 = bf2f(uu.y & 0xffffu) * (acc[ct][2] + bs), o3 = bf2f(uu.y >> 16) * (acc[ct][3] + bs);
        u32x2 o; o.x = cvt_pk_bf16(o0, o1); o.y = cvt_pk_bf16(o2, o3); *(u32x2*)(RS + (size_t)(row0 + p) * D + RW + grp * HD + c) = o; }
    __syncthreads();
}
__device__ __forceinline__ void phase_scan(const Args& a, Frame& F) {
    FR_LANE_TID;
    float* ST = (float*)(a.ws + WS_R2);
    const int NT = F.G * 512;
    for (int it = F.blk * 512 + tid_; it < 32 * 2 * 4096; it += NT) {
        const int bh = it >> 13, dir = (it >> 12) & 1, e4 = it & 4095, h = bh & 7;
        const float cd = expf(128.0f * logsig(a.decay[dir * NH + h]));
        float* base = ST + ((size_t)bh * NSLOT * 2 + dir) * 16384 + (size_t)e4 * 4;
        f32x4 st = (f32x4){0.f, 0.f, 0.f, 0.f};
#pragma unroll 2
        for (int n = 0; n < NSLOT; ++n) { const int s = dir == 0 ? n : (n < 2 ? 1 - n : 35 - n);
            float* p = base + (size_t)s * 2 * 16384; const f32x4 tmp = *(const f32x4*)p; *(f32x4*)p = st; st = st * cd + tmp; }
    }
}
__device__ __forceinline__ void ret_y_unit(const Args& a, Frame& F, int u) {
    FR_LANE_TID;
    unsigned char* ws = a.ws; const bf16* Z = (const bf16*)(ws + WS_R1); bf16* RS = (bf16*)(ws + WS_R3);
    const int bh = u / NSLOT, s = u % NSLOT, b = bh >> 3, h = bh & 7; const int row0 = unit_row0(b, s);
    const bf16* Qp = Z + (size_t)row0 * RW + h * HD; const bf16* Kp = Z + 1 * ZSEC + (size_t)row0 * RW + h * HD; const bf16* Vp = Z + 2 * ZSEC + (size_t)row0 * RW + h * HD;
    const bf16* Gp = Z + 3 * ZSEC + (size_t)row0 * RW + h * HD;
    const float lgf2 = logsig(a.decay[h]) * LOG2E, lgb2 = logsig(a.decay[NH + h]) * LOG2E;
    LAS bf16* KN = (LAS bf16*)(F.lds); LAS bf16* VT = (LAS bf16*)(F.lds + IMG); LAS bf16* SF = (LAS bf16*)(F.lds + 2 * IMG); LAS bf16* SB = (LAS bf16*)(F.lds + 3 * IMG);
#pragma unroll
    for (int k = 0; k < 4; ++k) { int j, ch; piece_rc(tid_ + 512 * k, j, ch);
        const u32x4 kv = *(const u32x4*)(Kp + (size_t)j * RW + 8 * ch), vv = *(const u32x4*)(Vp + (size_t)j * RW + 8 * ch);
        *(LAS u32x4*)(KN + j * LDP + 8 * ch) = kv;
#pragma unroll
        for (int i = 0; i < 8; ++i) { const unsigned vw = (i & 1) ? (vv[i >> 1] >> 16) : (vv[i >> 1] & 0xffffu); VT[(8 * ch + i) * LDP + j] = (bf16)vw; } }
    { const float* ST = (const float*)(ws + WS_R2) + (size_t)u * 2 * 16384;
#pragma unroll
        for (int k = 0; k < 8; ++k) { const int i4 = tid_ + 512 * k; const int e = i4 >> 5, d4 = (i4 & 31) * 4; const f32x4 sf = *(const f32x4*)(ST + e * 128 + d4), sb = *(const f32x4*)(ST + 16384 + e * 128 + d4);
            u32x2 o; o.x = cvt_pk_bf16(sf[0], sf[1]); o.y = cvt_pk_bf16(sf[2], sf[3]); *(LAS u32x2*)(SF + e * LDP + d4) = o;
            o.x = cvt_pk_bf16(sb[0], sb[1]); o.y = cvt_pk_bf16(sb[2], sb[3]); *(LAS u32x2*)(SB + e * LDP + d4) = o; } }
    const int fr = lane_ & 15, g = lane_ >> 4, it_ = F.wave; const int i_abs = 16 * it_ + fr;
    bf16x8 qf[4];
#pragma unroll
    for (int sI = 0; sI < 4; ++sI) qf[sI] = *(const bf16x8*)(Qp + (size_t)i_abs * RW + 32 * sI + 8 * g);
    __syncthreads();
    bf16x8 pf[4];
#pragma unroll
    for (int ks = 0; ks < 4; ++ks) { f32x4 s0 = (f32x4){0.f, 0.f, 0.f, 0.f}, s1 = s0;
#pragma unroll
        for (int sI = 0; sI < 4; ++sI) { const bf16x8 k0 = *(const LAS bf16x8*)(KN + (32 * ks + fr) * LDP + 32 * sI + 8 * g), k1 = *(const LAS bf16x8*)(KN + (32 * ks + 16 + fr) * LDP + 32 * sI + 8 * g);
            s0 = __builtin_amdgcn_mfma_f32_16x16x32_bf16(k0, qf[sI], s0, 0, 0, 0); s1 = __builtin_amdgcn_mfma_f32_16x16x32_bf16(k1, qf[sI], s1, 0, 0, 0); }
        unsigned w[4];
#pragma unroll
        for (int r = 0; r < 4; r += 2) {
            const int j0 = 32 * ks + 4 * g + r, j1 = j0 + 1, j2 = j0 + 16, j3 = j2 + 1;
            const float d0 = (float)(i_abs - j0), d1 = (float)(i_abs - j1), d2 = (float)(i_abs - j2), d3 = (float)(i_abs - j3);
            const float m0 = d0 >= 0.f ? exp2f(d0 * lgf2) : exp2f(-d0 * lgb2), m1 = d1 >= 0.f ? exp2f(d1 * lgf2) : exp2f(-d1 * lgb2);
            const float m2 = d2 >= 0.f ? exp2f(d2 * lgf2) : exp2f(-d2 * lgb2), m3 = d3 >= 0.f ? exp2f(d3 * lgf2) : exp2f(-d3 * lgb2);
            w[r >> 1] = cvt_pk_bf16(s0[r] * m0, s0[r + 1] * m1); w[2 + (r >> 1)] = cvt_pk_bf16(s1[r] * m2, s1[r + 1] * m3);
        }
        u32x4 ww; ww.x = w[0]; ww.y = w[1]; ww.z = w[2]; ww.w = w[3]; pf[ks] = __builtin_bit_cast(bf16x8, ww);
    }
    const float qdf = exp2f((float)(i_abs + 1) * lgf2), qdb = exp2f((float)(128 - i_abs) * lgb2);
    f32x4 y[8];
#pragma unroll
    for (int et = 0; et < 8; ++et) {
        f32x4 ai = (f32x4){0.f, 0.f, 0.f, 0.f}, cf = ai, cb = ai;
#pragma unroll
        for (int ks = 0; ks < 4; ++ks) { const LAS bf16* vp = VT + (16 * et + fr) * LDP + 32 * ks + 4 * g; const u32x2 lo = *(const LAS u32x2*)vp, hi = *(const LAS u32x2*)(vp + 16);
            u32x4 av; av.x = lo.x; av.y = lo.y; av.z = hi.x; av.w = hi.y;
            ai = __builtin_amdgcn_mfma_f32_16x16x32_bf16(__builtin_bit_cast(bf16x8, av), pf[ks], ai, 0, 0, 0); }
#pragma unroll
        for (int sI = 0; sI < 4; ++sI) { const bf16x8 sf = *(const LAS bf16x8*)(SF + (16 * et + fr) * LDP + 32 * sI + 8 * g), sb = *(const LAS bf16x8*)(SB + (16 * et + fr) * LDP + 32 * sI + 8 * g);
            cf = __builtin_amdgcn_mfma_f32_16x16x32_bf16(sf, qf[sI], cf, 0, 0, 0); cb = __builtin_amdgcn_mfma_f32_16x16x32_bf16(sb, qf[sI], cb, 0, 0, 0); }
        y[et] = ai + cf * qdf + cb * qdb;
    }
    float sm = 0.f;
#pragma unroll
    for (int et = 0; et < 8; ++et) sm += (y[et][0] + y[et][1]) + (y[et][2] + y[et][3]);
    sm += __shfl_xor(sm, 16); sm += __shfl_xor(sm, 32); const float mu = sm * (1.0f / 128.0f);
    float sq = 0.f;
#pragma unroll
    for (int et = 0; et < 8; ++et) { const f32x4 dl = y[et] - mu; sq += (dl[0] * dl[0] + dl[1] * dl[1]) + (dl[2] * dl[2] + dl[3] * dl[3]); }
    sq += __shfl_xor(sq, 16); sq += __shfl_xor(sq, 32); const float rstd = rsqrtf(sq * (1.0f / 128.0f) + EPSN);
#pragma unroll
    for (int et = 0; et < 8; ++et) { const int e = 16 * et + 4 * g; const u32x2 gg = *(const u32x2*)(Gp + (size_t)i_abs * RW + e);
        const f32x4 o = (y[et] - mu) * rstd; u32x2 w2; w2.x = cvt_pk_bf16(o[0] * bf2f(gg.x & 0xffffu), o[1] * bf2f(gg.x >> 16)); w2.y = cvt_pk_bf16(o[2] * bf2f(gg.y & 0xffffu), o[3] * bf2f(gg.y >> 16));
        *(u32x2*)(RS + (size_t)(row0 + i_abs) * D + h * HD + e) = w2; }
    __syncthreads();
}

__device__ __forceinline__ void phase_conv(const Args& a, Frame& F) {
    FR_LANE_TID;
    unsigned char* ws = a.ws; const bf16* GB = (const bf16*)(ws + WS_R1); const bf16* XG = GB + (size_t)NLAT * D; bf16* A1 = (bf16*)(ws + WS_R3);
    const int NT = F.G * 512;
    for (int it = F.blk * 512 + tid_; it < NLAT * 256; it += NT) {
        const int row = it >> 8, c = (it & 255) * 8; const int gc = row & 63;
        const u32x4 x1 = *(const u32x4*)(XG + (size_t)row * D + c), gb = *(const u32x4*)(GB + (size_t)row * D + c);
        u32x4 x0 = (u32x4){0u, 0u, 0u, 0u}, x2 = x0;
        if (gc > 0) x0 = *(const u32x4*)(XG + (size_t)(row - 1) * D + c);
        if (gc < 63) x2 = *(const u32x4*)(XG + (size_t)(row + 1) * D + c);
        float o[8];
#pragma unroll
        for (int i = 0; i < 8; ++i) { const int cc = c + i; const unsigned sh = (i & 1) ? 16u : 0u;
            const float f0 = bf2f((x0[i >> 1] >> sh) & 0xffffu), f1 = bf2f((x1[i >> 1] >> sh) & 0xffffu), f2 = bf2f((x2[i >> 1] >> sh) & 0xffffu), fg = bf2f((gb[i >> 1] >> sh) & 0xffffu);
            o[i] = fg * (a.cv_cb[cc] + a.cv_cw[cc] * f0 + a.cv_cw[D + cc] * f1 + a.cv_cw[2 * D + cc] * f2); }
        u32x4 w; w.x = cvt_pk_bf16(o[0], o[1]); w.y = cvt_pk_bf16(o[2], o[3]); w.z = cvt_pk_bf16(o[4], o[5]); w.w = cvt_pk_bf16(o[6], o[7]);
        *(u32x4*)(A1 + (size_t)row * D + c) = w;
    }
}

__device__ __forceinline__ void phase_route(const Args& a, Frame& F, int L) {
    FR_LANE_TID;
    unsigned char* ws = a.ws; const float* XB = (const float*)(ws + WS_XB); unsigned char* Fo = ws + WS_A;
    const float* MOD = (const float*)(ws + WS_MOD); const float* WR = (const float*)(ws + WS_WR) + (size_t)L * 20 * D;
    const int nrows = (L == 0) ? NTOK : NLAT; const int RPB = (nrows + F.G - 1) / F.G;
    LAS int* rinfo = (LAS int*)F.lds;
    LAS float* rw = (LAS float*)(F.lds + 8192);
    volatile LAS unsigned* lcnt = F.MISC + MI_LCNT; volatile LAS unsigned* gbase = F.MISC + MI_GBASE;
    if (tid_ < 16) lcnt[tid_] = 0u;
    __syncthreads();
    for (int i = F.wave; i < RPB; i += 8) {
        const int row = F.blk * RPB + i; if (row >= nrows) break;
        const int r = row < NLAT ? row >> 12 : 4;
        int ln4 = 4 * lane_; asm volatile("" : "+v"(ln4));
        f32x4 v[8];
#pragma unroll
        for (int j = 0; j < 8; ++j) v[j] = *(const f32x4*)(XB + (size_t)row * D + ln4 + 256 * j);
        const float rstd = row_rstd(v);
        const float* mp = MOD + (size_t)(L * 5 + r) * MODW; const float* gf = a.g_ffn + L * D;
#pragma unroll
        for (int j = 0; j < 8; ++j) { const int c = ln4 + 256 * j; const f32x4 g = *(const f32x4*)(gf + c), sh = *(const f32x4*)(mp + 3 * D + c), sc = *(const f32x4*)(mp + 4 * D + c);
            v[j] = v[j] * rstd * g * (sc + 1.0f) + sh; *(unsigned*)(Fo + (size_t)row * D + c) = pk4_fp8(v[j][0], v[j][1], v[j][2], v[j][3]); }
        float l1[4];
#pragma unroll
        for (int g = 0; g < 4; ++g) { float s = 0.f;
#pragma unroll
            for (int j = 0; j < 8; ++j) { const f32x4 w = *(const f32x4*)(WR + (size_t)g * D + ln4 + 256 * j); s += (v[j][0] * w[0] + v[j][1] * w[1]) + (v[j][2] * w[2] + v[j][3] * w[3]); }
            l1[g] = wave_sum(s) + a.b_r1[L * 4 + g]; asm volatile("" ::: "memory"); }
        int grp = 0; float mx = l1[0];
#pragma unroll
        for (int g = 1; g < 4; ++g) if (l1[g] > mx) { mx = l1[g]; grp = g; }
        float den = 0.f;
#pragma unroll
        for (int g = 0; g < 4; ++g) den += expf(l1[g] - mx);
        const float pg = 1.0f / den;
        float l2[4];
#pragma unroll
        for (int e = 0; e < 4; ++e) { float s = 0.f; const float* wp = WR + (size_t)(4 + 4 * grp + e) * D;
#pragma unroll
            for (int j = 0; j < 8; ++j) { const f32x4 w = *(const f32x4*)(wp + ln4 + 256 * j); s += (v[j][0] * w[0] + v[j][1] * w[1]) + (v[j][2] * w[2] + v[j][3] * w[3]); }
            l2[e] = wave_sum(s) + a.b_r2[(L * 4 + grp) * 4 + e]; asm volatile("" ::: "memory"); }
        int i0 = 0; float v0 = l2[0];
#pragma unroll
        for (int e = 1; e < 4; ++e) if (l2[e] > v0) { v0 = l2[e]; i0 = e; }
        int i1 = -1; float v1 = -3.0e38f;
#pragma unroll
        for (int e = 0; e < 4; ++e) if (e != i0 && l2[e] > v1) { v1 = l2[e]; i1 = e; }
        const float ex = expf(v1 - v0); const float w0 = pg / (1.0f + ex), w1 = pg * ex / (1.0f + ex);
        if (lane_ == 0) { const int e0 = grp * 4 + i0, e1 = grp * 4 + i1;
            const int li0 = (int)__hip_atomic_fetch_add((LAS unsigned*)&lcnt[e0], 1u, __ATOMIC_RELAXED, __HIP_MEMORY_SCOPE_WORKGROUP);
            const int li1 = (int)__hip_atomic_fetch_add((LAS unsigned*)&lcnt[e1], 1u, __ATOMIC_RELAXED, __HIP_MEMORY_SCOPE_WORKGROUP);
            rinfo[4 * i] = e0; rinfo[4 * i + 1] = li0; rinfo[4 * i + 2] = e1; rinfo[4 * i + 3] = li1; rw[2 * i] = w0; rw[2 * i + 1] = w1; }
    }
    __syncthreads();
    if (tid_ < 16) gbase[tid_] = xb_add((unsigned*)(ws + WS_CTL) + CW_CNT + L * 64 + tid_, lcnt[tid_]);
    __syncthreads();
    int* RIDX = (int*)(ws + WS_RIDX) + (size_t)L * NTOK * 4; float* RWT = (float*)(ws + WS_RWT) + (size_t)L * NTOK * 2;
    for (int i = tid_; i < RPB; i += 512) { const int row = F.blk * RPB + i; if (row < nrows) {
        const int e0 = rinfo[4 * i], e1 = rinfo[4 * i + 2];
        i32x4 o; o.x = e0; o.y = (int)gbase[e0] + rinfo[4 * i + 1]; o.z = e1; o.w = (int)gbase[e1] + rinfo[4 * i + 3]; *(i32x4*)(RIDX + 4 * (size_t)row) = o;
        f32x2 w; w.x = rw[2 * i]; w.y = rw[2 * i + 1]; *(f32x2*)(RWT + 2 * (size_t)row) = w; } }
    __syncthreads();
}
__device__ __forceinline__ int moe_tables(const Args& a, Frame& F, int L) {
    FR_LANE_TID;
    volatile LAS int* tb = (volatile LAS int*)(F.MISC + MI_TB); volatile LAS int* texp = (volatile LAS int*)(F.MISC + MI_TEXP);
    __syncthreads();
    if (tid_ == 0) { unsigned* cnt = (unsigned*)(a.ws + WS_CTL) + CW_CNT + L * 64; int acc = 0;
        for (int e = 0; e < NE; ++e) { tb[e] = acc; const int n = ((int)xb_ld(cnt + e) + 255) >> 8; for (int t = 0; t < n && acc + t < 160; ++t) texp[acc + t] = e; acc += n; }
        tb[NE] = acc; }
    __syncthreads();
    return tb[NE];
}
__device__ __forceinline__ void phase_gather(const Args& a, Frame& F, int L) {
    FR_LANE_TID;
    unsigned char* ws = a.ws; const unsigned char* Fi = ws + WS_A; unsigned char* FG = ws + WS_R1;
    (void)moe_tables(a, F, L);
    volatile LAS int* tb = (volatile LAS int*)(F.MISC + MI_TB);
    const int nrows = (L == 0) ? NTOK : NLAT;
    const int* RIDX = (const int*)(ws + WS_RIDX) + (size_t)L * NTOK * 4; int* RDST = (int*)(ws + WS_RDST) + (size_t)L * NTOK * 2;
    const int gw = F.blk * 8 + F.wave, NGW = F.G * 8;
    for (int row = gw; row < nrows; row += NGW) {
        const i32x4 ri = *(const i32x4*)(RIDX + 4 * (size_t)row);
        const int d0 = tb[ri.x] * 256 + ri.y, d1 = tb[ri.z] * 256 + ri.w;
        if (lane_ == 0) { i32x2 o; o.x = d0; o.y = d1; *(i32x2*)(RDST + 2 * (size_t)row) = o; }
        const u32x4* src = (const u32x4*)(Fi + (size_t)row * D); u32x4* p0 = (u32x4*)(FG + (size_t)d0 * D); u32x4* p1 = (u32x4*)(FG + (size_t)d1 * D);
#pragma unroll
        for (int j = 0; j < 2; ++j) { const u32x4 v = src[lane_ + 64 * j]; p0[lane_ + 64 * j] = v; p1[lane_ + 64 * j] = v; }
    }
}
__device__ __forceinline__ void phase_final(const Args& a, Frame& F, int Lc  ) {
    FR_LANE_TID;
    unsigned char* ws = a.ws; const float* XB = (const float*)(ws + WS_XB); const float* MOD = (const float*)(ws + WS_MOD);
    const int gw = F.blk * 8 + F.wave, NGW = F.G * 8;
    for (int row = gw; row < NLAT; row += NGW) {
        const int r = row >> 12;
        f32x4 v[8];
#pragma unroll
        for (int j = 0; j < 8; ++j) v[j] = *(const f32x4*)(XB + (size_t)row * D + 4 * lane_ + 256 * j);
        if (Lc >= 0) combine_row(v, (const bf16*)(ws + WS_R2), (const int*)(ws + WS_RDST) + (size_t)Lc * NTOK * 2, (const float*)(ws + WS_RWT) + (size_t)Lc * NTOK * 2,
                                 MOD + (size_t)(Lc * 5 + r) * MODW + 5 * D, row, lane_);
        const float rstd = row_rstd(v);
#pragma unroll
        for (int j = 0; j < 8; ++j) { const int c = 4 * lane_ + 256 * j; const f32x4 g = *(const f32x4*)(a.g_final + c); *(f32x4*)(a.out + (size_t)row * D + c) = v[j] * rstd * g; }
    }
}

__global__ void __launch_bounds__(512, 2) fwd_kernel(Args a) {
    extern __shared__ __attribute__((aligned(16))) unsigned char lds_raw[];
    Frame F; F.lds = (LAS unsigned char*)lds_raw; F.MISC = (volatile LAS unsigned*)(F.lds + MISC_OFF);
    F.wave = __builtin_amdgcn_readfirstlane((int)threadIdx.x >> 6); F.G = gridDim.x; F.blk = blockIdx.x;
    unsigned char* ws = a.ws;
    F.MISC[threadIdx.x] = 0u;
    __syncthreads();
#if MK_SPLIT
    #define GRID_BAR() do { } while (0)
#else
    XcdBarrier bar = xcd_barrier_post((unsigned*)(ws + WS_CTL) + CW_BAR, F.MISC);
    #define GRID_BAR() xcd_barrier(bar)
#endif
    const int lo = a.ph_lo, hi = a.ph_hi;
    unsigned long long pr_acc = 0ull, pr_t0 = 0ull;
#define IN(k) (lo <= (k) && (k) < hi && ((((PROBE_MASK) >> (k)) & 1u) ? (pr_t0 = __builtin_amdgcn_s_memrealtime(), true) : true))
#define SEAM(k) do { if (lo <= (k) + 1 && (k) + 1 < hi) GRID_BAR(); if (((PROBE_MASK) >> (k)) & 1u) pr_acc += __builtin_amdgcn_s_memrealtime() - pr_t0; } while (0)

    if (IN(PH_PRO)) { phase_prologue(a, F); SEAM(PH_PRO); }
#define RUN_LAYER(L) do { \
        constexpr int P = PH_L0 + (L) * PH_PER_LAYER; \
        constexpr int nM = ((L) == 0) ? NTOK / 256 : NLAT / 256; \
        if (IN(P + K_PRE)) { phase_pre(a, F, (L)); SEAM(P + K_PRE); } \
        if (DBG_STOP == 1) break; \
        if (IN(P + K_GIN)) { \
            if ((L) == 0) { pg8::Gemm g{(const bf16*)(ws + WS_A), (const bf16*)(ws + WS_WAB_IN), D}; pg8::StaticOrder S; S.init(nM, 24, F.G, F.blk); \
                pg8::EpiAB E{(bf16*)(ws + WS_R1), (const float*)(ws + WS_ROPE)}; pg8::gemm_phase<pg8::EpiAB, pg8::StaticOrder, true, true>(F.lds, F.wave, g, S, E); } \
            else { pg8::Gemm g{(const bf16*)(ws + WS_A), (const bf16*)(ws + WS_WCV_IN), D}; pg8::StaticOrder S; S.init(nM, 24, F.G, F.blk); \
                pg8::EpiCV E{(bf16*)(ws + WS_R1), (bf16*)(ws + WS_R1) + (size_t)NLAT * D}; pg8::gemm_phase<pg8::EpiCV, pg8::StaticOrder, true, true>(F.lds, F.wave, g, S, E); } \
            SEAM(P + K_GIN); \
        } \
        if (IN(P + K_MID1)) { \
            if ((L) == 0) { for (int u = F.blk; u < NUNIT; u += F.G) ret_u_unit(a, F, u); for (int u = F.blk; u < NUNIT; u += F.G) sgu_unit(a, F, u); } \
            else phase_conv(a, F); \
            SEAM(P + K_MID1); \
        } \
        if ((L) == 0) { \
            if (IN(P + K_MID2)) { phase_scan(a, F); SEAM(P + K_MID2); } \
            if (IN(P + K_MID3)) { for (int u = F.blk; u < NUNIT; u += F.G) ret_y_unit(a, F, u); SEAM(P + K_MID3); } \
        } \
        if (IN(P + K_GOUT)) { \
            pg8::Gemm g{(const bf16*)(ws + WS_R3), (const bf16*)(ws + ((L) == 0 ? WS_WAB_OUT : WS_WCV_OUT)), D}; pg8::StaticOrder S; S.init(nM, 8, F.G, F.blk); \
            pg8::EpiRes E{(float*)(ws + WS_XB), (const float*)(ws + WS_MOD) + (size_t)(L) * 5 * MODW + 2 * D}; \
            pg8::gemm_phase<pg8::EpiRes, pg8::StaticOrder, true, true>(F.lds, F.wave, g, S, E); \
            SEAM(P + K_GOUT); \
        } \
        if (DBG_STOP == 2 || (DBG_STOP == 4 && (L) == 1)) break; \
        if (IN(P + K_ROUTE)) { phase_route(a, F, (L)); SEAM(P + K_ROUTE); } \
        if (IN(P + K_GATHER)) { phase_gather(a, F, (L)); SEAM(P + K_GATHER); } \
        if (IN(P + K_MOE1)) { \
            const int TT = moe_tables(a, F, (L)); \
            pg8::Gemm g{(const bf16*)(ws + WS_R1), (const bf16*)(ws + WS_W13 + (size_t)(L) * NE * D * D), D / 2}; \
            pg8::MoeOrder S; S.init(TT, 8, F.G, F.blk); S.texp = (const volatile LAS int*)(F.MISC + MI_TEXP); S.bstride = (long)D * D; \
            pg8::EpiMoe1 E{ws + WS_R3}; pg8::gemm_phase<pg8::EpiMoe1, pg8::MoeOrder, true, true, true>(F.lds, F.wave, g, S, E); \
            SEAM(P + K_MOE1); \
        } \
        if (IN(P + K_MOE2)) { \
            const int TT = moe_tables(a, F, (L)); \
            pg8::Gemm g{(const bf16*)(ws + WS_R3), (const bf16*)(ws + WS_W2 + (size_t)(L) * NE * D * DE), DE / 2}; \
            pg8::MoeOrder S; S.init(TT, 8, F.G, F.blk); S.texp = (const volatile LAS int*)(F.MISC + MI_TEXP); S.bstride = (long)D * DE; \
            pg8::EpiMoe2 E{(bf16*)(ws + WS_R2)}; pg8::gemm_phase<pg8::EpiMoe2, pg8::MoeOrder, true, true, true>(F.lds, F.wave, g, S, E); \
            SEAM(P + K_MOE2); \
        } \
    } while (0)
    RUN_LAYER(0);
    if (DBG_STOP == 0 || DBG_STOP == 4) RUN_LAYER(1);
    if (IN(PH_FINAL)) phase_final(a, F, DBG_STOP == 0 ? 1 : (DBG_STOP == 3 ? 0 : -1));
#undef IN
#undef SEAM
    if ((PROBE_MASK) != 0u && F.blk == 0 && threadIdx.x == 0) { const unsigned long long t1 = __builtin_amdgcn_s_memrealtime(); while (__builtin_amdgcn_s_memrealtime() - t1 < (unsigned long long)(PROBE_MULT) * pr_acc) __builtin_amdgcn_s_sleep(8); }
}

extern "C" void kernel_launch(void* const* d_in, const int* in_sizes, int n_in, void* d_out, int out_size, void* d_ws, size_t ws_size, hipStream_t stream) {
    static int grid = 0;
    if (grid == 0) {
        if (n_in != 25 || in_sizes[0] != NLAT * D || out_size != NLAT * D || ws_size < WS_END) { fprintf(stderr, "kernel_launch: unexpected shapes (n_in %d, in0 %d, out %d, ws %zu)\n", n_in, n_in > 0 ? in_sizes[0] : -1, out_size, ws_size); grid = -1; return; }
        int dev = 0, cus = 0, per_cu = 0;
        if (hipGetDevice(&dev) != hipSuccess || hipDeviceGetAttribute(&cus, hipDeviceAttributeMultiprocessorCount, dev) != hipSuccess) { grid = -1; return; }
        if (hipFuncSetAttribute((const void*)fwd_kernel, hipFuncAttributeMaxDynamicSharedMemorySize, LDS_BYTES) != hipSuccess) { fprintf(stderr, "kernel_launch: hipFuncSetAttribute failed\n"); grid = -1; return; }
        if (hipOccupancyMaxActiveBlocksPerMultiprocessor(&per_cu, (const void*)fwd_kernel, 512, LDS_BYTES) != hipSuccess || per_cu < 1) fprintf(stderr, "kernel_launch: occupancy query reports %d\n", per_cu);
        (void)hipGetLastError();
        grid = cus;
    }
    if (grid < 0) return;
    (void)hipMemsetAsync((char*)d_ws + WS_CTL, 0, CTL_BYTES, stream);
    Args a{};
    const float** f = (const float**)&a;
    for (int i = 0; i < 25; ++i) f[i] = (const float*)d_in[i];
    a.out = (float*)d_out; a.ws = (unsigned char*)d_ws;
#if MK_SPLIT
    for (int ph = 0; ph < NPHASE; ++ph) { a.ph_lo = ph; a.ph_hi = ph + 1; hipLaunchKernelGGL(fwd_kernel, dim3(grid), dim3(512), LDS_BYTES, stream, a); }
#else
    a.ph_lo = 0; a.ph_hi = NPHASE; hipLaunchKernelGGL(fwd_kernel, dim3(grid), dim3(512), LDS_BYTES, stream, a);
#endif
}
```

```cpp
#include <hip/hip_runtime.h>
#include <cstdio>
#include <cstdint>

#ifndef MK_SPLIT
#define MK_SPLIT 0
#endif
#ifndef PROBE_MASK
#define PROBE_MASK 0u
#endif
#ifndef PROBE_MULT
#define PROBE_MULT 4
#endif
#ifndef DBG_STOP
#define DBG_STOP 0
#endif

#define LAS __attribute__((address_space(3)))
#define GAS __attribute__((address_space(1)))
typedef unsigned short bf16;
typedef short bf16x8 __attribute__((ext_vector_type(8)));
typedef short s16x4 __attribute__((ext_vector_type(4)));
typedef float f32x4 __attribute__((ext_vector_type(4)));
typedef float f32x2 __attribute__((ext_vector_type(2)));
typedef unsigned u32x4 __attribute__((ext_vector_type(4)));
typedef unsigned u32x2 __attribute__((ext_vector_type(2)));
typedef int i32x4 __attribute__((ext_vector_type(4)));
typedef int i32x8 __attribute__((ext_vector_type(8)));
typedef int i32x2 __attribute__((ext_vector_type(2)));

constexpr int D = 2048, NB = 4, TL = 4096, TCX = 256;
constexpr int NLAT = NB * TL;
constexpr int NCTX = NB * TCX;
constexpr int NTOK = NLAT + NCTX;
constexpr int HD = 128, NH = 8, RW = 1024;
constexpr int NSLOT = 34;
constexpr int NUNIT = NB * NH * NSLOT;
constexpr int DE = 1024, NE = 16;
constexpr int PCAP = 2 * NTOK + NE * 256;
constexpr float EPSN = 1e-6f;
constexpr float QK_SCALE = 0.08838834764831845f;
constexpr int MODW = 6 * D;

constexpr size_t MiB = 1u << 20;
constexpr size_t WS_CTL = 0, CTL_BYTES = 1 * MiB;
constexpr size_t WS_MOD = 1 * MiB;
constexpr size_t WS_ROPE = 1 * MiB + 512 * 1024;
constexpr size_t WS_WR = 2 * MiB;
constexpr size_t WS_RIDX = 3 * MiB;
constexpr size_t WS_RWT = 4 * MiB;
constexpr size_t WS_GIDX = 5 * MiB;
constexpr size_t WS_WAB_IN = 8 * MiB, WS_WAB_OUT = 32 * MiB, WS_WCV_IN = 40 * MiB, WS_WCV_OUT = 64 * MiB;
constexpr size_t WS_W13 = 72 * MiB;
constexpr size_t WS_W2 = 328 * MiB;
constexpr size_t WS_XB = 456 * MiB;
constexpr size_t WS_A = 592 * MiB;
constexpr size_t WS_R1 = 660 * MiB;
constexpr size_t WS_R2 = 864 * MiB;
constexpr size_t WS_R3 = 1016 * MiB;
constexpr size_t WS_END = 1092 * MiB;
constexpr size_t ZSEC = (size_t)NTOK * 1024;
constexpr int CW_BAR = 4096;
constexpr int CW_CNT = 1024;

constexpr int SCR_BYTES = 147456;
constexpr int MISC_OFF = SCR_BYTES;
constexpr int LDS_BYTES = SCR_BYTES + 2048;
constexpr int MI_LCNT = 16, MI_GBASE = 32, MI_TB = 64, MI_TEXP = 96;

__device__ __forceinline__ unsigned cvt_pk_bf16(float lo, float hi) { unsigned r; asm("v_cvt_pk_bf16_f32 %0, %1, %2" : "=v"(r) : "v"(lo), "v"(hi)); return r; }
__device__ __forceinline__ int lane_id() { int l; asm volatile("v_mbcnt_lo_u32_b32 %0, -1, 0\n\tv_mbcnt_hi_u32_b32 %0, -1, %0" : "=v"(l)); return l; }
__device__ __forceinline__ float bf2f(unsigned b) { return __uint_as_float(b << 16); }
__device__ __forceinline__ float wave_sum(float v) {
#pragma unroll
    for (int o = 1; o < 64; o <<= 1) v += __shfl_xor(v, o);
    return v;
}
__device__ __forceinline__ float silu_f(float x) { return x / (1.0f + __expf(-x)); }
__device__ __forceinline__ float gelu_tanh_f(float x) { const float z = 1.5957691216057308f * (x + 0.044715f * x * x * x); return x / (1.0f + __expf(-z)); }
__device__ __forceinline__ u32x4 pack8(f32x4 a, f32x4 b) { u32x4 w; w.x = cvt_pk_bf16(a[0], a[1]); w.y = cvt_pk_bf16(a[2], a[3]); w.z = cvt_pk_bf16(b[0], b[1]); w.w = cvt_pk_bf16(b[2], b[3]); return w; }
__device__ __forceinline__ unsigned pk4_fp8(float a, float b, float c, float d) { int w = 0; w = __builtin_amdgcn_cvt_pk_fp8_f32(a, b, w, false); w = __builtin_amdgcn_cvt_pk_fp8_f32(c, d, w, true); return (unsigned)w; }
__device__ __forceinline__ u32x2 pack8_fp8(f32x4 a, f32x4 b) { u32x2 w; w.x = pk4_fp8(a[0], a[1], a[2], a[3]); w.y = pk4_fp8(b[0], b[1], b[2], b[3]); return w; }
#define W8_SCALE 64.0f
#define SCALE_W8 0x79797979
#define SCALE_ONE 0x7f7f7f7f
__device__ __forceinline__ float logsig(float x) { return -log1pf(expf(-x)); }
#define LOG2E 1.4426950408889634f

namespace pg8 {
constexpr int BM = 256, BK = 64, HALF = 128, HTB = HALF * BK * 2, STAGE_BYTES = 8 * HTB, NXCD = 8, WGM = 8;
__host__ __device__ __forceinline__ int lds_byte(int r, int c) { const int st = (r >> 4) * 2 + (c >> 5), rr = r & 15, cc = c & 31, ob = rr * 64 + cc * 2; return st * 1024 + (ob ^ (((ob >> 9) & 1) << 5)); }
__host__ __device__ __forceinline__ void stage_rc(int b, int& R, int& C) { const int st = b / 1024, sb = b % 1024, swz = sb ^ (((sb >> 9) & 1) << 5); R = (st >> 1) * 16 + swz / 64; C = (st & 1) * 32 + (swz % 64) / 2; }

struct Unit { int pm, pn; long boff; };
struct Gemm { const bf16* A; const bf16* Bt; int K; };

struct StaticOrder {
    int nM, nN, nwg, G, c;
    __device__ void init(int nM_, int nN_, int G_, int c_) { nM = nM_; nN = nN_; nwg = nM * nN; G = G_; c = c_; }
    __device__ bool map(int i, int& pm, int& pn) const {
        const long L = (long)i * G + c; if (L >= nwg) return false;
        int wgid = (int)L; { const int q = nwg / NXCD, r = nwg % NXCD, xcd = wgid % NXCD, off = wgid / NXCD; wgid = (xcd < r ? xcd * (q + 1) : r * (q + 1) + (xcd - r) * q) + off; }
        const int nig = WGM * nN, gid = wgid / nig, fm = gid * WGM, gsz = (nM - fm) < WGM ? (nM - fm) : WGM;
        pm = fm + ((wgid % nig) % gsz); pn = (wgid % nig) / gsz; return true;
    }
    __device__ bool next(int i, Unit& u) const { u.boff = 0; return map(i, u.pm, u.pn); }
};
struct MoeOrder : StaticOrder {
    const volatile LAS int* texp; long bstride;
    __device__ bool next(int i, Unit& u) const { if (!map(i, u.pm, u.pn)) return false; u.boff = (long)texp[u.pm] * bstride; return true; }
};

template <class Epi, class Sched, bool ALIGN_EPI, bool SP2, bool FP8 = false, bool GATHER = false>
__device__ __forceinline__ void gemm_phase(LAS unsigned char* lds, const int wid, const Gemm g, const Sched& S, const Epi& E, const LAS int* gidx = nullptr) {
    static_assert(!GATHER || SP2, "row-gathered A operand: SP2 loop only");
    const int lane = lane_id(), tid = wid * 64 + lane, wr = wid >> 2, wc = wid & 3, fr = lane & 15, fq = lane >> 4;
    const int K = g.K, nt = K / BK;
    unsigned voffA[2];
#pragma unroll
    for (int i = 0; i < 2; ++i) { int R, C; stage_rc(tid * 16 + i * 8192, R, C); voffA[i] = (unsigned)(R * K + C) * 2u; }
    const size_t kstep = (size_t)(BK * 2);
    const size_t hstep = (size_t)HALF * K * 2;
    const size_t tstep = 2 * hstep;
    const unsigned ldsw = (unsigned)wid * 1024u;
    const int aoff = lds_byte(wr * 64 + fr, fq * 8), boff = lds_byte(wc * 32 + fr, fq * 8);
#define PG8_SA(b, h) (((b) * 2 + (h)) * HTB)
#define PG8_SB(b, h) ((4 + (b) * 2 + (h)) * HTB)
#define PG8_STAGE(bufoff, gbase) do { _Pragma("unroll") for (int _i = 0; _i < 2; ++_i) \
        __builtin_amdgcn_global_load_lds((const unsigned*)((const char*)(gbase) + voffA[_i]), (LAS unsigned*)(lds + (bufoff) + ldsw + _i * 8192), 16, 0, 0); } while (0)
#define PG8_STAGEA(bufoff, ptr, kq, h, useN) do { if constexpr (GATHER) { _Pragma("unroll") for (int _i = 0; _i < 2; ++_i) \
        __builtin_amdgcn_global_load_lds((const unsigned*)(gA + (kq) + ((useN) ? oN[h][_i] : oC[h][_i])), (LAS unsigned*)(lds + (bufoff) + ldsw + _i * 8192), 16, 0, 0); } \
        else { PG8_STAGE(bufoff, ptr); } } while (0)
#define PG8_OFFS(o, uidx) do { _Pragma("unroll") for (int _h = 0; _h < 2; ++_h) _Pragma("unroll") for (int _i = 0; _i < 2; ++_i) { int R_, C_; stage_rc(tid * 16 + _i * 8192, R_, C_); \
        o[_h][_i] = (unsigned)gidx[(uidx) * 256 + _h * HALF + R_] * (unsigned)(K * 2) + (unsigned)(C_ * 2); } } while (0)
#define PG8_CAT(lo, hi) __builtin_shufflevector(lo, hi, 0, 1, 2, 3, 4, 5, 6, 7)
#define PG8_LDA(dst, b, h) do { _Pragma("unroll") for (int m = 0; m < 4; ++m) dst[m] = PG8_CAT(*(const LAS i32x4*)(lds + PG8_SA(b, h) + aoff + m * 2048), *(const LAS i32x4*)(lds + PG8_SA(b, h) + aoff + m * 2048 + 1024)); } while (0)
#define PG8_LDB(dst, b, h) do { _Pragma("unroll") for (int n = 0; n < 2; ++n) dst[n] = PG8_CAT(*(const LAS i32x4*)(lds + PG8_SB(b, h) + boff + n * 2048), *(const LAS i32x4*)(lds + PG8_SB(b, h) + boff + n * 2048 + 1024)); } while (0)
#define PG8_LO(x) __builtin_bit_cast(bf16x8, __builtin_shufflevector(x, x, 0, 1, 2, 3))
#define PG8_HI(x) __builtin_bit_cast(bf16x8, __builtin_shufflevector(x, x, 4, 5, 6, 7))
#define PG8_MMA(ai, bj, At, Bt) do { __builtin_amdgcn_s_setprio(1); \
        if constexpr (FP8) { _Pragma("unroll") for (int m = 0; m < 4; ++m) _Pragma("unroll") for (int n = 0; n < 2; ++n) \
            asm volatile("v_mfma_scale_f32_16x16x128_f8f6f4 %0, %1, %2, %0, %3, %4 op_sel_hi:[0,0,0]" : "+v"(acc[ai][bj][m][n]) : "v"(Bt[n]), "v"(At[m]), "v"(scw), "v"(sca)); } \
        else { _Pragma("unroll") for (int m = 0; m < 4; ++m) _Pragma("unroll") for (int n = 0; n < 2; ++n) { \
            acc[ai][bj][m][n] = __builtin_amdgcn_mfma_f32_16x16x32_bf16(PG8_LO(Bt[n]), PG8_LO(At[m]), acc[ai][bj][m][n], 0, 0, 0); \
            acc[ai][bj][m][n] = __builtin_amdgcn_mfma_f32_16x16x32_bf16(PG8_HI(Bt[n]), PG8_HI(At[m]), acc[ai][bj][m][n], 0, 0, 0); } } \
        __builtin_amdgcn_s_setprio(0); } while (0)
#define PG8_WAIT_V(n) asm volatile("s_waitcnt vmcnt(" #n ")" ::: "memory")
#define PG8_WAIT_L(n) asm volatile("s_waitcnt lgkmcnt(" #n ")" ::: "memory")
#define PG8_BAR __builtin_amdgcn_s_barrier()
#define PG8_SCHED __builtin_amdgcn_sched_barrier(0)
    Unit cur, nxt; int ui = 0;
    if (!S.next(0, cur)) return;
    int scw = SCALE_W8, sca = SCALE_ONE; if constexpr (FP8) asm volatile("" : "+v"(scw), "+v"(sca));
    f32x4 acc[2][2][4][2];
#pragma unroll
    for (int a = 0; a < 2; ++a)
#pragma unroll
        for (int b = 0; b < 2; ++b)
#pragma unroll
            for (int m = 0; m < 4; ++m)
#pragma unroll
                for (int n = 0; n < 2; ++n) acc[a][b][m][n] = (f32x4){0.f, 0.f, 0.f, 0.f};
    i32x8 At[4], B0[2], B1[2];
    const char* cA = (const char*)g.A + (size_t)cur.pm * tstep; const char* cB = (const char*)g.Bt + cur.boff + (size_t)cur.pn * tstep;
    const char* const gA = (const char*)g.A; unsigned oC[2][2], oN[2][2];
    if constexpr (GATHER) { PG8_OFFS(oC, 0);
#pragma unroll
        for (int h = 0; h < 2; ++h) { oN[h][0] = oC[h][0]; oN[h][1] = oC[h][1]; } }
    if constexpr (SP2) {
        PG8_STAGE(PG8_SB(0, 0), cB); PG8_STAGE(PG8_SB(0, 1), cB + hstep); PG8_STAGEA(PG8_SA(0, 0), cA, (size_t)0, 0, false); PG8_STAGEA(PG8_SA(0, 1), cA + hstep, (size_t)0, 1, false);
        if (wr == 1) PG8_BAR;
        PG8_WAIT_V(2); PG8_BAR;
        PG8_STAGE(PG8_SB(1, 0), cB + kstep); PG8_STAGEA(PG8_SA(1, 0), cA + kstep, kstep, 0, false); PG8_STAGE(PG8_SB(1, 1), cB + hstep + kstep);
        PG8_WAIT_V(6); PG8_BAR;
    } else {
        PG8_STAGE(PG8_SB(0, 0), cB); PG8_STAGE(PG8_SA(0, 0), cA); PG8_STAGE(PG8_SB(0, 1), cB + hstep); PG8_STAGE(PG8_SA(0, 1), cA + hstep);
        if (wr == 1) PG8_BAR;
        PG8_WAIT_V(4); PG8_BAR;
        PG8_STAGE(PG8_SB(1, 0), cB + kstep); PG8_STAGE(PG8_SA(1, 0), cA + kstep); PG8_STAGE(PG8_SB(1, 1), cB + hstep + kstep);
        PG8_WAIT_V(6); PG8_BAR;
    }
    for (;;) {
        const bool has_next = S.next(ui + 1, nxt);
        const char* nA = has_next ? (const char*)g.A + (size_t)nxt.pm * tstep : cA; const char* nB = has_next ? (const char*)g.Bt + nxt.boff + (size_t)nxt.pn * tstep : cB;
        if constexpr (GATHER) { if (has_next) PG8_OFFS(oN, ui + 1); }
#pragma unroll 1
        for (int t = 0; t < nt; t += 2) {
            const bool last = (t == nt - 2);
            const char* a1 = cA + (size_t)(t + 1) * kstep;
            const char* a2 = last ? nA : cA + (size_t)(t + 2) * kstep; const char* b2 = last ? nB : cB + (size_t)(t + 2) * kstep;
            const char* a3 = a2 + kstep; const char* b3 = b2 + kstep;
            const size_t kq1 = (size_t)(t + 1) * kstep, kq2 = last ? (size_t)0 : (size_t)(t + 2) * kstep, kq3 = kq2 + kstep;
            if constexpr (SP2) {
            PG8_LDB(B0, 0, 0); PG8_LDB(B1, 0, 1); PG8_SCHED; PG8_LDA(At, 0, 0); PG8_STAGEA(PG8_SA(1, 1), a1 + hstep, kq1, 1, false);
            PG8_WAIT_V(8); PG8_WAIT_L(0); PG8_BAR; PG8_MMA(0, 0, At, B0); PG8_MMA(0, 1, At, B1); PG8_BAR; PG8_SCHED;
            PG8_LDA(At, 0, 1); PG8_STAGE(PG8_SB(0, 0), b2); PG8_STAGE(PG8_SB(0, 1), b2 + hstep); PG8_STAGEA(PG8_SA(0, 0), a2, kq2, 0, last);
            PG8_WAIT_V(8); PG8_WAIT_L(0); PG8_BAR; PG8_MMA(1, 0, At, B0); PG8_MMA(1, 1, At, B1); PG8_BAR; PG8_SCHED;
            PG8_LDB(B0, 1, 0); PG8_LDB(B1, 1, 1); PG8_SCHED; PG8_LDA(At, 1, 0); PG8_STAGEA(PG8_SA(0, 1), a2 + hstep, kq2, 1, last);
            PG8_WAIT_V(8); PG8_WAIT_L(0); PG8_BAR; PG8_MMA(0, 0, At, B0); PG8_MMA(0, 1, At, B1); PG8_BAR; PG8_SCHED;
            PG8_LDA(At, 1, 1); PG8_STAGE(PG8_SB(1, 0), b3); PG8_STAGE(PG8_SB(1, 1), b3 + hstep); PG8_STAGEA(PG8_SA(1, 0), a3, kq3, 0, last);
            PG8_WAIT_V(8); PG8_WAIT_L(0); PG8_BAR; PG8_MMA(1, 0, At, B0); PG8_MMA(1, 1, At, B1); PG8_BAR; PG8_SCHED;
            } else {
            PG8_LDB(B0, 0, 0); PG8_SCHED; PG8_LDA(At, 0, 0); PG8_STAGE(PG8_SA(1, 1), a1 + hstep);
            PG8_WAIT_L(8); PG8_BAR; PG8_WAIT_L(0); PG8_MMA(0, 0, At, B0); PG8_BAR; PG8_SCHED;
            PG8_LDB(B1, 0, 1); PG8_STAGE(PG8_SB(0, 0), b2);
            PG8_BAR; PG8_WAIT_L(0); PG8_MMA(0, 1, At, B1); PG8_BAR;
            PG8_LDA(At, 0, 1); PG8_STAGE(PG8_SA(0, 0), a2);
            PG8_BAR; PG8_WAIT_L(0); PG8_MMA(1, 0, At, B0); PG8_BAR; PG8_SCHED;
            PG8_STAGE(PG8_SB(0, 1), b2 + hstep);
            PG8_WAIT_V(6); PG8_BAR; PG8_MMA(1, 1, At, B1); PG8_BAR;
            PG8_LDB(B0, 1, 0); PG8_SCHED; PG8_LDA(At, 1, 0); PG8_STAGE(PG8_SA(0, 1), a2 + hstep);
            PG8_WAIT_L(8); PG8_BAR; PG8_WAIT_L(0); PG8_MMA(0, 0, At, B0); PG8_BAR; PG8_SCHED;
            PG8_LDB(B1, 1, 1); PG8_STAGE(PG8_SB(1, 0), b3);
            PG8_BAR; PG8_WAIT_L(0); PG8_MMA(0, 1, At, B1); PG8_BAR;
            PG8_LDA(At, 1, 1); PG8_STAGE(PG8_SA(1, 0), a3);
            PG8_BAR; PG8_WAIT_L(0); PG8_MMA(1, 0, At, B0); PG8_BAR; PG8_SCHED;
            PG8_STAGE(PG8_SB(1, 1), b3 + hstep);
            PG8_WAIT_V(6); PG8_BAR; PG8_MMA(1, 1, At, B1); PG8_BAR;
            }
        }
        if constexpr (ALIGN_EPI) { if (wr == 0) PG8_BAR; }
        if constexpr (FP8) asm volatile("s_nop 15\n\ts_nop 15" ::: "memory");
        { int fr_ = fr, fq_ = fq; asm volatile("" : "+v"(fr_), "+v"(fq_)); E(acc, cur, wr, wc, fr_, fq_); }
        if (!has_next) break;
#pragma unroll
        for (int a = 0; a < 2; ++a)
#pragma unroll
            for (int b = 0; b < 2; ++b)
#pragma unroll
                for (int m = 0; m < 4; ++m)
#pragma unroll
                    for (int n = 0; n < 2; ++n) acc[a][b][m][n] = (f32x4){0.f, 0.f, 0.f, 0.f};
        cur = nxt; cA = nA; cB = nB; ++ui;
        if constexpr (GATHER) {
#pragma unroll
            for (int h = 0; h < 2; ++h) { oC[h][0] = oN[h][0]; oC[h][1] = oN[h][1]; } }
        if constexpr (ALIGN_EPI) { if (wr == 1) PG8_BAR; }
    }
    PG8_WAIT_V(0);
    if constexpr (!ALIGN_EPI) { if (wr == 0) PG8_BAR; }
    PG8_BAR;
#undef PG8_SA
#undef PG8_SB
#undef PG8_STAGE
#undef PG8_STAGEA
#undef PG8_OFFS
#undef PG8_LDA
#undef PG8_LDB
#undef PG8_CAT
#undef PG8_LO
#undef PG8_HI
#undef PG8_MMA
#undef PG8_WAIT_V
#undef PG8_WAIT_L
#undef PG8_BAR
#undef PG8_SCHED
}

typedef const f32x4 (&AccRef)[2][2][4][2];

struct EpiAB {
    bf16* Z; const float* cs;
    __device__ __forceinline__ void operator()(AccRef acc, const Unit& u, int wr, int wc, int fr, int fq) const {
        const int sec = u.pn >> 2, ct = u.pn & 3;
        bf16* base = Z + (size_t)sec * ZSEC;
#pragma unroll
        for (int ai = 0; ai < 2; ++ai)
#pragma unroll
            for (int m = 0; m < 4; ++m) {
                const int row = u.pm * BM + ai * HALF + wr * 64 + m * 16 + fr;
                if (sec < 2) {
                    const float sc = sec == 0 ? QK_SCALE : 1.0f;
                    const f32x4 x1a = acc[ai][0][m][0], x1b = acc[ai][0][m][1], x2a = acc[ai][1][m][0], x2b = acc[ai][1][m][1];
                    f32x4 o1a, o1b, o2a, o2b;
                    if (row < NLAT) {
                        const int t = row & (TL - 1); const int pos = (wc & 1) ? (t & 63) : (t >> 6);
                        const float* cp = cs + pos * 32 + 8 * fq;
                        const f32x4 c0 = *(const f32x4*)cp, c1 = *(const f32x4*)(cp + 4), s0 = *(const f32x4*)(cp + 2048), s1 = *(const f32x4*)(cp + 2052);
                        o1a = (x1a * c0 - x2a * s0) * sc; o1b = (x1b * c1 - x2b * s1) * sc; o2a = (x1a * s0 + x2a * c0) * sc; o2b = (x1b * s1 + x2b * c1) * sc;
                    } else { o1a = x1a * sc; o1b = x1b * sc; o2a = x2a * sc; o2b = x2b * sc; }
                    bf16* dst = base + (size_t)row * RW + (2 * ct + (wc >> 1)) * HD + 32 * (wc & 1) + 8 * fq;
                    *(u32x4*)dst = pack8(o1a, o1b); *(u32x4*)(dst + 64) = pack8(o2a, o2b);
                } else {
#pragma unroll
                    for (int bj = 0; bj < 2; ++bj) {
                        f32x4 v0 = acc[ai][bj][m][0], v1 = acc[ai][bj][m][1];
                        if (sec == 3) {
#pragma unroll
                            for (int j = 0; j < 4; ++j) { v0[j] = silu_f(v0[j]); v1[j] = silu_f(v1[j]); }
                        } else if (sec >= 4) {
#pragma unroll
                            for (int j = 0; j < 4; ++j) { v0[j] = gelu_tanh_f(v0[j]); v1[j] = gelu_tanh_f(v1[j]); }
                        }
                        *(u32x4*)(base + (size_t)row * RW + ct * 256 + bj * HALF + wc * 32 + 8 * fq) = pack8(v0, v1);
                    }
                }
            }
    }
};
struct EpiRes {
    float* X; const float* base_lat; const float* base_ctx; const float* gate;
    __device__ __forceinline__ void operator()(AccRef acc, const Unit& u, int wr, int wc, int fr, int fq) const {
        const int r = u.pm < 64 ? (u.pm >> 4) : 4; const int col0 = u.pn * BM + wc * 32 + 8 * fq;
        const float* gp = gate + (size_t)r * MODW + col0;
        const float* bs = u.pm < 64 ? base_lat + (size_t)(u.pm * BM) * D : base_ctx + (size_t)(u.pm * BM - NLAT) * D;
        f32x4 g0[2], g1[2];
#pragma unroll
        for (int bj = 0; bj < 2; ++bj) { g0[bj] = *(const f32x4*)(gp + bj * HALF); g1[bj] = *(const f32x4*)(gp + bj * HALF + 4); }
#pragma unroll
        for (int ai = 0; ai < 2; ++ai)
#pragma unroll
            for (int m = 0; m < 4; ++m) { const size_t ro = (size_t)(ai * HALF + wr * 64 + m * 16 + fr) * D + col0; float* rowp = X + (size_t)(u.pm * BM) * D + ro; const float* bp = bs + ro;
#pragma unroll
                for (int bj = 0; bj < 2; ++bj) { f32x4 x0 = *(const f32x4*)(bp + bj * HALF), x1 = *(const f32x4*)(bp + bj * HALF + 4);
                    x0 += g0[bj] * acc[ai][bj][m][0]; x1 += g1[bj] * acc[ai][bj][m][1]; *(f32x4*)(rowp + bj * HALF) = x0; *(f32x4*)(rowp + bj * HALF + 4) = x1; } }
    }
};
struct EpiCV {
    bf16* GB; bf16* XG;
    __device__ __forceinline__ void operator()(AccRef acc, const Unit& u, int wr, int wc, int fr, int fq) const {
#pragma unroll
        for (int ai = 0; ai < 2; ++ai)
#pragma unroll
            for (int m = 0; m < 4; ++m) { const size_t row = (size_t)(u.pm * BM + ai * HALF + wr * 64 + m * 16 + fr);
                if (u.pn < 8) {
#pragma unroll
                    for (int bj = 0; bj < 2; ++bj) *(u32x4*)(GB + row * D + u.pn * 256 + bj * HALF + wc * 32 + 8 * fq) = pack8(acc[ai][bj][m][0], acc[ai][bj][m][1]);
                } else {
                    *(u32x4*)(XG + row * D + (u.pn - 8) * HALF + wc * 32 + 8 * fq) = pack8(acc[ai][0][m][0] * acc[ai][1][m][0], acc[ai][0][m][1] * acc[ai][1][m][1]);
                } }
    }
};
struct EpiMoe1 {
    unsigned char* H;
    __device__ __forceinline__ void operator()(AccRef acc, const Unit& u, int wr, int wc, int fr, int fq) const {
#pragma unroll
        for (int ai = 0; ai < 2; ++ai)
#pragma unroll
            for (int m = 0; m < 4; ++m) { const size_t row = (size_t)(u.pm * BM + ai * HALF + wr * 64 + m * 16 + fr);
                f32x4 a0 = acc[ai][0][m][0], a1 = acc[ai][0][m][1];
#pragma unroll
                for (int j = 0; j < 4; ++j) { a0[j] = silu_f(a0[j]); a1[j] = silu_f(a1[j]); }
                *(u32x2*)(H + row * DE + u.pn * HALF + wc * 32 + 8 * fq) = pack8_fp8(a0 * acc[ai][1][m][0], a1 * acc[ai][1][m][1]); }
    }
};
struct EpiMoe2 {
    bf16* Y;
    __device__ __forceinline__ void operator()(AccRef acc, const Unit& u, int wr, int wc, int fr, int fq) const {
#pragma unroll
        for (int ai = 0; ai < 2; ++ai)
#pragma unroll
            for (int m = 0; m < 4; ++m) { const size_t row = (size_t)(u.pm * BM + ai * HALF + wr * 64 + m * 16 + fr);
#pragma unroll
                for (int bj = 0; bj < 2; ++bj) *(u32x4*)(Y + row * D + u.pn * 256 + bj * HALF + wc * 32 + 8 * fq) = pack8(acc[ai][bj][m][0], acc[ai][bj][m][1]); }
    }
};
}

#define XB_TMO      128
#define XB_XCNT(j)  (256  + 64 * (j))
#define XB_XSUB(j)  (1280 + 64 * (j))
#define XB_XGEN(j)  (2304 + 64 * (j))
#define XB_TOP      3328
#define XB_TOPGEN   3392
#define XCD_BAR_WORDS 3456
#define XB_SPIN_CAP (1u << 18)
__device__ __forceinline__ unsigned xb_ld(unsigned* p)              { return __hip_atomic_load(p, __ATOMIC_RELAXED, __HIP_MEMORY_SCOPE_AGENT); }
__device__ __forceinline__ unsigned xb_add(unsigned* p, unsigned v) { return __hip_atomic_fetch_add(p, v, __ATOMIC_RELAXED, __HIP_MEMORY_SCOPE_AGENT); }
__device__ __forceinline__ unsigned xb_xcc_id() { return (unsigned)__builtin_amdgcn_s_getreg((3 << 11) | 20) & 0xFu; }
#define XB_SPIN(cond, bar) do { unsigned _sp = 0; while (cond) { __builtin_amdgcn_s_sleep(1); \
    if ((++_sp & 255u) == 0u) { if (xb_ld(&(bar)[XB_TMO])) break; if (_sp > XB_SPIN_CAP) { atomicAdd(&(bar)[XB_TMO], 1u); break; } } } } while (0)
struct XcdBarrier { unsigned* bar; unsigned x; volatile LAS unsigned* st; };
__device__ __forceinline__ XcdBarrier xcd_barrier_post(unsigned* bar, volatile LAS unsigned* st) {
    XcdBarrier b; b.bar = bar; b.x = xb_xcc_id(); b.st = st;
    if (threadIdx.x == 0) (void)xb_add(&bar[XB_XCNT(b.x)], 1u);
    return b;
}
__device__ __forceinline__ void xcd_barrier_complete(unsigned* bar, unsigned x, unsigned& nloc, unsigned& nx) {
    const unsigned G = gridDim.x * gridDim.y * gridDim.z;
    unsigned sum, cnt, mine, sp = 0u;
    for (;;) {
        sum = 0u; cnt = 0u; mine = 0u;
#pragma unroll
        for (unsigned j = 0; j < 16; ++j) { const unsigned c = xb_ld(&bar[XB_XCNT(j)]); sum += c; cnt += (c > 0u) ? 1u : 0u; mine = (j == x) ? c : mine; }
        if (sum == G) break;
        __builtin_amdgcn_s_sleep(1);
        if ((++sp & 255u) == 0u) { if (xb_ld(&bar[XB_TMO])) break; if (sp > XB_SPIN_CAP) { atomicAdd(&bar[XB_TMO], 1u); break; } }
    }
    nloc = mine > 0u ? mine : 1u; nx = cnt > 0u ? cnt : 1u;
}
__device__ __forceinline__ void xcd_barrier(const XcdBarrier& b) {
    asm volatile("s_waitcnt vmcnt(0)" ::: "memory");
    __syncthreads();
    if (threadIdx.x == 0) {
        unsigned* bar = b.bar;
        __builtin_amdgcn_s_waitcnt(0);
        unsigned nloc = b.st[0], nx = b.st[1];
        if (nloc == 0u) { xcd_barrier_complete(bar, b.x, nloc, nx); b.st[0] = nloc; b.st[1] = nx; }
        const unsigned old = xb_add(&bar[XB_XSUB(b.x)], 1u);
        const unsigned gen = old / nloc;
        if (old + 1u == (gen + 1u) * nloc) {
            __builtin_amdgcn_fence(__ATOMIC_RELEASE, "agent");
            asm volatile("s_waitcnt vmcnt(0)" ::: "memory");
            const unsigned og = xb_add(&bar[XB_TOP], 1u);
            const unsigned tg = og / nx;
            if (og + 1u == (tg + 1u) * nx) xb_add(&bar[XB_TOPGEN], 1u);
            else XB_SPIN(xb_ld(&bar[XB_TOPGEN]) == tg, bar);
            __builtin_amdgcn_fence(__ATOMIC_ACQUIRE, "agent");
            xb_add(&bar[XB_XGEN(b.x)], 1u);
            asm volatile("s_waitcnt vmcnt(0)" ::: "memory");
        } else {
            XB_SPIN(xb_ld(&bar[XB_XGEN(b.x)]) == gen, bar);
            __builtin_amdgcn_fence(__ATOMIC_ACQUIRE, "agent");
            asm volatile("s_waitcnt vmcnt(0)" ::: "memory");
        }
    }
    __syncthreads();
}

struct Args {
    const float *x, *c, *ctx, *c_ctx, *w_mod, *b_mod, *g_mix, *g_ffn, *ab_w_in, *ab_w_out, *decay, *sgu_w, *sgu_b,
                *cv_w_in, *cv_cw, *cv_cb, *cv_w_out, *w_r1, *b_r1, *w_r2, *b_r2, *w1, *w3, *w2, *g_final;
    float* out; unsigned char* ws; int ph_lo, ph_hi;
};
struct Frame { LAS unsigned char* lds; volatile LAS unsigned* MISC; int wave, G, blk; };
#define FR_LANE_TID const int lane_ = lane_id(); const int tid_ = F.wave * 64 + lane_

enum { PH_PRO = 0, PH_L0 = 1, PH_PER_LAYER = 10, PH_FINAL = 21, NPHASE = 22 };
enum { K_PRE = 0, K_GIN = 1, K_MID1 = 2, K_MID2 = 3, K_MID3 = 4, K_GOUT = 5, K_ROUTE = 6, K_GATHER = 7, K_MOE1 = 8, K_MOE2 = 9 };

__device__ __forceinline__ int pos32(int x) { return 16 * ((x >> 2) & 1) + 4 * (x >> 3) + (x & 3); }
__device__ __forceinline__ void transpose_item(const float* W, int K, int N, bf16* WT, int kb, int nb, int dgrp, LAS float* scr, int lane) {
    const int k0 = 64 * kb, n0 = 32 * nb;
    const float* src = W + (size_t)(k0 + (lane >> 3)) * N + n0 + 4 * (lane & 7);
    f32x4 v[8];
#pragma unroll
    for (int i = 0; i < 8; ++i) v[i] = *(const f32x4*)(src + (size_t)(8 * i) * N);
#pragma unroll
    for (int i = 0; i < 8; ++i) { LAS float* d = scr + ((lane >> 3) + 8 * i) * 33 + 4 * (lane & 7); d[0] = v[i][0]; d[1] = v[i][1]; d[2] = v[i][2]; d[3] = v[i][3]; }
    asm volatile("s_waitcnt lgkmcnt(0)" ::: "memory");
    const int c = lane & 7;
#pragma unroll
    for (int j = 0; j < 4; ++j) { const int n = (lane >> 3) + 8 * j; const LAS float* s = scr + (8 * c) * 33 + n;
        u32x4 o; o.x = cvt_pk_bf16(s[0 * 33], s[1 * 33]); o.y = cvt_pk_bf16(s[2 * 33], s[3 * 33]); o.z = cvt_pk_bf16(s[4 * 33], s[5 * 33]); o.w = cvt_pk_bf16(s[6 * 33], s[7 * 33]);
        *(u32x4*)(WT + (size_t)(dgrp * 32 + pos32(n)) * K + k0 + 8 * c) = o; }
    asm volatile("s_waitcnt lgkmcnt(0)" ::: "memory");
}
__device__ __forceinline__ void transpose_item_fp8(const float* W, int K, int N, unsigned char* WT, int kb, int nb, int dgrp, LAS float* scr, int lane) {
    const int k0 = 64 * kb, n0 = 32 * nb;
    const float* src = W + (size_t)(k0 + (lane >> 3)) * N + n0 + 4 * (lane & 7);
    f32x4 v[8];
#pragma unroll
    for (int i = 0; i < 8; ++i) v[i] = *(const f32x4*)(src + (size_t)(8 * i) * N);
#pragma unroll
    for (int i = 0; i < 8; ++i) { LAS float* d = scr + ((lane >> 3) + 8 * i) * 33 + 4 * (lane & 7); d[0] = v[i][0] * W8_SCALE; d[1] = v[i][1] * W8_SCALE; d[2] = v[i][2] * W8_SCALE; d[3] = v[i][3] * W8_SCALE; }
    asm volatile("s_waitcnt lgkmcnt(0)" ::: "memory");
    const int c = lane & 7;
#pragma unroll
    for (int j = 0; j < 4; ++j) { const int n = (lane >> 3) + 8 * j; const LAS float* s = scr + (8 * c) * 33 + n;
        u32x2 o; o.x = pk4_fp8(s[0 * 33], s[1 * 33], s[2 * 33], s[3 * 33]); o.y = pk4_fp8(s[4 * 33], s[5 * 33], s[6 * 33], s[7 * 33]);
        *(u32x2*)(WT + (size_t)(dgrp * 32 + pos32(n)) * K + k0 + 8 * c) = o; }
    asm volatile("s_waitcnt lgkmcnt(0)" ::: "memory");
}
__device__ __forceinline__ void phase_prologue(const Args& a, Frame& F) {
    FR_LANE_TID;
    unsigned char* ws = a.ws;
    {
        LAS float* S = (LAS float*)(F.lds + 69632);
        LAS float* red = (LAS float*)(F.lds + 110592);
        for (int i = tid_; i < 5 * D; i += 512) { const int r = i / D, k = i % D; const float v = r < 4 ? a.c[r * D + k] : a.c_ctx[k]; S[i] = silu_f(v); }
        __syncthreads();
        if (F.blk < 256) {
            const int Lm = F.blk >> 7, strip = F.blk & 127;
            const int rsub = lane_ / 24, c4 = lane_ % 24;
            float acc[5][4];
#pragma unroll
            for (int r = 0; r < 5; ++r) { acc[r][0] = 0.f; acc[r][1] = 0.f; acc[r][2] = 0.f; acc[r][3] = 0.f; }
            if (rsub < 2) {
                const float* wp = a.w_mod + (size_t)Lm * D * MODW + (size_t)(256 * F.wave + rsub) * MODW + 96 * strip + 4 * c4;
#pragma unroll 8
                for (int it = 0; it < 128; ++it) {
                    const f32x4 w = *(const f32x4*)(wp + (size_t)(2 * it) * MODW);
                    const int k = 256 * F.wave + 2 * it + rsub;
#pragma unroll
                    for (int r = 0; r < 5; ++r) { const float s = S[r * D + k]; acc[r][0] += s * w[0]; acc[r][1] += s * w[1]; acc[r][2] += s * w[2]; acc[r][3] += s * w[3]; }
                }
#pragma unroll
                for (int r = 0; r < 5; ++r)
#pragma unroll
                    for (int j = 0; j < 4; ++j) red[(F.wave * 2 + rsub) * 480 + r * 96 + 4 * c4 + j] = acc[r][j];
            }
            __syncthreads();
            if (tid_ < 480) { float s = 0.f;
#pragma unroll
                for (int p = 0; p < 16; ++p) s += red[p * 480 + tid_];
                const int r = tid_ / 96, cc = tid_ % 96; const int col = 96 * strip + cc;
                ((float*)(ws + WS_MOD))[(size_t)(Lm * 5 + r) * MODW + col] = s + a.b_mod[Lm * MODW + col]; }
        }
        __syncthreads();
    }
    {
        const int gt = F.blk * 512 + tid_, NT = F.G * 512;
        float* cs = (float*)(ws + WS_ROPE);
        for (int i = gt; i < 2048; i += NT) { const int pos = i >> 5, f = i & 31; const float inv = powf(10000.0f, -(float)f / 32.0f); const float ang = (float)pos * inv; cs[i] = cosf(ang); cs[2048 + i] = sinf(ang); }
        float* wr = (float*)(ws + WS_WR);
        for (int i = gt; i < 2 * 20 * D; i += NT) { const int L = i / (20 * D), r = (i / D) % 20, k = i % D;
            float v; if (r < 4) v = a.w_r1[((size_t)L * D + k) * 4 + r]; else { const int g = (r - 4) >> 2, e = (r - 4) & 3; v = a.w_r2[(((size_t)L * 4 + g) * D + k) * 4 + e]; }
            wr[i] = v; }
    }
    {
        LAS float* scr = (LAS float*)(F.lds + F.wave * 8448);
        const int gw = F.blk * 8 + F.wave, NGW = F.G * 8;
        constexpr int I_IN = 32 * 192, I_OUT = 32 * 64, I_FIX = 2 * I_IN + 2 * I_OUT, I_EXP = 3072, NITEMS = I_FIX + 32 * I_EXP;
        for (int it = gw; it < NITEMS; it += NGW) {
            if (it < I_IN) {
                const int kb = it / 192, nb = it % 192; const int n = nb * 32, sec = n >> 10; int dg;
                if (sec < 2) { const int h = (n & 1023) >> 7, dgi = (n & 127) >> 5; dg = (sec * 4 + (h >> 1)) * 8 + (dgi >> 1) * 4 + (h & 1) * 2 + (dgi & 1); } else dg = nb;
                transpose_item(a.ab_w_in, D, 6144, (bf16*)(ws + WS_WAB_IN), kb, nb, dg, scr, lane_);
            } else if (it < I_IN + I_OUT) { const int r = it - I_IN; transpose_item(a.ab_w_out, D, D, (bf16*)(ws + WS_WAB_OUT), r / 64, r % 64, r % 64, scr, lane_);
            } else if (it < 2 * I_IN + I_OUT) {
                const int r = it - I_IN - I_OUT; const int kb = r / 192, nb = r % 192; const int n = nb * 32; int dg;
                if (n < 2048) dg = nb; else if (n < 4096) { const int cc = n - 2048; dg = (8 + (cc >> 7)) * 8 + ((cc & 127) >> 5); } else { const int cc = n - 4096; dg = (8 + (cc >> 7)) * 8 + 4 + ((cc & 127) >> 5); }
                transpose_item(a.cv_w_in, D, 6144, (bf16*)(ws + WS_WCV_IN), kb, nb, dg, scr, lane_);
            } else if (it < I_FIX) { const int r = it - 2 * I_IN - I_OUT; transpose_item(a.cv_w_out, D, D, (bf16*)(ws + WS_WCV_OUT), r / 64, r % 64, r % 64, scr, lane_);
            } else {
                const int idx = it - I_FIX; const int le = idx / I_EXP, r = idx % I_EXP, which = r >> 10, item = r & 1023;
                if (which < 2) {
                    const int kb = item >> 5, nb = item & 31; const int cc = nb * 32; const int dg = (cc >> 7) * 8 + which * 4 + ((cc & 127) >> 5);
                    transpose_item_fp8((which ? a.w3 : a.w1) + (size_t)le * D * DE, D, DE, ws + WS_W13 + (size_t)le * D * D, kb, nb, dg, scr, lane_);
                } else {
                    const int kb = item >> 6, nb = item & 63;
                    transpose_item_fp8(a.w2 + (size_t)le * DE * D, DE, D, ws + WS_W2 + (size_t)le * D * DE, kb, nb, nb, scr, lane_);
                }
            }
        }
    }
}

__device__ __forceinline__ int moe_tables(const Args& a, Frame& F, int L) {
    FR_LANE_TID;
    volatile LAS int* tb = (volatile LAS int*)(F.MISC + MI_TB); volatile LAS int* texp = (volatile LAS int*)(F.MISC + MI_TEXP); volatile LAS int* cn = (volatile LAS int*)(F.MISC + MI_LCNT);
    __syncthreads();
    if (tid_ == 0) { unsigned* cnt = (unsigned*)(a.ws + WS_CTL) + CW_CNT + L * 64; int acc = 0;
        for (int e = 0; e < NE; ++e) { tb[e] = acc; const int c = (int)xb_ld(cnt + e); cn[e] = c; const int n = (c + 255) >> 8; for (int t = 0; t < n && acc + t < 160; ++t) texp[acc + t] = e; acc += n; }
        tb[NE] = acc; }
    __syncthreads();
    return tb[NE];
}
__device__ __forceinline__ void combine_row(f32x4 (&v)[8], const bf16* Y, const int* ridx, const float* rwt, const float* gate, const volatile LAS int* tb, int row, int lane) {
    const i32x4 ri = *(const i32x4*)(ridx + 4 * (size_t)row); const f32x2 w = *(const f32x2*)(rwt + 2 * (size_t)row);
    const int d0 = tb[ri.x] * 256 + ri.y, d1 = tb[ri.z] * 256 + ri.w;
    const bf16* y0 = Y + (size_t)d0 * D + 4 * lane; const bf16* y1 = Y + (size_t)d1 * D + 4 * lane;
#pragma unroll
    for (int j = 0; j < 8; ++j) { const u32x2 p0 = *(const u32x2*)(y0 + 256 * j), p1 = *(const u32x2*)(y1 + 256 * j); const f32x4 g = *(const f32x4*)(gate + 4 * lane + 256 * j);
        v[j][0] += g[0] * (w.x * bf2f(p0.x & 0xffffu) + w.y * bf2f(p1.x & 0xffffu)); v[j][1] += g[1] * (w.x * bf2f(p0.x >> 16) + w.y * bf2f(p1.x >> 16));
        v[j][2] += g[2] * (w.x * bf2f(p0.y & 0xffffu) + w.y * bf2f(p1.y & 0xffffu)); v[j][3] += g[3] * (w.x * bf2f(p0.y >> 16) + w.y * bf2f(p1.y >> 16)); }
}
__device__ __forceinline__ float row_rstd(const f32x4 (&v)[8]) {
    float ss = 0.f;
#pragma unroll
    for (int j = 0; j < 8; ++j) ss += (v[j][0] * v[j][0] + v[j][1] * v[j][1]) + (v[j][2] * v[j][2] + v[j][3] * v[j][3]);
    return rsqrtf(wave_sum(ss) * (1.0f / D) + EPSN);
}
__device__ __forceinline__ void phase_pre(const Args& a, Frame& F, int L) {
    FR_LANE_TID;
    unsigned char* ws = a.ws; float* XB = (float*)(ws + WS_XB); bf16* A = (bf16*)(ws + WS_A);
    const float* MOD = (const float*)(ws + WS_MOD);
    const int nrows = (L == 0) ? NTOK : NLAT;
    const int gw = F.blk * 8 + F.wave, NGW = F.G * 8;
    if (L > 0) (void)moe_tables(a, F, L - 1);
    const volatile LAS int* tb = (const volatile LAS int*)(F.MISC + MI_TB);
    for (int row = gw; row < nrows; row += NGW) {
        const int r = row < NLAT ? row >> 12 : 4;
        int ln4 = 4 * lane_; asm volatile("" : "+v"(ln4));
        f32x4 v[8];
        if (L == 0) { const float* src = row < NLAT ? a.x + (size_t)row * D : a.ctx + (size_t)(row - NLAT) * D;
#pragma unroll
            for (int j = 0; j < 8; ++j) v[j] = *(const f32x4*)(src + ln4 + 256 * j);
        } else {
#pragma unroll
            for (int j = 0; j < 8; ++j) v[j] = *(const f32x4*)(XB + (size_t)row * D + ln4 + 256 * j);
            combine_row(v, (const bf16*)(ws + WS_R2), (const int*)(ws + WS_RIDX) + (size_t)(L - 1) * NTOK * 4, (const float*)(ws + WS_RWT) + (size_t)(L - 1) * NTOK * 2,
                        MOD + (size_t)((L - 1) * 5 + r) * MODW + 5 * D, tb, row, lane_);
#pragma unroll
            for (int j = 0; j < 8; ++j) *(f32x4*)(XB + (size_t)row * D + ln4 + 256 * j) = v[j];
        }
        const float rstd = row_rstd(v);
        const float* mp = MOD + (size_t)(L * 5 + r) * MODW; const float* gm = a.g_mix + L * D;
#pragma unroll
        for (int j = 0; j < 8; ++j) { const int c = ln4 + 256 * j; const f32x4 g = *(const f32x4*)(gm + c), sh = *(const f32x4*)(mp + c), sc = *(const f32x4*)(mp + D + c);
            const f32x4 o = v[j] * rstd * g * (sc + 1.0f) + sh; u32x2 p; p.x = cvt_pk_bf16(o[0], o[1]); p.y = cvt_pk_bf16(o[2], o[3]); *(u32x2*)(A + (size_t)row * D + c) = p; }
    }
}

constexpr int LDP = 136;
constexpr int IMG = 128 * LDP * 2;
__device__ __forceinline__ int unit_row0(int b, int s) { return s < 2 ? NLAT + b * TCX + s * 128 : b * TL + (s - 2) * 128; }
__device__ __forceinline__ void piece_rc(int q, int& j, int& ch) { const int jr = q & 15, cq = (q >> 4) & 3, blk = q >> 6; j = 16 * (blk & 7) + jr; ch = 4 * (blk >> 3) + cq; }

__device__ __forceinline__ void ret_u_unit(const Args& a, Frame& F, int u) {
    FR_LANE_TID;
    unsigned char* ws = a.ws; const bf16* Z = (const bf16*)(ws + WS_R1);
    const int bh = u / NSLOT, s = u % NSLOT, b = bh >> 3, h = bh & 7; const int row0 = unit_row0(b, s);
    const bf16* Kp = Z + 1 * ZSEC + (size_t)row0 * RW + h * HD; const bf16* Vp = Z + 2 * ZSEC + (size_t)row0 * RW + h * HD;
    const float lgf2 = logsig(a.decay[h]) * LOG2E, lgb2 = logsig(a.decay[NH + h]) * LOG2E;
    LAS bf16* KTf = (LAS bf16*)(F.lds); LAS bf16* KTb = (LAS bf16*)(F.lds + IMG); LAS bf16* VT = (LAS bf16*)(F.lds + 2 * IMG);
#pragma unroll
    for (int k = 0; k < 4; ++k) { int j, ch; piece_rc(tid_ + 512 * k, j, ch);
        const u32x4 kv = *(const u32x4*)(Kp + (size_t)j * RW + 8 * ch), vv = *(const u32x4*)(Vp + (size_t)j * RW + 8 * ch);
        const float ff = exp2f((float)(127 - j) * lgf2), fb = exp2f((float)j * lgb2);
#pragma unroll
        for (int i = 0; i < 8; ++i) { const unsigned kw = (i & 1) ? (kv[i >> 1] >> 16) : (kv[i >> 1] & 0xffffu), vw = (i & 1) ? (vv[i >> 1] >> 16) : (vv[i >> 1] & 0xffffu);
            const float kf = bf2f(kw); const unsigned pf = cvt_pk_bf16(kf * ff, kf * fb);
            KTf[(8 * ch + i) * LDP + j] = (bf16)(pf & 0xffffu); KTb[(8 * ch + i) * LDP + j] = (bf16)(pf >> 16); VT[(8 * ch + i) * LDP + j] = (bf16)vw; } }
    __syncthreads();
    const int fr = lane_ & 15, g = lane_ >> 4, dt = F.wave;
    f32x4 accf[8], accb[8];
#pragma unroll
    for (int e = 0; e < 8; ++e) { accf[e] = (f32x4){0.f, 0.f, 0.f, 0.f}; accb[e] = (f32x4){0.f, 0.f, 0.f, 0.f}; }
#pragma unroll
    for (int sI = 0; sI < 4; ++sI) {
        const bf16x8 af = *(const LAS bf16x8*)(KTf + (16 * dt + fr) * LDP + 32 * sI + 8 * g), ab = *(const LAS bf16x8*)(KTb + (16 * dt + fr) * LDP + 32 * sI + 8 * g);
#pragma unroll
        for (int et = 0; et < 8; ++et) { const bf16x8 bv = *(const LAS bf16x8*)(VT + (16 * et + fr) * LDP + 32 * sI + 8 * g);
            accf[et] = __builtin_amdgcn_mfma_f32_16x16x32_bf16(af, bv, accf[et], 0, 0, 0); accb[et] = __builtin_amdgcn_mfma_f32_16x16x32_bf16(ab, bv, accb[et], 0, 0, 0); }
    }
    float* ST = (float*)(ws + WS_R2) + (size_t)u * 2 * 16384;
#pragma unroll
    for (int et = 0; et < 8; ++et) { *(f32x4*)(ST + (size_t)(16 * et + fr) * 128 + 16 * dt + 4 * g) = accf[et]; *(f32x4*)(ST + 16384 + (size_t)(16 * et + fr) * 128 + 16 * dt + 4 * g) = accb[et]; }
    __syncthreads();
}
__device__ __forceinline__ void sgu_unit(const Args& a, Frame& F, int u) {
    FR_LANE_TID;
    unsigned char* ws = a.ws; const bf16* Z = (const bf16*)(ws + WS_R1); bf16* RS = (bf16*)(ws + WS_R3);
    const int bg = u / NSLOT, s = u % NSLOT, b = bg >> 3, grp = bg & 7; const int row0 = unit_row0(b, s);
    const bf16* Up = Z + 4 * ZSEC + (size_t)row0 * RW + grp * HD; const bf16* Vp = Z + 5 * ZSEC + (size_t)row0 * RW + grp * HD;
    LAS bf16* WS_ = (LAS bf16*)(F.lds); LAS bf16* VT = (LAS bf16*)(F.lds + IMG);
    const float* wsrc = a.sgu_w + (size_t)grp * 16384;
#pragma unroll
    for (int k = 0; k < 8; ++k) { const int i4 = tid_ + 512 * k; const int p = i4 >> 5, q4 = (i4 & 31) * 4; const f32x4 w = *(const f32x4*)(wsrc + p * 128 + q4);
        u32x2 o; o.x = cvt_pk_bf16(w[0], w[1]); o.y = cvt_pk_bf16(w[2], w[3]); *(LAS u32x2*)(WS_ + p * LDP + q4) = o; }
    { const int q = tid_ >> 2, part = tid_ & 3; float x[32];
#pragma unroll
        for (int k = 0; k < 4; ++k) { const u32x4 vv = *(const u32x4*)(Vp + (size_t)q * RW + 32 * part + 8 * k);
#pragma unroll
            for (int i = 0; i < 4; ++i) { x[8 * k + 2 * i] = bf2f(vv[i] & 0xffffu); x[8 * k + 2 * i + 1] = bf2f(vv[i] >> 16); } }
        float sm = 0.f;
#pragma unroll
        for (int i = 0; i < 32; ++i) sm += x[i];
        sm += __shfl_xor(sm, 1); sm += __shfl_xor(sm, 2); const float mu = sm * (1.0f / 128.0f);
        float sq = 0.f;
#pragma unroll
        for (int i = 0; i < 32; ++i) { const float dlt = x[i] - mu; sq += dlt * dlt; }
        sq += __shfl_xor(sq, 1); sq += __shfl_xor(sq, 2); const float rstd = rsqrtf(sq * (1.0f / 128.0f) + EPSN);
#pragma unroll
        for (int i = 0; i < 32; i += 2) { const unsigned p2 = cvt_pk_bf16((x[i] - mu) * rstd, (x[i + 1] - mu) * rstd);
            VT[(32 * part + i) * LDP + q] = (bf16)(p2 & 0xffffu); VT[(32 * part + i + 1) * LDP + q] = (bf16)(p2 >> 16); } }
    __syncthreads();
    const int fr = lane_ & 15, g = lane_ >> 4, pt = F.wave;
    f32x4 acc[8];
#pragma unroll
    for (int c = 0; c < 8; ++c) acc[c] = (f32x4){0.f, 0.f, 0.f, 0.f};
#pragma unroll
    for (int sI = 0; sI < 4; ++sI) { const bf16x8 bw = *(const LAS bf16x8*)(WS_ + (16 * pt + fr) * LDP + 32 * sI + 8 * g);
#pragma unroll
        for (int ct = 0; ct < 8; ++ct) { const bf16x8 av = *(const LAS bf16x8*)(VT + (16 * ct + fr) * LDP + 32 * sI + 8 * g);
            acc[ct] = __builtin_amdgcn_mfma_f32_16x16x32_bf16(av, bw, acc[ct], 0, 0, 0); } }
    const int p = 16 * pt + fr; const float bs = a.sgu_b[grp * 128 + p];
#pragma unroll
    for (int ct = 0; ct < 8; ++ct) { const int c = 16 * ct + 4 * g; const u32x2 uu = *(const u32x2*)(Up + (size_t)p * RW + c);
        const float o0 = bf2f(uu.x & 0xffffu) * (acc[ct][0] + bs), o1 = bf2f(uu.x >> 16) * (acc[ct][1] + bs), o2 = bf2f(uu.y & 0xffffu) * (acc[ct][2] + bs), o3 = bf2f(uu.y >> 16) * (acc[ct][3] + bs);
        u32x2 o; o.x = cvt_pk_bf16(o0, o1); o.y = cvt_pk_bf16(o2, o3); *(u32x2*)(RS + (size_t)(row0 + p) * D + RW + grp * HD + c) = o; }
    __syncthreads();
}
__device__ __forceinline__ void phase_scan(const Args& a, Frame& F) {
    FR_LANE_TID;
    float* ST = (float*)(a.ws + WS_R2);
    const int NT = F.G * 512;
    for (int it = F.blk * 512 + tid_; it < 32 * 2 * 4096; it += NT) {
        const int bh = it >> 13, dir = (it >> 12) & 1, e4 = it & 4095, h = bh & 7;
        const float cd = expf(128.0f * logsig(a.decay[dir * NH + h]));
        float* base = ST + ((size_t)bh * NSLOT * 2 + dir) * 16384 + (size_t)e4 * 4;
        f32x4 st = (f32x4){0.f, 0.f, 0.f, 0.f};
#pragma unroll 2
        for (int n = 0; n < NSLOT; ++n) { const int s = dir == 0 ? n : (n < 2 ? 1 - n : 35 - n);
            float* p = base + (size_t)s * 2 * 16384; const f32x4 tmp = *(const f32x4*)p; *(f32x4*)p = st; st = st * cd + tmp; }
    }
}
__device__ __forceinline__ void ret_y_unit(const Args& a, Frame& F, int u) {
    FR_LANE_TID;
    unsigned char* ws = a.ws; const bf16* Z = (const bf16*)(ws + WS_R1); bf16* RS = (bf16*)(ws + WS_R3);
    const int bh = u / NSLOT, s = u % NSLOT, b = bh >> 3, h = bh & 7; const int row0 = unit_row0(b, s);
    const bf16* Qp = Z + (size_t)row0 * RW + h * HD; const bf16* Kp = Z + 1 * ZSEC + (size_t)row0 * RW + h * HD; const bf16* Vp = Z + 2 * ZSEC + (size_t)row0 * RW + h * HD;
    const bf16* Gp = Z + 3 * ZSEC + (size_t)row0 * RW + h * HD;
    const float lgf2 = logsig(a.decay[h]) * LOG2E, lgb2 = logsig(a.decay[NH + h]) * LOG2E;
    LAS bf16* KN = (LAS bf16*)(F.lds); LAS bf16* VT = (LAS bf16*)(F.lds + IMG); LAS bf16* SF = (LAS bf16*)(F.lds + 2 * IMG); LAS bf16* SB = (LAS bf16*)(F.lds + 3 * IMG);
#pragma unroll
    for (int k = 0; k < 4; ++k) { int j, ch; piece_rc(tid_ + 512 * k, j, ch);
        const u32x4 kv = *(const u32x4*)(Kp + (size_t)j * RW + 8 * ch), vv = *(const u32x4*)(Vp + (size_t)j * RW + 8 * ch);
        *(LAS u32x4*)(KN + j * LDP + 8 * ch) = kv;
#pragma unroll
        for (int i = 0; i < 8; ++i) { const unsigned vw = (i & 1) ? (vv[i >> 1] >> 16) : (vv[i >> 1] & 0xffffu); VT[(8 * ch + i) * LDP + j] = (bf16)vw; } }
    { const float* ST = (const float*)(ws + WS_R2) + (size_t)u * 2 * 16384;
#pragma unroll
        for (int k = 0; k < 8; ++k) { const int i4 = tid_ + 512 * k; const int e = i4 >> 5, d4 = (i4 & 31) * 4; const f32x4 sf = *(const f32x4*)(ST + e * 128 + d4), sb = *(const f32x4*)(ST + 16384 + e * 128 + d4);
            u32x2 o; o.x = cvt_pk_bf16(sf[0], sf[1]); o.y = cvt_pk_bf16(sf[2], sf[3]); *(LAS u32x2*)(SF + e * LDP + d4) = o;
            o.x = cvt_pk_bf16(sb[0], sb[1]); o.y = cvt_pk_bf16(sb[2], sb[3]); *(LAS u32x2*)(SB + e * LDP + d4) = o; } }
    const int fr = lane_ & 15, g = lane_ >> 4, it_ = F.wave; const int i_abs = 16 * it_ + fr;
    bf16x8 qf[4];
#pragma unroll
    for (int sI = 0; sI < 4; ++sI) qf[sI] = *(const bf16x8*)(Qp + (size_t)i_abs * RW + 32 * sI + 8 * g);
    __syncthreads();
    bf16x8 pf[4];
#pragma unroll
    for (int ks = 0; ks < 4; ++ks) { f32x4 s0 = (f32x4){0.f, 0.f, 0.f, 0.f}, s1 = s0;
#pragma unroll
        for (int sI = 0; sI < 4; ++sI) { const bf16x8 k0 = *(const LAS bf16x8*)(KN + (32 * ks + fr) * LDP + 32 * sI + 8 * g), k1 = *(const LAS bf16x8*)(KN + (32 * ks + 16 + fr) * LDP + 32 * sI + 8 * g);
            s0 = __builtin_amdgcn_mfma_f32_16x16x32_bf16(k0, qf[sI], s0, 0, 0, 0); s1 = __builtin_amdgcn_mfma_f32_16x16x32_bf16(k1, qf[sI], s1, 0, 0, 0); }
        unsigned w[4];
#pragma unroll
        for (int r = 0; r < 4; r += 2) {
            const int j0 = 32 * ks + 4 * g + r, j1 = j0 + 1, j2 = j0 + 16, j3 = j2 + 1;
            const float d0 = (float)(i_abs - j0), d1 = (float)(i_abs - j1), d2 = (float)(i_abs - j2), d3 = (float)(i_abs - j3);
            const float m0 = d0 >= 0.f ? exp2f(d0 * lgf2) : exp2f(-d0 * lgb2), m1 = d1 >= 0.f ? exp2f(d1 * lgf2) : exp2f(-d1 * lgb2);
            const float m2 = d2 >= 0.f ? exp2f(d2 * lgf2) : exp2f(-d2 * lgb2), m3 = d3 >= 0.f ? exp2f(d3 * lgf2) : exp2f(-d3 * lgb2);
            w[r >> 1] = cvt_pk_bf16(s0[r] * m0, s0[r + 1] * m1); w[2 + (r >> 1)] = cvt_pk_bf16(s1[r] * m2, s1[r + 1] * m3);
        }
        u32x4 ww; ww.x = w[0]; ww.y = w[1]; ww.z = w[2]; ww.w = w[3]; pf[ks] = __builtin_bit_cast(bf16x8, ww);
    }
    const float qdf = exp2f((float)(i_abs + 1) * lgf2), qdb = exp2f((float)(128 - i_abs) * lgb2);
    f32x4 y[8];
#pragma unroll
    for (int et = 0; et < 8; ++et) {
        f32x4 ai = (f32x4){0.f, 0.f, 0.f, 0.f}, cf = ai, cb = ai;
#pragma unroll
        for (int ks = 0; ks < 4; ++ks) { const LAS bf16* vp = VT + (16 * et + fr) * LDP + 32 * ks + 4 * g; const u32x2 lo = *(const LAS u32x2*)vp, hi = *(const LAS u32x2*)(vp + 16);
            u32x4 av; av.x = lo.x; av.y = lo.y; av.z = hi.x; av.w = hi.y;
            ai = __builtin_amdgcn_mfma_f32_16x16x32_bf16(__builtin_bit_cast(bf16x8, av), pf[ks], ai, 0, 0, 0); }
#pragma unroll
        for (int sI = 0; sI < 4; ++sI) { const bf16x8 sf = *(const LAS bf16x8*)(SF + (16 * et + fr) * LDP + 32 * sI + 8 * g), sb = *(const LAS bf16x8*)(SB + (16 * et + fr) * LDP + 32 * sI + 8 * g);
            cf = __builtin_amdgcn_mfma_f32_16x16x32_bf16(sf, qf[sI], cf, 0, 0, 0); cb = __builtin_amdgcn_mfma_f32_16x16x32_bf16(sb, qf[sI], cb, 0, 0, 0); }
        y[et] = ai + cf * qdf + cb * qdb;
    }
    float sm = 0.f;
#pragma unroll
    for (int et = 0; et < 8; ++et) sm += (y[et][0] + y[et][1]) + (y[et][2] + y[et][3]);
    sm += __shfl_xor(sm, 16); sm += __shfl_xor(sm, 32); const float mu = sm * (1.0f / 128.0f);
    float sq = 0.f;
#pragma unroll
    for (int et = 0; et < 8; ++et) { const f32x4 dl = y[et] - mu; sq += (dl[0] * dl[0] + dl[1] * dl[1]) + (dl[2] * dl[2] + dl[3] * dl[3]); }
    sq += __shfl_xor(sq, 16); sq += __shfl_xor(sq, 32); const float rstd = rsqrtf(sq * (1.0f / 128.0f) + EPSN);
#pragma unroll
    for (int et = 0; et < 8; ++et) { const int e = 16 * et + 4 * g; const u32x2 gg = *(const u32x2*)(Gp + (size_t)i_abs * RW + e);
        const f32x4 o = (y[et] - mu) * rstd; u32x2 w2; w2.x = cvt_pk_bf16(o[0] * bf2f(gg.x & 0xffffu), o[1] * bf2f(gg.x >> 16)); w2.y = cvt_pk_bf16(o[2] * bf2f(gg.y & 0xffffu), o[3] * bf2f(gg.y >> 16));
        *(u32x2*)(RS + (size_t)(row0 + i_abs) * D + h * HD + e) = w2; }
    __syncthreads();
}

__device__ __forceinline__ void phase_conv(const Args& a, Frame& F) {
    FR_LANE_TID;
    unsigned char* ws = a.ws; const bf16* GB = (const bf16*)(ws + WS_R1); const bf16* XG = GB + (size_t)NLAT * D; bf16* A1 = (bf16*)(ws + WS_R3);
    const int NT = F.G * 512;
    for (int it = F.blk * 512 + tid_; it < NLAT * 256; it += NT) {
        const int row = it >> 8, c = (it & 255) * 8; const int gc = row & 63;
        const u32x4 x1 = *(const u32x4*)(XG + (size_t)row * D + c), gb = *(const u32x4*)(GB + (size_t)row * D + c);
        u32x4 x0 = (u32x4){0u, 0u, 0u, 0u}, x2 = x0;
        if (gc > 0) x0 = *(const u32x4*)(XG + (size_t)(row - 1) * D + c);
        if (gc < 63) x2 = *(const u32x4*)(XG + (size_t)(row + 1) * D + c);
        float o[8];
#pragma unroll
        for (int i = 0; i < 8; ++i) { const int cc = c + i; const unsigned sh = (i & 1) ? 16u : 0u;
            const float f0 = bf2f((x0[i >> 1] >> sh) & 0xffffu), f1 = bf2f((x1[i >> 1] >> sh) & 0xffffu), f2 = bf2f((x2[i >> 1] >> sh) & 0xffffu), fg = bf2f((gb[i >> 1] >> sh) & 0xffffu);
            o[i] = fg * (a.cv_cb[cc] + a.cv_cw[cc] * f0 + a.cv_cw[D + cc] * f1 + a.cv_cw[2 * D + cc] * f2); }
        u32x4 w; w.x = cvt_pk_bf16(o[0], o[1]); w.y = cvt_pk_bf16(o[2], o[3]); w.z = cvt_pk_bf16(o[4], o[5]); w.w = cvt_pk_bf16(o[6], o[7]);
        *(u32x4*)(A1 + (size_t)row * D + c) = w;
    }
}

__device__ __forceinline__ void phase_route(const Args& a, Frame& F, int L) {
    FR_LANE_TID;
    unsigned char* ws = a.ws; const float* XB = (const float*)(ws + WS_XB); unsigned char* Fo = ws + WS_A;
    const float* MOD = (const float*)(ws + WS_MOD); const float* WR = (const float*)(ws + WS_WR) + (size_t)L * 20 * D;
    const int nrows = (L == 0) ? NTOK : NLAT; const int RPB = (nrows + F.G - 1) / F.G;
    LAS int* rinfo = (LAS int*)F.lds;
    LAS float* rw = (LAS float*)(F.lds + 8192);
    volatile LAS unsigned* lcnt = F.MISC + MI_LCNT; volatile LAS unsigned* gbase = F.MISC + MI_GBASE;
    if (tid_ < 16) lcnt[tid_] = 0u;
    __syncthreads();
    for (int i = F.wave; i < RPB; i += 8) {
        const int row = F.blk * RPB + i; if (row >= nrows) break;
        const int r = row < NLAT ? row >> 12 : 4;
        int ln4 = 4 * lane_; asm volatile("" : "+v"(ln4));
        f32x4 v[8];
#pragma unroll
        for (int j = 0; j < 8; ++j) v[j] = *(const f32x4*)(XB + (size_t)row * D + ln4 + 256 * j);
        const float rstd = row_rstd(v);
        const float* mp = MOD + (size_t)(L * 5 + r) * MODW; const float* gf = a.g_ffn + L * D;
#pragma unroll
        for (int j = 0; j < 8; ++j) { const int c = ln4 + 256 * j; const f32x4 g = *(const f32x4*)(gf + c), sh = *(const f32x4*)(mp + 3 * D + c), sc = *(const f32x4*)(mp + 4 * D + c);
            v[j] = v[j] * rstd * g * (sc + 1.0f) + sh; *(unsigned*)(Fo + (size_t)row * D + c) = pk4_fp8(v[j][0], v[j][1], v[j][2], v[j][3]); }
        float l1[4];
#pragma unroll
        for (int g = 0; g < 4; ++g) { float s = 0.f;
#pragma unroll
            for (int j = 0; j < 8; ++j) { const f32x4 w = *(const f32x4*)(WR + (size_t)g * D + ln4 + 256 * j); s += (v[j][0] * w[0] + v[j][1] * w[1]) + (v[j][2] * w[2] + v[j][3] * w[3]); }
            l1[g] = wave_sum(s) + a.b_r1[L * 4 + g]; asm volatile("" ::: "memory"); }
        int grp = 0; float mx = l1[0];
#pragma unroll
        for (int g = 1; g < 4; ++g) if (l1[g] > mx) { mx = l1[g]; grp = g; }
        float den = 0.f;
#pragma unroll
        for (int g = 0; g < 4; ++g) den += expf(l1[g] - mx);
        const float pg = 1.0f / den;
        float l2[4];
#pragma unroll
        for (int e = 0; e < 4; ++e) { float s = 0.f; const float* wp = WR + (size_t)(4 + 4 * grp + e) * D;
#pragma unroll
            for (int j = 0; j < 8; ++j) { const f32x4 w = *(const f32x4*)(wp + ln4 + 256 * j); s += (v[j][0] * w[0] + v[j][1] * w[1]) + (v[j][2] * w[2] + v[j][3] * w[3]); }
            l2[e] = wave_sum(s) + a.b_r2[(L * 4 + grp) * 4 + e]; asm volatile("" ::: "memory"); }
        int i0 = 0; float v0 = l2[0];
#pragma unroll
        for (int e = 1; e < 4; ++e) if (l2[e] > v0) { v0 = l2[e]; i0 = e; }
        int i1 = -1; float v1 = -3.0e38f;
#pragma unroll
        for (int e = 0; e < 4; ++e) if (e != i0 && l2[e] > v1) { v1 = l2[e]; i1 = e; }
        const float ex = expf(v1 - v0); const float w0 = pg / (1.0f + ex), w1 = pg * ex / (1.0f + ex);
        if (lane_ == 0) { const int e0 = grp * 4 + i0, e1 = grp * 4 + i1;
            const int li0 = (int)__hip_atomic_fetch_add((LAS unsigned*)&lcnt[e0], 1u, __ATOMIC_RELAXED, __HIP_MEMORY_SCOPE_WORKGROUP);
            const int li1 = (int)__hip_atomic_fetch_add((LAS unsigned*)&lcnt[e1], 1u, __ATOMIC_RELAXED, __HIP_MEMORY_SCOPE_WORKGROUP);
            rinfo[4 * i] = e0; rinfo[4 * i + 1] = li0; rinfo[4 * i + 2] = e1; rinfo[4 * i + 3] = li1; rw[2 * i] = w0; rw[2 * i + 1] = w1; }
    }
    __syncthreads();
    if (tid_ < 16) gbase[tid_] = xb_add((unsigned*)(ws + WS_CTL) + CW_CNT + L * 64 + tid_, lcnt[tid_]);
    __syncthreads();
    int* RIDX = (int*)(ws + WS_RIDX) + (size_t)L * NTOK * 4; float* RWT = (float*)(ws + WS_RWT) + (size_t)L * NTOK * 2;
    for (int i = tid_; i < RPB; i += 512) { const int row = F.blk * RPB + i; if (row < nrows) {
        const int e0 = rinfo[4 * i], e1 = rinfo[4 * i + 2];
        i32x4 o; o.x = e0; o.y = (int)gbase[e0] + rinfo[4 * i + 1]; o.z = e1; o.w = (int)gbase[e1] + rinfo[4 * i + 3]; *(i32x4*)(RIDX + 4 * (size_t)row) = o;
        f32x2 w; w.x = rw[2 * i]; w.y = rw[2 * i + 1]; *(f32x2*)(RWT + 2 * (size_t)row) = w;
        int* GI = (int*)(ws + WS_GIDX) + (size_t)L * NE * NTOK; GI[(size_t)e0 * NTOK + o.y] = row; GI[(size_t)e1 * NTOK + o.w] = row; } }
    __syncthreads();
}
__device__ __forceinline__ void phase_final(const Args& a, Frame& F, int Lc  ) {
    FR_LANE_TID;
    unsigned char* ws = a.ws; const float* XB = (const float*)(ws + WS_XB); const float* MOD = (const float*)(ws + WS_MOD);
    const int gw = F.blk * 8 + F.wave, NGW = F.G * 8;
    if (Lc >= 0) (void)moe_tables(a, F, Lc);
    const volatile LAS int* tb = (const volatile LAS int*)(F.MISC + MI_TB);
    for (int row = gw; row < NLAT; row += NGW) {
        const int r = row >> 12;
        int ln4 = 4 * lane_; asm volatile("" : "+v"(ln4));
        f32x4 v[8];
#pragma unroll
        for (int j = 0; j < 8; ++j) v[j] = *(const f32x4*)(XB + (size_t)row * D + ln4 + 256 * j);
        if (Lc >= 0) combine_row(v, (const bf16*)(ws + WS_R2), (const int*)(ws + WS_RIDX) + (size_t)Lc * NTOK * 4, (const float*)(ws + WS_RWT) + (size_t)Lc * NTOK * 2,
                                 MOD + (size_t)(Lc * 5 + r) * MODW + 5 * D, tb, row, lane_);
        const float rstd = row_rstd(v);
#pragma unroll
        for (int j = 0; j < 8; ++j) { const int c = ln4 + 256 * j; const f32x4 g = *(const f32x4*)(a.g_final + c); *(f32x4*)(a.out + (size_t)row * D + c) = v[j] * rstd * g; }
    }
}

__global__ void __launch_bounds__(512, 2) fwd_kernel(Args a) {
    extern __shared__ __attribute__((aligned(16))) unsigned char lds_raw[];
    Frame F; F.lds = (LAS unsigned char*)lds_raw; F.MISC = (volatile LAS unsigned*)(F.lds + MISC_OFF);
    F.wave = __builtin_amdgcn_readfirstlane((int)threadIdx.x >> 6); F.G = gridDim.x; F.blk = blockIdx.x;
    unsigned char* ws = a.ws;
    F.MISC[threadIdx.x] = 0u;
    __syncthreads();
#if MK_SPLIT
    #define GRID_BAR() do { } while (0)
#else
    XcdBarrier bar = xcd_barrier_post((unsigned*)(ws + WS_CTL) + CW_BAR, F.MISC);
    #define GRID_BAR() xcd_barrier(bar)
#endif
    const int lo = a.ph_lo, hi = a.ph_hi;
    unsigned long long pr_acc = 0ull, pr_t0 = 0ull;
#define IN(k) (lo <= (k) && (k) < hi && ((((PROBE_MASK) >> (k)) & 1u) ? (pr_t0 = __builtin_amdgcn_s_memrealtime(), true) : true))
#define SEAM(k) do { if (lo <= (k) + 1 && (k) + 1 < hi) GRID_BAR(); if (((PROBE_MASK) >> (k)) & 1u) pr_acc += __builtin_amdgcn_s_memrealtime() - pr_t0; } while (0)

    if (IN(PH_PRO)) { phase_prologue(a, F); SEAM(PH_PRO); }
#define RUN_LAYER(L) do { \
        constexpr int P = PH_L0 + (L) * PH_PER_LAYER; \
        constexpr int nM = ((L) == 0) ? NTOK / 256 : NLAT / 256; \
        if (IN(P + K_PRE)) { phase_pre(a, F, (L)); SEAM(P + K_PRE); } \
        if (DBG_STOP == 1) break; \
        if (IN(P + K_GIN)) { \
            if ((L) == 0) { pg8::Gemm g{(const bf16*)(ws + WS_A), (const bf16*)(ws + WS_WAB_IN), D}; pg8::StaticOrder S; S.init(nM, 24, F.G, F.blk); \
                pg8::EpiAB E{(bf16*)(ws + WS_R1), (const float*)(ws + WS_ROPE)}; pg8::gemm_phase<pg8::EpiAB, pg8::StaticOrder, true, true>(F.lds, F.wave, g, S, E); } \
            else { pg8::Gemm g{(const bf16*)(ws + WS_A), (const bf16*)(ws + WS_WCV_IN), D}; pg8::StaticOrder S; S.init(nM, 24, F.G, F.blk); \
                pg8::EpiCV E{(bf16*)(ws + WS_R1), (bf16*)(ws + WS_R1) + (size_t)NLAT * D}; pg8::gemm_phase<pg8::EpiCV, pg8::StaticOrder, true, true>(F.lds, F.wave, g, S, E); } \
            SEAM(P + K_GIN); \
        } \
        if (IN(P + K_MID1)) { \
            if ((L) == 0) { for (int u = F.blk; u < NUNIT; u += F.G) ret_u_unit(a, F, u); for (int u = F.blk; u < NUNIT; u += F.G) sgu_unit(a, F, u); } \
            else phase_conv(a, F); \
            SEAM(P + K_MID1); \
        } \
        if ((L) == 0) { \
            if (IN(P + K_MID2)) { phase_scan(a, F); SEAM(P + K_MID2); } \
            if (IN(P + K_MID3)) { for (int u = F.blk; u < NUNIT; u += F.G) ret_y_unit(a, F, u); SEAM(P + K_MID3); } \
        } \
        if (IN(P + K_GOUT)) { \
            pg8::Gemm g{(const bf16*)(ws + WS_R3), (const bf16*)(ws + ((L) == 0 ? WS_WAB_OUT : WS_WCV_OUT)), D}; pg8::StaticOrder S; S.init(nM, 8, F.G, F.blk); \
            pg8::EpiRes E{(float*)(ws + WS_XB), (L) == 0 ? a.x : (const float*)(ws + WS_XB), (L) == 0 ? a.ctx : (const float*)(ws + WS_XB) + (size_t)NLAT * D, (const float*)(ws + WS_MOD) + (size_t)(L) * 5 * MODW + 2 * D}; \
            pg8::gemm_phase<pg8::EpiRes, pg8::StaticOrder, true, true>(F.lds, F.wave, g, S, E); \
            SEAM(P + K_GOUT); \
        } \
        if (DBG_STOP == 2 || (DBG_STOP == 4 && (L) == 1)) break; \
        if (IN(P + K_ROUTE)) { phase_route(a, F, (L)); SEAM(P + K_ROUTE); } \
        if (IN(P + K_MOE1)) { \
            const int TT = moe_tables(a, F, (L)); \
            pg8::Gemm g{(const bf16*)(ws + WS_A), (const bf16*)(ws + WS_W13 + (size_t)(L) * NE * D * D), D / 2}; \
            pg8::MoeOrder S; S.init(TT, 8, F.G, F.blk); S.texp = (const volatile LAS int*)(F.MISC + MI_TEXP); S.bstride = (long)D * D; \
            { FR_LANE_TID; LAS int* idxbuf = (LAS int*)(F.lds + 131072); const volatile LAS int* tb_ = (const volatile LAS int*)(F.MISC + MI_TB); const volatile LAS int* cn_ = (const volatile LAS int*)(F.MISC + MI_LCNT); \
              const int* GI = (const int*)(ws + WS_GIDX) + (size_t)(L) * NE * NTOK; \
              for (int i_ = 0; i_ < 16; ++i_) { pg8::Unit u_; if (!S.next(i_, u_)) break; const int e_ = S.texp[u_.pm]; const int idx_ = (u_.pm - tb_[e_]) * 256 + tid_; \
                  if (tid_ < 256) idxbuf[i_ * 256 + tid_] = idx_ < cn_[e_] ? GI[(size_t)e_ * NTOK + idx_] : 0; } \
              __syncthreads(); } \
            pg8::EpiMoe1 E{ws + WS_R3}; pg8::gemm_phase<pg8::EpiMoe1, pg8::MoeOrder, true, true, true, true>(F.lds, F.wave, g, S, E, (const LAS int*)(F.lds + 131072)); \
            SEAM(P + K_MOE1); \
        } \
        if (IN(P + K_MOE2)) { \
            const int TT = moe_tables(a, F, (L)); \
            pg8::Gemm g{(const bf16*)(ws + WS_R3), (const bf16*)(ws + WS_W2 + (size_t)(L) * NE * D * DE), DE / 2}; \
            pg8::MoeOrder S; S.init(TT, 8, F.G, F.blk); S.texp = (const volatile LAS int*)(F.MISC + MI_TEXP); S.bstride = (long)D * DE; \
            pg8::EpiMoe2 E{(bf16*)(ws + WS_R2)}; pg8::gemm_phase<pg8::EpiMoe2, pg8::MoeOrder, true, true, true>(F.lds, F.wave, g, S, E); \
            SEAM(P + K_MOE2); \
        } \
    } while (0)
    RUN_LAYER(0);
    if (DBG_STOP == 0 || DBG_STOP == 4) RUN_LAYER(1);
    if (IN(PH_FINAL)) phase_final(a, F, DBG_STOP == 0 ? 1 : (DBG_STOP == 3 ? 0 : -1));
#undef IN
#undef SEAM
    if ((PROBE_MASK) != 0u && F.blk == 0 && threadIdx.x == 0) { const unsigned long long t1 = __builtin_amdgcn_s_memrealtime(); while (__builtin_amdgcn_s_memrealtime() - t1 < (unsigned long long)(PROBE_MULT) * pr_acc) __builtin_amdgcn_s_sleep(8); }
}

extern "C" void kernel_launch(void* const* d_in, const int* in_sizes, int n_in, void* d_out, int out_size, void* d_ws, size_t ws_size, hipStream_t stream) {
    static int grid = 0;
    if (grid == 0) {
        if (n_in != 25 || in_sizes[0] != NLAT * D || out_size != NLAT * D || ws_size < WS_END) { fprintf(stderr, "kernel_launch: unexpected shapes (n_in %d, in0 %d, out %d, ws %zu)\n", n_in, n_in > 0 ? in_sizes[0] : -1, out_size, ws_size); grid = -1; return; }
        int dev = 0, cus = 0, per_cu = 0;
        if (hipGetDevice(&dev) != hipSuccess || hipDeviceGetAttribute(&cus, hipDeviceAttributeMultiprocessorCount, dev) != hipSuccess) { grid = -1; return; }
        if (hipFuncSetAttribute((const void*)fwd_kernel, hipFuncAttributeMaxDynamicSharedMemorySize, LDS_BYTES) != hipSuccess) { fprintf(stderr, "kernel_launch: hipFuncSetAttribute failed\n"); grid = -1; return; }
        if (hipOccupancyMaxActiveBlocksPerMultiprocessor(&per_cu, (const void*)fwd_kernel, 512, LDS_BYTES) != hipSuccess || per_cu < 1) fprintf(stderr, "kernel_launch: occupancy query reports %d\n", per_cu);
        (void)hipGetLastError();
        grid = cus;
    }
    if (grid < 0) return;
    (void)hipMemsetAsync((char*)d_ws + WS_CTL, 0, CTL_BYTES, stream);
    Args a{};
    const float** f = (const float**)&a;
    for (int i = 0; i < 25; ++i) f[i] = (const float*)d_in[i];
    a.out = (float*)d_out; a.ws = (unsigned char*)d_ws;
#if MK_SPLIT
    for (int ph = 0; ph < NPHASE; ++ph) { a.ph_lo = ph; a.ph_hi = ph + 1; hipLaunchKernelGGL(fwd_kernel, dim3(grid), dim3(512), LDS_BYTES, stream, a); }
#else
    a.ph_lo = 0; a.ph_hi = NPHASE; hipLaunchKernelGGL(fwd_kernel, dim3(grid), dim3(512), LDS_BYTES, stream, a);
#endif
}
```

```cpp
#include <hip/hip_runtime.h>
#include <cstdio>
#include <cstdint>

#ifndef MK_SPLIT
#define MK_SPLIT 0
#endif
#ifndef PROBE_MASK
#define PROBE_MASK 0u
#endif
#ifndef PROBE_MULT
#define PROBE_MULT 4
#endif
#ifndef DBG_STOP
#define DBG_STOP 0
#endif

#define LAS __attribute__((address_space(3)))
#define GAS __attribute__((address_space(1)))
typedef unsigned short bf16;
typedef short bf16x8 __attribute__((ext_vector_type(8)));
typedef short s16x4 __attribute__((ext_vector_type(4)));
typedef float f32x4 __attribute__((ext_vector_type(4)));
typedef float f32x2 __attribute__((ext_vector_type(2)));
typedef unsigned u32x4 __attribute__((ext_vector_type(4)));
typedef unsigned u32x2 __attribute__((ext_vector_type(2)));
typedef int i32x4 __attribute__((ext_vector_type(4)));
typedef int i32x8 __attribute__((ext_vector_type(8)));
typedef int i32x2 __attribute__((ext_vector_type(2)));

constexpr int D = 2048, NB = 4, TL = 4096, TCX = 256;
constexpr int NLAT = NB * TL;
constexpr int NCTX = NB * TCX;
constexpr int NTOK = NLAT + NCTX;
constexpr int HD = 128, NH = 8, RW = 1024;
constexpr int NSLOT = 34;
constexpr int NUNIT = NB * NH * NSLOT;
constexpr int DE = 1024, NE = 16;
constexpr int PCAP = 2 * NTOK + NE * 256;
constexpr float EPSN = 1e-6f;
constexpr float QK_SCALE = 0.08838834764831845f;
constexpr int MODW = 6 * D;

constexpr size_t MiB = 1u << 20;
constexpr size_t WS_CTL = 0, CTL_BYTES = 1 * MiB;
constexpr size_t WS_MOD = 1 * MiB;
constexpr size_t WS_ROPE = 1 * MiB + 512 * 1024;
constexpr size_t WS_WR = 2 * MiB;
constexpr size_t WS_RIDX = 3 * MiB;
constexpr size_t WS_RWT = 4 * MiB;
constexpr size_t WS_GIDX = 5 * MiB;
constexpr size_t WS_WAB_IN = 8 * MiB, WS_WAB_OUT = 32 * MiB, WS_WCV_IN = 40 * MiB, WS_WCV_OUT = 64 * MiB;
constexpr size_t WS_W13 = 72 * MiB;
constexpr size_t WS_W2 = 328 * MiB;
constexpr size_t WS_XB = 456 * MiB;
constexpr size_t WS_A = 592 * MiB;
constexpr size_t WS_R1 = 660 * MiB;
constexpr size_t WS_R2 = 864 * MiB;
constexpr size_t WS_R3 = 1016 * MiB;
constexpr size_t WS_END = 1092 * MiB;
constexpr size_t ZSEC = (size_t)NTOK * 1024;
constexpr int CW_BAR = 4096;
constexpr int CW_CNT = 8192;

constexpr int SCR_BYTES = 155648;
constexpr int MISC_OFF = SCR_BYTES;
constexpr int LDS_BYTES = SCR_BYTES + 4096;
constexpr int MI_LCNT = 16, MI_GBASE = 32, MI_TB = 64, MI_TEXP = 96, MI_RINFO = 256, MI_RW = 768;

__device__ __forceinline__ unsigned cvt_pk_bf16(float lo, float hi) { unsigned r; asm("v_cvt_pk_bf16_f32 %0, %1, %2" : "=v"(r) : "v"(lo), "v"(hi)); return r; }
__device__ __forceinline__ int lane_id() { int l; asm volatile("v_mbcnt_lo_u32_b32 %0, -1, 0\n\tv_mbcnt_hi_u32_b32 %0, -1, %0" : "=v"(l)); return l; }
__device__ __forceinline__ float bf2f(unsigned b) { return __uint_as_float(b << 16); }
template <int CTRL> __device__ __forceinline__ float dpp_mov(float v) { return __int_as_float(__builtin_amdgcn_update_dpp(0, __float_as_int(v), CTRL, 0xf, 0xf, false)); }
__device__ __forceinline__ float wave_sum(float v) {
    v += dpp_mov<0xB1>(v); v += dpp_mov<0x4E>(v); v += dpp_mov<0x141>(v); v += dpp_mov<0x140>(v);
    return ((__int_as_float(__builtin_amdgcn_readlane(__float_as_int(v), 0)) + __int_as_float(__builtin_amdgcn_readlane(__float_as_int(v), 16))) +
           (__int_as_float(__builtin_amdgcn_readlane(__float_as_int(v), 32)) + __int_as_float(__builtin_amdgcn_readlane(__float_as_int(v), 48))));
}
__device__ __forceinline__ float silu_f(float x) { return x / (1.0f + __expf(-x)); }
__device__ __forceinline__ float gelu_tanh_f(float x) { const float z = 1.5957691216057308f * (x + 0.044715f * x * x * x); return x / (1.0f + __expf(-z)); }
__device__ __forceinline__ u32x4 pack8(f32x4 a, f32x4 b) { u32x4 w; w.x = cvt_pk_bf16(a[0], a[1]); w.y = cvt_pk_bf16(a[2], a[3]); w.z = cvt_pk_bf16(b[0], b[1]); w.w = cvt_pk_bf16(b[2], b[3]); return w; }
__device__ __forceinline__ unsigned pk4_fp8(float a, float b, float c, float d) { int w = 0; w = __builtin_amdgcn_cvt_pk_fp8_f32(a, b, w, false); w = __builtin_amdgcn_cvt_pk_fp8_f32(c, d, w, true); return (unsigned)w; }
__device__ __forceinline__ u32x2 pack8_fp8(f32x4 a, f32x4 b) { u32x2 w; w.x = pk4_fp8(a[0], a[1], a[2], a[3]); w.y = pk4_fp8(b[0], b[1], b[2], b[3]); return w; }
#define W8_SCALE 64.0f
#define SCALE_W8 0x79797979
#define SCALE_ONE 0x7f7f7f7f
__device__ __forceinline__ float logsig(float x) { return -log1pf(expf(-x)); }
#define LOG2E 1.4426950408889634f

namespace pg8 {
constexpr int BM = 256, BK = 64, HALF = 128, HTB = HALF * BK * 2, STAGE_BYTES = 8 * HTB, NXCD = 8, WGM = 8;
__host__ __device__ __forceinline__ int lds_byte(int r, int c) { const int st = (r >> 4) * 2 + (c >> 5), rr = r & 15, cc = c & 31, ob = rr * 64 + cc * 2; return st * 1024 + (ob ^ (((ob >> 9) & 1) << 5)); }
__host__ __device__ __forceinline__ void stage_rc(int b, int& R, int& C) { const int st = b / 1024, sb = b % 1024, swz = sb ^ (((sb >> 9) & 1) << 5); R = (st >> 1) * 16 + swz / 64; C = (st & 1) * 32 + (swz % 64) / 2; }

struct Unit { int pm, pn; long boff; };
struct Gemm { const bf16* A; const bf16* Bt; int K; };

struct StaticOrder {
    int nM, nN, nwg, G, c;
    __device__ __forceinline__ void init(int nM_, int nN_, int G_, int c_) { nM = nM_; nN = nN_; nwg = nM * nN; G = G_; c = c_; }
    __device__ __forceinline__ bool map(int i, int& pm, int& pn) const {
        const long L = (long)i * G + c; if (L >= nwg) return false;
        int wgid = (int)L; { const int q = nwg / NXCD, r = nwg % NXCD, xcd = wgid % NXCD, off = wgid / NXCD; wgid = (xcd < r ? xcd * (q + 1) : r * (q + 1) + (xcd - r) * q) + off; }
        const int nig = WGM * nN, gid = wgid / nig, fm = gid * WGM, gsz = (nM - fm) < WGM ? (nM - fm) : WGM;
        pm = fm + ((wgid % nig) % gsz); pn = (wgid % nig) / gsz; return true;
    }
    __device__ __forceinline__ bool next(int i, Unit& u) const { u.boff = 0; return map(i, u.pm, u.pn); }
};
struct MoeOrder : StaticOrder {
    const volatile LAS int* texp; long bstride;
    __device__ __forceinline__ bool next(int i, Unit& u) const { if (!map(i, u.pm, u.pn)) return false; u.boff = (long)texp[u.pm] * bstride; return true; }
};

template <class Epi, class Sched, bool ALIGN_EPI, bool SP2, bool FP8 = false, bool GATHER = false>
__device__ __forceinline__ void gemm_phase(LAS unsigned char* lds, const int wid, const Gemm g, const Sched& S, const Epi& E, const LAS int* gidx = nullptr) {
    static_assert(!GATHER || SP2, "row-gathered A operand: SP2 loop only");
    const int lane = lane_id(), tid = wid * 64 + lane, wr = wid >> 2, wc = wid & 3, fr = lane & 15, fq = lane >> 4;
    const int K = g.K, nt = K / BK;
    unsigned voffA[2];
#pragma unroll
    for (int i = 0; i < 2; ++i) { int R, C; stage_rc(tid * 16 + i * 8192, R, C); voffA[i] = (unsigned)(R * K + C) * 2u; }
    const size_t kstep = (size_t)(BK * 2);
    const size_t hstep = (size_t)HALF * K * 2;
    const size_t tstep = 2 * hstep;
    const unsigned ldsw = (unsigned)wid * 1024u;
    const int aoff = lds_byte(wr * 64 + fr, fq * 8), boff = lds_byte(wc * 32 + fr, fq * 8);
#define PG8_SA(b, h) (((b) * 2 + (h)) * HTB)
#define PG8_SB(b, h) ((4 + (b) * 2 + (h)) * HTB)
#define PG8_STAGE(bufoff, gbase) do { _Pragma("unroll") for (int _i = 0; _i < 2; ++_i) \
        __builtin_amdgcn_global_load_lds((const unsigned*)((const char*)(gbase) + voffA[_i]), (LAS unsigned*)(lds + (bufoff) + ldsw + _i * 8192), 16, 0, 0); } while (0)
#define PG8_STAGEA(bufoff, ptr, kq, h, useN) do { if constexpr (GATHER) { _Pragma("unroll") for (int _i = 0; _i < 2; ++_i) \
        __builtin_amdgcn_global_load_lds((const unsigned*)(gA + (kq) + ((useN) ? oN[h][_i] : oC[h][_i])), (LAS unsigned*)(lds + (bufoff) + ldsw + _i * 8192), 16, 0, 0); } \
        else { PG8_STAGE(bufoff, ptr); } } while (0)
#define PG8_OFFS(o, uidx) do { _Pragma("unroll") for (int _h = 0; _h < 2; ++_h) _Pragma("unroll") for (int _i = 0; _i < 2; ++_i) { int R_, C_; stage_rc(tid * 16 + _i * 8192, R_, C_); \
        o[_h][_i] = (unsigned)gidx[(uidx) * 256 + _h * HALF + R_] * (unsigned)(K * 2) + (unsigned)(C_ * 2); } } while (0)
#define PG8_CAT(lo, hi) __builtin_shufflevector(lo, hi, 0, 1, 2, 3, 4, 5, 6, 7)
#define PG8_LDA(dst, b, h) do { _Pragma("unroll") for (int m = 0; m < 4; ++m) dst[m] = PG8_CAT(*(const LAS i32x4*)(lds + PG8_SA(b, h) + aoff + m * 2048), *(const LAS i32x4*)(lds + PG8_SA(b, h) + aoff + m * 2048 + 1024)); } while (0)
#define PG8_LDB(dst, b, h) do { _Pragma("unroll") for (int n = 0; n < 2; ++n) dst[n] = PG8_CAT(*(const LAS i32x4*)(lds + PG8_SB(b, h) + boff + n * 2048), *(const LAS i32x4*)(lds + PG8_SB(b, h) + boff + n * 2048 + 1024)); } while (0)
#define PG8_LO(x) __builtin_bit_cast(bf16x8, __builtin_shufflevector(x, x, 0, 1, 2, 3))
#define PG8_HI(x) __builtin_bit_cast(bf16x8, __builtin_shufflevector(x, x, 4, 5, 6, 7))
#define PG8_MMA(ai, bj, At, Bt) do { __builtin_amdgcn_s_setprio(1); \
        if constexpr (FP8) { _Pragma("unroll") for (int m = 0; m < 4; ++m) _Pragma("unroll") for (int n = 0; n < 2; ++n) \
            asm volatile("v_mfma_scale_f32_16x16x128_f8f6f4 %0, %1, %2, %0, %3, %4 op_sel_hi:[0,0,0]" : "+v"(acc[ai][bj][m][n]) : "v"(Bt[n]), "v"(At[m]), "v"(scw), "v"(sca)); } \
        else { _Pragma("unroll") for (int m = 0; m < 4; ++m) _Pragma("unroll") for (int n = 0; n < 2; ++n) { \
            acc[ai][bj][m][n] = __builtin_amdgcn_mfma_f32_16x16x32_bf16(PG8_LO(Bt[n]), PG8_LO(At[m]), acc[ai][bj][m][n], 0, 0, 0); \
            acc[ai][bj][m][n] = __builtin_amdgcn_mfma_f32_16x16x32_bf16(PG8_HI(Bt[n]), PG8_HI(At[m]), acc[ai][bj][m][n], 0, 0, 0); } } \
        __builtin_amdgcn_s_setprio(0); } while (0)
#define PG8_WAIT_V(n) asm volatile("s_waitcnt vmcnt(" #n ")" ::: "memory")
#define PG8_WAIT_L(n) asm volatile("s_waitcnt lgkmcnt(" #n ")" ::: "memory")
#define PG8_BAR __builtin_amdgcn_s_barrier()
#define PG8_SCHED __builtin_amdgcn_sched_barrier(0)
    Unit cur, nxt; int ui = 0;
    if (!S.next(0, cur)) return;
    int scw = SCALE_W8, sca = SCALE_ONE; if constexpr (FP8) asm volatile("" : "+v"(scw), "+v"(sca));
    f32x4 acc[2][2][4][2];
#pragma unroll
    for (int a = 0; a < 2; ++a)
#pragma unroll
        for (int b = 0; b < 2; ++b)
#pragma unroll
            for (int m = 0; m < 4; ++m)
#pragma unroll
                for (int n = 0; n < 2; ++n) acc[a][b][m][n] = (f32x4){0.f, 0.f, 0.f, 0.f};
    i32x8 At[4], B0[2], B1[2];
    const char* cA = (const char*)g.A + (size_t)cur.pm * tstep; const char* cB = (const char*)g.Bt + cur.boff + (size_t)cur.pn * tstep;
    const char* const gA = (const char*)g.A; unsigned oC[2][2], oN[2][2];
    if constexpr (GATHER) { PG8_OFFS(oC, 0);
#pragma unroll
        for (int h = 0; h < 2; ++h) { oN[h][0] = oC[h][0]; oN[h][1] = oC[h][1]; } }
    if constexpr (SP2) {
        PG8_STAGE(PG8_SB(0, 0), cB); PG8_STAGE(PG8_SB(0, 1), cB + hstep); PG8_STAGEA(PG8_SA(0, 0), cA, (size_t)0, 0, false); PG8_STAGEA(PG8_SA(0, 1), cA + hstep, (size_t)0, 1, false);
        if (wr == 1) PG8_BAR;
        PG8_WAIT_V(2); PG8_BAR;
        PG8_STAGE(PG8_SB(1, 0), cB + kstep); PG8_STAGEA(PG8_SA(1, 0), cA + kstep, kstep, 0, false); PG8_STAGE(PG8_SB(1, 1), cB + hstep + kstep);
        PG8_WAIT_V(6); PG8_BAR;
    } else {
        PG8_STAGE(PG8_SB(0, 0), cB); PG8_STAGE(PG8_SA(0, 0), cA); PG8_STAGE(PG8_SB(0, 1), cB + hstep); PG8_STAGE(PG8_SA(0, 1), cA + hstep);
        if (wr == 1) PG8_BAR;
        PG8_WAIT_V(4); PG8_BAR;
        PG8_STAGE(PG8_SB(1, 0), cB + kstep); PG8_STAGE(PG8_SA(1, 0), cA + kstep); PG8_STAGE(PG8_SB(1, 1), cB + hstep + kstep);
        PG8_WAIT_V(6); PG8_BAR;
    }
    for (;;) {
        const bool has_next = S.next(ui + 1, nxt);
        const char* nA = has_next ? (const char*)g.A + (size_t)nxt.pm * tstep : cA; const char* nB = has_next ? (const char*)g.Bt + nxt.boff + (size_t)nxt.pn * tstep : cB;
        if constexpr (GATHER) { if (has_next) PG8_OFFS(oN, ui + 1); }
#pragma unroll 1
        for (int t = 0; t < nt; t += 2) {
            const bool last = (t == nt - 2);
            const char* a1 = cA + (size_t)(t + 1) * kstep;
            const char* a2 = last ? nA : cA + (size_t)(t + 2) * kstep; const char* b2 = last ? nB : cB + (size_t)(t + 2) * kstep;
            const char* a3 = a2 + kstep; const char* b3 = b2 + kstep;
            const size_t kq1 = (size_t)(t + 1) * kstep, kq2 = last ? (size_t)0 : (size_t)(t + 2) * kstep, kq3 = kq2 + kstep;
            if constexpr (SP2) {
            PG8_LDB(B0, 0, 0); PG8_LDB(B1, 0, 1); PG8_SCHED; PG8_LDA(At, 0, 0); PG8_STAGEA(PG8_SA(1, 1), a1 + hstep, kq1, 1, false);
            PG8_WAIT_V(8); PG8_WAIT_L(0); PG8_BAR; PG8_MMA(0, 0, At, B0); PG8_MMA(0, 1, At, B1); PG8_BAR; PG8_SCHED;
            PG8_LDA(At, 0, 1); PG8_STAGE(PG8_SB(0, 0), b2); PG8_STAGE(PG8_SB(0, 1), b2 + hstep); PG8_STAGEA(PG8_SA(0, 0), a2, kq2, 0, last);
            PG8_WAIT_V(8); PG8_WAIT_L(0); PG8_BAR; PG8_MMA(1, 0, At, B0); PG8_MMA(1, 1, At, B1); PG8_BAR; PG8_SCHED;
            PG8_LDB(B0, 1, 0); PG8_LDB(B1, 1, 1); PG8_SCHED; PG8_LDA(At, 1, 0); PG8_STAGEA(PG8_SA(0, 1), a2 + hstep, kq2, 1, last);
            PG8_WAIT_V(8); PG8_WAIT_L(0); PG8_BAR; PG8_MMA(0, 0, At, B0); PG8_MMA(0, 1, At, B1); PG8_BAR; PG8_SCHED;
            PG8_LDA(At, 1, 1); PG8_STAGE(PG8_SB(1, 0), b3); PG8_STAGE(PG8_SB(1, 1), b3 + hstep); PG8_STAGEA(PG8_SA(1, 0), a3, kq3, 0, last);
            PG8_WAIT_V(8); PG8_WAIT_L(0); PG8_BAR; PG8_MMA(1, 0, At, B0); PG8_MMA(1, 1, At, B1); PG8_BAR; PG8_SCHED;
            } else {
            PG8_LDB(B0, 0, 0); PG8_SCHED; PG8_LDA(At, 0, 0); PG8_STAGE(PG8_SA(1, 1), a1 + hstep);
            PG8_WAIT_L(8); PG8_BAR; PG8_WAIT_L(0); PG8_MMA(0, 0, At, B0); PG8_BAR; PG8_SCHED;
            PG8_LDB(B1, 0, 1); PG8_STAGE(PG8_SB(0, 0), b2);
            PG8_BAR; PG8_WAIT_L(0); PG8_MMA(0, 1, At, B1); PG8_BAR;
            PG8_LDA(At, 0, 1); PG8_STAGE(PG8_SA(0, 0), a2);
            PG8_BAR; PG8_WAIT_L(0); PG8_MMA(1, 0, At, B0); PG8_BAR; PG8_SCHED;
            PG8_STAGE(PG8_SB(0, 1), b2 + hstep);
            PG8_WAIT_V(6); PG8_BAR; PG8_MMA(1, 1, At, B1); PG8_BAR;
            PG8_LDB(B0, 1, 0); PG8_SCHED; PG8_LDA(At, 1, 0); PG8_STAGE(PG8_SA(0, 1), a2 + hstep);
            PG8_WAIT_L(8); PG8_BAR; PG8_WAIT_L(0); PG8_MMA(0, 0, At, B0); PG8_BAR; PG8_SCHED;
            PG8_LDB(B1, 1, 1); PG8_STAGE(PG8_SB(1, 0), b3);
            PG8_BAR; PG8_WAIT_L(0); PG8_MMA(0, 1, At, B1); PG8_BAR;
            PG8_LDA(At, 1, 1); PG8_STAGE(PG8_SA(1, 0), a3);
            PG8_BAR; PG8_WAIT_L(0); PG8_MMA(1, 0, At, B0); PG8_BAR; PG8_SCHED;
            PG8_STAGE(PG8_SB(1, 1), b3 + hstep);
            PG8_WAIT_V(6); PG8_BAR; PG8_MMA(1, 1, At, B1); PG8_BAR;
            }
        }
        if constexpr (ALIGN_EPI) { if (wr == 0) PG8_BAR; }
        if constexpr (FP8) asm volatile("s_nop 15\n\ts_nop 15" ::: "memory");
        { int fr_ = fr, fq_ = fq; asm volatile("" : "+v"(fr_), "+v"(fq_)); E(acc, cur, wr, wc, fr_, fq_); }
        if (!has_next) break;
#pragma unroll
        for (int a = 0; a < 2; ++a)
#pragma unroll
            for (int b = 0; b < 2; ++b)
#pragma unroll
                for (int m = 0; m < 4; ++m)
#pragma unroll
                    for (int n = 0; n < 2; ++n) acc[a][b][m][n] = (f32x4){0.f, 0.f, 0.f, 0.f};
        cur = nxt; cA = nA; cB = nB; ++ui;
        if constexpr (GATHER) {
#pragma unroll
            for (int h = 0; h < 2; ++h) { oC[h][0] = oN[h][0]; oC[h][1] = oN[h][1]; } }
        if constexpr (ALIGN_EPI) { if (wr == 1) PG8_BAR; }
    }
    PG8_WAIT_V(0);
    if constexpr (!ALIGN_EPI) { if (wr == 0) PG8_BAR; }
    PG8_BAR;
#undef PG8_SA
#undef PG8_SB
#undef PG8_STAGE
#undef PG8_STAGEA
#undef PG8_OFFS
#undef PG8_LDA
#undef PG8_LDB
#undef PG8_CAT
#undef PG8_LO
#undef PG8_HI
#undef PG8_MMA
#undef PG8_WAIT_V
#undef PG8_WAIT_L
#undef PG8_BAR
#undef PG8_SCHED
}

typedef const f32x4 (&AccRef)[2][2][4][2];

struct EpiAB {
    bf16* Z; const float* cs;
    __device__ __forceinline__ void operator()(AccRef acc, const Unit& u, int wr, int wc, int fr, int fq) const {
        const int sec = u.pn >> 2, ct = u.pn & 3;
        bf16* base = Z + (size_t)sec * ZSEC;
#pragma unroll
        for (int ai = 0; ai < 2; ++ai)
#pragma unroll
            for (int m = 0; m < 4; ++m) {
                const int row = u.pm * BM + ai * HALF + wr * 64 + m * 16 + fr;
                if (sec < 2) {
                    const float sc = sec == 0 ? QK_SCALE : 1.0f;
                    const f32x4 x1a = acc[ai][0][m][0], x1b = acc[ai][0][m][1], x2a = acc[ai][1][m][0], x2b = acc[ai][1][m][1];
                    f32x4 o1a, o1b, o2a, o2b;
                    if (row < NLAT) {
                        const int t = row & (TL - 1); const int pos = (wc & 1) ? (t & 63) : (t >> 6);
                        const float* cp = cs + pos * 32 + 8 * fq;
                        const f32x4 c0 = *(const f32x4*)cp, c1 = *(const f32x4*)(cp + 4), s0 = *(const f32x4*)(cp + 2048), s1 = *(const f32x4*)(cp + 2052);
                        o1a = (x1a * c0 - x2a * s0) * sc; o1b = (x1b * c1 - x2b * s1) * sc; o2a = (x1a * s0 + x2a * c0) * sc; o2b = (x1b * s1 + x2b * c1) * sc;
                    } else { o1a = x1a * sc; o1b = x1b * sc; o2a = x2a * sc; o2b = x2b * sc; }
                    bf16* dst = base + (size_t)row * RW + (2 * ct + (wc >> 1)) * HD + 32 * (wc & 1) + 8 * fq;
                    *(u32x4*)dst = pack8(o1a, o1b); *(u32x4*)(dst + 64) = pack8(o2a, o2b);
                } else {
#pragma unroll
                    for (int bj = 0; bj < 2; ++bj) {
                        f32x4 v0 = acc[ai][bj][m][0], v1 = acc[ai][bj][m][1];
                        if (sec == 3) {
#pragma unroll
                            for (int j = 0; j < 4; ++j) { v0[j] = silu_f(v0[j]); v1[j] = silu_f(v1[j]); }
                        } else if (sec >= 4) {
#pragma unroll
                            for (int j = 0; j < 4; ++j) { v0[j] = gelu_tanh_f(v0[j]); v1[j] = gelu_tanh_f(v1[j]); }
                        }
                        *(u32x4*)(base + (size_t)row * RW + ct * 256 + bj * HALF + wc * 32 + 8 * fq) = pack8(v0, v1);
                    }
                }
            }
    }
};
struct EpiRes {
    float* X; const float* base_lat; const float* base_ctx; const float* gate;
    __device__ __forceinline__ void operator()(AccRef acc, const Unit& u, int wr, int wc, int fr, int fq) const {
        const int r = u.pm < 64 ? (u.pm >> 4) : 4; const int col0 = u.pn * BM + wc * 32 + 8 * fq;
        const float* gp = gate + (size_t)r * MODW + col0;
        const float* bs = (u.pm < 64 ? base_lat + (size_t)(u.pm * BM) * D : base_ctx + (size_t)(u.pm * BM - NLAT) * D) + (size_t)(wr * 64 + fr) * D + col0;
        float* xp = X + (size_t)(u.pm * BM) * D + (size_t)(wr * 64 + fr) * D + col0;
#pragma unroll
        for (int bj = 0; bj < 2; ++bj) {
            const f32x4 g0 = *(const f32x4*)(gp + bj * HALF), g1 = *(const f32x4*)(gp + bj * HALF + 4);
            f32x4 x0[2][4], x1[2][4];
#pragma unroll
            for (int ai = 0; ai < 2; ++ai)
#pragma unroll
                for (int m = 0; m < 4; ++m) { const float* bp = bs + (size_t)(ai * HALF + m * 16) * D + bj * HALF; x0[ai][m] = *(const f32x4*)bp; x1[ai][m] = *(const f32x4*)(bp + 4); }
#pragma unroll
            for (int ai = 0; ai < 2; ++ai)
#pragma unroll
                for (int m = 0; m < 4; ++m) { float* p = xp + (size_t)(ai * HALF + m * 16) * D + bj * HALF;
                    *(f32x4*)p = x0[ai][m] + g0 * acc[ai][bj][m][0]; *(f32x4*)(p + 4) = x1[ai][m] + g1 * acc[ai][bj][m][1]; }
        }
    }
};
struct EpiCV {
    bf16* GB; bf16* XG;
    __device__ __forceinline__ void operator()(AccRef acc, const Unit& u, int wr, int wc, int fr, int fq) const {
#pragma unroll
        for (int ai = 0; ai < 2; ++ai)
#pragma unroll
            for (int m = 0; m < 4; ++m) { const size_t row = (size_t)(u.pm * BM + ai * HALF + wr * 64 + m * 16 + fr);
                if (u.pn < 8) {
#pragma unroll
                    for (int bj = 0; bj < 2; ++bj) *(u32x4*)(GB + row * D + u.pn * 256 + bj * HALF + wc * 32 + 8 * fq) = pack8(acc[ai][bj][m][0], acc[ai][bj][m][1]);
                } else {
                    *(u32x4*)(XG + row * D + (u.pn - 8) * HALF + wc * 32 + 8 * fq) = pack8(acc[ai][0][m][0] * acc[ai][1][m][0], acc[ai][0][m][1] * acc[ai][1][m][1]);
                } }
    }
};
struct EpiMoe1 {
    unsigned char* H;
    __device__ __forceinline__ void operator()(AccRef acc, const Unit& u, int wr, int wc, int fr, int fq) const {
#pragma unroll
        for (int ai = 0; ai < 2; ++ai)
#pragma unroll
            for (int m = 0; m < 4; ++m) { const size_t row = (size_t)(u.pm * BM + ai * HALF + wr * 64 + m * 16 + fr);
                f32x4 a0 = acc[ai][0][m][0], a1 = acc[ai][0][m][1];
#pragma unroll
                for (int j = 0; j < 4; ++j) { a0[j] = silu_f(a0[j]); a1[j] = silu_f(a1[j]); }
                *(u32x2*)(H + row * DE + u.pn * HALF + wc * 32 + 8 * fq) = pack8_fp8(a0 * acc[ai][1][m][0], a1 * acc[ai][1][m][1]); }
    }
};
struct EpiMoe2 {
    bf16* Y;
    __device__ __forceinline__ void operator()(AccRef acc, const Unit& u, int wr, int wc, int fr, int fq) const {
#pragma unroll
        for (int ai = 0; ai < 2; ++ai)
#pragma unroll
            for (int m = 0; m < 4; ++m) { const size_t row = (size_t)(u.pm * BM + ai * HALF + wr * 64 + m * 16 + fr);
#pragma unroll
                for (int bj = 0; bj < 2; ++bj) *(u32x4*)(Y + row * D + u.pn * 256 + bj * HALF + wc * 32 + 8 * fq) = pack8(acc[ai][bj][m][0], acc[ai][bj][m][1]); }
    }
};
}

#define XB_TMO      128
#define XB_XCNT(j)  (256  + 64 * (j))
#define XB_XSUB(j)  (1280 + 64 * (j))
#define XB_XGEN(j)  (2304 + 64 * (j))
#define XB_TOP      3328
#define XB_TOPGEN   3392
#define XCD_BAR_WORDS 3456
#define XB_SPIN_CAP (1u << 18)
__device__ __forceinline__ unsigned xb_ld(unsigned* p)              { return __hip_atomic_load(p, __ATOMIC_RELAXED, __HIP_MEMORY_SCOPE_AGENT); }
__device__ __forceinline__ unsigned xb_add(unsigned* p, unsigned v) { return __hip_atomic_fetch_add(p, v, __ATOMIC_RELAXED, __HIP_MEMORY_SCOPE_AGENT); }
__device__ __forceinline__ unsigned xb_xcc_id() { return (unsigned)__builtin_amdgcn_s_getreg((3 << 11) | 20) & 0xFu; }
#define XB_SPIN(cond, bar) do { unsigned _sp = 0; while (cond) { __builtin_amdgcn_s_sleep(1); \
    if ((++_sp & 255u) == 0u) { if (xb_ld(&(bar)[XB_TMO])) break; if (_sp > XB_SPIN_CAP) { atomicAdd(&(bar)[XB_TMO], 1u); break; } } } } while (0)
struct XcdBarrier { unsigned* bar; unsigned x; volatile LAS unsigned* st; };
__device__ __forceinline__ XcdBarrier xcd_barrier_post(unsigned* bar, volatile LAS unsigned* st) {
    XcdBarrier b; b.bar = bar; b.x = xb_xcc_id(); b.st = st;
    if (threadIdx.x == 0) (void)xb_add(&bar[XB_XCNT(b.x)], 1u);
    return b;
}
__device__ __forceinline__ void xcd_barrier_complete(unsigned* bar, unsigned x, unsigned& nloc, unsigned& nx) {
    const unsigned G = gridDim.x * gridDim.y * gridDim.z;
    unsigned sum, cnt, mine, sp = 0u;
    for (;;) {
        sum = 0u; cnt = 0u; mine = 0u;
#pragma unroll
        for (unsigned j = 0; j < 16; ++j) { const unsigned c = xb_ld(&bar[XB_XCNT(j)]); sum += c; cnt += (c > 0u) ? 1u : 0u; mine = (j == x) ? c : mine; }
        if (sum == G) break;
        __builtin_amdgcn_s_sleep(1);
        if ((++sp & 255u) == 0u) { if (xb_ld(&bar[XB_TMO])) break; if (sp > XB_SPIN_CAP) { atomicAdd(&bar[XB_TMO], 1u); break; } }
    }
    nloc = mine > 0u ? mine : 1u; nx = cnt > 0u ? cnt : 1u;
}
__device__ __forceinline__ void xcd_barrier(const XcdBarrier& b) {
    asm volatile("s_waitcnt vmcnt(0)" ::: "memory");
    __syncthreads();
    if (threadIdx.x == 0) {
        unsigned* bar = b.bar;
        __builtin_amdgcn_s_waitcnt(0);
        unsigned nloc = b.st[0], nx = b.st[1];
        if (nloc == 0u) { xcd_barrier_complete(bar, b.x, nloc, nx); b.st[0] = nloc; b.st[1] = nx; }
        const unsigned old = xb_add(&bar[XB_XSUB(b.x)], 1u);
        const unsigned gen = old / nloc;
        if (old + 1u == (gen + 1u) * nloc) {
            __builtin_amdgcn_fence(__ATOMIC_RELEASE, "agent");
            asm volatile("s_waitcnt vmcnt(0)" ::: "memory");
            const unsigned og = xb_add(&bar[XB_TOP], 1u);
            const unsigned tg = og / nx;
            if (og + 1u == (tg + 1u) * nx) xb_add(&bar[XB_TOPGEN], 1u);
            else XB_SPIN(xb_ld(&bar[XB_TOPGEN]) == tg, bar);
            __builtin_amdgcn_fence(__ATOMIC_ACQUIRE, "agent");
            xb_add(&bar[XB_XGEN(b.x)], 1u);
            asm volatile("s_waitcnt vmcnt(0)" ::: "memory");
        } else {
            XB_SPIN(xb_ld(&bar[XB_XGEN(b.x)]) == gen, bar);
            __builtin_amdgcn_fence(__ATOMIC_ACQUIRE, "agent");
            asm volatile("s_waitcnt vmcnt(0)" ::: "memory");
        }
    }
    __syncthreads();
}

struct Args {
    const float *x, *c, *ctx, *c_ctx, *w_mod, *b_mod, *g_mix, *g_ffn, *ab_w_in, *ab_w_out, *decay, *sgu_w, *sgu_b,
                *cv_w_in, *cv_cw, *cv_cb, *cv_w_out, *w_r1, *b_r1, *w_r2, *b_r2, *w1, *w3, *w2, *g_final;
    float* out; unsigned char* ws; int ph_lo, ph_hi;
};
struct Frame { LAS unsigned char* lds; volatile LAS unsigned* MISC; int wave, G, blk; };
#define FR_LANE_TID const int lane_ = lane_id(); const int tid_ = F.wave * 64 + lane_

enum { PH_PRO = 0, PH_L0 = 1, PH_PER_LAYER = 10, PH_FINAL = 21, NPHASE = 22 };
enum { K_PRE = 0, K_GIN = 1, K_MID1 = 2, K_MID2 = 3, K_MID3 = 4, K_GOUT = 5, K_ROUTE = 6, K_GATHER = 7, K_MOE1 = 8, K_MOE2 = 9 };

__device__ __forceinline__ int pos32(int x) { return 16 * ((x >> 2) & 1) + 4 * (x >> 3) + (x & 3); }
constexpr int I_IN = 32 * 192, I_OUT = 32 * 64, I_FIX = 2 * I_IN + 2 * I_OUT, I_EXP = 3072, I_MOE = 16 * I_EXP, NITEMS = I_FIX + 2 * I_MOE;
struct ItemDesc { const float* src; unsigned char* dst; int N, K, k0, dgrp, fp8; };
__device__ __forceinline__ ItemDesc decode_item(const Args& a, int it) {
    unsigned char* ws = a.ws; ItemDesc d; int kb, nb;
    if (it < I_IN) {
        kb = it / 192; nb = it % 192; const int n = nb * 32, sec = n >> 10;
        if (sec < 2) { const int h = (n & 1023) >> 7, dgi = (n & 127) >> 5; d.dgrp = (sec * 4 + (h >> 1)) * 8 + (dgi >> 1) * 4 + (h & 1) * 2 + (dgi & 1); } else d.dgrp = nb;
        d.src = a.ab_w_in; d.N = 6144; d.K = D; d.dst = ws + WS_WAB_IN; d.fp8 = 0;
    } else if (it < I_IN + I_OUT) { const int r = it - I_IN; kb = r / 64; nb = r % 64; d.dgrp = nb; d.src = a.ab_w_out; d.N = D; d.K = D; d.dst = ws + WS_WAB_OUT; d.fp8 = 0;
    } else if (it < 2 * I_IN + I_OUT) {
        const int r = it - I_IN - I_OUT; kb = r / 192; nb = r % 192; const int n = nb * 32;
        if (n < 2048) d.dgrp = nb; else if (n < 4096) { const int cc = n - 2048; d.dgrp = (8 + (cc >> 7)) * 8 + ((cc & 127) >> 5); } else { const int cc = n - 4096; d.dgrp = (8 + (cc >> 7)) * 8 + 4 + ((cc & 127) >> 5); }
        d.src = a.cv_w_in; d.N = 6144; d.K = D; d.dst = ws + WS_WCV_IN; d.fp8 = 0;
    } else if (it < I_FIX) { const int r = it - 2 * I_IN - I_OUT; kb = r / 64; nb = r % 64; d.dgrp = nb; d.src = a.cv_w_out; d.N = D; d.K = D; d.dst = ws + WS_WCV_OUT; d.fp8 = 0;
    } else {
        const int idx = it - I_FIX; const int le = idx / I_EXP, r = idx % I_EXP, which = r >> 10, item = r & 1023; d.fp8 = 1;
        if (which < 2) {
            kb = item >> 5; nb = item & 31; const int cc = nb * 32; d.dgrp = (cc >> 7) * 8 + which * 4 + ((cc & 127) >> 5);
            d.src = (which ? a.w3 : a.w1) + (size_t)le * D * DE; d.N = DE; d.K = D; d.dst = ws + WS_W13 + (size_t)le * D * D;
        } else {
            kb = item >> 6; nb = item & 63; d.dgrp = nb; d.src = a.w2 + (size_t)le * DE * D; d.N = D; d.K = DE; d.dst = ws + WS_W2 + (size_t)le * D * DE;
        }
    }
    d.k0 = 64 * kb; d.src += (size_t)d.k0 * d.N + 32 * nb;
    return d;
}
__device__ __forceinline__ void item_load(const ItemDesc& d, f32x4 (&v)[8], int lane) {
    const float* src = d.src + (size_t)(8 * (lane >> 3)) * d.N + 4 * (lane & 7);
#pragma unroll
    for (int i = 0; i < 8; ++i) v[i] = __builtin_nontemporal_load((const f32x4*)(src + (size_t)i * d.N));
}
__device__ __forceinline__ void item_finish(const ItemDesc& d, const f32x4 (&v)[8], LAS float* scr, int lane) {
    (void)scr;
    const int kq = 8 * (lane >> 3), nq = 4 * (lane & 7);
    if (d.fp8) {
#pragma unroll
        for (int j = 0; j < 4; ++j) { u32x2 o; o.x = pk4_fp8(v[0][j] * W8_SCALE, v[1][j] * W8_SCALE, v[2][j] * W8_SCALE, v[3][j] * W8_SCALE); o.y = pk4_fp8(v[4][j] * W8_SCALE, v[5][j] * W8_SCALE, v[6][j] * W8_SCALE, v[7][j] * W8_SCALE);
            *(u32x2*)(d.dst + (size_t)(d.dgrp * 32 + pos32(nq + j)) * d.K + d.k0 + kq) = o; }
    } else {
#pragma unroll
        for (int j = 0; j < 4; ++j) { u32x4 o; o.x = cvt_pk_bf16(v[0][j], v[1][j]); o.y = cvt_pk_bf16(v[2][j], v[3][j]); o.z = cvt_pk_bf16(v[4][j], v[5][j]); o.w = cvt_pk_bf16(v[6][j], v[7][j]);
            *(u32x4*)((bf16*)d.dst + (size_t)(d.dgrp * 32 + pos32(nq + j)) * d.K + d.k0 + kq) = o; }
    }
}
__device__ __forceinline__ void convert_items(const Args& a, Frame& F, int it0, int it1, int stride) {
    const int lane = lane_id(); LAS float* scr = (LAS float*)(F.lds + F.wave * 8448);
    if (it0 >= it1) return;
    f32x4 vc[8], vn[8]; ItemDesc cur = decode_item(a, it0); item_load(cur, vc, lane);
    for (int it = it0; it < it1; it += stride) {
        const bool hn = it + stride < it1; const ItemDesc nxt = decode_item(a, hn ? it + stride : it);
        if (hn) item_load(nxt, vn, lane);
        item_finish(cur, vc, scr, lane);
        cur.src = nxt.src; cur.dst = nxt.dst; cur.N = nxt.N; cur.K = nxt.K; cur.k0 = nxt.k0; cur.dgrp = nxt.dgrp; cur.fp8 = nxt.fp8;
#pragma unroll
        for (int i = 0; i < 8; ++i) vc[i] = vn[i];
    }
}
constexpr int TAIL_N1 = 10, TAIL_N2 = 8, TAIL_T1 = 160 * 8 * TAIL_N1, TAIL_T2 = 224 * 8 * TAIL_N2;
static_assert(TAIL_T1 + TAIL_T2 <= I_MOE, "tail shares");
__device__ __forceinline__ void phase_prologue(const Args& a, Frame& F) {
    FR_LANE_TID;
    unsigned char* ws = a.ws;
    {
        LAS float* S = (LAS float*)(F.lds + 69632);
        LAS float* red = (LAS float*)(F.lds + 110592);
        for (int i = tid_; i < 5 * D; i += 512) { const int r = i / D, k = i % D; const float v = r < 4 ? a.c[r * D + k] : a.c_ctx[k]; S[i] = silu_f(v); }
        __syncthreads();
        if (F.blk < 256) {
            const int Lm = F.blk >> 7, strip = F.blk & 127;
            const int rsub = lane_ / 24, c4 = lane_ % 24;
            float acc[5][4];
#pragma unroll
            for (int r = 0; r < 5; ++r) { acc[r][0] = 0.f; acc[r][1] = 0.f; acc[r][2] = 0.f; acc[r][3] = 0.f; }
            if (rsub < 2) {
                const float* wp = a.w_mod + (size_t)Lm * D * MODW + (size_t)(256 * F.wave + rsub) * MODW + 96 * strip + 4 * c4;
#pragma unroll 8
                for (int it = 0; it < 128; ++it) {
                    const f32x4 w = *(const f32x4*)(wp + (size_t)(2 * it) * MODW);
                    const int k = 256 * F.wave + 2 * it + rsub;
#pragma unroll
                    for (int r = 0; r < 5; ++r) { const float s = S[r * D + k]; acc[r][0] += s * w[0]; acc[r][1] += s * w[1]; acc[r][2] += s * w[2]; acc[r][3] += s * w[3]; }
                }
#pragma unroll
                for (int r = 0; r < 5; ++r)
#pragma unroll
                    for (int j = 0; j < 4; ++j) red[(F.wave * 2 + rsub) * 480 + r * 96 + 4 * c4 + j] = acc[r][j];
            }
            __syncthreads();
            if (tid_ < 480) { float s = 0.f;
#pragma unroll
                for (int p = 0; p < 16; ++p) s += red[p * 480 + tid_];
                const int r = tid_ / 96, cc = tid_ % 96; const int col = 96 * strip + cc;
                ((float*)(ws + WS_MOD))[(size_t)(Lm * 5 + r) * MODW + col] = s + a.b_mod[Lm * MODW + col]; }
        }
        __syncthreads();
    }
    {
        const int gt = F.blk * 512 + tid_, NT = F.G * 512;
        float* cs = (float*)(ws + WS_ROPE);
        for (int i = gt; i < 2048; i += NT) { const int pos = i >> 5, f = i & 31; const float inv = powf(10000.0f, -(float)f / 32.0f); const float ang = (float)pos * inv; cs[i] = cosf(ang); cs[2048 + i] = sinf(ang); }
        float* wr = (float*)(ws + WS_WR);
        for (int i = gt; i < 2 * 20 * D; i += NT) { const int L = i / (20 * D), r = (i / D) % 20, k = i % D;
            float v; if (r < 4) v = a.w_r1[((size_t)L * D + k) * 4 + r]; else { const int g = (r - 4) >> 2, e = (r - 4) & 3; v = a.w_r2[(((size_t)L * 4 + g) * D + k) * 4 + e]; }
            wr[i] = v; }
    }
    {
        const int gw = F.blk * 8 + F.wave, NGW = F.G * 8;
        constexpr int R0 = I_MOE - TAIL_T1 - TAIL_T2;
        constexpr int NPRO = I_FIX + R0 + I_MOE;
        int v0 = gw;
        if (v0 < I_FIX) { const int n = (I_FIX - v0 + NGW - 1) / NGW; convert_items(a, F, v0, I_FIX, NGW); v0 += n * NGW; }
        if (v0 < I_FIX + R0) { const int n = (I_FIX + R0 - v0 + NGW - 1) / NGW; convert_items(a, F, v0 + TAIL_T1 + TAIL_T2, I_FIX + I_MOE, NGW); v0 += n * NGW; }
        if (v0 < NPRO) convert_items(a, F, v0 - R0 + I_MOE, NITEMS, NGW);
    }
}

__device__ __forceinline__ int moe_tables(const Args& a, Frame& F, int L) {
    FR_LANE_TID;
    volatile LAS int* tb = (volatile LAS int*)(F.MISC + MI_TB); volatile LAS int* texp = (volatile LAS int*)(F.MISC + MI_TEXP); volatile LAS int* cn = (volatile LAS int*)(F.MISC + MI_LCNT);
    __syncthreads();
    if (tid_ == 0) { unsigned* cnt = (unsigned*)(a.ws + WS_CTL) + CW_CNT + L * 16 * 64; int acc = 0;
        for (int e = 0; e < NE; ++e) { tb[e] = acc; const int c = (int)xb_ld(cnt + e * 64); cn[e] = c; const int n = (c + 255) >> 8; for (int t = 0; t < n && acc + t < 160; ++t) texp[acc + t] = e; acc += n; }
        tb[NE] = acc; }
    __syncthreads();
    return tb[NE];
}
__device__ __forceinline__ void combine_row(f32x4 (&v)[8], const bf16* Y, const int* ridx, const float* rwt, const float* gate, const volatile LAS int* tb, int row, int lane) {
    const i32x4 ri = *(const i32x4*)(ridx + 4 * (size_t)row); const f32x2 w = *(const f32x2*)(rwt + 2 * (size_t)row);
    const int d0 = tb[ri.x] * 256 + ri.y, d1 = tb[ri.z] * 256 + ri.w;
    const bf16* y0 = Y + (size_t)d0 * D + 4 * lane; const bf16* y1 = Y + (size_t)d1 * D + 4 * lane;
#pragma unroll
    for (int j = 0; j < 8; ++j) { const u32x2 p0 = *(const u32x2*)(y0 + 256 * j), p1 = *(const u32x2*)(y1 + 256 * j); const f32x4 g = *(const f32x4*)(gate + 4 * lane + 256 * j);
        v[j][0] += g[0] * (w.x * bf2f(p0.x & 0xffffu) + w.y * bf2f(p1.x & 0xffffu)); v[j][1] += g[1] * (w.x * bf2f(p0.x >> 16) + w.y * bf2f(p1.x >> 16));
        v[j][2] += g[2] * (w.x * bf2f(p0.y & 0xffffu) + w.y * bf2f(p1.y & 0xffffu)); v[j][3] += g[3] * (w.x * bf2f(p0.y >> 16) + w.y * bf2f(p1.y >> 16)); }
}
__device__ __forceinline__ float row_rstd(const f32x4 (&v)[8]) {
    float ss = 0.f;
#pragma unroll
    for (int j = 0; j < 8; ++j) ss += (v[j][0] * v[j][0] + v[j][1] * v[j][1]) + (v[j][2] * v[j][2] + v[j][3] * v[j][3]);
    return rsqrtf(wave_sum(ss) * (1.0f / D) + EPSN);
}
__device__ __forceinline__ void phase_pre(const Args& a, Frame& F, int L) {
    FR_LANE_TID;
    unsigned char* ws = a.ws; float* XB = (float*)(ws + WS_XB); bf16* A = (bf16*)(ws + WS_A);
    const float* MOD = (const float*)(ws + WS_MOD);
    const int nrows = (L == 0) ? NTOK : NLAT;
    const int gw = F.blk * 8 + F.wave, NGW = F.G * 8;
    if (L > 0) (void)moe_tables(a, F, L - 1);
    const volatile LAS int* tb = (const volatile LAS int*)(F.MISC + MI_TB);
    f32x4 vn[8];
    if (gw < nrows) { const float* src = L == 0 ? (gw < NLAT ? a.x + (size_t)gw * D : a.ctx + (size_t)(gw - NLAT) * D) : XB + (size_t)gw * D;
#pragma unroll
        for (int j = 0; j < 8; ++j) vn[j] = *(const f32x4*)(src + 4 * lane_ + 256 * j); }
    for (int row = gw; row < nrows; row += NGW) {
        const int r = row < NLAT ? row >> 12 : 4;
        int ln4 = 4 * lane_; asm volatile("" : "+v"(ln4));
        f32x4 v[8];
#pragma unroll
        for (int j = 0; j < 8; ++j) v[j] = vn[j];
        { const int rn = row + NGW; if (rn < nrows) { const float* src = L == 0 ? (rn < NLAT ? a.x + (size_t)rn * D : a.ctx + (size_t)(rn - NLAT) * D) : XB + (size_t)rn * D;
#pragma unroll
            for (int j = 0; j < 8; ++j) vn[j] = *(const f32x4*)(src + ln4 + 256 * j); } }
        if (L > 0) {
            combine_row(v, (const bf16*)(ws + WS_R2), (const int*)(ws + WS_RIDX) + (size_t)(L - 1) * NTOK * 4, (const float*)(ws + WS_RWT) + (size_t)(L - 1) * NTOK * 2,
                        MOD + (size_t)((L - 1) * 5 + r) * MODW + 5 * D, tb, row, lane_);
#pragma unroll
            for (int j = 0; j < 8; ++j) *(f32x4*)(XB + (size_t)row * D + ln4 + 256 * j) = v[j];
        }
        const float rstd = row_rstd(v);
        const float* mp = MOD + (size_t)(L * 5 + r) * MODW; const float* gm = a.g_mix + L * D;
#pragma unroll
        for (int j = 0; j < 8; ++j) { const int c = ln4 + 256 * j; const f32x4 g = *(const f32x4*)(gm + c), sh = *(const f32x4*)(mp + c), sc = *(const f32x4*)(mp + D + c);
            const f32x4 o = v[j] * rstd * g * (sc + 1.0f) + sh; u32x2 p; p.x = cvt_pk_bf16(o[0], o[1]); p.y = cvt_pk_bf16(o[2], o[3]); *(u32x2*)(A + (size_t)row * D + c) = p; }
    }
}

constexpr int LDP = 136;
constexpr int IMG = 128 * LDP * 2;
__device__ __forceinline__ int unit_row0(int b, int s) { return s < 2 ? NLAT + b * TCX + s * 128 : b * TL + (s - 2) * 128; }
__device__ __forceinline__ void piece_rc(int q, int& j, int& ch) { const int jr = q & 15, cq = (q >> 4) & 3, blk = q >> 6; j = 16 * (blk & 7) + jr; ch = 4 * (blk >> 3) + cq; }

__device__ __forceinline__ void ret_u_unit(const Args& a, Frame& F, int u) {
    FR_LANE_TID;
    unsigned char* ws = a.ws; const bf16* Z = (const bf16*)(ws + WS_R1);
    const int bh = u / NSLOT, s = u % NSLOT, b = bh >> 3, h = bh & 7; const int row0 = unit_row0(b, s);
    const bf16* Kp = Z + 1 * ZSEC + (size_t)row0 * RW + h * HD; const bf16* Vp = Z + 2 * ZSEC + (size_t)row0 * RW + h * HD;
    const float lgf2 = logsig(a.decay[h]) * LOG2E, lgb2 = logsig(a.decay[NH + h]) * LOG2E;
    LAS bf16* KTf = (LAS bf16*)(F.lds); LAS bf16* KTb = (LAS bf16*)(F.lds + IMG); LAS bf16* VT = (LAS bf16*)(F.lds + 2 * IMG);
#pragma unroll
    for (int k = 0; k < 4; ++k) { int j, ch; piece_rc(tid_ + 512 * k, j, ch);
        const u32x4 kv = *(const u32x4*)(Kp + (size_t)j * RW + 8 * ch), vv = *(const u32x4*)(Vp + (size_t)j * RW + 8 * ch);
        const float ff = exp2f((float)(127 - j) * lgf2), fb = exp2f((float)j * lgb2);
#pragma unroll
        for (int i = 0; i < 8; ++i) { const unsigned kw = (i & 1) ? (kv[i >> 1] >> 16) : (kv[i >> 1] & 0xffffu), vw = (i & 1) ? (vv[i >> 1] >> 16) : (vv[i >> 1] & 0xffffu);
            const float kf = bf2f(kw); const unsigned pf = cvt_pk_bf16(kf * ff, kf * fb);
            KTf[(8 * ch + i) * LDP + j] = (bf16)(pf & 0xffffu); KTb[(8 * ch + i) * LDP + j] = (bf16)(pf >> 16); VT[(8 * ch + i) * LDP + j] = (bf16)vw; } }
    __syncthreads();
    const int fr = lane_ & 15, g = lane_ >> 4, dt = F.wave;
    f32x4 accf[8], accb[8];
#pragma unroll
    for (int e = 0; e < 8; ++e) { accf[e] = (f32x4){0.f, 0.f, 0.f, 0.f}; accb[e] = (f32x4){0.f, 0.f, 0.f, 0.f}; }
#pragma unroll
    for (int sI = 0; sI < 4; ++sI) {
        const bf16x8 af = *(const LAS bf16x8*)(KTf + (16 * dt + fr) * LDP + 32 * sI + 8 * g), ab = *(const LAS bf16x8*)(KTb + (16 * dt + fr) * LDP + 32 * sI + 8 * g);
#pragma unroll
        for (int et = 0; et < 8; ++et) { const bf16x8 bv = *(const LAS bf16x8*)(VT + (16 * et + fr) * LDP + 32 * sI + 8 * g);
            accf[et] = __builtin_amdgcn_mfma_f32_16x16x32_bf16(af, bv, accf[et], 0, 0, 0); accb[et] = __builtin_amdgcn_mfma_f32_16x16x32_bf16(ab, bv, accb[et], 0, 0, 0); }
    }
    float* ST = (float*)(ws + WS_R2) + (size_t)u * 2 * 16384;
#pragma unroll
    for (int et = 0; et < 8; ++et) { *(f32x4*)(ST + (size_t)(16 * et + fr) * 128 + 16 * dt + 4 * g) = accf[et]; *(f32x4*)(ST + 16384 + (size_t)(16 * et + fr) * 128 + 16 * dt + 4 * g) = accb[et]; }
    __syncthreads();
}
__device__ __forceinline__ void sgu_unit(const Args& a, Frame& F, int u) {
    FR_LANE_TID;
    unsigned char* ws = a.ws; const bf16* Z = (const bf16*)(ws + WS_R1); bf16* RS = (bf16*)(ws + WS_R3);
    const int bg = u / NSLOT, s = u % NSLOT, b = bg >> 3, grp = bg & 7; const int row0 = unit_row0(b, s);
    const bf16* Up = Z + 4 * ZSEC + (size_t)row0 * RW + grp * HD; const bf16* Vp = Z + 5 * ZSEC + (size_t)row0 * RW + grp * HD;
    LAS bf16* WS_ = (LAS bf16*)(F.lds); LAS bf16* VT = (LAS bf16*)(F.lds + IMG);
    const float* wsrc = a.sgu_w + (size_t)grp * 16384;
#pragma unroll
    for (int k = 0; k < 8; ++k) { const int i4 = tid_ + 512 * k; const int p = i4 >> 5, q4 = (i4 & 31) * 4; const f32x4 w = *(const f32x4*)(wsrc + p * 128 + q4);
        u32x2 o; o.x = cvt_pk_bf16(w[0], w[1]); o.y = cvt_pk_bf16(w[2], w[3]); *(LAS u32x2*)(WS_ + p * LDP + q4) = o; }
    { const int q = tid_ >> 2, part = tid_ & 3; float x[32];
#pragma unroll
        for (int k = 0; k < 4; ++k) { const u32x4 vv = *(const u32x4*)(Vp + (size_t)q * RW + 32 * part + 8 * k);
#pragma unroll
            for (int i = 0; i < 4; ++i) { x[8 * k + 2 * i] = bf2f(vv[i] & 0xffffu); x[8 * k + 2 * i + 1] = bf2f(vv[i] >> 16); } }
        float sm = 0.f;
#pragma unroll
        for (int i = 0; i < 32; ++i) sm += x[i];
        sm += __shfl_xor(sm, 1); sm += __shfl_xor(sm, 2); const float mu = sm * (1.0f / 128.0f);
        float sq = 0.f;
#pragma unroll
        for (int i = 0; i < 32; ++i) { const float dlt = x[i] - mu; sq += dlt * dlt; }
        sq += __shfl_xor(sq, 1); sq += __shfl_xor(sq, 2); const float rstd = rsqrtf(sq * (1.0f / 128.0f) + EPSN);
#pragma unroll
        for (int i = 0; i < 32; i += 2) { const unsigned p2 = cvt_pk_bf16((x[i] - mu) * rstd, (x[i + 1] - mu) * rstd);
            VT[(32 * part + i) * LDP + q] = (bf16)(p2 & 0xffffu); VT[(32 * part + i + 1) * LDP + q] = (bf16)(p2 >> 16); } }
    __syncthreads();
    const int fr = lane_ & 15, g = lane_ >> 4, pt = F.wave;
    f32x4 acc[8];
#pragma unroll
    for (int c = 0; c < 8; ++c) acc[c] = (f32x4){0.f, 0.f, 0.f, 0.f};
#pragma unroll
    for (int sI = 0; sI < 4; ++sI) { const bf16x8 bw = *(const LAS bf16x8*)(WS_ + (16 * pt + fr) * LDP + 32 * sI + 8 * g);
#pragma unroll
        for (int ct = 0; ct < 8; ++ct) { const bf16x8 av = *(const LAS bf16x8*)(VT + (16 * ct + fr) * LDP + 32 * sI + 8 * g);
            acc[ct] = __builtin_amdgcn_mfma_f32_16x16x32_bf16(av, bw, acc[ct], 0, 0, 0); } }
    const int p = 16 * pt + fr; const float bs = a.sgu_b[grp * 128 + p];
#pragma unroll
    for (int ct = 0; ct < 8; ++ct) { const int c = 16 * ct + 4 * g; const u32x2 uu = *(const u32x2*)(Up + (size_t)p * RW + c);
        const float o0 = bf2f(uu.x & 0xffffu) * (acc[ct][0] + bs), o1 = bf2f(uu.x >> 16) * (acc[ct][1] + bs), o2 = bf2f(uu.y & 0xffffu) * (acc[ct][2] + bs), o3 = bf2f(uu.y >> 16) * (acc[ct][3] + bs);
        u32x2 o; o.x = cvt_pk_bf16(o0, o1); o.y = cvt_pk_bf16(o2, o3); *(u32x2*)(RS + (size_t)(row0 + p) * D + RW + grp * HD + c) = o; }
    __syncthreads();
}
__device__ __forceinline__ void phase_scan(const Args& a, Frame& F) {
    FR_LANE_TID;
    float* ST = (float*)(a.ws + WS_R2);
    const int NT = F.G * 512;
    for (int it = F.blk * 512 + tid_; it < 32 * 2 * 4096; it += NT) {
        const int bh = it >> 13, dir = (it >> 12) & 1, e4 = it & 4095, h = bh & 7;
        const float cd = expf(128.0f * logsig(a.decay[dir * NH + h]));
        float* base = ST + ((size_t)bh * NSLOT * 2 + dir) * 16384 + (size_t)e4 * 4;
        f32x4 st = (f32x4){0.f, 0.f, 0.f, 0.f};
#pragma unroll 2
        for (int n = 0; n < NSLOT; ++n) { const int s = dir == 0 ? n : (n < 2 ? 1 - n : 35 - n);
            float* p = base + (size_t)s * 2 * 16384; const f32x4 tmp = *(const f32x4*)p; *(f32x4*)p = st; st = st * cd + tmp; }
    }
}
__device__ __forceinline__ void ret_y_unit(const Args& a, Frame& F, int u) {
    FR_LANE_TID;
    unsigned char* ws = a.ws; const bf16* Z = (const bf16*)(ws + WS_R1); bf16* RS = (bf16*)(ws + WS_R3);
    const int bh = u / NSLOT, s = u % NSLOT, b = bh >> 3, h = bh & 7; const int row0 = unit_row0(b, s);
    const bf16* Qp = Z + (size_t)row0 * RW + h * HD; const bf16* Kp = Z + 1 * ZSEC + (size_t)row0 * RW + h * HD; const bf16* Vp = Z + 2 * ZSEC + (size_t)row0 * RW + h * HD;
    const bf16* Gp = Z + 3 * ZSEC + (size_t)row0 * RW + h * HD;
    const float lgf2 = logsig(a.decay[h]) * LOG2E, lgb2 = logsig(a.decay[NH + h]) * LOG2E;
    LAS bf16* KN = (LAS bf16*)(F.lds); LAS bf16* VT = (LAS bf16*)(F.lds + IMG); LAS bf16* SF = (LAS bf16*)(F.lds + 2 * IMG); LAS bf16* SB = (LAS bf16*)(F.lds + 3 * IMG);
#pragma unroll
    for (int k = 0; k < 4; ++k) { int j, ch; piece_rc(tid_ + 512 * k, j, ch);
        const u32x4 kv = *(const u32x4*)(Kp + (size_t)j * RW + 8 * ch), vv = *(const u32x4*)(Vp + (size_t)j * RW + 8 * ch);
        *(LAS u32x4*)(KN + j * LDP + 8 * ch) = kv;
#pragma unroll
        for (int i = 0; i < 8; ++i) { const unsigned vw = (i & 1) ? (vv[i >> 1] >> 16) : (vv[i >> 1] & 0xffffu); VT[(8 * ch + i) * LDP + j] = (bf16)vw; } }
    { const float* ST = (const float*)(ws + WS_R2) + (size_t)u * 2 * 16384;
#pragma unroll
        for (int k = 0; k < 8; ++k) { const int i4 = tid_ + 512 * k; const int e = i4 >> 5, d4 = (i4 & 31) * 4; const f32x4 sf = *(const f32x4*)(ST + e * 128 + d4), sb = *(const f32x4*)(ST + 16384 + e * 128 + d4);
            u32x2 o; o.x = cvt_pk_bf16(sf[0], sf[1]); o.y = cvt_pk_bf16(sf[2], sf[3]); *(LAS u32x2*)(SF + e * LDP + d4) = o;
            o.x = cvt_pk_bf16(sb[0], sb[1]); o.y = cvt_pk_bf16(sb[2], sb[3]); *(LAS u32x2*)(SB + e * LDP + d4) = o; } }
    const int fr = lane_ & 15, g = lane_ >> 4, it_ = F.wave; const int i_abs = 16 * it_ + fr;
    bf16x8 qf[4];
#pragma unroll
    for (int sI = 0; sI < 4; ++sI) qf[sI] = *(const bf16x8*)(Qp + (size_t)i_abs * RW + 32 * sI + 8 * g);
    __syncthreads();
    bf16x8 pf[4];
#pragma unroll
    for (int ks = 0; ks < 4; ++ks) { f32x4 s0 = (f32x4){0.f, 0.f, 0.f, 0.f}, s1 = s0;
#pragma unroll
        for (int sI = 0; sI < 4; ++sI) { const bf16x8 k0 = *(const LAS bf16x8*)(KN + (32 * ks + fr) * LDP + 32 * sI + 8 * g), k1 = *(const LAS bf16x8*)(KN + (32 * ks + 16 + fr) * LDP + 32 * sI + 8 * g);
            s0 = __builtin_amdgcn_mfma_f32_16x16x32_bf16(k0, qf[sI], s0, 0, 0, 0); s1 = __builtin_amdgcn_mfma_f32_16x16x32_bf16(k1, qf[sI], s1, 0, 0, 0); }
        unsigned w[4];
#pragma unroll
        for (int r = 0; r < 4; r += 2) {
            const int j0 = 32 * ks + 4 * g + r, j1 = j0 + 1, j2 = j0 + 16, j3 = j2 + 1;
            const float d0 = (float)(i_abs - j0), d1 = (float)(i_abs - j1), d2 = (float)(i_abs - j2), d3 = (float)(i_abs - j3);
            const float m0 = d0 >= 0.f ? exp2f(d0 * lgf2) : exp2f(-d0 * lgb2), m1 = d1 >= 0.f ? exp2f(d1 * lgf2) : exp2f(-d1 * lgb2);
            const float m2 = d2 >= 0.f ? exp2f(d2 * lgf2) : exp2f(-d2 * lgb2), m3 = d3 >= 0.f ? exp2f(d3 * lgf2) : exp2f(-d3 * lgb2);
            w[r >> 1] = cvt_pk_bf16(s0[r] * m0, s0[r + 1] * m1); w[2 + (r >> 1)] = cvt_pk_bf16(s1[r] * m2, s1[r + 1] * m3);
        }
        u32x4 ww; ww.x = w[0]; ww.y = w[1]; ww.z = w[2]; ww.w = w[3]; pf[ks] = __builtin_bit_cast(bf16x8, ww);
    }
    const float qdf = exp2f((float)(i_abs + 1) * lgf2), qdb = exp2f((float)(128 - i_abs) * lgb2);
    f32x4 y[8];
#pragma unroll
    for (int et = 0; et < 8; ++et) {
        f32x4 ai = (f32x4){0.f, 0.f, 0.f, 0.f}, cf = ai, cb = ai;
#pragma unroll
        for (int ks = 0; ks < 4; ++ks) { const LAS bf16* vp = VT + (16 * et + fr) * LDP + 32 * ks + 4 * g; const u32x2 lo = *(const LAS u32x2*)vp, hi = *(const LAS u32x2*)(vp + 16);
            u32x4 av; av.x = lo.x; av.y = lo.y; av.z = hi.x; av.w = hi.y;
            ai = __builtin_amdgcn_mfma_f32_16x16x32_bf16(__builtin_bit_cast(bf16x8, av), pf[ks], ai, 0, 0, 0); }
#pragma unroll
        for (int sI = 0; sI < 4; ++sI) { const bf16x8 sf = *(const LAS bf16x8*)(SF + (16 * et + fr) * LDP + 32 * sI + 8 * g), sb = *(const LAS bf16x8*)(SB + (16 * et + fr) * LDP + 32 * sI + 8 * g);
            cf = __builtin_amdgcn_mfma_f32_16x16x32_bf16(sf, qf[sI], cf, 0, 0, 0); cb = __builtin_amdgcn_mfma_f32_16x16x32_bf16(sb, qf[sI], cb, 0, 0, 0); }
        y[et] = ai + cf * qdf + cb * qdb; asm volatile("" ::: "memory");
    }
    float sm = 0.f;
#pragma unroll
    for (int et = 0; et < 8; ++et) sm += (y[et][0] + y[et][1]) + (y[et][2] + y[et][3]);
    sm += __shfl_xor(sm, 16); sm += __shfl_xor(sm, 32); const float mu = sm * (1.0f / 128.0f);
    float sq = 0.f;
#pragma unroll
    for (int et = 0; et < 8; ++et) { const f32x4 dl = y[et] - mu; sq += (dl[0] * dl[0] + dl[1] * dl[1]) + (dl[2] * dl[2] + dl[3] * dl[3]); }
    sq += __shfl_xor(sq, 16); sq += __shfl_xor(sq, 32); const float rstd = rsqrtf(sq * (1.0f / 128.0f) + EPSN);
#pragma unroll
    for (int et = 0; et < 8; ++et) { const int e = 16 * et + 4 * g; const u32x2 gg = *(const u32x2*)(Gp + (size_t)i_abs * RW + e);
        const f32x4 o = (y[et] - mu) * rstd; u32x2 w2; w2.x = cvt_pk_bf16(o[0] * bf2f(gg.x & 0xffffu), o[1] * bf2f(gg.x >> 16)); w2.y = cvt_pk_bf16(o[2] * bf2f(gg.y & 0xffffu), o[3] * bf2f(gg.y >> 16));
        *(u32x2*)(RS + (size_t)(row0 + i_abs) * D + h * HD + e) = w2; }
    __syncthreads();
}

__device__ __forceinline__ void phase_conv(const Args& a, Frame& F) {
    FR_LANE_TID;
    unsigned char* ws = a.ws; const bf16* GB = (const bf16*)(ws + WS_R1); const bf16* XG = GB + (size_t)NLAT * D; bf16* A1 = (bf16*)(ws + WS_R3);
    const int NT = F.G * 512;
    for (int it = F.blk * 512 + tid_; it < NLAT * 256; it += NT) {
        const int row = it >> 8, c = (it & 255) * 8; const int gc = row & 63;
        const u32x4 x1 = *(const u32x4*)(XG + (size_t)row * D + c), gb = *(const u32x4*)(GB + (size_t)row * D + c);
        u32x4 x0 = (u32x4){0u, 0u, 0u, 0u}, x2 = x0;
        if (gc > 0) x0 = *(const u32x4*)(XG + (size_t)(row - 1) * D + c);
        if (gc < 63) x2 = *(const u32x4*)(XG + (size_t)(row + 1) * D + c);
        float o[8];
#pragma unroll
        for (int i = 0; i < 8; ++i) { const int cc = c + i; const unsigned sh = (i & 1) ? 16u : 0u;
            const float f0 = bf2f((x0[i >> 1] >> sh) & 0xffffu), f1 = bf2f((x1[i >> 1] >> sh) & 0xffffu), f2 = bf2f((x2[i >> 1] >> sh) & 0xffffu), fg = bf2f((gb[i >> 1] >> sh) & 0xffffu);
            o[i] = fg * (a.cv_cb[cc] + a.cv_cw[cc] * f0 + a.cv_cw[D + cc] * f1 + a.cv_cw[2 * D + cc] * f2); }
        u32x4 w; w.x = cvt_pk_bf16(o[0], o[1]); w.y = cvt_pk_bf16(o[2], o[3]); w.z = cvt_pk_bf16(o[4], o[5]); w.w = cvt_pk_bf16(o[6], o[7]);
        *(u32x4*)(A1 + (size_t)row * D + c) = w;
    }
}

__device__ __forceinline__ void phase_route(const Args& a, Frame& F, int L) {
    FR_LANE_TID;
    unsigned char* ws = a.ws; const float* XB = (const float*)(ws + WS_XB); unsigned char* Fo = ws + WS_A;
    const float* MOD = (const float*)(ws + WS_MOD); const float* WR = (const float*)(ws + WS_WR) + (size_t)L * 20 * D;
    const int nrows = (L == 0) ? NTOK : NLAT; const int RPB = (nrows + F.G - 1) / F.G;
    LAS int* rinfo = (LAS int*)(F.lds + MISC_OFF + 4 * MI_RINFO);
    LAS float* rw = (LAS float*)(F.lds + MISC_OFF + 4 * MI_RW);
    volatile LAS unsigned* lcnt = F.MISC + MI_LCNT; volatile LAS unsigned* gbase = F.MISC + MI_GBASE;
    LAS float* WL = (LAS float*)F.lds;
    if (tid_ < 16) lcnt[tid_] = 0u;
    for (int i = tid_; i < 19 * D / 4; i += 512) *(LAS f32x4*)(WL + 4 * i) = *(const f32x4*)(WR + 4 * (size_t)i);
    __syncthreads();
    f32x4 vn[8];
    { const int row = F.blk * RPB + F.wave; if (F.wave < RPB && row < nrows) {
#pragma unroll
        for (int j = 0; j < 8; ++j) vn[j] = *(const f32x4*)(XB + (size_t)row * D + 4 * lane_ + 256 * j); } }
    for (int i = F.wave; i < RPB; i += 8) {
        const int row = F.blk * RPB + i; if (row >= nrows) break;
        const int r = row < NLAT ? row >> 12 : 4;
        int ln4 = 4 * lane_; asm volatile("" : "+v"(ln4));
        f32x4 v[8];
#pragma unroll
        for (int j = 0; j < 8; ++j) v[j] = vn[j];
        if (i + 8 < RPB && row + 8 < nrows) {
#pragma unroll
            for (int j = 0; j < 8; ++j) vn[j] = *(const f32x4*)(XB + (size_t)(row + 8) * D + ln4 + 256 * j); }
        const float rstd = row_rstd(v);
        const float* mp = MOD + (size_t)(L * 5 + r) * MODW; const float* gf = a.g_ffn + L * D;
#pragma unroll
        for (int j = 0; j < 8; ++j) { const int c = ln4 + 256 * j; const f32x4 g = *(const f32x4*)(gf + c), sh = *(const f32x4*)(mp + 3 * D + c), sc = *(const f32x4*)(mp + 4 * D + c);
            v[j] = v[j] * rstd * g * (sc + 1.0f) + sh; *(unsigned*)(Fo + (size_t)row * D + c) = pk4_fp8(v[j][0], v[j][1], v[j][2], v[j][3]); }
        float l1[4] = {0.f, 0.f, 0.f, 0.f};
#pragma unroll
        for (int j = 0; j < 8; ++j)
#pragma unroll
            for (int g = 0; g < 4; ++g) { const f32x4 w = *(const LAS f32x4*)(WL + g * D + ln4 + 256 * j); l1[g] += (v[j][0] * w[0] + v[j][1] * w[1]) + (v[j][2] * w[2] + v[j][3] * w[3]); }
#pragma unroll
        for (int g = 0; g < 4; ++g) l1[g] = wave_sum(l1[g]) + a.b_r1[L * 4 + g];
        int grp = 0; float mx = l1[0];
#pragma unroll
        for (int g = 1; g < 4; ++g) if (l1[g] > mx) { mx = l1[g]; grp = g; }
        grp = __builtin_amdgcn_readfirstlane(grp);
        float den = 0.f;
#pragma unroll
        for (int g = 0; g < 4; ++g) den += expf(l1[g] - mx);
        const float pg = 1.0f / den;
        float l2[4] = {0.f, 0.f, 0.f, 0.f};
#pragma unroll
        for (int j = 0; j < 8; ++j)
#pragma unroll
            for (int e = 0; e < 3; ++e) { const f32x4 w = *(const LAS f32x4*)(WL + (4 + 4 * grp + e) * D + ln4 + 256 * j); l2[e] += (v[j][0] * w[0] + v[j][1] * w[1]) + (v[j][2] * w[2] + v[j][3] * w[3]); }
        if (grp < 3) {
#pragma unroll
            for (int j = 0; j < 8; ++j) { const f32x4 w = *(const LAS f32x4*)(WL + (7 + 4 * grp) * D + ln4 + 256 * j); l2[3] += (v[j][0] * w[0] + v[j][1] * w[1]) + (v[j][2] * w[2] + v[j][3] * w[3]); }
        } else {
#pragma unroll
            for (int j = 0; j < 8; ++j) { const f32x4 w = *(const f32x4*)(WR + (size_t)19 * D + ln4 + 256 * j); l2[3] += (v[j][0] * w[0] + v[j][1] * w[1]) + (v[j][2] * w[2] + v[j][3] * w[3]); }
        }
#pragma unroll
        for (int e = 0; e < 4; ++e) l2[e] = wave_sum(l2[e]) + a.b_r2[(L * 4 + grp) * 4 + e];
        int i0 = 0; float v0 = l2[0];
#pragma unroll
        for (int e = 1; e < 4; ++e) if (l2[e] > v0) { v0 = l2[e]; i0 = e; }
        int i1 = -1; float v1 = -3.0e38f;
#pragma unroll
        for (int e = 0; e < 4; ++e) if (e != i0 && l2[e] > v1) { v1 = l2[e]; i1 = e; }
        const float ex = expf(v1 - v0); const float w0 = pg / (1.0f + ex), w1 = pg * ex / (1.0f + ex);
        if (lane_ == 0) { const int e0 = grp * 4 + i0, e1 = grp * 4 + i1;
            const int li0 = (int)__hip_atomic_fetch_add((LAS unsigned*)&lcnt[e0], 1u, __ATOMIC_RELAXED, __HIP_MEMORY_SCOPE_WORKGROUP);
            const int li1 = (int)__hip_atomic_fetch_add((LAS unsigned*)&lcnt[e1], 1u, __ATOMIC_RELAXED, __HIP_MEMORY_SCOPE_WORKGROUP);
            rinfo[4 * i] = e0; rinfo[4 * i + 1] = li0; rinfo[4 * i + 2] = e1; rinfo[4 * i + 3] = li1; rw[2 * i] = w0; rw[2 * i + 1] = w1; }
    }
    __syncthreads();
    if (tid_ < 16) gbase[tid_] = xb_add((unsigned*)(ws + WS_CTL) + CW_CNT + (L * 16 + tid_) * 64, lcnt[tid_]);
    __syncthreads();
    int* RIDX = (int*)(ws + WS_RIDX) + (size_t)L * NTOK * 4; float* RWT = (float*)(ws + WS_RWT) + (size_t)L * NTOK * 2;
    for (int i = tid_; i < RPB; i += 512) { const int row = F.blk * RPB + i; if (row < nrows) {
        const int e0 = rinfo[4 * i], e1 = rinfo[4 * i + 2];
        i32x4 o; o.x = e0; o.y = (int)gbase[e0] + rinfo[4 * i + 1]; o.z = e1; o.w = (int)gbase[e1] + rinfo[4 * i + 3]; *(i32x4*)(RIDX + 4 * (size_t)row) = o;
        f32x2 w; w.x = rw[2 * i]; w.y = rw[2 * i + 1]; *(f32x2*)(RWT + 2 * (size_t)row) = w;
        int* GI = (int*)(ws + WS_GIDX) + (size_t)L * NE * NTOK; GI[(size_t)e0 * NTOK + o.y] = row; GI[(size_t)e1 * NTOK + o.w] = row; } }
    __syncthreads();
}
__device__ __forceinline__ void phase_final(const Args& a, Frame& F, int Lc  ) {
    FR_LANE_TID;
    unsigned char* ws = a.ws; const float* XB = (const float*)(ws + WS_XB); const float* MOD = (const float*)(ws + WS_MOD);
    const int gw = F.blk * 8 + F.wave, NGW = F.G * 8;
    if (Lc >= 0) (void)moe_tables(a, F, Lc);
    const volatile LAS int* tb = (const volatile LAS int*)(F.MISC + MI_TB);
    f32x4 vn[8];
    if (gw < NLAT) {
#pragma unroll
        for (int j = 0; j < 8; ++j) vn[j] = *(const f32x4*)(XB + (size_t)gw * D + 4 * lane_ + 256 * j); }
    for (int row = gw; row < NLAT; row += NGW) {
        const int r = row >> 12;
        int ln4 = 4 * lane_; asm volatile("" : "+v"(ln4));
        f32x4 v[8];
#pragma unroll
        for (int j = 0; j < 8; ++j) v[j] = vn[j];
        if (row + NGW < NLAT) {
#pragma unroll
            for (int j = 0; j < 8; ++j) vn[j] = *(const f32x4*)(XB + (size_t)(row + NGW) * D + ln4 + 256 * j); }
        if (Lc >= 0) combine_row(v, (const bf16*)(ws + WS_R2), (const int*)(ws + WS_RIDX) + (size_t)Lc * NTOK * 4, (const float*)(ws + WS_RWT) + (size_t)Lc * NTOK * 2,
                                 MOD + (size_t)(Lc * 5 + r) * MODW + 5 * D, tb, row, lane_);
        const float rstd = row_rstd(v);
#pragma unroll
        for (int j = 0; j < 8; ++j) { const int c = ln4 + 256 * j; const f32x4 g = *(const f32x4*)(a.g_final + c); *(f32x4*)(a.out + (size_t)row * D + c) = v[j] * rstd * g; }
    }
}

__global__ void __launch_bounds__(512, 2) fwd_kernel(Args a) {
    extern __shared__ __attribute__((aligned(16))) unsigned char lds_raw[];
    Frame F; F.lds = (LAS unsigned char*)lds_raw; F.MISC = (volatile LAS unsigned*)(F.lds + MISC_OFF);
    F.wave = __builtin_amdgcn_readfirstlane((int)threadIdx.x >> 6); F.G = gridDim.x; F.blk = blockIdx.x;
    unsigned char* ws = a.ws;
    F.MISC[threadIdx.x] = 0u; F.MISC[threadIdx.x + 512] = 0u;
    __syncthreads();
#if MK_SPLIT
    #define GRID_BAR() do { } while (0)
#else
    XcdBarrier bar = xcd_barrier_post((unsigned*)(ws + WS_CTL) + CW_BAR, F.MISC);
    #define GRID_BAR() xcd_barrier(bar)
#endif
    const int lo = a.ph_lo, hi = a.ph_hi;
    unsigned long long pr_acc = 0ull, pr_t0 = 0ull;
#define IN(k) (lo <= (k) && (k) < hi && ((((PROBE_MASK) >> (k)) & 1u) ? (pr_t0 = __builtin_amdgcn_s_memrealtime(), true) : true))
#define SEAM(k) do { if (lo <= (k) + 1 && (k) + 1 < hi) GRID_BAR(); if (((PROBE_MASK) >> (k)) & 1u) pr_acc += __builtin_amdgcn_s_memrealtime() - pr_t0; } while (0)

    if (IN(PH_PRO)) { phase_prologue(a, F); SEAM(PH_PRO); }
#define RUN_LAYER(L) do { \
        constexpr int P = PH_L0 + (L) * PH_PER_LAYER; \
        constexpr int nM = ((L) == 0) ? NTOK / 256 : NLAT / 256; \
        if (IN(P + K_PRE)) { phase_pre(a, F, (L)); SEAM(P + K_PRE); } \
        if (DBG_STOP == 1) break; \
        if (IN(P + K_GIN)) { \
            if ((L) == 0) { pg8::Gemm g{(const bf16*)(ws + WS_A), (const bf16*)(ws + WS_WAB_IN), D}; pg8::StaticOrder S; S.init(nM, 24, F.G, F.blk); \
                pg8::EpiAB E{(bf16*)(ws + WS_R1), (const float*)(ws + WS_ROPE)}; pg8::gemm_phase<pg8::EpiAB, pg8::StaticOrder, true, true>(F.lds, F.wave, g, S, E); \
                  if (F.G == 256 && F.blk >= 96) convert_items(a, F, I_FIX + (F.blk - 96) * 8 + F.wave, I_FIX + TAIL_T1, 160 * 8); } \
            else { pg8::Gemm g{(const bf16*)(ws + WS_A), (const bf16*)(ws + WS_WCV_IN), D}; pg8::StaticOrder S; S.init(nM, 24, F.G, F.blk); \
                pg8::EpiCV E{(bf16*)(ws + WS_R1), (bf16*)(ws + WS_R1) + (size_t)NLAT * D}; pg8::gemm_phase<pg8::EpiCV, pg8::StaticOrder, true, true>(F.lds, F.wave, g, S, E); } \
            SEAM(P + K_GIN); \
        } \
        if (IN(P + K_MID1)) { \
            if ((L) == 0) { for (int u = F.blk; u < NUNIT; u += F.G) ret_u_unit(a, F, u); for (int u = F.blk; u < NUNIT; u += F.G) sgu_unit(a, F, u); } \
            else phase_conv(a, F); \
            SEAM(P + K_MID1); \
        } \
        if ((L) == 0) { \
            if (IN(P + K_MID2)) { phase_scan(a, F); SEAM(P + K_MID2); } \
            if (IN(P + K_MID3)) { for (int u = F.blk; u < NUNIT; u += F.G) ret_y_unit(a, F, u); SEAM(P + K_MID3); } \
        } \
        if (IN(P + K_GOUT)) { \
            pg8::Gemm g{(const bf16*)(ws + WS_R3), (const bf16*)(ws + ((L) == 0 ? WS_WAB_OUT : WS_WCV_OUT)), D}; pg8::StaticOrder S; S.init(nM, 8, F.G, F.blk); \
            pg8::EpiRes E{(float*)(ws + WS_XB), (L) == 0 ? a.x : (const float*)(ws + WS_XB), (L) == 0 ? a.ctx : (const float*)(ws + WS_XB) + (size_t)NLAT * D, (const float*)(ws + WS_MOD) + (size_t)(L) * 5 * MODW + 2 * D}; \
            pg8::gemm_phase<pg8::EpiRes, pg8::StaticOrder, true, true>(F.lds, F.wave, g, S, E); \
            if ((L) == 0 && F.G == 256 && F.blk >= 32) convert_items(a, F, I_FIX + TAIL_T1 + (F.blk - 32) * 8 + F.wave, I_FIX + TAIL_T1 + TAIL_T2, 224 * 8); \
            SEAM(P + K_GOUT); \
        } \
        if (DBG_STOP == 2 || (DBG_STOP == 4 && (L) == 1)) break; \
        if (IN(P + K_ROUTE)) { phase_route(a, F, (L)); SEAM(P + K_ROUTE); } \
        if (IN(P + K_MOE1)) { \
            const int TT = moe_tables(a, F, (L)); \
            pg8::Gemm g{(const bf16*)(ws + WS_A), (const bf16*)(ws + WS_W13 + (size_t)(L) * NE * D * D), D / 2}; \
            pg8::MoeOrder S; S.init(TT, 8, F.G, F.blk); S.texp = (const volatile LAS int*)(F.MISC + MI_TEXP); S.bstride = (long)D * D; \
            { FR_LANE_TID; LAS int* idxbuf = (LAS int*)(F.lds + 131072); const volatile LAS int* tb_ = (const volatile LAS int*)(F.MISC + MI_TB); const volatile LAS int* cn_ = (const volatile LAS int*)(F.MISC + MI_LCNT); \
              const int* GI = (const int*)(ws + WS_GIDX) + (size_t)(L) * NE * NTOK; \
              for (int i_ = 0; i_ < 16; ++i_) { pg8::Unit u_; if (!S.next(i_, u_)) break; const int e_ = S.texp[u_.pm]; const int idx_ = (u_.pm - tb_[e_]) * 256 + tid_; \
                  if (tid_ < 256) idxbuf[i_ * 256 + tid_] = idx_ < cn_[e_] ? GI[(size_t)e_ * NTOK + idx_] : 0; } \
              __syncthreads(); } \
            pg8::EpiMoe1 E{ws + WS_R3}; pg8::gemm_phase<pg8::EpiMoe1, pg8::MoeOrder, true, true, true, true>(F.lds, F.wave, g, S, E, (const LAS int*)(F.lds + 131072)); \
            SEAM(P + K_MOE1); \
        } \
        if (IN(P + K_MOE2)) { \
            const int TT = moe_tables(a, F, (L)); \
            pg8::Gemm g{(const bf16*)(ws + WS_R3), (const bf16*)(ws + WS_W2 + (size_t)(L) * NE * D * DE), DE / 2}; \
            pg8::MoeOrder S; S.init(TT, 8, F.G, F.blk); S.texp = (const volatile LAS int*)(F.MISC + MI_TEXP); S.bstride = (long)D * DE; \
            pg8::EpiMoe2 E{(bf16*)(ws + WS_R2)}; pg8::gemm_phase<pg8::EpiMoe2, pg8::MoeOrder, true, true, true>(F.lds, F.wave, g, S, E); \
            SEAM(P + K_MOE2); \
        } \
    } while (0)
    RUN_LAYER(0);
    if (DBG_STOP == 0 || DBG_STOP == 4) RUN_LAYER(1);
    if (IN(PH_FINAL)) phase_final(a, F, DBG_STOP == 0 ? 1 : (DBG_STOP == 3 ? 0 : -1));
#undef IN
#undef SEAM
    if ((PROBE_MASK) != 0u && F.blk == 0 && threadIdx.x == 0) { const unsigned long long t1 = __builtin_amdgcn_s_memrealtime(); while (__builtin_amdgcn_s_memrealtime() - t1 < (unsigned long long)(PROBE_MULT) * pr_acc) __builtin_amdgcn_s_sleep(8); }
}

extern "C" void kernel_launch(void* const* d_in, const int* in_sizes, int n_in, void* d_out, int out_size, void* d_ws, size_t ws_size, hipStream_t stream) {
    static int grid = 0;
    if (grid == 0) {
        if (n_in != 25 || in_sizes[0] != NLAT * D || out_size != NLAT * D || ws_size < WS_END) { fprintf(stderr, "kernel_launch: unexpected shapes (n_in %d, in0 %d, out %d, ws %zu)\n", n_in, n_in > 0 ? in_sizes[0] : -1, out_size, ws_size); grid = -1; return; }
        int dev = 0, cus = 0, per_cu = 0;
        if (hipGetDevice(&dev) != hipSuccess || hipDeviceGetAttribute(&cus, hipDeviceAttributeMultiprocessorCount, dev) != hipSuccess) { grid = -1; return; }
        if (hipFuncSetAttribute((const void*)fwd_kernel, hipFuncAttributeMaxDynamicSharedMemorySize, LDS_BYTES) != hipSuccess) { fprintf(stderr, "kernel_launch: hipFuncSetAttribute failed\n"); grid = -1; return; }
        if (hipOccupancyMaxActiveBlocksPerMultiprocessor(&per_cu, (const void*)fwd_kernel, 512, LDS_BYTES) != hipSuccess || per_cu < 1) fprintf(stderr, "kernel_launch: occupancy query reports %d\n", per_cu);
        (void)hipGetLastError();
        grid = cus;
    }
    if (grid < 0) return;
    (void)hipMemsetAsync((char*)d_ws + WS_CTL, 0, CTL_BYTES, stream);
    Args a{};
    const float** f = (const float**)&a;
    for (int i = 0; i < 25; ++i) f[i] = (const float*)d_in[i];
    a.out = (float*)d_out; a.ws = (unsigned char*)d_ws;
#if MK_SPLIT
    for (int ph = 0; ph < NPHASE; ++ph) { a.ph_lo = ph; a.ph_hi = ph + 1; hipLaunchKernelGGL(fwd_kernel, dim3(grid), dim3(512), LDS_BYTES, stream, a); }
#else
    a.ph_lo = 0; a.ph_hi = NPHASE; hipLaunchKernelGGL(fwd_kernel, dim3(grid), dim3(512), LDS_BYTES, stream, a);
#endif
}
```

```cpp
#include <hip/hip_runtime.h>
#include <cstdio>
#include <cstdint>

#ifndef MK_SPLIT
#define MK_SPLIT 0
#endif
#ifndef PROBE_MASK
#define PROBE_MASK 0u
#endif
#ifndef PROBE_MULT
#define PROBE_MULT 4
#endif
#ifndef DBG_STOP
#define DBG_STOP 0
#endif

#define LAS __attribute__((address_space(3)))
#define GAS __attribute__((address_space(1)))
typedef unsigned short bf16;
typedef short bf16x8 __attribute__((ext_vector_type(8)));
typedef short s16x4 __attribute__((ext_vector_type(4)));
typedef float f32x4 __attribute__((ext_vector_type(4)));
typedef float f32x2 __attribute__((ext_vector_type(2)));
typedef unsigned u32x4 __attribute__((ext_vector_type(4)));
typedef unsigned u32x2 __attribute__((ext_vector_type(2)));
typedef int i32x4 __attribute__((ext_vector_type(4)));
typedef int i32x8 __attribute__((ext_vector_type(8)));
typedef int i32x2 __attribute__((ext_vector_type(2)));

constexpr int D = 2048, NB = 4, TL = 4096, TCX = 256;
constexpr int NLAT = NB * TL;
constexpr int NCTX = NB * TCX;
constexpr int NTOK = NLAT + NCTX;
constexpr int HD = 128, NH = 8, RW = 1024;
constexpr int NSLOT = 34;
constexpr int NUNIT = NB * NH * NSLOT;
constexpr int DE = 1024, NE = 16;
constexpr int PCAP = 2 * NTOK + NE * 256;
constexpr float EPSN = 1e-6f;
constexpr float QK_SCALE = 0.08838834764831845f;
constexpr int MODW = 6 * D;

constexpr size_t MiB = 1u << 20;
constexpr size_t WS_CTL = 0, CTL_BYTES = 1 * MiB;
constexpr size_t WS_MOD = 1 * MiB;
constexpr size_t WS_ROPE = 1 * MiB + 512 * 1024;
constexpr size_t WS_WR = 2 * MiB;
constexpr size_t WS_RIDX = 3 * MiB;
constexpr size_t WS_RWT = 4 * MiB;
constexpr size_t WS_GIDX = 5 * MiB;
constexpr size_t WS_WAB_IN = 8 * MiB, WS_WAB_OUT = 32 * MiB, WS_WCV_IN = 40 * MiB, WS_WCV_OUT = 64 * MiB;
constexpr size_t WS_W13 = 72 * MiB;
constexpr size_t WS_W2 = 328 * MiB;
constexpr size_t WS_XB = 456 * MiB;
constexpr size_t WS_A = 592 * MiB;
constexpr size_t WS_R1 = 660 * MiB;
constexpr size_t WS_R2 = 864 * MiB;
constexpr size_t WS_R3 = 1016 * MiB;
constexpr size_t WS_END = 1092 * MiB;
constexpr size_t ZSEC = (size_t)NTOK * 1024;
constexpr int CW_BAR = 4096;
constexpr int CW_Q = 2048;
constexpr int CW_CNT = 8192;

constexpr int SCR_BYTES = 155648;
constexpr int MISC_OFF = SCR_BYTES;
constexpr int LDS_BYTES = SCR_BYTES + 4096;
constexpr int MI_LCNT = 16, MI_GBASE = 32, MI_TB = 64, MI_TEXP = 96, MI_RINFO = 256, MI_RW = 768;

__device__ __forceinline__ unsigned cvt_pk_bf16(float lo, float hi) { unsigned r; asm("v_cvt_pk_bf16_f32 %0, %1, %2" : "=v"(r) : "v"(lo), "v"(hi)); return r; }
__device__ __forceinline__ int lane_id() { int l; asm volatile("v_mbcnt_lo_u32_b32 %0, -1, 0\n\tv_mbcnt_hi_u32_b32 %0, -1, %0" : "=v"(l)); return l; }
__device__ __forceinline__ float bf2f(unsigned b) { return __uint_as_float(b << 16); }
template <int CTRL> __device__ __forceinline__ float dpp_mov(float v) { return __int_as_float(__builtin_amdgcn_update_dpp(0, __float_as_int(v), CTRL, 0xf, 0xf, false)); }
__device__ __forceinline__ float wave_sum(float v) {
    v += dpp_mov<0xB1>(v); v += dpp_mov<0x4E>(v); v += dpp_mov<0x141>(v); v += dpp_mov<0x140>(v);
    return ((__int_as_float(__builtin_amdgcn_readlane(__float_as_int(v), 0)) + __int_as_float(__builtin_amdgcn_readlane(__float_as_int(v), 16))) +
           (__int_as_float(__builtin_amdgcn_readlane(__float_as_int(v), 32)) + __int_as_float(__builtin_amdgcn_readlane(__float_as_int(v), 48))));
}
__device__ __forceinline__ float silu_f(float x) { return x / (1.0f + __expf(-x)); }
__device__ __forceinline__ float gelu_tanh_f(float x) { const float z = 1.5957691216057308f * (x + 0.044715f * x * x * x); return x / (1.0f + __expf(-z)); }
__device__ __forceinline__ u32x4 pack8(f32x4 a, f32x4 b) { u32x4 w; w.x = cvt_pk_bf16(a[0], a[1]); w.y = cvt_pk_bf16(a[2], a[3]); w.z = cvt_pk_bf16(b[0], b[1]); w.w = cvt_pk_bf16(b[2], b[3]); return w; }
__device__ __forceinline__ unsigned pk4_fp8(float a, float b, float c, float d) { int w = 0; w = __builtin_amdgcn_cvt_pk_fp8_f32(a, b, w, false); w = __builtin_amdgcn_cvt_pk_fp8_f32(c, d, w, true); return (unsigned)w; }
__device__ __forceinline__ u32x2 pack8_fp8(f32x4 a, f32x4 b) { u32x2 w; w.x = pk4_fp8(a[0], a[1], a[2], a[3]); w.y = pk4_fp8(b[0], b[1], b[2], b[3]); return w; }
#define W8_SCALE 64.0f
#define SCALE_W8 0x79797979
#define SCALE_ONE 0x7f7f7f7f
__device__ __forceinline__ float logsig(float x) { return -log1pf(expf(-x)); }
#define LOG2E 1.4426950408889634f

namespace pg8 {
constexpr int BM = 256, BK = 64, HALF = 128, HTB = HALF * BK * 2, STAGE_BYTES = 8 * HTB, NXCD = 8, WGM = 8;
__host__ __device__ __forceinline__ int lds_byte(int r, int c) { const int st = (r >> 4) * 2 + (c >> 5), rr = r & 15, cc = c & 31, ob = rr * 64 + cc * 2; return st * 1024 + (ob ^ (((ob >> 9) & 1) << 5)); }
__host__ __device__ __forceinline__ void stage_rc(int b, int& R, int& C) { const int st = b / 1024, sb = b % 1024, swz = sb ^ (((sb >> 9) & 1) << 5); R = (st >> 1) * 16 + swz / 64; C = (st & 1) * 32 + (swz % 64) / 2; }

struct Unit { int pm, pn; long boff; };
struct Gemm { const bf16* A; const bf16* Bt; int K; };

struct StaticOrder {
    int nM, nN, nwg, G, c;
    __device__ __forceinline__ void init(int nM_, int nN_, int G_, int c_) { nM = nM_; nN = nN_; nwg = nM * nN; G = G_; c = c_; }
    __device__ __forceinline__ bool map(int i, int& pm, int& pn) const {
        const long L = (long)i * G + c; if (L >= nwg) return false;
        int wgid = (int)L; { const int q = nwg / NXCD, r = nwg % NXCD, xcd = wgid % NXCD, off = wgid / NXCD; wgid = (xcd < r ? xcd * (q + 1) : r * (q + 1) + (xcd - r) * q) + off; }
        const int nig = WGM * nN, gid = wgid / nig, fm = gid * WGM, gsz = (nM - fm) < WGM ? (nM - fm) : WGM;
        pm = fm + ((wgid % nig) % gsz); pn = (wgid % nig) / gsz; return true;
    }
    __device__ __forceinline__ bool next(int i, Unit& u) const { u.boff = 0; return map(i, u.pm, u.pn); }
};
struct CtxKvOrder {
    int c;
    __device__ __forceinline__ bool next(int i, Unit& u) const { if (i != 0 || c >= 32) return false; u.pm = 64 + (c >> 3); u.pn = 4 + (c & 7); u.boff = 0; return true; }
};
struct MoeOrder : StaticOrder {
    const volatile LAS int* texp; long bstride;
    __device__ __forceinline__ bool next(int i, Unit& u) const { if (!map(i, u.pm, u.pn)) return false; u.boff = (long)texp[u.pm] * bstride; return true; }
};

template <class Epi, class Sched, bool ALIGN_EPI, bool SP2, bool FP8 = false, bool GATHER = false>
__device__ __forceinline__ void gemm_phase(LAS unsigned char* lds, const int wid, const Gemm g, const Sched& S, const Epi& E, const LAS int* gidx = nullptr) {
    static_assert(!GATHER || SP2, "row-gathered A operand: SP2 loop only");
    const int lane = lane_id(), tid = wid * 64 + lane, wr = wid >> 2, wc = wid & 3, fr = lane & 15, fq = lane >> 4;
    const int K = g.K, nt = K / BK;
    unsigned voffA[2];
#pragma unroll
    for (int i = 0; i < 2; ++i) { int R, C; stage_rc(tid * 16 + i * 8192, R, C); voffA[i] = (unsigned)(R * K + C) * 2u; }
    const size_t kstep = (size_t)(BK * 2);
    const size_t hstep = (size_t)HALF * K * 2;
    const size_t tstep = 2 * hstep;
    const unsigned ldsw = (unsigned)wid * 1024u;
    const int aoff = lds_byte(wr * 64 + fr, fq * 8), boff = lds_byte(wc * 32 + fr, fq * 8);
#define PG8_SA(b, h) (((b) * 2 + (h)) * HTB)
#define PG8_SB(b, h) ((4 + (b) * 2 + (h)) * HTB)
#define PG8_STAGE(bufoff, gbase) do { _Pragma("unroll") for (int _i = 0; _i < 2; ++_i) \
        __builtin_amdgcn_global_load_lds((const unsigned*)((const char*)(gbase) + voffA[_i]), (LAS unsigned*)(lds + (bufoff) + ldsw + _i * 8192), 16, 0, 0); } while (0)
#define PG8_STAGEA(bufoff, ptr, kq, h, useN) do { if constexpr (GATHER) { _Pragma("unroll") for (int _i = 0; _i < 2; ++_i) \
        __builtin_amdgcn_global_load_lds((const unsigned*)(gA + (kq) + ((useN) ? oN[h][_i] : oC[h][_i])), (LAS unsigned*)(lds + (bufoff) + ldsw + _i * 8192), 16, 0, 0); } \
        else { PG8_STAGE(bufoff, ptr); } } while (0)
#define PG8_OFFS(o, uidx) do { _Pragma("unroll") for (int _h = 0; _h < 2; ++_h) _Pragma("unroll") for (int _i = 0; _i < 2; ++_i) { int R_, C_; stage_rc(tid * 16 + _i * 8192, R_, C_); \
        o[_h][_i] = (unsigned)gidx[(uidx) * 256 + _h * HALF + R_] * (unsigned)(K * 2) + (unsigned)(C_ * 2); } } while (0)
#define PG8_CAT(lo, hi) __builtin_shufflevector(lo, hi, 0, 1, 2, 3, 4, 5, 6, 7)
#define PG8_LDA(dst, b, h) do { _Pragma("unroll") for (int m = 0; m < 4; ++m) dst[m] = PG8_CAT(*(const LAS i32x4*)(lds + PG8_SA(b, h) + aoff + m * 2048), *(const LAS i32x4*)(lds + PG8_SA(b, h) + aoff + m * 2048 + 1024)); } while (0)
#define PG8_LDB(dst, b, h) do { _Pragma("unroll") for (int n = 0; n < 2; ++n) dst[n] = PG8_CAT(*(const LAS i32x4*)(lds + PG8_SB(b, h) + boff + n * 2048), *(const LAS i32x4*)(lds + PG8_SB(b, h) + boff + n * 2048 + 1024)); } while (0)
#define PG8_LO(x) __builtin_bit_cast(bf16x8, __builtin_shufflevector(x, x, 0, 1, 2, 3))
#define PG8_HI(x) __builtin_bit_cast(bf16x8, __builtin_shufflevector(x, x, 4, 5, 6, 7))
#define PG8_MMA(ai, bj, At, Bt) do { __builtin_amdgcn_s_setprio(1); \
        if constexpr (FP8) { _Pragma("unroll") for (int m = 0; m < 4; ++m) _Pragma("unroll") for (int n = 0; n < 2; ++n) \
            asm volatile("v_mfma_scale_f32_16x16x128_f8f6f4 %0, %1, %2, %0, %3, %4 op_sel_hi:[0,0,0]" : "+v"(acc[ai][bj][m][n]) : "v"(Bt[n]), "v"(At[m]), "v"(scw), "v"(sca)); } \
        else { _Pragma("unroll") for (int m = 0; m < 4; ++m) _Pragma("unroll") for (int n = 0; n < 2; ++n) { \
            acc[ai][bj][m][n] = __builtin_amdgcn_mfma_f32_16x16x32_bf16(PG8_LO(Bt[n]), PG8_LO(At[m]), acc[ai][bj][m][n], 0, 0, 0); \
            acc[ai][bj][m][n] = __builtin_amdgcn_mfma_f32_16x16x32_bf16(PG8_HI(Bt[n]), PG8_HI(At[m]), acc[ai][bj][m][n], 0, 0, 0); } } \
        __builtin_amdgcn_s_setprio(0); } while (0)
#define PG8_WAIT_V(n) asm volatile("s_waitcnt vmcnt(" #n ")" ::: "memory")
#define PG8_WAIT_L(n) asm volatile("s_waitcnt lgkmcnt(" #n ")" ::: "memory")
#define PG8_BAR __builtin_amdgcn_s_barrier()
#define PG8_SCHED __builtin_amdgcn_sched_barrier(0)
    Unit cur, nxt; int ui = 0;
    if (!S.next(0, cur)) return;
    int scw = SCALE_W8, sca = SCALE_ONE; if constexpr (FP8) asm volatile("" : "+v"(scw), "+v"(sca));
    f32x4 acc[2][2][4][2];
#pragma unroll
    for (int a = 0; a < 2; ++a)
#pragma unroll
        for (int b = 0; b < 2; ++b)
#pragma unroll
            for (int m = 0; m < 4; ++m)
#pragma unroll
                for (int n = 0; n < 2; ++n) acc[a][b][m][n] = (f32x4){0.f, 0.f, 0.f, 0.f};
    i32x8 At[4], B0[2], B1[2];
    const char* cA = (const char*)g.A + (size_t)cur.pm * tstep; const char* cB = (const char*)g.Bt + cur.boff + (size_t)cur.pn * tstep;
    const char* const gA = (const char*)g.A; unsigned oC[2][2], oN[2][2];
    if constexpr (GATHER) { PG8_OFFS(oC, 0);
#pragma unroll
        for (int h = 0; h < 2; ++h) { oN[h][0] = oC[h][0]; oN[h][1] = oC[h][1]; } }
    if constexpr (SP2) {
        PG8_STAGE(PG8_SB(0, 0), cB); PG8_STAGE(PG8_SB(0, 1), cB + hstep); PG8_STAGEA(PG8_SA(0, 0), cA, (size_t)0, 0, false); PG8_STAGEA(PG8_SA(0, 1), cA + hstep, (size_t)0, 1, false);
        if (wr == 1) PG8_BAR;
        PG8_WAIT_V(2); PG8_BAR;
        PG8_STAGE(PG8_SB(1, 0), cB + kstep); PG8_STAGEA(PG8_SA(1, 0), cA + kstep, kstep, 0, false); PG8_STAGE(PG8_SB(1, 1), cB + hstep + kstep);
        PG8_WAIT_V(6); PG8_BAR;
    } else {
        PG8_STAGE(PG8_SB(0, 0), cB); PG8_STAGE(PG8_SA(0, 0), cA); PG8_STAGE(PG8_SB(0, 1), cB + hstep); PG8_STAGE(PG8_SA(0, 1), cA + hstep);
        if (wr == 1) PG8_BAR;
        PG8_WAIT_V(4); PG8_BAR;
        PG8_STAGE(PG8_SB(1, 0), cB + kstep); PG8_STAGE(PG8_SA(1, 0), cA + kstep); PG8_STAGE(PG8_SB(1, 1), cB + hstep + kstep);
        PG8_WAIT_V(6); PG8_BAR;
    }
    for (;;) {
        const bool has_next = S.next(ui + 1, nxt);
        const char* nA = has_next ? (const char*)g.A + (size_t)nxt.pm * tstep : cA; const char* nB = has_next ? (const char*)g.Bt + nxt.boff + (size_t)nxt.pn * tstep : cB;
        if constexpr (GATHER) { if (has_next) PG8_OFFS(oN, ui + 1); }
#pragma unroll 1
        for (int t = 0; t < nt; t += 2) {
            const bool last = (t == nt - 2);
            const char* a1 = cA + (size_t)(t + 1) * kstep;
            const char* a2 = last ? nA : cA + (size_t)(t + 2) * kstep; const char* b2 = last ? nB : cB + (size_t)(t + 2) * kstep;
            const char* a3 = a2 + kstep; const char* b3 = b2 + kstep;
            const size_t kq1 = (size_t)(t + 1) * kstep, kq2 = last ? (size_t)0 : (size_t)(t + 2) * kstep, kq3 = kq2 + kstep;
            if constexpr (SP2) {
            PG8_LDB(B0, 0, 0); PG8_LDB(B1, 0, 1); PG8_SCHED; PG8_LDA(At, 0, 0); PG8_STAGEA(PG8_SA(1, 1), a1 + hstep, kq1, 1, false);
            PG8_WAIT_V(8); PG8_WAIT_L(0); PG8_BAR; PG8_MMA(0, 0, At, B0); PG8_MMA(0, 1, At, B1); PG8_BAR; PG8_SCHED;
            PG8_LDA(At, 0, 1); PG8_STAGE(PG8_SB(0, 0), b2); PG8_STAGE(PG8_SB(0, 1), b2 + hstep); PG8_STAGEA(PG8_SA(0, 0), a2, kq2, 0, last);
            PG8_WAIT_V(8); PG8_WAIT_L(0); PG8_BAR; PG8_MMA(1, 0, At, B0); PG8_MMA(1, 1, At, B1); PG8_BAR; PG8_SCHED;
            PG8_LDB(B0, 1, 0); PG8_LDB(B1, 1, 1); PG8_SCHED; PG8_LDA(At, 1, 0); PG8_STAGEA(PG8_SA(0, 1), a2 + hstep, kq2, 1, last);
            PG8_WAIT_V(8); PG8_WAIT_L(0); PG8_BAR; PG8_MMA(0, 0, At, B0); PG8_MMA(0, 1, At, B1); PG8_BAR; PG8_SCHED;
            PG8_LDA(At, 1, 1); PG8_STAGE(PG8_SB(1, 0), b3); PG8_STAGE(PG8_SB(1, 1), b3 + hstep); PG8_STAGEA(PG8_SA(1, 0), a3, kq3, 0, last);
            PG8_WAIT_V(8); PG8_WAIT_L(0); PG8_BAR; PG8_MMA(1, 0, At, B0); PG8_MMA(1, 1, At, B1); PG8_BAR; PG8_SCHED;
            } else {
            PG8_LDB(B0, 0, 0); PG8_SCHED; PG8_LDA(At, 0, 0); PG8_STAGE(PG8_SA(1, 1), a1 + hstep);
            PG8_WAIT_L(8); PG8_BAR; PG8_WAIT_L(0); PG8_MMA(0, 0, At, B0); PG8_BAR; PG8_SCHED;
            PG8_LDB(B1, 0, 1); PG8_STAGE(PG8_SB(0, 0), b2);
            PG8_BAR; PG8_WAIT_L(0); PG8_MMA(0, 1, At, B1); PG8_BAR;
            PG8_LDA(At, 0, 1); PG8_STAGE(PG8_SA(0, 0), a2);
            PG8_BAR; PG8_WAIT_L(0); PG8_MMA(1, 0, At, B0); PG8_BAR; PG8_SCHED;
            PG8_STAGE(PG8_SB(0, 1), b2 + hstep);
            PG8_WAIT_V(6); PG8_BAR; PG8_MMA(1, 1, At, B1); PG8_BAR;
            PG8_LDB(B0, 1, 0); PG8_SCHED; PG8_LDA(At, 1, 0); PG8_STAGE(PG8_SA(0, 1), a2 + hstep);
            PG8_WAIT_L(8); PG8_BAR; PG8_WAIT_L(0); PG8_MMA(0, 0, At, B0); PG8_BAR; PG8_SCHED;
            PG8_LDB(B1, 1, 1); PG8_STAGE(PG8_SB(1, 0), b3);
            PG8_BAR; PG8_WAIT_L(0); PG8_MMA(0, 1, At, B1); PG8_BAR;
            PG8_LDA(At, 1, 1); PG8_STAGE(PG8_SA(1, 0), a3);
            PG8_BAR; PG8_WAIT_L(0); PG8_MMA(1, 0, At, B0); PG8_BAR; PG8_SCHED;
            PG8_STAGE(PG8_SB(1, 1), b3 + hstep);
            PG8_WAIT_V(6); PG8_BAR; PG8_MMA(1, 1, At, B1); PG8_BAR;
            }
        }
        if constexpr (ALIGN_EPI) { if (wr == 0) PG8_BAR; }
        if constexpr (FP8) asm volatile("s_nop 15\n\ts_nop 15" ::: "memory");
        { int fr_ = fr, fq_ = fq; asm volatile("" : "+v"(fr_), "+v"(fq_)); E(acc, cur, wr, wc, fr_, fq_); }
        if (!has_next) break;
#pragma unroll
        for (int a = 0; a < 2; ++a)
#pragma unroll
            for (int b = 0; b < 2; ++b)
#pragma unroll
                for (int m = 0; m < 4; ++m)
#pragma unroll
                    for (int n = 0; n < 2; ++n) acc[a][b][m][n] = (f32x4){0.f, 0.f, 0.f, 0.f};
        cur = nxt; cA = nA; cB = nB; ++ui;
        if constexpr (GATHER) {
#pragma unroll
            for (int h = 0; h < 2; ++h) { oC[h][0] = oN[h][0]; oC[h][1] = oN[h][1]; } }
        if constexpr (ALIGN_EPI) { if (wr == 1) PG8_BAR; }
    }
    PG8_WAIT_V(0);
    if constexpr (!ALIGN_EPI) { if (wr == 0) PG8_BAR; }
    PG8_BAR;
#undef PG8_SA
#undef PG8_SB
#undef PG8_STAGE
#undef PG8_STAGEA
#undef PG8_OFFS
#undef PG8_LDA
#undef PG8_LDB
#undef PG8_CAT
#undef PG8_LO
#undef PG8_HI
#undef PG8_MMA
#undef PG8_WAIT_V
#undef PG8_WAIT_L
#undef PG8_BAR
#undef PG8_SCHED
}

typedef const f32x4 (&AccRef)[2][2][4][2];

struct EpiAB {
    bf16* Z; const float* cs;
    __device__ __forceinline__ void operator()(AccRef acc, const Unit& u, int wr, int wc, int fr, int fq) const {
        const int sec = u.pn >> 2, ct = u.pn & 3;
        bf16* base = Z + (size_t)sec * ZSEC;
#pragma unroll
        for (int ai = 0; ai < 2; ++ai)
#pragma unroll
            for (int m = 0; m < 4; ++m) {
                const int row = u.pm * BM + ai * HALF + wr * 64 + m * 16 + fr;
                if (sec < 2) {
                    const float sc = sec == 0 ? QK_SCALE : 1.0f;
                    const f32x4 x1a = acc[ai][0][m][0], x1b = acc[ai][0][m][1], x2a = acc[ai][1][m][0], x2b = acc[ai][1][m][1];
                    f32x4 o1a, o1b, o2a, o2b;
                    if (row < NLAT) {
                        const int t = row & (TL - 1); const int pos = (wc & 1) ? (t & 63) : (t >> 6);
                        const float* cp = cs + pos * 32 + 8 * fq;
                        const f32x4 c0 = *(const f32x4*)cp, c1 = *(const f32x4*)(cp + 4), s0 = *(const f32x4*)(cp + 2048), s1 = *(const f32x4*)(cp + 2052);
                        o1a = (x1a * c0 - x2a * s0) * sc; o1b = (x1b * c1 - x2b * s1) * sc; o2a = (x1a * s0 + x2a * c0) * sc; o2b = (x1b * s1 + x2b * c1) * sc;
                    } else { o1a = x1a * sc; o1b = x1b * sc; o2a = x2a * sc; o2b = x2b * sc; }
                    bf16* dst = base + (size_t)row * RW + (2 * ct + (wc >> 1)) * HD + 32 * (wc & 1) + 8 * fq;
                    *(u32x4*)dst = pack8(o1a, o1b); *(u32x4*)(dst + 64) = pack8(o2a, o2b);
                } else {
#pragma unroll
                    for (int bj = 0; bj < 2; ++bj) {
                        f32x4 v0 = acc[ai][bj][m][0], v1 = acc[ai][bj][m][1];
                        if (sec == 3) {
#pragma unroll
                            for (int j = 0; j < 4; ++j) { v0[j] = silu_f(v0[j]); v1[j] = silu_f(v1[j]); }
                        } else if (sec >= 4) {
#pragma unroll
                            for (int j = 0; j < 4; ++j) { v0[j] = gelu_tanh_f(v0[j]); v1[j] = gelu_tanh_f(v1[j]); }
                        }
                        *(u32x4*)(base + (size_t)row * RW + ct * 256 + bj * HALF + wc * 32 + 8 * fq) = pack8(v0, v1);
                    }
                }
            }
    }
};
struct EpiRes {
    float* X; const float* base_lat; const float* base_ctx; const float* gate;
    __device__ __forceinline__ void operator()(AccRef acc, const Unit& u, int wr, int wc, int fr, int fq) const {
        const int r = u.pm < 64 ? (u.pm >> 4) : 4; const int col0 = u.pn * BM + wc * 32 + 8 * fq;
        const float* gp = gate + (size_t)r * MODW + col0;
        const float* bs = (u.pm < 64 ? base_lat + (size_t)(u.pm * BM) * D : base_ctx + (size_t)(u.pm * BM - NLAT) * D) + (size_t)(wr * 64 + fr) * D + col0;
        float* xp = X + (size_t)(u.pm * BM) * D + (size_t)(wr * 64 + fr) * D + col0;
#pragma unroll
        for (int bj = 0; bj < 2; ++bj) {
            const f32x4 g0 = *(const f32x4*)(gp + bj * HALF), g1 = *(const f32x4*)(gp + bj * HALF + 4);
            f32x4 x0[2][4], x1[2][4];
#pragma unroll
            for (int ai = 0; ai < 2; ++ai)
#pragma unroll
                for (int m = 0; m < 4; ++m) { const float* bp = bs + (size_t)(ai * HALF + m * 16) * D + bj * HALF; x0[ai][m] = *(const f32x4*)bp; x1[ai][m] = *(const f32x4*)(bp + 4); }
#pragma unroll
            for (int ai = 0; ai < 2; ++ai)
#pragma unroll
                for (int m = 0; m < 4; ++m) { float* p = xp + (size_t)(ai * HALF + m * 16) * D + bj * HALF;
                    *(f32x4*)p = x0[ai][m] + g0 * acc[ai][bj][m][0]; *(f32x4*)(p + 4) = x1[ai][m] + g1 * acc[ai][bj][m][1]; }
        }
    }
};
struct EpiCV {
    bf16* GB; bf16* XG;
    __device__ __forceinline__ void operator()(AccRef acc, const Unit& u, int wr, int wc, int fr, int fq) const {
#pragma unroll
        for (int ai = 0; ai < 2; ++ai)
#pragma unroll
            for (int m = 0; m < 4; ++m) { const size_t row = (size_t)(u.pm * BM + ai * HALF + wr * 64 + m * 16 + fr);
                if (u.pn < 8) {
#pragma unroll
                    for (int bj = 0; bj < 2; ++bj) *(u32x4*)(GB + row * D + u.pn * 256 + bj * HALF + wc * 32 + 8 * fq) = pack8(acc[ai][bj][m][0], acc[ai][bj][m][1]);
                } else {
                    *(u32x4*)(XG + row * D + (u.pn - 8) * HALF + wc * 32 + 8 * fq) = pack8(acc[ai][0][m][0] * acc[ai][1][m][0], acc[ai][0][m][1] * acc[ai][1][m][1]);
                } }
    }
};
struct EpiMoe1 {
    unsigned char* H;
    __device__ __forceinline__ void operator()(AccRef acc, const Unit& u, int wr, int wc, int fr, int fq) const {
#pragma unroll
        for (int ai = 0; ai < 2; ++ai)
#pragma unroll
            for (int m = 0; m < 4; ++m) { const size_t row = (size_t)(u.pm * BM + ai * HALF + wr * 64 + m * 16 + fr);
                f32x4 a0 = acc[ai][0][m][0], a1 = acc[ai][0][m][1];
#pragma unroll
                for (int j = 0; j < 4; ++j) { a0[j] = silu_f(a0[j]); a1[j] = silu_f(a1[j]); }
                *(u32x2*)(H + row * DE + u.pn * HALF + wc * 32 + 8 * fq) = pack8_fp8(a0 * acc[ai][1][m][0], a1 * acc[ai][1][m][1]); }
    }
};
struct EpiMoe2 {
    bf16* Y;
    __device__ __forceinline__ void operator()(AccRef acc, const Unit& u, int wr, int wc, int fr, int fq) const {
#pragma unroll
        for (int ai = 0; ai < 2; ++ai)
#pragma unroll
            for (int m = 0; m < 4; ++m) { const size_t row = (size_t)(u.pm * BM + ai * HALF + wr * 64 + m * 16 + fr);
#pragma unroll
                for (int bj = 0; bj < 2; ++bj) *(u32x4*)(Y + row * D + u.pn * 256 + bj * HALF + wc * 32 + 8 * fq) = pack8(acc[ai][bj][m][0], acc[ai][bj][m][1]); }
    }
};
}

#define XB_TMO      128
#define XB_XCNT(j)  (256  + 64 * (j))
#define XB_XSUB(j)  (1280 + 64 * (j))
#define XB_XGEN(j)  (2304 + 64 * (j))
#define XB_TOP      3328
#define XB_TOPGEN   3392
#define XCD_BAR_WORDS 3456
#define XB_SPIN_CAP (1u << 18)
__device__ __forceinline__ unsigned xb_ld(unsigned* p)              { return __hip_atomic_load(p, __ATOMIC_RELAXED, __HIP_MEMORY_SCOPE_AGENT); }
__device__ __forceinline__ unsigned xb_add(unsigned* p, unsigned v) { return __hip_atomic_fetch_add(p, v, __ATOMIC_RELAXED, __HIP_MEMORY_SCOPE_AGENT); }
__device__ __forceinline__ unsigned xb_xcc_id() { return (unsigned)__builtin_amdgcn_s_getreg((3 << 11) | 20) & 0xFu; }
#define XB_SPIN(cond, bar) do { unsigned _sp = 0; while (cond) { __builtin_amdgcn_s_sleep(1); \
    if ((++_sp & 255u) == 0u) { if (xb_ld(&(bar)[XB_TMO])) break; if (_sp > XB_SPIN_CAP) { atomicAdd(&(bar)[XB_TMO], 1u); break; } } } } while (0)
struct XcdBarrier { unsigned* bar; unsigned x; volatile LAS unsigned* st; };
__device__ __forceinline__ XcdBarrier xcd_barrier_post(unsigned* bar, volatile LAS unsigned* st) {
    XcdBarrier b; b.bar = bar; b.x = xb_xcc_id(); b.st = st;
    if (threadIdx.x == 0) (void)xb_add(&bar[XB_XCNT(b.x)], 1u);
    return b;
}
__device__ __forceinline__ void xcd_barrier_complete(unsigned* bar, unsigned x, unsigned& nloc, unsigned& nx) {
    const unsigned G = gridDim.x * gridDim.y * gridDim.z;
    unsigned sum, cnt, mine, sp = 0u;
    for (;;) {
        sum = 0u; cnt = 0u; mine = 0u;
#pragma unroll
        for (unsigned j = 0; j < 16; ++j) { const unsigned c = xb_ld(&bar[XB_XCNT(j)]); sum += c; cnt += (c > 0u) ? 1u : 0u; mine = (j == x) ? c : mine; }
        if (sum == G) break;
        __builtin_amdgcn_s_sleep(1);
        if ((++sp & 255u) == 0u) { if (xb_ld(&bar[XB_TMO])) break; if (sp > XB_SPIN_CAP) { atomicAdd(&bar[XB_TMO], 1u); break; } }
    }
    nloc = mine > 0u ? mine : 1u; nx = cnt > 0u ? cnt : 1u;
}
__device__ __forceinline__ void xcd_barrier(const XcdBarrier& b) {
    asm volatile("s_waitcnt vmcnt(0)" ::: "memory");
    __syncthreads();
    if (threadIdx.x == 0) {
        unsigned* bar = b.bar;
        __builtin_amdgcn_s_waitcnt(0);
        unsigned nloc = b.st[0], nx = b.st[1];
        if (nloc == 0u) { xcd_barrier_complete(bar, b.x, nloc, nx); b.st[0] = nloc; b.st[1] = nx; }
        const unsigned old = xb_add(&bar[XB_XSUB(b.x)], 1u);
        const unsigned gen = old / nloc;
        if (old + 1u == (gen + 1u) * nloc) {
            __builtin_amdgcn_fence(__ATOMIC_RELEASE, "agent");
            asm volatile("s_waitcnt vmcnt(0)" ::: "memory");
            const unsigned og = xb_add(&bar[XB_TOP], 1u);
            const unsigned tg = og / nx;
            if (og + 1u == (tg + 1u) * nx) xb_add(&bar[XB_TOPGEN], 1u);
            else XB_SPIN(xb_ld(&bar[XB_TOPGEN]) == tg, bar);
            __builtin_amdgcn_fence(__ATOMIC_ACQUIRE, "agent");
            xb_add(&bar[XB_XGEN(b.x)], 1u);
            asm volatile("s_waitcnt vmcnt(0)" ::: "memory");
        } else {
            XB_SPIN(xb_ld(&bar[XB_XGEN(b.x)]) == gen, bar);
            __builtin_amdgcn_fence(__ATOMIC_ACQUIRE, "agent");
            asm volatile("s_waitcnt vmcnt(0)" ::: "memory");
        }
    }
    __syncthreads();
}

struct Args {
    const float *x, *c, *ctx, *c_ctx, *w_mod, *b_mod, *g_mix, *g_ffn, *ab_w_in, *ab_w_out, *decay, *sgu_w, *sgu_b,
                *cv_w_in, *cv_cw, *cv_cb, *cv_w_out, *w_r1, *b_r1, *w_r2, *b_r2, *w1, *w3, *w2, *g_final;
    float* out; unsigned char* ws; int ph_lo, ph_hi;
};
struct Frame { LAS unsigned char* lds; volatile LAS unsigned* MISC; int wave, G, blk; };
#define FR_LANE_TID const int lane_ = lane_id(); const int tid_ = F.wave * 64 + lane_

enum { PH_PRO = 0, PH_L0 = 1, PH_PER_LAYER = 10, PH_FINAL = 21, NPHASE = 22 };
enum { K_PRE = 0, K_GIN = 1, K_MID1 = 2, K_MID1B = 3, K_MID2 = 4, K_MID3 = 5, K_GOUT = 6, K_ROUTE = 7, K_MOE1 = 8, K_MOE2 = 9 };

__device__ __forceinline__ int pos32(int x) { return 16 * ((x >> 2) & 1) + 4 * (x >> 3) + (x & 3); }
constexpr int I_IN = 32 * 192, I_OUT = 32 * 64, I_FIX = 2 * I_IN + 2 * I_OUT, I_EXP = 3072, I_MOE = 16 * I_EXP, NITEMS = I_FIX + 2 * I_MOE;
struct ItemDesc { const float* src; unsigned char* dst; int N, K, k0, dgrp, fp8; };
__device__ __forceinline__ ItemDesc decode_item(const Args& a, int it) {
    unsigned char* ws = a.ws; ItemDesc d; int kb, nb;
    if (it < I_IN) {
        kb = it / 192; nb = it % 192; const int n = nb * 32, sec = n >> 10;
        if (sec < 2) { const int h = (n & 1023) >> 7, dgi = (n & 127) >> 5; d.dgrp = (sec * 4 + (h >> 1)) * 8 + (dgi >> 1) * 4 + (h & 1) * 2 + (dgi & 1); } else d.dgrp = nb;
        d.src = a.ab_w_in; d.N = 6144; d.K = D; d.dst = ws + WS_WAB_IN; d.fp8 = 0;
    } else if (it < I_IN + I_OUT) { const int r = it - I_IN; kb = r / 64; nb = r % 64; d.dgrp = nb; d.src = a.ab_w_out; d.N = D; d.K = D; d.dst = ws + WS_WAB_OUT; d.fp8 = 0;
    } else if (it < 2 * I_IN + I_OUT) {
        const int r = it - I_IN - I_OUT; kb = r / 192; nb = r % 192; const int n = nb * 32;
        if (n < 2048) d.dgrp = nb; else if (n < 4096) { const int cc = n - 2048; d.dgrp = (8 + (cc >> 7)) * 8 + ((cc & 127) >> 5); } else { const int cc = n - 4096; d.dgrp = (8 + (cc >> 7)) * 8 + 4 + ((cc & 127) >> 5); }
        d.src = a.cv_w_in; d.N = 6144; d.K = D; d.dst = ws + WS_WCV_IN; d.fp8 = 0;
    } else if (it < I_FIX) { const int r = it - 2 * I_IN - I_OUT; kb = r / 64; nb = r % 64; d.dgrp = nb; d.src = a.cv_w_out; d.N = D; d.K = D; d.dst = ws + WS_WCV_OUT; d.fp8 = 0;
    } else {
        const int idx = it - I_FIX; const int le = idx / I_EXP, r = idx % I_EXP, which = r >> 10, item = r & 1023; d.fp8 = 1;
        if (which < 2) {
            kb = item >> 5; nb = item & 31; const int cc = nb * 32; d.dgrp = (cc >> 7) * 8 + which * 4 + ((cc & 127) >> 5);
            d.src = (which ? a.w3 : a.w1) + (size_t)le * D * DE; d.N = DE; d.K = D; d.dst = ws + WS_W13 + (size_t)le * D * D;
        } else {
            kb = item >> 6; nb = item & 63; d.dgrp = nb; d.src = a.w2 + (size_t)le * DE * D; d.N = D; d.K = DE; d.dst = ws + WS_W2 + (size_t)le * D * DE;
        }
    }
    d.k0 = 64 * kb; d.src += (size_t)d.k0 * d.N + 32 * nb;
    return d;
}
__device__ __forceinline__ void item_load(const ItemDesc& d, f32x4 (&v)[8], int lane) {
    const float* src = d.src + (size_t)(8 * (lane >> 3)) * d.N + 4 * (lane & 7);
#pragma unroll
    for (int i = 0; i < 8; ++i) v[i] = __builtin_nontemporal_load((const f32x4*)(src + (size_t)i * d.N));
}
__device__ __forceinline__ void item_finish(const ItemDesc& d, const f32x4 (&v)[8], LAS float* scr, int lane) {
    (void)scr;
    const int kq = 8 * (lane >> 3), nq = 4 * (lane & 7);
    if (d.fp8) {
#pragma unroll
        for (int j = 0; j < 4; ++j) { u32x2 o; o.x = pk4_fp8(v[0][j] * W8_SCALE, v[1][j] * W8_SCALE, v[2][j] * W8_SCALE, v[3][j] * W8_SCALE); o.y = pk4_fp8(v[4][j] * W8_SCALE, v[5][j] * W8_SCALE, v[6][j] * W8_SCALE, v[7][j] * W8_SCALE);
            *(u32x2*)(d.dst + (size_t)(d.dgrp * 32 + pos32(nq + j)) * d.K + d.k0 + kq) = o; }
    } else {
#pragma unroll
        for (int j = 0; j < 4; ++j) { u32x4 o; o.x = cvt_pk_bf16(v[0][j], v[1][j]); o.y = cvt_pk_bf16(v[2][j], v[3][j]); o.z = cvt_pk_bf16(v[4][j], v[5][j]); o.w = cvt_pk_bf16(v[6][j], v[7][j]);
            *(u32x4*)((bf16*)d.dst + (size_t)(d.dgrp * 32 + pos32(nq + j)) * d.K + d.k0 + kq) = o; }
    }
}
__device__ __forceinline__ void convert_items(const Args& a, Frame& F, int it0, int it1, int stride) {
    const int lane = lane_id(); LAS float* scr = (LAS float*)(F.lds + F.wave * 8448);
    if (it0 >= it1) return;
    f32x4 vc[8], vn[8]; ItemDesc cur = decode_item(a, it0); item_load(cur, vc, lane);
    for (int it = it0; it < it1; it += stride) {
        const bool hn = it + stride < it1; const ItemDesc nxt = decode_item(a, hn ? it + stride : it);
        if (hn) item_load(nxt, vn, lane);
        item_finish(cur, vc, scr, lane);
        cur.src = nxt.src; cur.dst = nxt.dst; cur.N = nxt.N; cur.K = nxt.K; cur.k0 = nxt.k0; cur.dgrp = nxt.dgrp; cur.fp8 = nxt.fp8;
#pragma unroll
        for (int i = 0; i < 8; ++i) vc[i] = vn[i];
    }
}
constexpr int TAIL_N1 = 0, TAIL_N2 = 0, TAIL_T1 = 160 * 8 * TAIL_N1, TAIL_T2 = 224 * 8 * TAIL_N2;
static_assert(TAIL_T1 + TAIL_T2 <= I_MOE, "tail shares");
__device__ __forceinline__ void phase_prologue(const Args& a, Frame& F) {
    FR_LANE_TID;
    unsigned char* ws = a.ws;
    {
        LAS float* S = (LAS float*)(F.lds + 69632);
        LAS float* red = (LAS float*)(F.lds + 110592);
        for (int i = tid_; i < 5 * D; i += 512) { const int r = i / D, k = i % D; const float v = r < 4 ? a.c[r * D + k] : a.c_ctx[k]; S[i] = silu_f(v); }
        __syncthreads();
        if (F.blk < 256) {
            const int Lm = F.blk >> 7, strip = F.blk & 127;
            const int rsub = lane_ / 24, c4 = lane_ % 24;
            float acc[5][4];
#pragma unroll
            for (int r = 0; r < 5; ++r) { acc[r][0] = 0.f; acc[r][1] = 0.f; acc[r][2] = 0.f; acc[r][3] = 0.f; }
            if (rsub < 2) {
                const float* wp = a.w_mod + (size_t)Lm * D * MODW + (size_t)(256 * F.wave + rsub) * MODW + 96 * strip + 4 * c4;
#pragma unroll 8
                for (int it = 0; it < 128; ++it) {
                    const f32x4 w = *(const f32x4*)(wp + (size_t)(2 * it) * MODW);
                    const int k = 256 * F.wave + 2 * it + rsub;
#pragma unroll
                    for (int r = 0; r < 5; ++r) { const float s = S[r * D + k]; acc[r][0] += s * w[0]; acc[r][1] += s * w[1]; acc[r][2] += s * w[2]; acc[r][3] += s * w[3]; }
                }
#pragma unroll
                for (int r = 0; r < 5; ++r)
#pragma unroll
                    for (int j = 0; j < 4; ++j) red[(F.wave * 2 + rsub) * 480 + r * 96 + 4 * c4 + j] = acc[r][j];
            }
            __syncthreads();
            if (tid_ < 480) { float s = 0.f;
#pragma unroll
                for (int p = 0; p < 16; ++p) s += red[p * 480 + tid_];
                const int r = tid_ / 96, cc = tid_ % 96; const int col = 96 * strip + cc;
                ((float*)(ws + WS_MOD))[(size_t)(Lm * 5 + r) * MODW + col] = s + a.b_mod[Lm * MODW + col]; }
        }
        __syncthreads();
    }
    {
        const int gt = F.blk * 512 + tid_, NT = F.G * 512;
        float* cs = (float*)(ws + WS_ROPE);
        for (int i = gt; i < 2048; i += NT) { const int pos = i >> 5, f = i & 31; const float inv = powf(10000.0f, -(float)f / 32.0f); const float ang = (float)pos * inv; cs[i] = cosf(ang); cs[2048 + i] = sinf(ang); }
        float* wr = (float*)(ws + WS_WR);
        for (int i = gt; i < 2 * 20 * D; i += NT) { const int L = i / (20 * D), r = (i / D) % 20, k = i % D;
            float v; if (r < 4) v = a.w_r1[((size_t)L * D + k) * 4 + r]; else { const int g = (r - 4) >> 2, e = (r - 4) & 3; v = a.w_r2[(((size_t)L * 4 + g) * D + k) * 4 + e]; }
            wr[i] = v; }
    }
    {
        const int gw = F.blk * 8 + F.wave, NGW = F.G * 8;
        constexpr int R0 = I_MOE - TAIL_T1 - TAIL_T2;
        constexpr int NPRO = I_FIX + R0 + I_MOE;
        int v0 = gw;
        if (v0 < I_FIX) { const int n = (I_FIX - v0 + NGW - 1) / NGW; convert_items(a, F, v0, I_FIX, NGW); v0 += n * NGW; }
        if (v0 < I_FIX + R0) { const int n = (I_FIX + R0 - v0 + NGW - 1) / NGW; convert_items(a, F, v0 + TAIL_T1 + TAIL_T2, I_FIX + I_MOE, NGW); v0 += n * NGW; }
        if (v0 < NPRO) convert_items(a, F, v0 - R0 + I_MOE, NITEMS, NGW);
    }
}

__device__ __forceinline__ int moe_tables(const Args& a, Frame& F, int L) {
    FR_LANE_TID;
    volatile LAS int* tb = (volatile LAS int*)(F.MISC + MI_TB); volatile LAS int* texp = (volatile LAS int*)(F.MISC + MI_TEXP); volatile LAS int* cn = (volatile LAS int*)(F.MISC + MI_LCNT);
    __syncthreads();
    if (tid_ == 0) { unsigned* cnt = (unsigned*)(a.ws + WS_CTL) + CW_CNT + L * 16 * 64; int acc = 0;
        for (int e = 0; e < NE; ++e) { tb[e] = acc; const int c = (int)xb_ld(cnt + e * 64); cn[e] = c; const int n = (c + 255) >> 8; for (int t = 0; t < n && acc + t < 160; ++t) texp[acc + t] = e; acc += n; }
        tb[NE] = acc; }
    __syncthreads();
    return tb[NE];
}
__device__ __forceinline__ void combine_row(f32x4 (&v)[8], const bf16* Y, const int* ridx, const float* rwt, const float* gate, const volatile LAS int* tb, int row, int lane) {
    const i32x4 ri = *(const i32x4*)(ridx + 4 * (size_t)row); const f32x2 w = *(const f32x2*)(rwt + 2 * (size_t)row);
    const int d0 = tb[ri.x] * 256 + ri.y, d1 = tb[ri.z] * 256 + ri.w;
    const bf16* y0 = Y + (size_t)d0 * D + 4 * lane; const bf16* y1 = Y + (size_t)d1 * D + 4 * lane;
#pragma unroll
    for (int j = 0; j < 8; ++j) { const u32x2 p0 = *(const u32x2*)(y0 + 256 * j), p1 = *(const u32x2*)(y1 + 256 * j); const f32x4 g = *(const f32x4*)(gate + 4 * lane + 256 * j);
        v[j][0] += g[0] * (w.x * bf2f(p0.x & 0xffffu) + w.y * bf2f(p1.x & 0xffffu)); v[j][1] += g[1] * (w.x * bf2f(p0.x >> 16) + w.y * bf2f(p1.x >> 16));
        v[j][2] += g[2] * (w.x * bf2f(p0.y & 0xffffu) + w.y * bf2f(p1.y & 0xffffu)); v[j][3] += g[3] * (w.x * bf2f(p0.y >> 16) + w.y * bf2f(p1.y >> 16)); }
}
__device__ __forceinline__ float row_rstd(const f32x4 (&v)[8]) {
    float ss = 0.f;
#pragma unroll
    for (int j = 0; j < 8; ++j) ss += (v[j][0] * v[j][0] + v[j][1] * v[j][1]) + (v[j][2] * v[j][2] + v[j][3] * v[j][3]);
    return rsqrtf(wave_sum(ss) * (1.0f / D) + EPSN);
}
__device__ __forceinline__ void phase_pre(const Args& a, Frame& F, int L) {
    FR_LANE_TID;
    unsigned char* ws = a.ws; float* XB = (float*)(ws + WS_XB); bf16* A = (bf16*)(ws + WS_A);
    const float* MOD = (const float*)(ws + WS_MOD);
    const int nrows = (L == 0) ? NTOK : NLAT;
    const int gw = F.blk * 8 + F.wave, NGW = F.G * 8;
    if (L > 0) (void)moe_tables(a, F, L - 1);
    const volatile LAS int* tb = (const volatile LAS int*)(F.MISC + MI_TB);
    f32x4 vn[8];
    if (gw < nrows) { const float* src = L == 0 ? (gw < NLAT ? a.x + (size_t)gw * D : a.ctx + (size_t)(gw - NLAT) * D) : XB + (size_t)gw * D;
#pragma unroll
        for (int j = 0; j < 8; ++j) vn[j] = *(const f32x4*)(src + 4 * lane_ + 256 * j); }
    for (int row = gw; row < nrows; row += NGW) {
        const int r = row < NLAT ? row >> 12 : 4;
        int ln4 = 4 * lane_; asm volatile("" : "+v"(ln4));
        f32x4 v[8];
#pragma unroll
        for (int j = 0; j < 8; ++j) v[j] = vn[j];
        { const int rn = row + NGW; if (rn < nrows) { const float* src = L == 0 ? (rn < NLAT ? a.x + (size_t)rn * D : a.ctx + (size_t)(rn - NLAT) * D) : XB + (size_t)rn * D;
#pragma unroll
            for (int j = 0; j < 8; ++j) vn[j] = *(const f32x4*)(src + ln4 + 256 * j); } }
        if (L > 0) {
            combine_row(v, (const bf16*)(ws + WS_R2), (const int*)(ws + WS_RIDX) + (size_t)(L - 1) * NTOK * 4, (const float*)(ws + WS_RWT) + (size_t)(L - 1) * NTOK * 2,
                        MOD + (size_t)((L - 1) * 5 + r) * MODW + 5 * D, tb, row, lane_);
#pragma unroll
            for (int j = 0; j < 8; ++j) *(f32x4*)(XB + (size_t)row * D + ln4 + 256 * j) = v[j];
        }
        const float rstd = row_rstd(v);
        const float* mp = MOD + (size_t)(L * 5 + r) * MODW; const float* gm = a.g_mix + L * D;
#pragma unroll
        for (int j = 0; j < 8; ++j) { const int c = ln4 + 256 * j; const f32x4 g = *(const f32x4*)(gm + c), sh = *(const f32x4*)(mp + c), sc = *(const f32x4*)(mp + D + c);
            const f32x4 o = v[j] * rstd * g * (sc + 1.0f) + sh; u32x2 p; p.x = cvt_pk_bf16(o[0], o[1]); p.y = cvt_pk_bf16(o[2], o[3]); *(u32x2*)(A + (size_t)row * D + c) = p; }
    }
}

constexpr int LDP = 136;
constexpr int IMG = 128 * LDP * 2;
__device__ __forceinline__ int unit_row0(int b, int s) { return s < 2 ? NLAT + b * TCX + s * 128 : b * TL + (s - 2) * 128; }
__device__ __forceinline__ void piece_rc(int q, int& j, int& ch) { const int jr = q & 15, cq = (q >> 4) & 3, blk = q >> 6; j = 16 * (blk & 7) + jr; ch = 4 * (blk >> 3) + cq; }

__device__ __forceinline__ void ret_u_unit(const Args& a, Frame& F, int u) {
    FR_LANE_TID;
    unsigned char* ws = a.ws; const bf16* Z = (const bf16*)(ws + WS_R1);
    const int bh = u / NSLOT, s = u % NSLOT, b = bh >> 3, h = bh & 7; const int row0 = unit_row0(b, s);
    const bf16* Kp = Z + 1 * ZSEC + (size_t)row0 * RW + h * HD; const bf16* Vp = Z + 2 * ZSEC + (size_t)row0 * RW + h * HD;
    const float lgf2 = logsig(a.decay[h]) * LOG2E, lgb2 = logsig(a.decay[NH + h]) * LOG2E;
    LAS bf16* KTf = (LAS bf16*)(F.lds); LAS bf16* KTb = (LAS bf16*)(F.lds + IMG); LAS bf16* VT = (LAS bf16*)(F.lds + 2 * IMG);
#pragma unroll
    for (int k = 0; k < 4; ++k) { int j, ch; piece_rc(tid_ + 512 * k, j, ch);
        const u32x4 kv = *(const u32x4*)(Kp + (size_t)j * RW + 8 * ch), vv = *(const u32x4*)(Vp + (size_t)j * RW + 8 * ch);
        const float ff = exp2f((float)(127 - j) * lgf2), fb = exp2f((float)j * lgb2);
#pragma unroll
        for (int i = 0; i < 8; ++i) { const unsigned kw = (i & 1) ? (kv[i >> 1] >> 16) : (kv[i >> 1] & 0xffffu), vw = (i & 1) ? (vv[i >> 1] >> 16) : (vv[i >> 1] & 0xffffu);
            const float kf = bf2f(kw); const unsigned pf = cvt_pk_bf16(kf * ff, kf * fb);
            KTf[(8 * ch + i) * LDP + j] = (bf16)(pf & 0xffffu); KTb[(8 * ch + i) * LDP + j] = (bf16)(pf >> 16); VT[(8 * ch + i) * LDP + j] = (bf16)vw; } }
    __syncthreads();
    const int fr = lane_ & 15, g = lane_ >> 4, dt = F.wave;
    f32x4 accf[8], accb[8];
#pragma unroll
    for (int e = 0; e < 8; ++e) { accf[e] = (f32x4){0.f, 0.f, 0.f, 0.f}; accb[e] = (f32x4){0.f, 0.f, 0.f, 0.f}; }
#pragma unroll
    for (int sI = 0; sI < 4; ++sI) {
        const bf16x8 af = *(const LAS bf16x8*)(KTf + (16 * dt + fr) * LDP + 32 * sI + 8 * g), ab = *(const LAS bf16x8*)(KTb + (16 * dt + fr) * LDP + 32 * sI + 8 * g);
#pragma unroll
        for (int et = 0; et < 8; ++et) { const bf16x8 bv = *(const LAS bf16x8*)(VT + (16 * et + fr) * LDP + 32 * sI + 8 * g);
            accf[et] = __builtin_amdgcn_mfma_f32_16x16x32_bf16(af, bv, accf[et], 0, 0, 0); accb[et] = __builtin_amdgcn_mfma_f32_16x16x32_bf16(ab, bv, accb[et], 0, 0, 0); }
    }
    float* ST = (float*)(ws + WS_R2) + (size_t)u * 2 * 16384;
#pragma unroll
    for (int et = 0; et < 8; ++et) { *(f32x4*)(ST + (size_t)(16 * et + fr) * 128 + 16 * dt + 4 * g) = accf[et]; *(f32x4*)(ST + 16384 + (size_t)(16 * et + fr) * 128 + 16 * dt + 4 * g) = accb[et]; }
    __syncthreads();
}
__device__ __forceinline__ void sgu_unit(const Args& a, Frame& F, int u) {
    FR_LANE_TID;
    unsigned char* ws = a.ws; const bf16* Z = (const bf16*)(ws + WS_R1); bf16* RS = (bf16*)(ws + WS_R3);
    const int bg = u / NSLOT, s = u % NSLOT, b = bg >> 3, grp = bg & 7; const int row0 = unit_row0(b, s);
    const bf16* Up = Z + 4 * ZSEC + (size_t)row0 * RW + grp * HD; const bf16* Vp = Z + 5 * ZSEC + (size_t)row0 * RW + grp * HD;
    LAS bf16* WS_ = (LAS bf16*)(F.lds); LAS bf16* VT = (LAS bf16*)(F.lds + IMG);
    const float* wsrc = a.sgu_w + (size_t)grp * 16384;
#pragma unroll
    for (int k = 0; k < 8; ++k) { const int i4 = tid_ + 512 * k; const int p = i4 >> 5, q4 = (i4 & 31) * 4; const f32x4 w = *(const f32x4*)(wsrc + p * 128 + q4);
        u32x2 o; o.x = cvt_pk_bf16(w[0], w[1]); o.y = cvt_pk_bf16(w[2], w[3]); *(LAS u32x2*)(WS_ + p * LDP + q4) = o; }
    { const int q = tid_ >> 2, part = tid_ & 3; float x[32];
#pragma unroll
        for (int k = 0; k < 4; ++k) { const u32x4 vv = *(const u32x4*)(Vp + (size_t)q * RW + 32 * part + 8 * k);
#pragma unroll
            for (int i = 0; i < 4; ++i) { x[8 * k + 2 * i] = bf2f(vv[i] & 0xffffu); x[8 * k + 2 * i + 1] = bf2f(vv[i] >> 16); } }
        float sm = 0.f;
#pragma unroll
        for (int i = 0; i < 32; ++i) sm += x[i];
        sm += __shfl_xor(sm, 1); sm += __shfl_xor(sm, 2); const float mu = sm * (1.0f / 128.0f);
        float sq = 0.f;
#pragma unroll
        for (int i = 0; i < 32; ++i) { const float dlt = x[i] - mu; sq += dlt * dlt; }
        sq += __shfl_xor(sq, 1); sq += __shfl_xor(sq, 2); const float rstd = rsqrtf(sq * (1.0f / 128.0f) + EPSN);
#pragma unroll
        for (int i = 0; i < 32; i += 2) { const unsigned p2 = cvt_pk_bf16((x[i] - mu) * rstd, (x[i + 1] - mu) * rstd);
            VT[(32 * part + i) * LDP + q] = (bf16)(p2 & 0xffffu); VT[(32 * part + i + 1) * LDP + q] = (bf16)(p2 >> 16); } }
    __syncthreads();
    const int fr = lane_ & 15, g = lane_ >> 4, pt = F.wave;
    f32x4 acc[8];
#pragma unroll
    for (int c = 0; c < 8; ++c) acc[c] = (f32x4){0.f, 0.f, 0.f, 0.f};
#pragma unroll
    for (int sI = 0; sI < 4; ++sI) { const bf16x8 bw = *(const LAS bf16x8*)(WS_ + (16 * pt + fr) * LDP + 32 * sI + 8 * g);
#pragma unroll
        for (int ct = 0; ct < 8; ++ct) { const bf16x8 av = *(const LAS bf16x8*)(VT + (16 * ct + fr) * LDP + 32 * sI + 8 * g);
            acc[ct] = __builtin_amdgcn_mfma_f32_16x16x32_bf16(av, bw, acc[ct], 0, 0, 0); } }
    const int p = 16 * pt + fr; const float bs = a.sgu_b[grp * 128 + p];
#pragma unroll
    for (int ct = 0; ct < 8; ++ct) { const int c = 16 * ct + 4 * g; const u32x2 uu = *(const u32x2*)(Up + (size_t)p * RW + c);
        const float o0 = bf2f(uu.x & 0xffffu) * (acc[ct][0] + bs), o1 = bf2f(uu.x >> 16) * (acc[ct][1] + bs), o2 = bf2f(uu.y & 0xffffu) * (acc[ct][2] + bs), o3 = bf2f(uu.y >> 16) * (acc[ct][3] + bs);
        u32x2 o; o.x = cvt_pk_bf16(o0, o1); o.y = cvt_pk_bf16(o2, o3); *(u32x2*)(RS + (size_t)(row0 + p) * D + RW + grp * HD + c) = o; }
    __syncthreads();
}
__device__ __forceinline__ void phase_scan(const Args& a, Frame& F) {
    FR_LANE_TID;
    float* ST = (float*)(a.ws + WS_R2);
    const int NT = F.G * 512;
    for (int it = F.blk * 512 + tid_; it < 32 * 2 * 4096; it += NT) {
        const int bh = it >> 13, dir = (it >> 12) & 1, e4 = it & 4095, h = bh & 7;
        const float cd = expf(128.0f * logsig(a.decay[dir * NH + h]));
        float* base = ST + ((size_t)bh * NSLOT * 2 + dir) * 16384 + (size_t)e4 * 4;
        f32x4 st = (f32x4){0.f, 0.f, 0.f, 0.f};
#pragma unroll 2
        for (int n = 0; n < NSLOT; ++n) { const int s = dir == 0 ? n : (n < 2 ? 1 - n : 35 - n);
            float* p = base + (size_t)s * 2 * 16384; const f32x4 tmp = *(const f32x4*)p; *(f32x4*)p = st; st = st * cd + tmp; }
    }
}
__device__ __forceinline__ void ret_y_unit(const Args& a, Frame& F, int u) {
    FR_LANE_TID;
    unsigned char* ws = a.ws; const bf16* Z = (const bf16*)(ws + WS_R1); bf16* RS = (bf16*)(ws + WS_R3);
    const int bh = u / NSLOT, s = u % NSLOT, b = bh >> 3, h = bh & 7; const int row0 = unit_row0(b, s);
    const bf16* Qp = Z + (size_t)row0 * RW + h * HD; const bf16* Kp = Z + 1 * ZSEC + (size_t)row0 * RW + h * HD; const bf16* Vp = Z + 2 * ZSEC + (size_t)row0 * RW + h * HD;
    const bf16* Gp = Z + 3 * ZSEC + (size_t)row0 * RW + h * HD;
    const float lgf2 = logsig(a.decay[h]) * LOG2E, lgb2 = logsig(a.decay[NH + h]) * LOG2E;
    LAS bf16* KN = (LAS bf16*)(F.lds); LAS bf16* VT = (LAS bf16*)(F.lds + IMG); LAS bf16* SF = (LAS bf16*)(F.lds + 2 * IMG); LAS bf16* SB = (LAS bf16*)(F.lds + 3 * IMG);
#pragma unroll
    for (int k = 0; k < 4; ++k) { int j, ch; piece_rc(tid_ + 512 * k, j, ch);
        const u32x4 kv = *(const u32x4*)(Kp + (size_t)j * RW + 8 * ch), vv = *(const u32x4*)(Vp + (size_t)j * RW + 8 * ch);
        *(LAS u32x4*)(KN + j * LDP + 8 * ch) = kv;
#pragma unroll
        for (int i = 0; i < 8; ++i) { const unsigned vw = (i & 1) ? (vv[i >> 1] >> 16) : (vv[i >> 1] & 0xffffu); VT[(8 * ch + i) * LDP + j] = (bf16)vw; } }
    { const float* ST = (const float*)(ws + WS_R2) + (size_t)u * 2 * 16384;
#pragma unroll
        for (int k = 0; k < 8; ++k) { const int i4 = tid_ + 512 * k; const int e = i4 >> 5, d4 = (i4 & 31) * 4; const f32x4 sf = *(const f32x4*)(ST + e * 128 + d4), sb = *(const f32x4*)(ST + 16384 + e * 128 + d4);
            u32x2 o; o.x = cvt_pk_bf16(sf[0], sf[1]); o.y = cvt_pk_bf16(sf[2], sf[3]); *(LAS u32x2*)(SF + e * LDP + d4) = o;
            o.x = cvt_pk_bf16(sb[0], sb[1]); o.y = cvt_pk_bf16(sb[2], sb[3]); *(LAS u32x2*)(SB + e * LDP + d4) = o; } }
    const int fr = lane_ & 15, g = lane_ >> 4, it_ = F.wave; const int i_abs = 16 * it_ + fr;
    bf16x8 qf[4];
#pragma unroll
    for (int sI = 0; sI < 4; ++sI) qf[sI] = *(const bf16x8*)(Qp + (size_t)i_abs * RW + 32 * sI + 8 * g);
    __syncthreads();
    bf16x8 pf[4];
#pragma unroll
    for (int ks = 0; ks < 4; ++ks) { f32x4 s0 = (f32x4){0.f, 0.f, 0.f, 0.f}, s1 = s0;
#pragma unroll
        for (int sI = 0; sI < 4; ++sI) { const bf16x8 k0 = *(const LAS bf16x8*)(KN + (32 * ks + fr) * LDP + 32 * sI + 8 * g), k1 = *(const LAS bf16x8*)(KN + (32 * ks + 16 + fr) * LDP + 32 * sI + 8 * g);
            s0 = __builtin_amdgcn_mfma_f32_16x16x32_bf16(k0, qf[sI], s0, 0, 0, 0); s1 = __builtin_amdgcn_mfma_f32_16x16x32_bf16(k1, qf[sI], s1, 0, 0, 0); }
        unsigned w[4];
#pragma unroll
        for (int r = 0; r < 4; r += 2) {
            const int j0 = 32 * ks + 4 * g + r, j1 = j0 + 1, j2 = j0 + 16, j3 = j2 + 1;
            const float d0 = (float)(i_abs - j0), d1 = (float)(i_abs - j1), d2 = (float)(i_abs - j2), d3 = (float)(i_abs - j3);
            const float m0 = d0 >= 0.f ? exp2f(d0 * lgf2) : exp2f(-d0 * lgb2), m1 = d1 >= 0.f ? exp2f(d1 * lgf2) : exp2f(-d1 * lgb2);
            const float m2 = d2 >= 0.f ? exp2f(d2 * lgf2) : exp2f(-d2 * lgb2), m3 = d3 >= 0.f ? exp2f(d3 * lgf2) : exp2f(-d3 * lgb2);
            w[r >> 1] = cvt_pk_bf16(s0[r] * m0, s0[r + 1] * m1); w[2 + (r >> 1)] = cvt_pk_bf16(s1[r] * m2, s1[r + 1] * m3);
        }
        u32x4 ww; ww.x = w[0]; ww.y = w[1]; ww.z = w[2]; ww.w = w[3]; pf[ks] = __builtin_bit_cast(bf16x8, ww);
    }
    const float qdf = exp2f((float)(i_abs + 1) * lgf2), qdb = exp2f((float)(128 - i_abs) * lgb2);
    f32x4 y[8];
#pragma unroll
    for (int et = 0; et < 8; ++et) {
        f32x4 ai = (f32x4){0.f, 0.f, 0.f, 0.f}, cf = ai, cb = ai;
#pragma unroll
        for (int ks = 0; ks < 4; ++ks) { const LAS bf16* vp = VT + (16 * et + fr) * LDP + 32 * ks + 4 * g; const u32x2 lo = *(const LAS u32x2*)vp, hi = *(const LAS u32x2*)(vp + 16);
            u32x4 av; av.x = lo.x; av.y = lo.y; av.z = hi.x; av.w = hi.y;
            ai = __builtin_amdgcn_mfma_f32_16x16x32_bf16(__builtin_bit_cast(bf16x8, av), pf[ks], ai, 0, 0, 0); }
#pragma unroll
        for (int sI = 0; sI < 4; ++sI) { const bf16x8 sf = *(const LAS bf16x8*)(SF + (16 * et + fr) * LDP + 32 * sI + 8 * g), sb = *(const LAS bf16x8*)(SB + (16 * et + fr) * LDP + 32 * sI + 8 * g);
            cf = __builtin_amdgcn_mfma_f32_16x16x32_bf16(sf, qf[sI], cf, 0, 0, 0); cb = __builtin_amdgcn_mfma_f32_16x16x32_bf16(sb, qf[sI], cb, 0, 0, 0); }
        y[et] = ai + cf * qdf + cb * qdb; asm volatile("" ::: "memory");
    }
    float sm = 0.f;
#pragma unroll
    for (int et = 0; et < 8; ++et) sm += (y[et][0] + y[et][1]) + (y[et][2] + y[et][3]);
    sm += __shfl_xor(sm, 16); sm += __shfl_xor(sm, 32); const float mu = sm * (1.0f / 128.0f);
    float sq = 0.f;
#pragma unroll
    for (int et = 0; et < 8; ++et) { const f32x4 dl = y[et] - mu; sq += (dl[0] * dl[0] + dl[1] * dl[1]) + (dl[2] * dl[2] + dl[3] * dl[3]); }
    sq += __shfl_xor(sq, 16); sq += __shfl_xor(sq, 32); const float rstd = rsqrtf(sq * (1.0f / 128.0f) + EPSN);
#pragma unroll
    for (int et = 0; et < 8; ++et) { const int e = 16 * et + 4 * g; const u32x2 gg = *(const u32x2*)(Gp + (size_t)i_abs * RW + e);
        const f32x4 o = (y[et] - mu) * rstd; u32x2 w2; w2.x = cvt_pk_bf16(o[0] * bf2f(gg.x & 0xffffu), o[1] * bf2f(gg.x >> 16)); w2.y = cvt_pk_bf16(o[2] * bf2f(gg.y & 0xffffu), o[3] * bf2f(gg.y >> 16));
        *(u32x2*)(RS + (size_t)(row0 + i_abs) * D + h * HD + e) = w2; }
    __syncthreads();
}

__device__ __forceinline__ void phase_conv(const Args& a, Frame& F) {
    FR_LANE_TID;
    unsigned char* ws = a.ws; const bf16* GB = (const bf16*)(ws + WS_R1); const bf16* XG = GB + (size_t)NLAT * D; bf16* A1 = (bf16*)(ws + WS_R3);
    const int NT = F.G * 512;
    for (int it = F.blk * 512 + tid_; it < NLAT * 256; it += NT) {
        const int row = it >> 8, c = (it & 255) * 8; const int gc = row & 63;
        const u32x4 x1 = *(const u32x4*)(XG + (size_t)row * D + c), gb = *(const u32x4*)(GB + (size_t)row * D + c);
        u32x4 x0 = (u32x4){0u, 0u, 0u, 0u}, x2 = x0;
        if (gc > 0) x0 = *(const u32x4*)(XG + (size_t)(row - 1) * D + c);
        if (gc < 63) x2 = *(const u32x4*)(XG + (size_t)(row + 1) * D + c);
        float o[8];
#pragma unroll
        for (int i = 0; i < 8; ++i) { const int cc = c + i; const unsigned sh = (i & 1) ? 16u : 0u;
            const float f0 = bf2f((x0[i >> 1] >> sh) & 0xffffu), f1 = bf2f((x1[i >> 1] >> sh) & 0xffffu), f2 = bf2f((x2[i >> 1] >> sh) & 0xffffu), fg = bf2f((gb[i >> 1] >> sh) & 0xffffu);
            o[i] = fg * (a.cv_cb[cc] + a.cv_cw[cc] * f0 + a.cv_cw[D + cc] * f1 + a.cv_cw[2 * D + cc] * f2); }
        u32x4 w; w.x = cvt_pk_bf16(o[0], o[1]); w.y = cvt_pk_bf16(o[2], o[3]); w.z = cvt_pk_bf16(o[4], o[5]); w.w = cvt_pk_bf16(o[6], o[7]);
        *(u32x4*)(A1 + (size_t)row * D + c) = w;
    }
}

__device__ __forceinline__ void phase_route(const Args& a, Frame& F, int L) {
    FR_LANE_TID;
    unsigned char* ws = a.ws; const float* XB = (const float*)(ws + WS_XB); unsigned char* Fo = ws + WS_A;
    const float* MOD = (const float*)(ws + WS_MOD); const float* WR = (const float*)(ws + WS_WR) + (size_t)L * 20 * D;
    const int nrows = NLAT; const int RPB = (nrows + F.G - 1) / F.G;
    LAS int* rinfo = (LAS int*)(F.lds + MISC_OFF + 4 * MI_RINFO);
    LAS float* rw = (LAS float*)(F.lds + MISC_OFF + 4 * MI_RW);
    volatile LAS unsigned* lcnt = F.MISC + MI_LCNT; volatile LAS unsigned* gbase = F.MISC + MI_GBASE;
    LAS float* WL = (LAS float*)F.lds;
    if (tid_ < 16) lcnt[tid_] = 0u;
    for (int i = tid_; i < 19 * D / 4; i += 512) *(LAS f32x4*)(WL + 4 * i) = *(const f32x4*)(WR + 4 * (size_t)i);
    __syncthreads();
    f32x4 vn[8];
    { const int row = F.blk * RPB + F.wave; if (F.wave < RPB && row < nrows) {
#pragma unroll
        for (int j = 0; j < 8; ++j) vn[j] = *(const f32x4*)(XB + (size_t)row * D + 4 * lane_ + 256 * j); } }
    for (int i = F.wave; i < RPB; i += 8) {
        const int row = F.blk * RPB + i; if (row >= nrows) break;
        const int r = row < NLAT ? row >> 12 : 4;
        int ln4 = 4 * lane_; asm volatile("" : "+v"(ln4));
        f32x4 v[8];
#pragma unroll
        for (int j = 0; j < 8; ++j) v[j] = vn[j];
        if (i + 8 < RPB && row + 8 < nrows) {
#pragma unroll
            for (int j = 0; j < 8; ++j) vn[j] = *(const f32x4*)(XB + (size_t)(row + 8) * D + ln4 + 256 * j); }
        const float rstd = row_rstd(v);
        const float* mp = MOD + (size_t)(L * 5 + r) * MODW; const float* gf = a.g_ffn + L * D;
#pragma unroll
        for (int j = 0; j < 8; ++j) { const int c = ln4 + 256 * j; const f32x4 g = *(const f32x4*)(gf + c), sh = *(const f32x4*)(mp + 3 * D + c), sc = *(const f32x4*)(mp + 4 * D + c);
            v[j] = v[j] * rstd * g * (sc + 1.0f) + sh; *(unsigned*)(Fo + (size_t)row * D + c) = pk4_fp8(v[j][0], v[j][1], v[j][2], v[j][3]); }
        float l1[4] = {0.f, 0.f, 0.f, 0.f};
#pragma unroll
        for (int j = 0; j < 8; ++j)
#pragma unroll
            for (int g = 0; g < 4; ++g) { const f32x4 w = *(const LAS f32x4*)(WL + g * D + ln4 + 256 * j); l1[g] += (v[j][0] * w[0] + v[j][1] * w[1]) + (v[j][2] * w[2] + v[j][3] * w[3]); }
#pragma unroll
        for (int g = 0; g < 4; ++g) l1[g] = wave_sum(l1[g]) + a.b_r1[L * 4 + g];
        int grp = 0; float mx = l1[0];
#pragma unroll
        for (int g = 1; g < 4; ++g) if (l1[g] > mx) { mx = l1[g]; grp = g; }
        grp = __builtin_amdgcn_readfirstlane(grp);
        float den = 0.f;
#pragma unroll
        for (int g = 0; g < 4; ++g) den += expf(l1[g] - mx);
        const float pg = 1.0f / den;
        float l2[4] = {0.f, 0.f, 0.f, 0.f};
#pragma unroll
        for (int j = 0; j < 8; ++j)
#pragma unroll
            for (int e = 0; e < 3; ++e) { const f32x4 w = *(const LAS f32x4*)(WL + (4 + 4 * grp + e) * D + ln4 + 256 * j); l2[e] += (v[j][0] * w[0] + v[j][1] * w[1]) + (v[j][2] * w[2] + v[j][3] * w[3]); }
        if (grp < 3) {
#pragma unroll
            for (int j = 0; j < 8; ++j) { const f32x4 w = *(const LAS f32x4*)(WL + (7 + 4 * grp) * D + ln4 + 256 * j); l2[3] += (v[j][0] * w[0] + v[j][1] * w[1]) + (v[j][2] * w[2] + v[j][3] * w[3]); }
        } else {
#pragma unroll
            for (int j = 0; j < 8; ++j) { const f32x4 w = *(const f32x4*)(WR + (size_t)19 * D + ln4 + 256 * j); l2[3] += (v[j][0] * w[0] + v[j][1] * w[1]) + (v[j][2] * w[2] + v[j][3] * w[3]); }
        }
#pragma unroll
        for (int e = 0; e < 4; ++e) l2[e] = wave_sum(l2[e]) + a.b_r2[(L * 4 + grp) * 4 + e];
        int i0 = 0; float v0 = l2[0];
#pragma unroll
        for (int e = 1; e < 4; ++e) if (l2[e] > v0) { v0 = l2[e]; i0 = e; }
        int i1 = -1; float v1 = -3.0e38f;
#pragma unroll
        for (int e = 0; e < 4; ++e) if (e != i0 && l2[e] > v1) { v1 = l2[e]; i1 = e; }
        const float ex = expf(v1 - v0); const float w0 = pg / (1.0f + ex), w1 = pg * ex / (1.0f + ex);
        if (lane_ == 0) { const int e0 = grp * 4 + i0, e1 = grp * 4 + i1;
            const int li0 = (int)__hip_atomic_fetch_add((LAS unsigned*)&lcnt[e0], 1u, __ATOMIC_RELAXED, __HIP_MEMORY_SCOPE_WORKGROUP);
            const int li1 = (int)__hip_atomic_fetch_add((LAS unsigned*)&lcnt[e1], 1u, __ATOMIC_RELAXED, __HIP_MEMORY_SCOPE_WORKGROUP);
            rinfo[4 * i] = e0; rinfo[4 * i + 1] = li0; rinfo[4 * i + 2] = e1; rinfo[4 * i + 3] = li1; rw[2 * i] = w0; rw[2 * i + 1] = w1; }
    }
    __syncthreads();
    if (tid_ < 16) gbase[tid_] = xb_add((unsigned*)(ws + WS_CTL) + CW_CNT + (L * 16 + tid_) * 64, lcnt[tid_]);
    __syncthreads();
    int* RIDX = (int*)(ws + WS_RIDX) + (size_t)L * NTOK * 4; float* RWT = (float*)(ws + WS_RWT) + (size_t)L * NTOK * 2;
    for (int i = tid_; i < RPB; i += 512) { const int row = F.blk * RPB + i; if (row < nrows) {
        const int e0 = rinfo[4 * i], e1 = rinfo[4 * i + 2];
        i32x4 o; o.x = e0; o.y = (int)gbase[e0] + rinfo[4 * i + 1]; o.z = e1; o.w = (int)gbase[e1] + rinfo[4 * i + 3]; *(i32x4*)(RIDX + 4 * (size_t)row) = o;
        f32x2 w; w.x = rw[2 * i]; w.y = rw[2 * i + 1]; *(f32x2*)(RWT + 2 * (size_t)row) = w;
        int* GI = (int*)(ws + WS_GIDX) + (size_t)L * NE * NTOK; GI[(size_t)e0 * NTOK + o.y] = row; GI[(size_t)e1 * NTOK + o.w] = row; } }
    __syncthreads();
}
__device__ __forceinline__ void phase_final(const Args& a, Frame& F, int Lc  ) {
    FR_LANE_TID;
    unsigned char* ws = a.ws; const float* XB = (const float*)(ws + WS_XB); const float* MOD = (const float*)(ws + WS_MOD);
    const int gw = F.blk * 8 + F.wave, NGW = F.G * 8;
    if (Lc >= 0) (void)moe_tables(a, F, Lc);
    const volatile LAS int* tb = (const volatile LAS int*)(F.MISC + MI_TB);
    f32x4 vn[8];
    if (gw < NLAT) {
#pragma unroll
        for (int j = 0; j < 8; ++j) vn[j] = *(const f32x4*)(XB + (size_t)gw * D + 4 * lane_ + 256 * j); }
    for (int row = gw; row < NLAT; row += NGW) {
        const int r = row >> 12;
        int ln4 = 4 * lane_; asm volatile("" : "+v"(ln4));
        f32x4 v[8];
#pragma unroll
        for (int j = 0; j < 8; ++j) v[j] = vn[j];
        if (row + NGW < NLAT) {
#pragma unroll
            for (int j = 0; j < 8; ++j) vn[j] = *(const f32x4*)(XB + (size_t)(row + NGW) * D + ln4 + 256 * j); }
        if (Lc >= 0) combine_row(v, (const bf16*)(ws + WS_R2), (const int*)(ws + WS_RIDX) + (size_t)Lc * NTOK * 4, (const float*)(ws + WS_RWT) + (size_t)Lc * NTOK * 2,
                                 MOD + (size_t)(Lc * 5 + r) * MODW + 5 * D, tb, row, lane_);
        const float rstd = row_rstd(v);
#pragma unroll
        for (int j = 0; j < 8; ++j) { const int c = ln4 + 256 * j; const f32x4 g = *(const f32x4*)(a.g_final + c); *(f32x4*)(a.out + (size_t)row * D + c) = v[j] * rstd * g; }
    }
}

__global__ void __launch_bounds__(512, 2) fwd_kernel(Args a) {
    extern __shared__ __attribute__((aligned(16))) unsigned char lds_raw[];
    Frame F; F.lds = (LAS unsigned char*)lds_raw; F.MISC = (volatile LAS unsigned*)(F.lds + MISC_OFF);
    F.wave = __builtin_amdgcn_readfirstlane((int)threadIdx.x >> 6); F.G = gridDim.x; F.blk = blockIdx.x;
    unsigned char* ws = a.ws;
    F.MISC[threadIdx.x] = 0u; F.MISC[threadIdx.x + 512] = 0u;
    __syncthreads();
#if MK_SPLIT
    #define GRID_BAR() do { } while (0)
#else
    XcdBarrier bar = xcd_barrier_post((unsigned*)(ws + WS_CTL) + CW_BAR, F.MISC);
    #define GRID_BAR() xcd_barrier(bar)
#endif
    const int lo = a.ph_lo, hi = a.ph_hi;
    unsigned long long pr_acc = 0ull, pr_t0 = 0ull;
#define IN(k) (lo <= (k) && (k) < hi && ((((PROBE_MASK) >> (k)) & 1u) ? (pr_t0 = __builtin_amdgcn_s_memrealtime(), true) : true))
#define SEAM(k) do { if (lo <= (k) + 1 && (k) + 1 < hi) GRID_BAR(); if (((PROBE_MASK) >> (k)) & 1u) pr_acc += __builtin_amdgcn_s_memrealtime() - pr_t0; } while (0)

    if (IN(PH_PRO)) { phase_prologue(a, F); SEAM(PH_PRO); }
#define RUN_LAYER(L) do { \
        constexpr int P = PH_L0 + (L) * PH_PER_LAYER; \
        constexpr int nM = NLAT / 256;        \
        if (IN(P + K_PRE)) { phase_pre(a, F, (L)); SEAM(P + K_PRE); } \
        if (DBG_STOP == 1) break; \
        if (IN(P + K_GIN)) { \
            if ((L) == 0) { pg8::Gemm g{(const bf16*)(ws + WS_A), (const bf16*)(ws + WS_WAB_IN), D}; pg8::StaticOrder S; S.init(nM, 24, F.G, F.blk); \
                pg8::EpiAB E{(bf16*)(ws + WS_R1), (const float*)(ws + WS_ROPE)}; pg8::gemm_phase<pg8::EpiAB, pg8::StaticOrder, true, true>(F.lds, F.wave, g, S, E); } \
            else { pg8::Gemm g{(const bf16*)(ws + WS_A), (const bf16*)(ws + WS_WCV_IN), D}; pg8::StaticOrder S; S.init(nM, 24, F.G, F.blk); \
                pg8::EpiCV E{(bf16*)(ws + WS_R1), (bf16*)(ws + WS_R1) + (size_t)NLAT * D}; pg8::gemm_phase<pg8::EpiCV, pg8::StaticOrder, true, true>(F.lds, F.wave, g, S, E); } \
            SEAM(P + K_GIN); \
        } \
        if (IN(P + K_MID1)) { \
            if ((L) == 0) { \
                { pg8::Gemm g{(const bf16*)(ws + WS_A), (const bf16*)(ws + WS_WAB_IN), D}; pg8::CtxKvOrder S; S.c = F.blk; \
                  pg8::EpiAB E{(bf16*)(ws + WS_R1), (const float*)(ws + WS_ROPE)}; pg8::gemm_phase<pg8::EpiAB, pg8::CtxKvOrder, true, true>(F.lds, F.wave, g, S, E); } \
                  \
                for (;;) { __syncthreads(); if (threadIdx.x == 0) F.MISC[4] = xb_add((unsigned*)(ws + WS_CTL) + CW_Q, 1u); __syncthreads(); const int v_ = (int)F.MISC[4]; if (v_ >= 2048) break; \
                    if (v_ < 1024) ret_u_unit(a, F, (v_ >> 5) * NSLOT + 2 + (v_ & 31)); else sgu_unit(a, F, ((v_ - 1024) >> 5) * NSLOT + 2 + (v_ & 31)); } \
            } else phase_conv(a, F); \
            SEAM(P + K_MID1); \
        } \
        if ((L) == 0) { \
            if (IN(P + K_MID1B)) { for (int i_ = F.blk; i_ < 64; i_ += F.G) ret_u_unit(a, F, (i_ >> 1) * NSLOT + (i_ & 1)); SEAM(P + K_MID1B); } \
            if (IN(P + K_MID2)) { phase_scan(a, F); SEAM(P + K_MID2); } \
            if (IN(P + K_MID3)) { for (int v_ = F.blk; v_ < 1024; v_ += F.G) ret_y_unit(a, F, (v_ >> 5) * NSLOT + 2 + (v_ & 31)); SEAM(P + K_MID3); } \
        } \
        if (IN(P + K_GOUT)) { \
            pg8::Gemm g{(const bf16*)(ws + WS_R3), (const bf16*)(ws + ((L) == 0 ? WS_WAB_OUT : WS_WCV_OUT)), D}; pg8::StaticOrder S; S.init(nM, 8, F.G, F.blk); \
            pg8::EpiRes E{(float*)(ws + WS_XB), (L) == 0 ? a.x : (const float*)(ws + WS_XB), (L) == 0 ? a.ctx : (const float*)(ws + WS_XB) + (size_t)NLAT * D, (const float*)(ws + WS_MOD) + (size_t)(L) * 5 * MODW + 2 * D}; \
            pg8::gemm_phase<pg8::EpiRes, pg8::StaticOrder, true, true>(F.lds, F.wave, g, S, E); \
            SEAM(P + K_GOUT); \
        } \
        if (DBG_STOP == 2 || (DBG_STOP == 4 && (L) == 1)) break; \
        if (IN(P + K_ROUTE)) { phase_route(a, F, (L)); SEAM(P + K_ROUTE); } \
        if (IN(P + K_MOE1)) { \
            const int TT = moe_tables(a, F, (L)); \
            pg8::Gemm g{(const bf16*)(ws + WS_A), (const bf16*)(ws + WS_W13 + (size_t)(L) * NE * D * D), D / 2}; \
            pg8::MoeOrder S; S.init(TT, 8, F.G, F.blk); S.texp = (const volatile LAS int*)(F.MISC + MI_TEXP); S.bstride = (long)D * D; \
            { FR_LANE_TID; LAS int* idxbuf = (LAS int*)(F.lds + 131072); const volatile LAS int* tb_ = (const volatile LAS int*)(F.MISC + MI_TB); const volatile LAS int* cn_ = (const volatile LAS int*)(F.MISC + MI_LCNT); \
              const int* GI = (const int*)(ws + WS_GIDX) + (size_t)(L) * NE * NTOK; \
              for (int i_ = 0; i_ < 16; ++i_) { pg8::Unit u_; if (!S.next(i_, u_)) break; const int e_ = S.texp[u_.pm]; const int idx_ = (u_.pm - tb_[e_]) * 256 + tid_; \
                  if (tid_ < 256) idxbuf[i_ * 256 + tid_] = idx_ < cn_[e_] ? GI[(size_t)e_ * NTOK + idx_] : 0; } \
              __syncthreads(); } \
            pg8::EpiMoe1 E{ws + WS_R3}; pg8::gemm_phase<pg8::EpiMoe1, pg8::MoeOrder, true, true, true, true>(F.lds, F.wave, g, S, E, (const LAS int*)(F.lds + 131072)); \
            SEAM(P + K_MOE1); \
        } \
        if (IN(P + K_MOE2)) { \
            const int TT = moe_tables(a, F, (L)); \
            pg8::Gemm g{(const bf16*)(ws + WS_R3), (const bf16*)(ws + WS_W2 + (size_t)(L) * NE * D * DE), DE / 2}; \
            pg8::MoeOrder S; S.init(TT, 8, F.G, F.blk); S.texp = (const volatile LAS int*)(F.MISC + MI_TEXP); S.bstride = (long)D * DE; \
            pg8::EpiMoe2 E{(bf16*)(ws + WS_R2)}; pg8::gemm_phase<pg8::EpiMoe2, pg8::MoeOrder, true, true, true>(F.lds, F.wave, g, S, E); \
            SEAM(P + K_MOE2); \
        } \
    } while (0)
    RUN_LAYER(0);
    if (DBG_STOP == 0 || DBG_STOP == 4) RUN_LAYER(1);
    if (IN(PH_FINAL)) phase_final(a, F, DBG_STOP == 0 ? 1 : (DBG_STOP == 3 ? 0 : -1));
#undef IN
#undef SEAM
    if ((PROBE_MASK) != 0u && F.blk == 0 && threadIdx.x == 0) { const unsigned long long t1 = __builtin_amdgcn_s_memrealtime(); while (__builtin_amdgcn_s_memrealtime() - t1 < (unsigned long long)(PROBE_MULT) * pr_acc) __builtin_amdgcn_s_sleep(8); }
}

extern "C" void kernel_launch(void* const* d_in, const int* in_sizes, int n_in, void* d_out, int out_size, void* d_ws, size_t ws_size, hipStream_t stream) {
    static int grid = 0;
    if (grid == 0) {
        if (n_in != 25 || in_sizes[0] != NLAT * D || out_size != NLAT * D || ws_size < WS_END) { fprintf(stderr, "kernel_launch: unexpected shapes (n_in %d, in0 %d, out %d, ws %zu)\n", n_in, n_in > 0 ? in_sizes[0] : -1, out_size, ws_size); grid = -1; return; }
        int dev = 0, cus = 0, per_cu = 0;
        if (hipGetDevice(&dev) != hipSuccess || hipDeviceGetAttribute(&cus, hipDeviceAttributeMultiprocessorCount, dev) != hipSuccess) { grid = -1; return; }
        if (hipFuncSetAttribute((const void*)fwd_kernel, hipFuncAttributeMaxDynamicSharedMemorySize, LDS_BYTES) != hipSuccess) { fprintf(stderr, "kernel_launch: hipFuncSetAttribute failed\n"); grid = -1; return; }
        if (hipOccupancyMaxActiveBlocksPerMultiprocessor(&per_cu, (const void*)fwd_kernel, 512, LDS_BYTES) != hipSuccess || per_cu < 1) fprintf(stderr, "kernel_launch: occupancy query reports %d\n", per_cu);
        (void)hipGetLastError();
        grid = cus;
    }
    if (grid < 0) return;
    (void)hipMemsetAsync((char*)d_ws + WS_CTL, 0, CTL_BYTES, stream);
    Args a{};
    const float** f = (const float**)&a;
    for (int i = 0; i < 25; ++i) f[i] = (const float*)d_in[i];
    a.out = (float*)d_out; a.ws = (unsigned char*)d_ws;
#if MK_SPLIT
    for (int ph = 0; ph < NPHASE; ++ph) { a.ph_lo = ph; a.ph_hi = ph + 1; hipLaunchKernelGGL(fwd_kernel, dim3(grid), dim3(512), LDS_BYTES, stream, a); }
#else
    a.ph_lo = 0; a.ph_hi = NPHASE; hipLaunchKernelGGL(fwd_kernel, dim3(grid), dim3(512), LDS_BYTES, stream, a);
#endif
}
```

```cpp
#include <hip/hip_runtime.h>
#include <cstdio>
#include <cstdint>

#ifndef MK_SPLIT
#define MK_SPLIT 0
#endif
#ifndef PROBE_MASK
#define PROBE_MASK 0u
#endif
#ifndef PROBE_MULT
#define PROBE_MULT 4
#endif
#ifndef DBG_STOP
#define DBG_STOP 0
#endif

#define LAS __attribute__((address_space(3)))
#define GAS __attribute__((address_space(1)))
typedef unsigned short bf16;
typedef short bf16x8 __attribute__((ext_vector_type(8)));
typedef short s16x4 __attribute__((ext_vector_type(4)));
typedef float f32x4 __attribute__((ext_vector_type(4)));
typedef float f32x2 __attribute__((ext_vector_type(2)));
typedef unsigned u32x4 __attribute__((ext_vector_type(4)));
typedef unsigned u32x2 __attribute__((ext_vector_type(2)));
typedef int i32x4 __attribute__((ext_vector_type(4)));
typedef int i32x8 __attribute__((ext_vector_type(8)));
typedef int i32x2 __attribute__((ext_vector_type(2)));

constexpr int D = 2048, NB = 4, TL = 4096, TCX = 256;
constexpr int NLAT = NB * TL;
constexpr int NCTX = NB * TCX;
constexpr int NTOK = NLAT + NCTX;
constexpr int HD = 128, NH = 8, RW = 1024;
constexpr int NSLOT = 34;
constexpr int NUNIT = NB * NH * NSLOT;
constexpr int DE = 1024, NE = 16;
constexpr int PCAP = 2 * NTOK + NE * 256;
constexpr float EPSN = 1e-6f;
constexpr float QK_SCALE = 0.08838834764831845f;
constexpr int MODW = 6 * D;

constexpr size_t MiB = 1u << 20;
constexpr size_t WS_CTL = 0, CTL_BYTES = 1 * MiB;
constexpr size_t WS_MOD = 1 * MiB;
constexpr size_t WS_ROPE = 1 * MiB + 512 * 1024;
constexpr size_t WS_WR = 2 * MiB;
constexpr size_t WS_RIDX = 3 * MiB;
constexpr size_t WS_RWT = 4 * MiB;
constexpr size_t WS_GIDX = 5 * MiB;
constexpr size_t WS_WAB_IN = 8 * MiB, WS_WAB_OUT = 32 * MiB, WS_WCV_IN = 40 * MiB, WS_WCV_OUT = 64 * MiB;
constexpr size_t WS_W13 = 72 * MiB;
constexpr size_t WS_W2 = 328 * MiB;
constexpr size_t WS_XB = 456 * MiB;
constexpr size_t WS_A = 592 * MiB;
constexpr size_t WS_R1 = 660 * MiB;
constexpr size_t WS_R2 = 864 * MiB;
constexpr size_t WS_R3 = 1016 * MiB;
constexpr size_t WS_END = 1092 * MiB;
constexpr size_t ZSEC = (size_t)NTOK * 1024;
constexpr int CW_BAR = 4096;
constexpr int CW_Q = 2048;
constexpr int CW_CNT = 8192;

constexpr int SCR_BYTES = 155648;
constexpr int MISC_OFF = SCR_BYTES;
constexpr int LDS_BYTES = SCR_BYTES + 4096;
constexpr int MI_LCNT = 16, MI_GBASE = 32, MI_TB = 64, MI_TEXP = 96, MI_RINFO = 256, MI_RW = 768;

__device__ __forceinline__ unsigned cvt_pk_bf16(float lo, float hi) { unsigned r; asm("v_cvt_pk_bf16_f32 %0, %1, %2" : "=v"(r) : "v"(lo), "v"(hi)); return r; }
__device__ __forceinline__ int lane_id() { int l; asm volatile("v_mbcnt_lo_u32_b32 %0, -1, 0\n\tv_mbcnt_hi_u32_b32 %0, -1, %0" : "=v"(l)); return l; }
__device__ __forceinline__ float bf2f(unsigned b) { return __uint_as_float(b << 16); }
template <int CTRL> __device__ __forceinline__ float dpp_mov(float v) { return __int_as_float(__builtin_amdgcn_update_dpp(0, __float_as_int(v), CTRL, 0xf, 0xf, false)); }
__device__ __forceinline__ float wave_sum(float v) {
    v += dpp_mov<0xB1>(v); v += dpp_mov<0x4E>(v); v += dpp_mov<0x141>(v); v += dpp_mov<0x140>(v);
    return ((__int_as_float(__builtin_amdgcn_readlane(__float_as_int(v), 0)) + __int_as_float(__builtin_amdgcn_readlane(__float_as_int(v), 16))) +
           (__int_as_float(__builtin_amdgcn_readlane(__float_as_int(v), 32)) + __int_as_float(__builtin_amdgcn_readlane(__float_as_int(v), 48))));
}
__device__ __forceinline__ float silu_f(float x) { return x / (1.0f + __expf(-x)); }
__device__ __forceinline__ float gelu_tanh_f(float x) { const float z = 1.5957691216057308f * (x + 0.044715f * x * x * x); return x / (1.0f + __expf(-z)); }
__device__ __forceinline__ u32x4 pack8(f32x4 a, f32x4 b) { u32x4 w; w.x = cvt_pk_bf16(a[0], a[1]); w.y = cvt_pk_bf16(a[2], a[3]); w.z = cvt_pk_bf16(b[0], b[1]); w.w = cvt_pk_bf16(b[2], b[3]); return w; }
__device__ __forceinline__ unsigned pk4_fp8(float a, float b, float c, float d) { int w = 0; w = __builtin_amdgcn_cvt_pk_fp8_f32(a, b, w, false); w = __builtin_amdgcn_cvt_pk_fp8_f32(c, d, w, true); return (unsigned)w; }
__device__ __forceinline__ u32x2 pack8_fp8(f32x4 a, f32x4 b) { u32x2 w; w.x = pk4_fp8(a[0], a[1], a[2], a[3]); w.y = pk4_fp8(b[0], b[1], b[2], b[3]); return w; }
#define W8_SCALE 64.0f
#define SCALE_W8 0x79797979
#define SCALE_ONE 0x7f7f7f7f
__device__ __forceinline__ f32x4 bf4_to_f32(u32x2 p) { return (f32x4){bf2f(p.x & 0xffffu), bf2f(p.x >> 16), bf2f(p.y & 0xffffu), bf2f(p.y >> 16)}; }
__device__ __forceinline__ u32x2 f32_to_bf4(f32x4 v) { u32x2 p; p.x = cvt_pk_bf16(v[0], v[1]); p.y = cvt_pk_bf16(v[2], v[3]); return p; }
__device__ __forceinline__ float logsig(float x) { return -log1pf(expf(-x)); }
#define LOG2E 1.4426950408889634f

namespace pg8 {
constexpr int BM = 256, BK = 64, HALF = 128, HTB = HALF * BK * 2, STAGE_BYTES = 8 * HTB, NXCD = 8, WGM = 8;
__host__ __device__ __forceinline__ int lds_byte(int r, int c) { const int st = (r >> 4) * 2 + (c >> 5), rr = r & 15, cc = c & 31, ob = rr * 64 + cc * 2; return st * 1024 + (ob ^ (((ob >> 9) & 1) << 5)); }
__host__ __device__ __forceinline__ void stage_rc(int b, int& R, int& C) { const int st = b / 1024, sb = b % 1024, swz = sb ^ (((sb >> 9) & 1) << 5); R = (st >> 1) * 16 + swz / 64; C = (st & 1) * 32 + (swz % 64) / 2; }

struct Unit { int pm, pn; long boff; };
struct Gemm { const bf16* A; const bf16* Bt; int K; };

struct StaticOrder {
    int nM, nN, nwg, G, c;
    __device__ __forceinline__ void init(int nM_, int nN_, int G_, int c_) { nM = nM_; nN = nN_; nwg = nM * nN; G = G_; c = c_; }
    __device__ __forceinline__ bool map(int i, int& pm, int& pn) const {
        const long L = (long)i * G + c; if (L >= nwg) return false;
        int wgid = (int)L; { const int q = nwg / NXCD, r = nwg % NXCD, xcd = wgid % NXCD, off = wgid / NXCD; wgid = (xcd < r ? xcd * (q + 1) : r * (q + 1) + (xcd - r) * q) + off; }
        const int nig = WGM * nN, gid = wgid / nig, fm = gid * WGM, gsz = (nM - fm) < WGM ? (nM - fm) : WGM;
        pm = fm + ((wgid % nig) % gsz); pn = (wgid % nig) / gsz; return true;
    }
    __device__ __forceinline__ bool next(int i, Unit& u) const { u.boff = 0; return map(i, u.pm, u.pn); }
};
struct CtxKvOrder {
    int c;
    __device__ __forceinline__ bool next(int i, Unit& u) const { if (i != 0 || c >= 32) return false; u.pm = 64 + (c >> 3); u.pn = 4 + (c & 7); u.boff = 0; return true; }
};
struct MoeOrder : StaticOrder {
    const volatile LAS int* texp; long bstride;
    __device__ __forceinline__ bool next(int i, Unit& u) const { if (!map(i, u.pm, u.pn)) return false; u.boff = (long)texp[u.pm] * bstride; return true; }
};

template <class Epi, class Sched, bool ALIGN_EPI, bool SP2, bool FP8 = false, bool GATHER = false>
__device__ __forceinline__ void gemm_phase(LAS unsigned char* lds, const int wid, const Gemm g, const Sched& S, const Epi& E, const LAS int* gidx = nullptr) {
    static_assert(!GATHER || SP2, "row-gathered A operand: SP2 loop only");
    const int lane = lane_id(), tid = wid * 64 + lane, wr = wid >> 2, wc = wid & 3, fr = lane & 15, fq = lane >> 4;
    const int K = g.K, nt = K / BK;
    unsigned voffA[2];
#pragma unroll
    for (int i = 0; i < 2; ++i) { int R, C; stage_rc(tid * 16 + i * 8192, R, C); voffA[i] = (unsigned)(R * K + C) * 2u; }
    const size_t kstep = (size_t)(BK * 2);
    const size_t hstep = (size_t)HALF * K * 2;
    const size_t tstep = 2 * hstep;
    const unsigned ldsw = (unsigned)wid * 1024u;
    const int aoff = lds_byte(wr * 64 + fr, fq * 8), boff = lds_byte(wc * 32 + fr, fq * 8);
#define PG8_SA(b, h) (((b) * 2 + (h)) * HTB)
#define PG8_SB(b, h) ((4 + (b) * 2 + (h)) * HTB)
#define PG8_STAGE(bufoff, gbase) do { _Pragma("unroll") for (int _i = 0; _i < 2; ++_i) \
        __builtin_amdgcn_global_load_lds((const unsigned*)((const char*)(gbase) + voffA[_i]), (LAS unsigned*)(lds + (bufoff) + ldsw + _i * 8192), 16, 0, 0); } while (0)
#define PG8_STAGEA(bufoff, ptr, kq, h, useN) do { if constexpr (GATHER) { _Pragma("unroll") for (int _i = 0; _i < 2; ++_i) \
        __builtin_amdgcn_global_load_lds((const unsigned*)(gA + (kq) + ((useN) ? oN[h][_i] : oC[h][_i])), (LAS unsigned*)(lds + (bufoff) + ldsw + _i * 8192), 16, 0, 0); } \
        else { PG8_STAGE(bufoff, ptr); } } while (0)
#define PG8_OFFS(o, uidx) do { _Pragma("unroll") for (int _h = 0; _h < 2; ++_h) _Pragma("unroll") for (int _i = 0; _i < 2; ++_i) { int R_, C_; stage_rc(tid * 16 + _i * 8192, R_, C_); \
        o[_h][_i] = (unsigned)gidx[(uidx) * 256 + _h * HALF + R_] * (unsigned)(K * 2) + (unsigned)(C_ * 2); } } while (0)
#define PG8_CAT(lo, hi) __builtin_shufflevector(lo, hi, 0, 1, 2, 3, 4, 5, 6, 7)
#define PG8_LDA(dst, b, h) do { _Pragma("unroll") for (int m = 0; m < 4; ++m) dst[m] = PG8_CAT(*(const LAS i32x4*)(lds + PG8_SA(b, h) + aoff + m * 2048), *(const LAS i32x4*)(lds + PG8_SA(b, h) + aoff + m * 2048 + 1024)); } while (0)
#define PG8_LDB(dst, b, h) do { _Pragma("unroll") for (int n = 0; n < 2; ++n) dst[n] = PG8_CAT(*(const LAS i32x4*)(lds + PG8_SB(b, h) + boff + n * 2048), *(const LAS i32x4*)(lds + PG8_SB(b, h) + boff + n * 2048 + 1024)); } while (0)
#define PG8_LO(x) __builtin_bit_cast(bf16x8, __builtin_shufflevector(x, x, 0, 1, 2, 3))
#define PG8_HI(x) __builtin_bit_cast(bf16x8, __builtin_shufflevector(x, x, 4, 5, 6, 7))
#define PG8_MMA(ai, bj, At, Bt) do { __builtin_amdgcn_s_setprio(1); \
        if constexpr (FP8) { _Pragma("unroll") for (int m = 0; m < 4; ++m) _Pragma("unroll") for (int n = 0; n < 2; ++n) \
            asm volatile("v_mfma_scale_f32_16x16x128_f8f6f4 %0, %1, %2, %0, %3, %4 op_sel_hi:[0,0,0]" : "+v"(acc[ai][bj][m][n]) : "v"(Bt[n]), "v"(At[m]), "v"(scw), "v"(sca)); } \
        else { _Pragma("unroll") for (int m = 0; m < 4; ++m) _Pragma("unroll") for (int n = 0; n < 2; ++n) { \
            acc[ai][bj][m][n] = __builtin_amdgcn_mfma_f32_16x16x32_bf16(PG8_LO(Bt[n]), PG8_LO(At[m]), acc[ai][bj][m][n], 0, 0, 0); \
            acc[ai][bj][m][n] = __builtin_amdgcn_mfma_f32_16x16x32_bf16(PG8_HI(Bt[n]), PG8_HI(At[m]), acc[ai][bj][m][n], 0, 0, 0); } } \
        __builtin_amdgcn_s_setprio(0); } while (0)
#define PG8_WAIT_V(n) asm volatile("s_waitcnt vmcnt(" #n ")" ::: "memory")
#define PG8_WAIT_L(n) asm volatile("s_waitcnt lgkmcnt(" #n ")" ::: "memory")
#define PG8_BAR __builtin_amdgcn_s_barrier()
#define PG8_SCHED __builtin_amdgcn_sched_barrier(0)
    Unit cur, nxt; int ui = 0;
    if (!S.next(0, cur)) return;
    int scw = SCALE_W8, sca = SCALE_ONE; if constexpr (FP8) asm volatile("" : "+v"(scw), "+v"(sca));
    f32x4 acc[2][2][4][2];
#pragma unroll
    for (int a = 0; a < 2; ++a)
#pragma unroll
        for (int b = 0; b < 2; ++b)
#pragma unroll
            for (int m = 0; m < 4; ++m)
#pragma unroll
                for (int n = 0; n < 2; ++n) acc[a][b][m][n] = (f32x4){0.f, 0.f, 0.f, 0.f};
    i32x8 At[4], B0[2], B1[2];
    const char* cA = (const char*)g.A + (size_t)cur.pm * tstep; const char* cB = (const char*)g.Bt + cur.boff + (size_t)cur.pn * tstep;
    const char* const gA = (const char*)g.A; unsigned oC[2][2], oN[2][2];
    if constexpr (GATHER) { PG8_OFFS(oC, 0);
#pragma unroll
        for (int h = 0; h < 2; ++h) { oN[h][0] = oC[h][0]; oN[h][1] = oC[h][1]; } }
    if constexpr (SP2) {
        PG8_STAGE(PG8_SB(0, 0), cB); PG8_STAGE(PG8_SB(0, 1), cB + hstep); PG8_STAGEA(PG8_SA(0, 0), cA, (size_t)0, 0, false); PG8_STAGEA(PG8_SA(0, 1), cA + hstep, (size_t)0, 1, false);
        if (wr == 1) PG8_BAR;
        PG8_WAIT_V(2); PG8_BAR;
        PG8_STAGE(PG8_SB(1, 0), cB + kstep); PG8_STAGEA(PG8_SA(1, 0), cA + kstep, kstep, 0, false); PG8_STAGE(PG8_SB(1, 1), cB + hstep + kstep);
        PG8_WAIT_V(6); PG8_BAR;
    } else {
        PG8_STAGE(PG8_SB(0, 0), cB); PG8_STAGE(PG8_SA(0, 0), cA); PG8_STAGE(PG8_SB(0, 1), cB + hstep); PG8_STAGE(PG8_SA(0, 1), cA + hstep);
        if (wr == 1) PG8_BAR;
        PG8_WAIT_V(4); PG8_BAR;
        PG8_STAGE(PG8_SB(1, 0), cB + kstep); PG8_STAGE(PG8_SA(1, 0), cA + kstep); PG8_STAGE(PG8_SB(1, 1), cB + hstep + kstep);
        PG8_WAIT_V(6); PG8_BAR;
    }
    for (;;) {
        const bool has_next = S.next(ui + 1, nxt);
        const char* nA = has_next ? (const char*)g.A + (size_t)nxt.pm * tstep : cA; const char* nB = has_next ? (const char*)g.Bt + nxt.boff + (size_t)nxt.pn * tstep : cB;
        if constexpr (GATHER) { if (has_next) PG8_OFFS(oN, ui + 1); }
#pragma unroll 1
        for (int t = 0; t < nt; t += 2) {
            const bool last = (t == nt - 2);
            const char* a1 = cA + (size_t)(t + 1) * kstep;
            const char* a2 = last ? nA : cA + (size_t)(t + 2) * kstep; const char* b2 = last ? nB : cB + (size_t)(t + 2) * kstep;
            const char* a3 = a2 + kstep; const char* b3 = b2 + kstep;
            const size_t kq1 = (size_t)(t + 1) * kstep, kq2 = last ? (size_t)0 : (size_t)(t + 2) * kstep, kq3 = kq2 + kstep;
            if constexpr (SP2) {
            PG8_LDB(B0, 0, 0); PG8_LDB(B1, 0, 1); PG8_SCHED; PG8_LDA(At, 0, 0); PG8_STAGEA(PG8_SA(1, 1), a1 + hstep, kq1, 1, false);
            PG8_WAIT_V(8); PG8_WAIT_L(0); PG8_BAR; PG8_MMA(0, 0, At, B0); PG8_MMA(0, 1, At, B1); PG8_BAR; PG8_SCHED;
            PG8_LDA(At, 0, 1); PG8_STAGE(PG8_SB(0, 0), b2); PG8_STAGE(PG8_SB(0, 1), b2 + hstep); PG8_STAGEA(PG8_SA(0, 0), a2, kq2, 0, last);
            PG8_WAIT_V(8); PG8_WAIT_L(0); PG8_BAR; PG8_MMA(1, 0, At, B0); PG8_MMA(1, 1, At, B1); PG8_BAR; PG8_SCHED;
            PG8_LDB(B0, 1, 0); PG8_LDB(B1, 1, 1); PG8_SCHED; PG8_LDA(At, 1, 0); PG8_STAGEA(PG8_SA(0, 1), a2 + hstep, kq2, 1, last);
            PG8_WAIT_V(8); PG8_WAIT_L(0); PG8_BAR; PG8_MMA(0, 0, At, B0); PG8_MMA(0, 1, At, B1); PG8_BAR; PG8_SCHED;
            PG8_LDA(At, 1, 1); PG8_STAGE(PG8_SB(1, 0), b3); PG8_STAGE(PG8_SB(1, 1), b3 + hstep); PG8_STAGEA(PG8_SA(1, 0), a3, kq3, 0, last);
            PG8_WAIT_V(8); PG8_WAIT_L(0); PG8_BAR; PG8_MMA(1, 0, At, B0); PG8_MMA(1, 1, At, B1); PG8_BAR; PG8_SCHED;
            } else {
            PG8_LDB(B0, 0, 0); PG8_SCHED; PG8_LDA(At, 0, 0); PG8_STAGE(PG8_SA(1, 1), a1 + hstep);
            PG8_WAIT_L(8); PG8_BAR; PG8_WAIT_L(0); PG8_MMA(0, 0, At, B0); PG8_BAR; PG8_SCHED;
            PG8_LDB(B1, 0, 1); PG8_STAGE(PG8_SB(0, 0), b2);
            PG8_BAR; PG8_WAIT_L(0); PG8_MMA(0, 1, At, B1); PG8_BAR;
            PG8_LDA(At, 0, 1); PG8_STAGE(PG8_SA(0, 0), a2);
            PG8_BAR; PG8_WAIT_L(0); PG8_MMA(1, 0, At, B0); PG8_BAR; PG8_SCHED;
            PG8_STAGE(PG8_SB(0, 1), b2 + hstep);
            PG8_WAIT_V(6); PG8_BAR; PG8_MMA(1, 1, At, B1); PG8_BAR;
            PG8_LDB(B0, 1, 0); PG8_SCHED; PG8_LDA(At, 1, 0); PG8_STAGE(PG8_SA(0, 1), a2 + hstep);
            PG8_WAIT_L(8); PG8_BAR; PG8_WAIT_L(0); PG8_MMA(0, 0, At, B0); PG8_BAR; PG8_SCHED;
            PG8_LDB(B1, 1, 1); PG8_STAGE(PG8_SB(1, 0), b3);
            PG8_BAR; PG8_WAIT_L(0); PG8_MMA(0, 1, At, B1); PG8_BAR;
            PG8_LDA(At, 1, 1); PG8_STAGE(PG8_SA(1, 0), a3);
            PG8_BAR; PG8_WAIT_L(0); PG8_MMA(1, 0, At, B0); PG8_BAR; PG8_SCHED;
            PG8_STAGE(PG8_SB(1, 1), b3 + hstep);
            PG8_WAIT_V(6); PG8_BAR; PG8_MMA(1, 1, At, B1); PG8_BAR;
            }
        }
        if constexpr (ALIGN_EPI) { if (wr == 0) PG8_BAR; }
        if constexpr (FP8) asm volatile("s_nop 15\n\ts_nop 15" ::: "memory");
        { int fr_ = fr, fq_ = fq; asm volatile("" : "+v"(fr_), "+v"(fq_)); E(acc, cur, wr, wc, fr_, fq_); }
        if (!has_next) break;
#pragma unroll
        for (int a = 0; a < 2; ++a)
#pragma unroll
            for (int b = 0; b < 2; ++b)
#pragma unroll
                for (int m = 0; m < 4; ++m)
#pragma unroll
                    for (int n = 0; n < 2; ++n) acc[a][b][m][n] = (f32x4){0.f, 0.f, 0.f, 0.f};
        cur = nxt; cA = nA; cB = nB; ++ui;
        if constexpr (GATHER) {
#pragma unroll
            for (int h = 0; h < 2; ++h) { oC[h][0] = oN[h][0]; oC[h][1] = oN[h][1]; } }
        if constexpr (ALIGN_EPI) { if (wr == 1) PG8_BAR; }
    }
    PG8_WAIT_V(0);
    if constexpr (!ALIGN_EPI) { if (wr == 0) PG8_BAR; }
    PG8_BAR;
#undef PG8_SA
#undef PG8_SB
#undef PG8_STAGE
#undef PG8_STAGEA
#undef PG8_OFFS
#undef PG8_LDA
#undef PG8_LDB
#undef PG8_CAT
#undef PG8_LO
#undef PG8_HI
#undef PG8_MMA
#undef PG8_WAIT_V
#undef PG8_WAIT_L
#undef PG8_BAR
#undef PG8_SCHED
}

typedef const f32x4 (&AccRef)[2][2][4][2];

struct EpiAB {
    bf16* Z; const float* cs;
    __device__ __forceinline__ void operator()(AccRef acc, const Unit& u, int wr, int wc, int fr, int fq) const {
        const int sec = u.pn >> 2, ct = u.pn & 3;
        bf16* base = Z + (size_t)sec * ZSEC;
#pragma unroll
        for (int ai = 0; ai < 2; ++ai)
#pragma unroll
            for (int m = 0; m < 4; ++m) {
                const int row = u.pm * BM + ai * HALF + wr * 64 + m * 16 + fr;
                if (sec < 2) {
                    const float sc = sec == 0 ? QK_SCALE : 1.0f;
                    const f32x4 x1a = acc[ai][0][m][0], x1b = acc[ai][0][m][1], x2a = acc[ai][1][m][0], x2b = acc[ai][1][m][1];
                    f32x4 o1a, o1b, o2a, o2b;
                    if (row < NLAT) {
                        const int t = row & (TL - 1); const int pos = (wc & 1) ? (t & 63) : (t >> 6);
                        const float* cp = cs + pos * 32 + 8 * fq;
                        const f32x4 c0 = *(const f32x4*)cp, c1 = *(const f32x4*)(cp + 4), s0 = *(const f32x4*)(cp + 2048), s1 = *(const f32x4*)(cp + 2052);
                        o1a = (x1a * c0 - x2a * s0) * sc; o1b = (x1b * c1 - x2b * s1) * sc; o2a = (x1a * s0 + x2a * c0) * sc; o2b = (x1b * s1 + x2b * c1) * sc;
                    } else { o1a = x1a * sc; o1b = x1b * sc; o2a = x2a * sc; o2b = x2b * sc; }
                    bf16* dst = base + (size_t)row * RW + (2 * ct + (wc >> 1)) * HD + 32 * (wc & 1) + 8 * fq;
                    *(u32x4*)dst = pack8(o1a, o1b); *(u32x4*)(dst + 64) = pack8(o2a, o2b);
                } else {
#pragma unroll
                    for (int bj = 0; bj < 2; ++bj) {
                        f32x4 v0 = acc[ai][bj][m][0], v1 = acc[ai][bj][m][1];
                        if (sec == 3) {
#pragma unroll
                            for (int j = 0; j < 4; ++j) { v0[j] = silu_f(v0[j]); v1[j] = silu_f(v1[j]); }
                        } else if (sec >= 4) {
#pragma unroll
                            for (int j = 0; j < 4; ++j) { v0[j] = gelu_tanh_f(v0[j]); v1[j] = gelu_tanh_f(v1[j]); }
                        }
                        *(u32x4*)(base + (size_t)row * RW + ct * 256 + bj * HALF + wc * 32 + 8 * fq) = pack8(v0, v1);
                    }
                }
            }
    }
};
struct EpiRes {
    bf16* X; const float* base_f32; const float* gate;
    __device__ __forceinline__ void operator()(AccRef acc, const Unit& u, int wr, int wc, int fr, int fq) const {
        const int r = u.pm >> 4; const int col0 = u.pn * BM + wc * 32 + 8 * fq;
        const float* gp = gate + (size_t)r * MODW + col0;
        const size_t ro = (size_t)(u.pm * BM + wr * 64 + fr) * D + col0;
#pragma unroll
        for (int bj = 0; bj < 2; ++bj) {
            const f32x4 g0 = *(const f32x4*)(gp + bj * HALF), g1 = *(const f32x4*)(gp + bj * HALF + 4);
            f32x4 x0[2][4], x1[2][4];
            if (base_f32) {
#pragma unroll
                for (int ai = 0; ai < 2; ++ai)
#pragma unroll
                    for (int m = 0; m < 4; ++m) { const float* bp = base_f32 + ro + (size_t)(ai * HALF + m * 16) * D + bj * HALF; x0[ai][m] = *(const f32x4*)bp; x1[ai][m] = *(const f32x4*)(bp + 4); }
            } else {
#pragma unroll
                for (int ai = 0; ai < 2; ++ai)
#pragma unroll
                    for (int m = 0; m < 4; ++m) { const u32x4 p = *(const u32x4*)(X + ro + (size_t)(ai * HALF + m * 16) * D + bj * HALF); u32x2 lo, hi; lo.x = p.x; lo.y = p.y; hi.x = p.z; hi.y = p.w; x0[ai][m] = bf4_to_f32(lo); x1[ai][m] = bf4_to_f32(hi); }
            }
#pragma unroll
            for (int ai = 0; ai < 2; ++ai)
#pragma unroll
                for (int m = 0; m < 4; ++m) *(u32x4*)(X + ro + (size_t)(ai * HALF + m * 16) * D + bj * HALF) = pack8(x0[ai][m] + g0 * acc[ai][bj][m][0], x1[ai][m] + g1 * acc[ai][bj][m][1]);
        }
    }
};
struct EpiCV {
    bf16* GB; bf16* XG;
    __device__ __forceinline__ void operator()(AccRef acc, const Unit& u, int wr, int wc, int fr, int fq) const {
#pragma unroll
        for (int ai = 0; ai < 2; ++ai)
#pragma unroll
            for (int m = 0; m < 4; ++m) { const size_t row = (size_t)(u.pm * BM + ai * HALF + wr * 64 + m * 16 + fr);
                if (u.pn < 8) {
#pragma unroll
                    for (int bj = 0; bj < 2; ++bj) *(u32x4*)(GB + row * D + u.pn * 256 + bj * HALF + wc * 32 + 8 * fq) = pack8(acc[ai][bj][m][0], acc[ai][bj][m][1]);
                } else {
                    *(u32x4*)(XG + row * D + (u.pn - 8) * HALF + wc * 32 + 8 * fq) = pack8(acc[ai][0][m][0] * acc[ai][1][m][0], acc[ai][0][m][1] * acc[ai][1][m][1]);
                } }
    }
};
struct EpiMoe1 {
    unsigned char* H;
    __device__ __forceinline__ void operator()(AccRef acc, const Unit& u, int wr, int wc, int fr, int fq) const {
#pragma unroll
        for (int ai = 0; ai < 2; ++ai)
#pragma unroll
            for (int m = 0; m < 4; ++m) { const size_t row = (size_t)(u.pm * BM + ai * HALF + wr * 64 + m * 16 + fr);
                f32x4 a0 = acc[ai][0][m][0], a1 = acc[ai][0][m][1];
#pragma unroll
                for (int j = 0; j < 4; ++j) { a0[j] = silu_f(a0[j]); a1[j] = silu_f(a1[j]); }
                *(u32x2*)(H + row * DE + u.pn * HALF + wc * 32 + 8 * fq) = pack8_fp8(a0 * acc[ai][1][m][0], a1 * acc[ai][1][m][1]); }
    }
};
struct EpiMoe2 {
    bf16* Y;
    __device__ __forceinline__ void operator()(AccRef acc, const Unit& u, int wr, int wc, int fr, int fq) const {
#pragma unroll
        for (int ai = 0; ai < 2; ++ai)
#pragma unroll
            for (int m = 0; m < 4; ++m) { const size_t row = (size_t)(u.pm * BM + ai * HALF + wr * 64 + m * 16 + fr);
#pragma unroll
                for (int bj = 0; bj < 2; ++bj) *(u32x4*)(Y + row * D + u.pn * 256 + bj * HALF + wc * 32 + 8 * fq) = pack8(acc[ai][bj][m][0], acc[ai][bj][m][1]); }
    }
};
}

#define XB_TMO      128
#define XB_XCNT(j)  (256  + 64 * (j))
#define XB_XSUB(j)  (1280 + 64 * (j))
#define XB_XGEN(j)  (2304 + 64 * (j))
#define XB_TOP      3328
#define XB_TOPGEN   3392
#define XCD_BAR_WORDS 3456
#define XB_SPIN_CAP (1u << 18)
__device__ __forceinline__ unsigned xb_ld(unsigned* p)              { return __hip_atomic_load(p, __ATOMIC_RELAXED, __HIP_MEMORY_SCOPE_AGENT); }
__device__ __forceinline__ unsigned xb_add(unsigned* p, unsigned v) { return __hip_atomic_fetch_add(p, v, __ATOMIC_RELAXED, __HIP_MEMORY_SCOPE_AGENT); }
__device__ __forceinline__ unsigned xb_xcc_id() { return (unsigned)__builtin_amdgcn_s_getreg((3 << 11) | 20) & 0xFu; }
#define XB_SPIN(cond, bar) do { unsigned _sp = 0; while (cond) { __builtin_amdgcn_s_sleep(1); \
    if ((++_sp & 255u) == 0u) { if (xb_ld(&(bar)[XB_TMO])) break; if (_sp > XB_SPIN_CAP) { atomicAdd(&(bar)[XB_TMO], 1u); break; } } } } while (0)
struct XcdBarrier { unsigned* bar; unsigned x; volatile LAS unsigned* st; };
__device__ __forceinline__ XcdBarrier xcd_barrier_post(unsigned* bar, volatile LAS unsigned* st) {
    XcdBarrier b; b.bar = bar; b.x = xb_xcc_id(); b.st = st;
    if (threadIdx.x == 0) (void)xb_add(&bar[XB_XCNT(b.x)], 1u);
    return b;
}
__device__ __forceinline__ void xcd_barrier_complete(unsigned* bar, unsigned x, unsigned& nloc, unsigned& nx) {
    const unsigned G = gridDim.x * gridDim.y * gridDim.z;
    unsigned sum, cnt, mine, sp = 0u;
    for (;;) {
        sum = 0u; cnt = 0u; mine = 0u;
#pragma unroll
        for (unsigned j = 0; j < 16; ++j) { const unsigned c = xb_ld(&bar[XB_XCNT(j)]); sum += c; cnt += (c > 0u) ? 1u : 0u; mine = (j == x) ? c : mine; }
        if (sum == G) break;
        __builtin_amdgcn_s_sleep(1);
        if ((++sp & 255u) == 0u) { if (xb_ld(&bar[XB_TMO])) break; if (sp > XB_SPIN_CAP) { atomicAdd(&bar[XB_TMO], 1u); break; } }
    }
    nloc = mine > 0u ? mine : 1u; nx = cnt > 0u ? cnt : 1u;
}
__device__ __forceinline__ void xcd_barrier(const XcdBarrier& b) {
    asm volatile("s_waitcnt vmcnt(0)" ::: "memory");
    __syncthreads();
    if (threadIdx.x == 0) {
        unsigned* bar = b.bar;
        __builtin_amdgcn_s_waitcnt(0);
        unsigned nloc = b.st[0], nx = b.st[1];
        if (nloc == 0u) { xcd_barrier_complete(bar, b.x, nloc, nx); b.st[0] = nloc; b.st[1] = nx; }
        const unsigned old = xb_add(&bar[XB_XSUB(b.x)], 1u);
        const unsigned gen = old / nloc;
        if (old + 1u == (gen + 1u) * nloc) {
            __builtin_amdgcn_fence(__ATOMIC_RELEASE, "agent");
            asm volatile("s_waitcnt vmcnt(0)" ::: "memory");
            const unsigned og = xb_add(&bar[XB_TOP], 1u);
            const unsigned tg = og / nx;
            if (og + 1u == (tg + 1u) * nx) xb_add(&bar[XB_TOPGEN], 1u);
            else XB_SPIN(xb_ld(&bar[XB_TOPGEN]) == tg, bar);
            __builtin_amdgcn_fence(__ATOMIC_ACQUIRE, "agent");
            xb_add(&bar[XB_XGEN(b.x)], 1u);
            asm volatile("s_waitcnt vmcnt(0)" ::: "memory");
        } else {
            XB_SPIN(xb_ld(&bar[XB_XGEN(b.x)]) == gen, bar);
            __builtin_amdgcn_fence(__ATOMIC_ACQUIRE, "agent");
            asm volatile("s_waitcnt vmcnt(0)" ::: "memory");
        }
    }
    __syncthreads();
}

struct Args {
    const float *x, *c, *ctx, *c_ctx, *w_mod, *b_mod, *g_mix, *g_ffn, *ab_w_in, *ab_w_out, *decay, *sgu_w, *sgu_b,
                *cv_w_in, *cv_cw, *cv_cb, *cv_w_out, *w_r1, *b_r1, *w_r2, *b_r2, *w1, *w3, *w2, *g_final;
    float* out; unsigned char* ws; int ph_lo, ph_hi;
};
struct Frame { LAS unsigned char* lds; volatile LAS unsigned* MISC; int wave, G, blk; };
#define FR_LANE_TID const int lane_ = lane_id(); const int tid_ = F.wave * 64 + lane_

enum { PH_PRO = 0, PH_L0 = 1, PH_PER_LAYER = 10, PH_FINAL = 21, NPHASE = 22 };
enum { K_PRE = 0, K_GIN = 1, K_MID1 = 2, K_MID1B = 3, K_MID2 = 4, K_MID3 = 5, K_GOUT = 6, K_ROUTE = 7, K_MOE1 = 8, K_MOE2 = 9 };

__device__ __forceinline__ int pos32(int x) { return 16 * ((x >> 2) & 1) + 4 * (x >> 3) + (x & 3); }
constexpr int I_IN = 32 * 192, I_OUT = 32 * 64, I_FIX = 2 * I_IN + 2 * I_OUT, I_EXP = 3072, I_MOE = 16 * I_EXP, NITEMS = I_FIX + 2 * I_MOE;
struct ItemDesc { const float* src; unsigned char* dst; int N, K, k0, dgrp, fp8; };
__device__ __forceinline__ ItemDesc decode_item(const Args& a, int it) {
    unsigned char* ws = a.ws; ItemDesc d; int kb, nb;
    if (it < I_IN) {
        kb = it / 192; nb = it % 192; const int n = nb * 32, sec = n >> 10;
        if (sec < 2) { const int h = (n & 1023) >> 7, dgi = (n & 127) >> 5; d.dgrp = (sec * 4 + (h >> 1)) * 8 + (dgi >> 1) * 4 + (h & 1) * 2 + (dgi & 1); } else d.dgrp = nb;
        d.src = a.ab_w_in; d.N = 6144; d.K = D; d.dst = ws + WS_WAB_IN; d.fp8 = 0;
    } else if (it < I_IN + I_OUT) { const int r = it - I_IN; kb = r / 64; nb = r % 64; d.dgrp = nb; d.src = a.ab_w_out; d.N = D; d.K = D; d.dst = ws + WS_WAB_OUT; d.fp8 = 0;
    } else if (it < 2 * I_IN + I_OUT) {
        const int r = it - I_IN - I_OUT; kb = r / 192; nb = r % 192; const int n = nb * 32;
        if (n < 2048) d.dgrp = nb; else if (n < 4096) { const int cc = n - 2048; d.dgrp = (8 + (cc >> 7)) * 8 + ((cc & 127) >> 5); } else { const int cc = n - 4096; d.dgrp = (8 + (cc >> 7)) * 8 + 4 + ((cc & 127) >> 5); }
        d.src = a.cv_w_in; d.N = 6144; d.K = D; d.dst = ws + WS_WCV_IN; d.fp8 = 0;
    } else if (it < I_FIX) { const int r = it - 2 * I_IN - I_OUT; kb = r / 64; nb = r % 64; d.dgrp = nb; d.src = a.cv_w_out; d.N = D; d.K = D; d.dst = ws + WS_WCV_OUT; d.fp8 = 0;
    } else {
        const int idx = it - I_FIX; const int le = idx / I_EXP, r = idx % I_EXP, which = r >> 10, item = r & 1023; d.fp8 = 1;
        if (which < 2) {
            kb = item >> 5; nb = item & 31; const int cc = nb * 32; d.dgrp = (cc >> 7) * 8 + which * 4 + ((cc & 127) >> 5);
            d.src = (which ? a.w3 : a.w1) + (size_t)le * D * DE; d.N = DE; d.K = D; d.dst = ws + WS_W13 + (size_t)le * D * D;
        } else {
            kb = item >> 6; nb = item & 63; d.dgrp = nb; d.src = a.w2 + (size_t)le * DE * D; d.N = D; d.K = DE; d.dst = ws + WS_W2 + (size_t)le * D * DE;
        }
    }
    d.k0 = 64 * kb; d.src += (size_t)d.k0 * d.N + 32 * nb;
    return d;
}
__device__ __forceinline__ void item_load(const ItemDesc& d, f32x4 (&v)[8], int lane) {
    const float* src = d.src + (size_t)(8 * (lane >> 3)) * d.N + 4 * (lane & 7);
#pragma unroll
    for (int i = 0; i < 8; ++i) v[i] = __builtin_nontemporal_load((const f32x4*)(src + (size_t)i * d.N));
}
__device__ __forceinline__ void item_finish(const ItemDesc& d, const f32x4 (&v)[8], LAS float* scr, int lane) {
    (void)scr;
    const int kq = 8 * (lane >> 3), nq = 4 * (lane & 7);
    if (d.fp8) {
#pragma unroll
        for (int j = 0; j < 4; ++j) { u32x2 o; o.x = pk4_fp8(v[0][j] * W8_SCALE, v[1][j] * W8_SCALE, v[2][j] * W8_SCALE, v[3][j] * W8_SCALE); o.y = pk4_fp8(v[4][j] * W8_SCALE, v[5][j] * W8_SCALE, v[6][j] * W8_SCALE, v[7][j] * W8_SCALE);
            *(u32x2*)(d.dst + (size_t)(d.dgrp * 32 + pos32(nq + j)) * d.K + d.k0 + kq) = o; }
    } else {
#pragma unroll
        for (int j = 0; j < 4; ++j) { u32x4 o; o.x = cvt_pk_bf16(v[0][j], v[1][j]); o.y = cvt_pk_bf16(v[2][j], v[3][j]); o.z = cvt_pk_bf16(v[4][j], v[5][j]); o.w = cvt_pk_bf16(v[6][j], v[7][j]);
            *(u32x4*)((bf16*)d.dst + (size_t)(d.dgrp * 32 + pos32(nq + j)) * d.K + d.k0 + kq) = o; }
    }
}
__device__ __forceinline__ void convert_items(const Args& a, Frame& F, int it0, int it1, int stride) {
    const int lane = lane_id(); LAS float* scr = (LAS float*)(F.lds + F.wave * 8448);
    if (it0 >= it1) return;
    f32x4 vc[8], vn[8]; ItemDesc cur = decode_item(a, it0); item_load(cur, vc, lane);
    for (int it = it0; it < it1; it += stride) {
        const bool hn = it + stride < it1; const ItemDesc nxt = decode_item(a, hn ? it + stride : it);
        if (hn) item_load(nxt, vn, lane);
        item_finish(cur, vc, scr, lane);
        cur.src = nxt.src; cur.dst = nxt.dst; cur.N = nxt.N; cur.K = nxt.K; cur.k0 = nxt.k0; cur.dgrp = nxt.dgrp; cur.fp8 = nxt.fp8;
#pragma unroll
        for (int i = 0; i < 8; ++i) vc[i] = vn[i];
    }
}
constexpr int TAIL_N1 = 0, TAIL_N2 = 0, TAIL_T1 = 160 * 8 * TAIL_N1, TAIL_T2 = 224 * 8 * TAIL_N2;
static_assert(TAIL_T1 + TAIL_T2 <= I_MOE, "tail shares");
__device__ __forceinline__ void phase_prologue(const Args& a, Frame& F) {
    FR_LANE_TID;
    unsigned char* ws = a.ws;
    {
        LAS float* S = (LAS float*)(F.lds + 69632);
        LAS float* red = (LAS float*)(F.lds + 110592);
        for (int i = tid_; i < 5 * D; i += 512) { const int r = i / D, k = i % D; const float v = r < 4 ? a.c[r * D + k] : a.c_ctx[k]; S[i] = silu_f(v); }
        __syncthreads();
        if (F.blk < 256) {
            const int Lm = F.blk >> 7, strip = F.blk & 127;
            const int rsub = lane_ / 24, c4 = lane_ % 24;
            float acc[5][4];
#pragma unroll
            for (int r = 0; r < 5; ++r) { acc[r][0] = 0.f; acc[r][1] = 0.f; acc[r][2] = 0.f; acc[r][3] = 0.f; }
            if (rsub < 2) {
                const float* wp = a.w_mod + (size_t)Lm * D * MODW + (size_t)(256 * F.wave + rsub) * MODW + 96 * strip + 4 * c4;
#pragma unroll 8
                for (int it = 0; it < 128; ++it) {
                    const f32x4 w = *(const f32x4*)(wp + (size_t)(2 * it) * MODW);
                    const int k = 256 * F.wave + 2 * it + rsub;
#pragma unroll
                    for (int r = 0; r < 5; ++r) { const float s = S[r * D + k]; acc[r][0] += s * w[0]; acc[r][1] += s * w[1]; acc[r][2] += s * w[2]; acc[r][3] += s * w[3]; }
                }
#pragma unroll
                for (int r = 0; r < 5; ++r)
#pragma unroll
                    for (int j = 0; j < 4; ++j) red[(F.wave * 2 + rsub) * 480 + r * 96 + 4 * c4 + j] = acc[r][j];
            }
            __syncthreads();
            if (tid_ < 480) { float s = 0.f;
#pragma unroll
                for (int p = 0; p < 16; ++p) s += red[p * 480 + tid_];
                const int r = tid_ / 96, cc = tid_ % 96; const int col = 96 * strip + cc;
                ((float*)(ws + WS_MOD))[(size_t)(Lm * 5 + r) * MODW + col] = s + a.b_mod[Lm * MODW + col]; }
        }
        __syncthreads();
    }
    {
        const int gt = F.blk * 512 + tid_, NT = F.G * 512;
        float* cs = (float*)(ws + WS_ROPE);
        for (int i = gt; i < 2048; i += NT) { const int pos = i >> 5, f = i & 31; const float inv = powf(10000.0f, -(float)f / 32.0f); const float ang = (float)pos * inv; cs[i] = cosf(ang); cs[2048 + i] = sinf(ang); }
        float* wr = (float*)(ws + WS_WR);
        for (int i = gt; i < 2 * 20 * D; i += NT) { const int L = i / (20 * D), r = (i / D) % 20, k = i % D;
            float v; if (r < 4) v = a.w_r1[((size_t)L * D + k) * 4 + r]; else { const int g = (r - 4) >> 2, e = (r - 4) & 3; v = a.w_r2[(((size_t)L * 4 + g) * D + k) * 4 + e]; }
            wr[i] = v; }
    }
    {
        const int gw = F.blk * 8 + F.wave, NGW = F.G * 8;
        constexpr int R0 = I_MOE - TAIL_T1 - TAIL_T2;
        constexpr int NPRO = I_FIX + R0 + I_MOE;
        int v0 = gw;
        if (v0 < I_FIX) { const int n = (I_FIX - v0 + NGW - 1) / NGW; convert_items(a, F, v0, I_FIX, NGW); v0 += n * NGW; }
        if (v0 < I_FIX + R0) { const int n = (I_FIX + R0 - v0 + NGW - 1) / NGW; convert_items(a, F, v0 + TAIL_T1 + TAIL_T2, I_FIX + I_MOE, NGW); v0 += n * NGW; }
        if (v0 < NPRO) convert_items(a, F, v0 - R0 + I_MOE, NITEMS, NGW);
    }
}

__device__ __forceinline__ int moe_tables(const Args& a, Frame& F, int L) {
    FR_LANE_TID;
    volatile LAS int* tb = (volatile LAS int*)(F.MISC + MI_TB); volatile LAS int* texp = (volatile LAS int*)(F.MISC + MI_TEXP); volatile LAS int* cn = (volatile LAS int*)(F.MISC + MI_LCNT);
    __syncthreads();
    if (tid_ == 0) { unsigned* cnt = (unsigned*)(a.ws + WS_CTL) + CW_CNT + L * 16 * 64; int acc = 0;
        for (int e = 0; e < NE; ++e) { tb[e] = acc; const int c = (int)xb_ld(cnt + e * 64); cn[e] = c; const int n = (c + 255) >> 8; for (int t = 0; t < n && acc + t < 160; ++t) texp[acc + t] = e; acc += n; }
        tb[NE] = acc; }
    __syncthreads();
    return tb[NE];
}
__device__ __forceinline__ float row_rstd(const f32x4 (&v)[8]) {
    float ss = 0.f;
#pragma unroll
    for (int j = 0; j < 8; ++j) ss += (v[j][0] * v[j][0] + v[j][1] * v[j][1]) + (v[j][2] * v[j][2] + v[j][3] * v[j][3]);
    return rsqrtf(wave_sum(ss) * (1.0f / D) + EPSN);
}
struct RowBuf { u32x2 xb[8], y0[8], y1[8]; f32x2 w; };
__device__ __forceinline__ void rowbuf_issue(RowBuf& b, const bf16* XB, const bf16* Y, const int* ridx, const float* rwt, const volatile LAS int* tb, int row, int ln4) {
    const i32x4 ri = *(const i32x4*)(ridx + 4 * (size_t)row); b.w = *(const f32x2*)(rwt + 2 * (size_t)row);
    const int d0 = tb[ri.x] * 256 + ri.y, d1 = tb[ri.z] * 256 + ri.w;
#pragma unroll
    for (int j = 0; j < 8; ++j) { b.xb[j] = *(const u32x2*)(XB + (size_t)row * D + ln4 + 256 * j); b.y0[j] = *(const u32x2*)(Y + (size_t)d0 * D + ln4 + 256 * j); b.y1[j] = *(const u32x2*)(Y + (size_t)d1 * D + ln4 + 256 * j); }
}
__device__ __forceinline__ void rowbuf_combine(const RowBuf& b, const f32x4 (&gate)[8], f32x4 (&v)[8]) {
#pragma unroll
    for (int j = 0; j < 8; ++j) v[j] = bf4_to_f32(b.xb[j]) + gate[j] * (bf4_to_f32(b.y0[j]) * b.w.x + bf4_to_f32(b.y1[j]) * b.w.y);
}
__device__ __forceinline__ void phase_pre(const Args& a, Frame& F, int L) {
    FR_LANE_TID;
    unsigned char* ws = a.ws; bf16* XB = (bf16*)(ws + WS_XB); bf16* A = (bf16*)(ws + WS_A);
    const float* MOD = (const float*)(ws + WS_MOD);
    if (L == 0) {
        const int nrows = NTOK; const int gw = F.blk * 8 + F.wave, NGW = F.G * 8;
        f32x4 vn[8];
        if (gw < nrows) { const float* src = gw < NLAT ? a.x + (size_t)gw * D : a.ctx + (size_t)(gw - NLAT) * D;
#pragma unroll
            for (int j = 0; j < 8; ++j) vn[j] = *(const f32x4*)(src + 4 * lane_ + 256 * j); }
        for (int row = gw; row < nrows; row += NGW) {
            const int r = row < NLAT ? row >> 12 : 4;
            int ln4 = 4 * lane_; asm volatile("" : "+v"(ln4));
            f32x4 v[8];
#pragma unroll
            for (int j = 0; j < 8; ++j) v[j] = vn[j];
            { const int rn = row + NGW; if (rn < nrows) { const float* src = rn < NLAT ? a.x + (size_t)rn * D : a.ctx + (size_t)(rn - NLAT) * D;
#pragma unroll
                for (int j = 0; j < 8; ++j) vn[j] = *(const f32x4*)(src + ln4 + 256 * j); } }
            const float rstd = row_rstd(v);
            const float* mp = MOD + (size_t)r * MODW; const float* gm = a.g_mix;
#pragma unroll
            for (int j = 0; j < 8; ++j) { const int c = ln4 + 256 * j; const f32x4 g = *(const f32x4*)(gm + c), sh = *(const f32x4*)(mp + c), sc = *(const f32x4*)(mp + D + c);
                *(u32x2*)(A + (size_t)row * D + c) = f32_to_bf4(v[j] * rstd * g * (sc + 1.0f) + sh); }
        }
    } else {
        (void)moe_tables(a, F, L - 1);
        const volatile LAS int* tb = (const volatile LAS int*)(F.MISC + MI_TB);
        const int RPB = NLAT / F.G, r = (F.blk * RPB) >> 12;
        const bf16* Y = (const bf16*)(ws + WS_R2); const int* ridx = (const int*)(ws + WS_RIDX) + (size_t)(L - 1) * NTOK * 4; const float* rwt = (const float*)(ws + WS_RWT) + (size_t)(L - 1) * NTOK * 2;
        const float* mp = MOD + (size_t)(L * 5 + r) * MODW;
        f32x4 gate[8], Gm[8];
#pragma unroll
        for (int j = 0; j < 8; ++j) { const int c = 4 * lane_ + 256 * j; gate[j] = *(const f32x4*)(MOD + (size_t)((L - 1) * 5 + r) * MODW + 5 * D + c); Gm[j] = *(const f32x4*)(a.g_mix + L * D + c) * (*(const f32x4*)(mp + D + c) + 1.0f); }
        RowBuf bA, bB;
        const int row0 = F.blk * RPB + F.wave;
        if (F.wave < RPB) rowbuf_issue(bA, XB, Y, ridx, rwt, tb, row0, 4 * lane_);
        for (int i = F.wave; i < RPB; i += 16) {
            int ln4 = 4 * lane_; asm volatile("" : "+v"(ln4));
            const int row = F.blk * RPB + i;
            if (i + 8 < RPB) rowbuf_issue(bB, XB, Y, ridx, rwt, tb, row + 8, ln4);
            { f32x4 v[8]; rowbuf_combine(bA, gate, v);
#pragma unroll
              for (int j = 0; j < 8; ++j) *(u32x2*)(XB + (size_t)row * D + ln4 + 256 * j) = f32_to_bf4(v[j]);
              const float rstd = row_rstd(v);
#pragma unroll
              for (int j = 0; j < 8; ++j) { const int c = ln4 + 256 * j; *(u32x2*)(A + (size_t)row * D + c) = f32_to_bf4(v[j] * rstd * Gm[j] + *(const f32x4*)(mp + c)); } }
            if (i + 8 >= RPB) break;
            if (i + 16 < RPB) rowbuf_issue(bA, XB, Y, ridx, rwt, tb, row + 16, ln4);
            { f32x4 v[8]; rowbuf_combine(bB, gate, v);
#pragma unroll
              for (int j = 0; j < 8; ++j) *(u32x2*)(XB + (size_t)(row + 8) * D + ln4 + 256 * j) = f32_to_bf4(v[j]);
              const float rstd = row_rstd(v);
#pragma unroll
              for (int j = 0; j < 8; ++j) { const int c = ln4 + 256 * j; *(u32x2*)(A + (size_t)(row + 8) * D + c) = f32_to_bf4(v[j] * rstd * Gm[j] + *(const f32x4*)(mp + c)); } }
        }
    }
}

constexpr int LDP = 136;
constexpr int IMG = 128 * LDP * 2;
__device__ __forceinline__ int unit_row0(int b, int s) { return s < 2 ? NLAT + b * TCX + s * 128 : b * TL + (s - 2) * 128; }
__device__ __forceinline__ void piece_rc(int q, int& j, int& ch) { const int jr = q & 15, cq = (q >> 4) & 3, blk = q >> 6; j = 16 * (blk & 7) + jr; ch = 4 * (blk >> 3) + cq; }

__device__ __forceinline__ void ret_u_unit(const Args& a, Frame& F, int u) {
    FR_LANE_TID;
    unsigned char* ws = a.ws; const bf16* Z = (const bf16*)(ws + WS_R1);
    const int bh = u / NSLOT, s = u % NSLOT, b = bh >> 3, h = bh & 7; const int row0 = unit_row0(b, s);
    const bf16* Kp = Z + 1 * ZSEC + (size_t)row0 * RW + h * HD; const bf16* Vp = Z + 2 * ZSEC + (size_t)row0 * RW + h * HD;
    const float lgf2 = logsig(a.decay[h]) * LOG2E, lgb2 = logsig(a.decay[NH + h]) * LOG2E;
    LAS bf16* KTf = (LAS bf16*)(F.lds); LAS bf16* KTb = (LAS bf16*)(F.lds + IMG); LAS bf16* VT = (LAS bf16*)(F.lds + 2 * IMG);
#pragma unroll
    for (int k = 0; k < 4; ++k) { int j, ch; piece_rc(tid_ + 512 * k, j, ch);
        const u32x4 kv = *(const u32x4*)(Kp + (size_t)j * RW + 8 * ch), vv = *(const u32x4*)(Vp + (size_t)j * RW + 8 * ch);
        const float ff = exp2f((float)(127 - j) * lgf2), fb = exp2f((float)j * lgb2);
#pragma unroll
        for (int i = 0; i < 8; ++i) { const unsigned kw = (i & 1) ? (kv[i >> 1] >> 16) : (kv[i >> 1] & 0xffffu), vw = (i & 1) ? (vv[i >> 1] >> 16) : (vv[i >> 1] & 0xffffu);
            const float kf = bf2f(kw); const unsigned pf = cvt_pk_bf16(kf * ff, kf * fb);
            KTf[(8 * ch + i) * LDP + j] = (bf16)(pf & 0xffffu); KTb[(8 * ch + i) * LDP + j] = (bf16)(pf >> 16); VT[(8 * ch + i) * LDP + j] = (bf16)vw; } }
    __syncthreads();
    const int fr = lane_ & 15, g = lane_ >> 4, dt = F.wave;
    f32x4 accf[8], accb[8];
#pragma unroll
    for (int e = 0; e < 8; ++e) { accf[e] = (f32x4){0.f, 0.f, 0.f, 0.f}; accb[e] = (f32x4){0.f, 0.f, 0.f, 0.f}; }
#pragma unroll
    for (int sI = 0; sI < 4; ++sI) {
        const bf16x8 af = *(const LAS bf16x8*)(KTf + (16 * dt + fr) * LDP + 32 * sI + 8 * g), ab = *(const LAS bf16x8*)(KTb + (16 * dt + fr) * LDP + 32 * sI + 8 * g);
#pragma unroll
        for (int et = 0; et < 8; ++et) { const bf16x8 bv = *(const LAS bf16x8*)(VT + (16 * et + fr) * LDP + 32 * sI + 8 * g);
            accf[et] = __builtin_amdgcn_mfma_f32_16x16x32_bf16(af, bv, accf[et], 0, 0, 0); accb[et] = __builtin_amdgcn_mfma_f32_16x16x32_bf16(ab, bv, accb[et], 0, 0, 0); }
    }
    float* ST = (float*)(ws + WS_R2) + (size_t)u * 2 * 16384;
#pragma unroll
    for (int et = 0; et < 8; ++et) { *(f32x4*)(ST + (size_t)(16 * et + fr) * 128 + 16 * dt + 4 * g) = accf[et]; *(f32x4*)(ST + 16384 + (size_t)(16 * et + fr) * 128 + 16 * dt + 4 * g) = accb[et]; }
    __syncthreads();
}
__device__ __forceinline__ void sgu_unit(const Args& a, Frame& F, int u) {
    FR_LANE_TID;
    unsigned char* ws = a.ws; const bf16* Z = (const bf16*)(ws + WS_R1); bf16* RS = (bf16*)(ws + WS_R3);
    const int bg = u / NSLOT, s = u % NSLOT, b = bg >> 3, grp = bg & 7; const int row0 = unit_row0(b, s);
    const bf16* Up = Z + 4 * ZSEC + (size_t)row0 * RW + grp * HD; const bf16* Vp = Z + 5 * ZSEC + (size_t)row0 * RW + grp * HD;
    LAS bf16* WS_ = (LAS bf16*)(F.lds); LAS bf16* VT = (LAS bf16*)(F.lds + IMG);
    const float* wsrc = a.sgu_w + (size_t)grp * 16384;
#pragma unroll
    for (int k = 0; k < 8; ++k) { const int i4 = tid_ + 512 * k; const int p = i4 >> 5, q4 = (i4 & 31) * 4; const f32x4 w = *(const f32x4*)(wsrc + p * 128 + q4);
        u32x2 o; o.x = cvt_pk_bf16(w[0], w[1]); o.y = cvt_pk_bf16(w[2], w[3]); *(LAS u32x2*)(WS_ + p * LDP + q4) = o; }
    { const int q = tid_ >> 2, part = tid_ & 3; float x[32];
#pragma unroll
        for (int k = 0; k < 4; ++k) { const u32x4 vv = *(const u32x4*)(Vp + (size_t)q * RW + 32 * part + 8 * k);
#pragma unroll
            for (int i = 0; i < 4; ++i) { x[8 * k + 2 * i] = bf2f(vv[i] & 0xffffu); x[8 * k + 2 * i + 1] = bf2f(vv[i] >> 16); } }
        float sm = 0.f;
#pragma unroll
        for (int i = 0; i < 32; ++i) sm += x[i];
        sm += __shfl_xor(sm, 1); sm += __shfl_xor(sm, 2); const float mu = sm * (1.0f / 128.0f);
        float sq = 0.f;
#pragma unroll
        for (int i = 0; i < 32; ++i) { const float dlt = x[i] - mu; sq += dlt * dlt; }
        sq += __shfl_xor(sq, 1); sq += __shfl_xor(sq, 2); const float rstd = rsqrtf(sq * (1.0f / 128.0f) + EPSN);
#pragma unroll
        for (int i = 0; i < 32; i += 2) { const unsigned p2 = cvt_pk_bf16((x[i] - mu) * rstd, (x[i + 1] - mu) * rstd);
            VT[(32 * part + i) * LDP + q] = (bf16)(p2 & 0xffffu); VT[(32 * part + i + 1) * LDP + q] = (bf16)(p2 >> 16); } }
    __syncthreads();
    const int fr = lane_ & 15, g = lane_ >> 4, pt = F.wave;
    f32x4 acc[8];
#pragma unroll
    for (int c = 0; c < 8; ++c) acc[c] = (f32x4){0.f, 0.f, 0.f, 0.f};
#pragma unroll
    for (int sI = 0; sI < 4; ++sI) { const bf16x8 bw = *(const LAS bf16x8*)(WS_ + (16 * pt + fr) * LDP + 32 * sI + 8 * g);
#pragma unroll
        for (int ct = 0; ct < 8; ++ct) { const bf16x8 av = *(const LAS bf16x8*)(VT + (16 * ct + fr) * LDP + 32 * sI + 8 * g);
            acc[ct] = __builtin_amdgcn_mfma_f32_16x16x32_bf16(av, bw, acc[ct], 0, 0, 0); } }
    const int p = 16 * pt + fr; const float bs = a.sgu_b[grp * 128 + p];
#pragma unroll
    for (int ct = 0; ct < 8; ++ct) { const int c = 16 * ct + 4 * g; const u32x2 uu = *(const u32x2*)(Up + (size_t)p * RW + c);
        const float o0 = bf2f(uu.x & 0xffffu) * (acc[ct][0] + bs), o1 = bf2f(uu.x >> 16) * (acc[ct][1] + bs), o2 = bf2f(uu.y & 0xffffu) * (acc[ct][2] + bs), o3 = bf2f(uu.y >> 16) * (acc[ct][3] + bs);
        u32x2 o; o.x = cvt_pk_bf16(o0, o1); o.y = cvt_pk_bf16(o2, o3); *(u32x2*)(RS + (size_t)(row0 + p) * D + RW + grp * HD + c) = o; }
    __syncthreads();
}
__device__ __forceinline__ void phase_scan(const Args& a, Frame& F) {
    FR_LANE_TID;
    float* ST = (float*)(a.ws + WS_R2);
    const int NT = F.G * 512;
    for (int it = F.blk * 512 + tid_; it < 32 * 2 * 4096; it += NT) {
        const int bh = it >> 13, dir = (it >> 12) & 1, e4 = it & 4095, h = bh & 7;
        const float cd = expf(128.0f * logsig(a.decay[dir * NH + h]));
        float* base = ST + ((size_t)bh * NSLOT * 2 + dir) * 16384 + (size_t)e4 * 4;
        f32x4 st = (f32x4){0.f, 0.f, 0.f, 0.f};
#pragma unroll 2
        for (int n = 0; n < NSLOT; ++n) { const int s = dir == 0 ? n : (n < 2 ? 1 - n : 35 - n);
            float* p = base + (size_t)s * 2 * 16384; const f32x4 tmp = *(const f32x4*)p; *(f32x4*)p = st; st = st * cd + tmp; }
    }
}
__device__ __forceinline__ void ret_y_unit(const Args& a, Frame& F, int u) {
    FR_LANE_TID;
    unsigned char* ws = a.ws; const bf16* Z = (const bf16*)(ws + WS_R1); bf16* RS = (bf16*)(ws + WS_R3);
    const int bh = u / NSLOT, s = u % NSLOT, b = bh >> 3, h = bh & 7; const int row0 = unit_row0(b, s);
    const bf16* Qp = Z + (size_t)row0 * RW + h * HD; const bf16* Kp = Z + 1 * ZSEC + (size_t)row0 * RW + h * HD; const bf16* Vp = Z + 2 * ZSEC + (size_t)row0 * RW + h * HD;
    const bf16* Gp = Z + 3 * ZSEC + (size_t)row0 * RW + h * HD;
    const float lgf2 = logsig(a.decay[h]) * LOG2E, lgb2 = logsig(a.decay[NH + h]) * LOG2E;
    LAS bf16* KN = (LAS bf16*)(F.lds); LAS bf16* VT = (LAS bf16*)(F.lds + IMG); LAS bf16* SF = (LAS bf16*)(F.lds + 2 * IMG); LAS bf16* SB = (LAS bf16*)(F.lds + 3 * IMG);
#pragma unroll
    for (int k = 0; k < 4; ++k) { int j, ch; piece_rc(tid_ + 512 * k, j, ch);
        const u32x4 kv = *(const u32x4*)(Kp + (size_t)j * RW + 8 * ch), vv = *(const u32x4*)(Vp + (size_t)j * RW + 8 * ch);
        *(LAS u32x4*)(KN + j * LDP + 8 * ch) = kv;
#pragma unroll
        for (int i = 0; i < 8; ++i) { const unsigned vw = (i & 1) ? (vv[i >> 1] >> 16) : (vv[i >> 1] & 0xffffu); VT[(8 * ch + i) * LDP + j] = (bf16)vw; } }
    { const float* ST = (const float*)(ws + WS_R2) + (size_t)u * 2 * 16384;
#pragma unroll
        for (int k = 0; k < 8; ++k) { const int i4 = tid_ + 512 * k; const int e = i4 >> 5, d4 = (i4 & 31) * 4; const f32x4 sf = *(const f32x4*)(ST + e * 128 + d4), sb = *(const f32x4*)(ST + 16384 + e * 128 + d4);
            u32x2 o; o.x = cvt_pk_bf16(sf[0], sf[1]); o.y = cvt_pk_bf16(sf[2], sf[3]); *(LAS u32x2*)(SF + e * LDP + d4) = o;
            o.x = cvt_pk_bf16(sb[0], sb[1]); o.y = cvt_pk_bf16(sb[2], sb[3]); *(LAS u32x2*)(SB + e * LDP + d4) = o; } }
    const int fr = lane_ & 15, g = lane_ >> 4, it_ = F.wave; const int i_abs = 16 * it_ + fr;
    bf16x8 qf[4];
#pragma unroll
    for (int sI = 0; sI < 4; ++sI) qf[sI] = *(const bf16x8*)(Qp + (size_t)i_abs * RW + 32 * sI + 8 * g);
    __syncthreads();
    bf16x8 pf[4];
#pragma unroll
    for (int ks = 0; ks < 4; ++ks) { f32x4 s0 = (f32x4){0.f, 0.f, 0.f, 0.f}, s1 = s0;
#pragma unroll
        for (int sI = 0; sI < 4; ++sI) { const bf16x8 k0 = *(const LAS bf16x8*)(KN + (32 * ks + fr) * LDP + 32 * sI + 8 * g), k1 = *(const LAS bf16x8*)(KN + (32 * ks + 16 + fr) * LDP + 32 * sI + 8 * g);
            s0 = __builtin_amdgcn_mfma_f32_16x16x32_bf16(k0, qf[sI], s0, 0, 0, 0); s1 = __builtin_amdgcn_mfma_f32_16x16x32_bf16(k1, qf[sI], s1, 0, 0, 0); }
        unsigned w[4];
#pragma unroll
        for (int r = 0; r < 4; r += 2) {
            const int j0 = 32 * ks + 4 * g + r, j1 = j0 + 1, j2 = j0 + 16, j3 = j2 + 1;
            const float d0 = (float)(i_abs - j0), d1 = (float)(i_abs - j1), d2 = (float)(i_abs - j2), d3 = (float)(i_abs - j3);
            const float m0 = d0 >= 0.f ? exp2f(d0 * lgf2) : exp2f(-d0 * lgb2), m1 = d1 >= 0.f ? exp2f(d1 * lgf2) : exp2f(-d1 * lgb2);
            const float m2 = d2 >= 0.f ? exp2f(d2 * lgf2) : exp2f(-d2 * lgb2), m3 = d3 >= 0.f ? exp2f(d3 * lgf2) : exp2f(-d3 * lgb2);
            w[r >> 1] = cvt_pk_bf16(s0[r] * m0, s0[r + 1] * m1); w[2 + (r >> 1)] = cvt_pk_bf16(s1[r] * m2, s1[r + 1] * m3);
        }
        u32x4 ww; ww.x = w[0]; ww.y = w[1]; ww.z = w[2]; ww.w = w[3]; pf[ks] = __builtin_bit_cast(bf16x8, ww);
    }
    const float qdf = exp2f((float)(i_abs + 1) * lgf2), qdb = exp2f((float)(128 - i_abs) * lgb2);
    f32x4 y[8];
#pragma unroll
    for (int et = 0; et < 8; ++et) {
        f32x4 ai = (f32x4){0.f, 0.f, 0.f, 0.f}, cf = ai, cb = ai;
#pragma unroll
        for (int ks = 0; ks < 4; ++ks) { const LAS bf16* vp = VT + (16 * et + fr) * LDP + 32 * ks + 4 * g; const u32x2 lo = *(const LAS u32x2*)vp, hi = *(const LAS u32x2*)(vp + 16);
            u32x4 av; av.x = lo.x; av.y = lo.y; av.z = hi.x; av.w = hi.y;
            ai = __builtin_amdgcn_mfma_f32_16x16x32_bf16(__builtin_bit_cast(bf16x8, av), pf[ks], ai, 0, 0, 0); }
#pragma unroll
        for (int sI = 0; sI < 4; ++sI) { const bf16x8 sf = *(const LAS bf16x8*)(SF + (16 * et + fr) * LDP + 32 * sI + 8 * g), sb = *(const LAS bf16x8*)(SB + (16 * et + fr) * LDP + 32 * sI + 8 * g);
            cf = __builtin_amdgcn_mfma_f32_16x16x32_bf16(sf, qf[sI], cf, 0, 0, 0); cb = __builtin_amdgcn_mfma_f32_16x16x32_bf16(sb, qf[sI], cb, 0, 0, 0); }
        y[et] = ai + cf * qdf + cb * qdb; asm volatile("" ::: "memory");
    }
    float sm = 0.f;
#pragma unroll
    for (int et = 0; et < 8; ++et) sm += (y[et][0] + y[et][1]) + (y[et][2] + y[et][3]);
    sm += __shfl_xor(sm, 16); sm += __shfl_xor(sm, 32); const float mu = sm * (1.0f / 128.0f);
    float sq = 0.f;
#pragma unroll
    for (int et = 0; et < 8; ++et) { const f32x4 dl = y[et] - mu; sq += (dl[0] * dl[0] + dl[1] * dl[1]) + (dl[2] * dl[2] + dl[3] * dl[3]); }
    sq += __shfl_xor(sq, 16); sq += __shfl_xor(sq, 32); const float rstd = rsqrtf(sq * (1.0f / 128.0f) + EPSN);
#pragma unroll
    for (int et = 0; et < 8; ++et) { const int e = 16 * et + 4 * g; const u32x2 gg = *(const u32x2*)(Gp + (size_t)i_abs * RW + e);
        const f32x4 o = (y[et] - mu) * rstd; u32x2 w2; w2.x = cvt_pk_bf16(o[0] * bf2f(gg.x & 0xffffu), o[1] * bf2f(gg.x >> 16)); w2.y = cvt_pk_bf16(o[2] * bf2f(gg.y & 0xffffu), o[3] * bf2f(gg.y >> 16));
        *(u32x2*)(RS + (size_t)(row0 + i_abs) * D + h * HD + e) = w2; }
    __syncthreads();
}

__device__ __forceinline__ void phase_conv(const Args& a, Frame& F) {
    FR_LANE_TID;
    unsigned char* ws = a.ws; const bf16* GB = (const bf16*)(ws + WS_R1); const bf16* XG = GB + (size_t)NLAT * D; bf16* A1 = (bf16*)(ws + WS_R3);
    const int NT = F.G * 512;
    for (int it = F.blk * 512 + tid_; it < NLAT * 256; it += NT) {
        const int row = it >> 8, c = (it & 255) * 8; const int gc = row & 63;
        const u32x4 x1 = *(const u32x4*)(XG + (size_t)row * D + c), gb = *(const u32x4*)(GB + (size_t)row * D + c);
        u32x4 x0 = (u32x4){0u, 0u, 0u, 0u}, x2 = x0;
        if (gc > 0) x0 = *(const u32x4*)(XG + (size_t)(row - 1) * D + c);
        if (gc < 63) x2 = *(const u32x4*)(XG + (size_t)(row + 1) * D + c);
        float o[8];
#pragma unroll
        for (int i = 0; i < 8; ++i) { const int cc = c + i; const unsigned sh = (i & 1) ? 16u : 0u;
            const float f0 = bf2f((x0[i >> 1] >> sh) & 0xffffu), f1 = bf2f((x1[i >> 1] >> sh) & 0xffffu), f2 = bf2f((x2[i >> 1] >> sh) & 0xffffu), fg = bf2f((gb[i >> 1] >> sh) & 0xffffu);
            o[i] = fg * (a.cv_cb[cc] + a.cv_cw[cc] * f0 + a.cv_cw[D + cc] * f1 + a.cv_cw[2 * D + cc] * f2); }
        u32x4 w; w.x = cvt_pk_bf16(o[0], o[1]); w.y = cvt_pk_bf16(o[2], o[3]); w.z = cvt_pk_bf16(o[4], o[5]); w.w = cvt_pk_bf16(o[6], o[7]);
        *(u32x4*)(A1 + (size_t)row * D + c) = w;
    }
}

__device__ __forceinline__ void phase_route(const Args& a, Frame& F, int L) {
    FR_LANE_TID;
    unsigned char* ws = a.ws; const bf16* XB = (const bf16*)(ws + WS_XB); unsigned char* Fo = ws + WS_A;
    const float* MOD = (const float*)(ws + WS_MOD); const float* WR = (const float*)(ws + WS_WR) + (size_t)L * 20 * D;
    const int nrows = NLAT; const int RPB = (nrows + F.G - 1) / F.G;
    LAS int* rinfo = (LAS int*)(F.lds + MISC_OFF + 4 * MI_RINFO);
    LAS float* rw = (LAS float*)(F.lds + MISC_OFF + 4 * MI_RW);
    volatile LAS unsigned* lcnt = F.MISC + MI_LCNT; volatile LAS unsigned* gbase = F.MISC + MI_GBASE;
    LAS float* WL = (LAS float*)F.lds;
    if (tid_ < 16) lcnt[tid_] = 0u;
    { f32x4 t_[10];
#pragma unroll
      for (int k = 0; k < 10; ++k) t_[k] = *(const f32x4*)(WR + 4 * (size_t)(tid_ + 512 * k));
#pragma unroll
      for (int k = 0; k < 10; ++k) *(LAS f32x4*)(WL + 4 * (tid_ + 512 * k)) = t_[k];
      asm volatile("" ::: "memory");
#pragma unroll
      for (int k = 0; k < 9; ++k) t_[k] = *(const f32x4*)(WR + 4 * (size_t)(tid_ + 512 * (10 + k)));
#pragma unroll
      for (int k = 0; k < 9; ++k) *(LAS f32x4*)(WL + 4 * (tid_ + 512 * (10 + k))) = t_[k];
      asm volatile("" ::: "memory"); }
    __syncthreads();
    f32x4 Gm[8];
    const float* mp0 = MOD + (size_t)(L * 5 + ((F.blk * RPB) >> 12)) * MODW;
    { const float* gf = a.g_ffn + L * D;
#pragma unroll
      for (int j = 0; j < 8; ++j) { const int c = 4 * lane_ + 256 * j; const f32x4 g = *(const f32x4*)(gf + c), sc = *(const f32x4*)(mp0 + 4 * D + c); Gm[j] = g * (sc + 1.0f); } }
    f32x4 vn[8];
    { const int row = F.blk * RPB + F.wave; if (F.wave < RPB && row < nrows) {
#pragma unroll
        for (int j = 0; j < 8; ++j) vn[j] = bf4_to_f32(*(const u32x2*)(XB + (size_t)row * D + 4 * lane_ + 256 * j)); } }
    for (int i = F.wave; i < RPB; i += 8) {
        const int row = F.blk * RPB + i; if (row >= nrows) break;
        int ln4 = 4 * lane_; asm volatile("" : "+v"(ln4));
        f32x4 v[8];
#pragma unroll
        for (int j = 0; j < 8; ++j) v[j] = vn[j];
        if (i + 8 < RPB && row + 8 < nrows) {
#pragma unroll
            for (int j = 0; j < 8; ++j) vn[j] = bf4_to_f32(*(const u32x2*)(XB + (size_t)(row + 8) * D + ln4 + 256 * j)); }
        const float rstd = row_rstd(v);
#pragma unroll
        for (int j = 0; j < 8; ++j) { const int c = ln4 + 256 * j;
            v[j] = v[j] * rstd * Gm[j] + *(const f32x4*)(mp0 + 3 * D + c); *(unsigned*)(Fo + (size_t)row * D + c) = pk4_fp8(v[j][0], v[j][1], v[j][2], v[j][3]); }
        float l1[4] = {0.f, 0.f, 0.f, 0.f};
#pragma unroll
        for (int j = 0; j < 8; ++j)
#pragma unroll
            for (int g = 0; g < 4; ++g) { const f32x4 w = *(const LAS f32x4*)(WL + g * D + ln4 + 256 * j); l1[g] += (v[j][0] * w[0] + v[j][1] * w[1]) + (v[j][2] * w[2] + v[j][3] * w[3]); if (g == 3 && (j & 1)) asm volatile("" ::: "memory"); }
#pragma unroll
        for (int g = 0; g < 4; ++g) l1[g] = wave_sum(l1[g]) + a.b_r1[L * 4 + g];
        int grp = 0; float mx = l1[0];
#pragma unroll
        for (int g = 1; g < 4; ++g) if (l1[g] > mx) { mx = l1[g]; grp = g; }
        grp = __builtin_amdgcn_readfirstlane(grp);
        float den = 0.f;
#pragma unroll
        for (int g = 0; g < 4; ++g) den += expf(l1[g] - mx);
        const float pg = 1.0f / den;
        float l2[4] = {0.f, 0.f, 0.f, 0.f};
#pragma unroll
        for (int j = 0; j < 8; ++j)
#pragma unroll
            for (int e = 0; e < 3; ++e) { const f32x4 w = *(const LAS f32x4*)(WL + (4 + 4 * grp + e) * D + ln4 + 256 * j); l2[e] += (v[j][0] * w[0] + v[j][1] * w[1]) + (v[j][2] * w[2] + v[j][3] * w[3]); if (e == 2 && (j & 1)) asm volatile("" ::: "memory"); }
        if (grp < 3) {
#pragma unroll
            for (int j = 0; j < 8; ++j) { const f32x4 w = *(const LAS f32x4*)(WL + (7 + 4 * grp) * D + ln4 + 256 * j); l2[3] += (v[j][0] * w[0] + v[j][1] * w[1]) + (v[j][2] * w[2] + v[j][3] * w[3]); }
        } else {
#pragma unroll
            for (int j = 0; j < 8; ++j) { const f32x4 w = *(const f32x4*)(WR + (size_t)19 * D + ln4 + 256 * j); l2[3] += (v[j][0] * w[0] + v[j][1] * w[1]) + (v[j][2] * w[2] + v[j][3] * w[3]); }
        }
#pragma unroll
        for (int e = 0; e < 4; ++e) l2[e] = wave_sum(l2[e]) + a.b_r2[(L * 4 + grp) * 4 + e];
        int i0 = 0; float v0 = l2[0];
#pragma unroll
        for (int e = 1; e < 4; ++e) if (l2[e] > v0) { v0 = l2[e]; i0 = e; }
        int i1 = -1; float v1 = -3.0e38f;
#pragma unroll
        for (int e = 0; e < 4; ++e) if (e != i0 && l2[e] > v1) { v1 = l2[e]; i1 = e; }
        const float ex = expf(v1 - v0); const float w0 = pg / (1.0f + ex), w1 = pg * ex / (1.0f + ex);
        if (lane_ == 0) { const int e0 = grp * 4 + i0, e1 = grp * 4 + i1;
            const int li0 = (int)__hip_atomic_fetch_add((LAS unsigned*)&lcnt[e0], 1u, __ATOMIC_RELAXED, __HIP_MEMORY_SCOPE_WORKGROUP);
            const int li1 = (int)__hip_atomic_fetch_add((LAS unsigned*)&lcnt[e1], 1u, __ATOMIC_RELAXED, __HIP_MEMORY_SCOPE_WORKGROUP);
            rinfo[4 * i] = e0; rinfo[4 * i + 1] = li0; rinfo[4 * i + 2] = e1; rinfo[4 * i + 3] = li1; rw[2 * i] = w0; rw[2 * i + 1] = w1; }
    }
    __syncthreads();
    if (tid_ < 16) gbase[tid_] = xb_add((unsigned*)(ws + WS_CTL) + CW_CNT + (L * 16 + tid_) * 64, lcnt[tid_]);
    __syncthreads();
    int* RIDX = (int*)(ws + WS_RIDX) + (size_t)L * NTOK * 4; float* RWT = (float*)(ws + WS_RWT) + (size_t)L * NTOK * 2;
    for (int i = tid_; i < RPB; i += 512) { const int row = F.blk * RPB + i; if (row < nrows) {
        const int e0 = rinfo[4 * i], e1 = rinfo[4 * i + 2];
        i32x4 o; o.x = e0; o.y = (int)gbase[e0] + rinfo[4 * i + 1]; o.z = e1; o.w = (int)gbase[e1] + rinfo[4 * i + 3]; *(i32x4*)(RIDX + 4 * (size_t)row) = o;
        f32x2 w; w.x = rw[2 * i]; w.y = rw[2 * i + 1]; *(f32x2*)(RWT + 2 * (size_t)row) = w;
        int* GI = (int*)(ws + WS_GIDX) + (size_t)L * NE * NTOK; GI[(size_t)e0 * NTOK + o.y] = row; GI[(size_t)e1 * NTOK + o.w] = row; } }
    __syncthreads();
}
__device__ __forceinline__ void phase_final(const Args& a, Frame& F, int Lc  ) {
    FR_LANE_TID;
    unsigned char* ws = a.ws; const bf16* XB = (const bf16*)(ws + WS_XB); const float* MOD = (const float*)(ws + WS_MOD);
    if (Lc < 0) {
        const int gw = F.blk * 8 + F.wave, NGW = F.G * 8;
        for (int row = gw; row < NLAT; row += NGW) { f32x4 v[8];
#pragma unroll
            for (int j = 0; j < 8; ++j) v[j] = bf4_to_f32(*(const u32x2*)(XB + (size_t)row * D + 4 * lane_ + 256 * j));
            const float rstd = row_rstd(v);
#pragma unroll
            for (int j = 0; j < 8; ++j) { const int c = 4 * lane_ + 256 * j; *(f32x4*)(a.out + (size_t)row * D + c) = v[j] * rstd * *(const f32x4*)(a.g_final + c); } }
        return;
    }
    (void)moe_tables(a, F, Lc);
    const volatile LAS int* tb = (const volatile LAS int*)(F.MISC + MI_TB);
    const int RPB = NLAT / F.G, r = (F.blk * RPB) >> 12;
    const bf16* Y = (const bf16*)(ws + WS_R2); const int* ridx = (const int*)(ws + WS_RIDX) + (size_t)Lc * NTOK * 4; const float* rwt = (const float*)(ws + WS_RWT) + (size_t)Lc * NTOK * 2;
    f32x4 gate[8], Gf[8];
#pragma unroll
    for (int j = 0; j < 8; ++j) { const int c = 4 * lane_ + 256 * j; gate[j] = *(const f32x4*)(MOD + (size_t)(Lc * 5 + r) * MODW + 5 * D + c); Gf[j] = *(const f32x4*)(a.g_final + c); }
    RowBuf bA, bB;
    if (F.wave < RPB) rowbuf_issue(bA, XB, Y, ridx, rwt, tb, F.blk * RPB + F.wave, 4 * lane_);
    for (int i = F.wave; i < RPB; i += 16) {
        int ln4 = 4 * lane_; asm volatile("" : "+v"(ln4));
        const int row = F.blk * RPB + i;
        if (i + 8 < RPB) rowbuf_issue(bB, XB, Y, ridx, rwt, tb, row + 8, ln4);
        { f32x4 v[8]; rowbuf_combine(bA, gate, v); const float rstd = row_rstd(v);
#pragma unroll
          for (int j = 0; j < 8; ++j) *(f32x4*)(a.out + (size_t)row * D + ln4 + 256 * j) = v[j] * rstd * Gf[j]; }
        if (i + 8 >= RPB) break;
        if (i + 16 < RPB) rowbuf_issue(bA, XB, Y, ridx, rwt, tb, row + 16, ln4);
        { f32x4 v[8]; rowbuf_combine(bB, gate, v); const float rstd = row_rstd(v);
#pragma unroll
          for (int j = 0; j < 8; ++j) *(f32x4*)(a.out + (size_t)(row + 8) * D + ln4 + 256 * j) = v[j] * rstd * Gf[j]; }
    }
}

__global__ void __launch_bounds__(512, 2) fwd_kernel(Args a) {
    extern __shared__ __attribute__((aligned(16))) unsigned char lds_raw[];
    Frame F; F.lds = (LAS unsigned char*)lds_raw; F.MISC = (volatile LAS unsigned*)(F.lds + MISC_OFF);
    F.wave = __builtin_amdgcn_readfirstlane((int)threadIdx.x >> 6); F.G = gridDim.x; F.blk = blockIdx.x;
    unsigned char* ws = a.ws;
    F.MISC[threadIdx.x] = 0u; F.MISC[threadIdx.x + 512] = 0u;
    __syncthreads();
#if MK_SPLIT
    #define GRID_BAR() do { } while (0)
#else
    XcdBarrier bar = xcd_barrier_post((unsigned*)(ws + WS_CTL) + CW_BAR, F.MISC);
    #define GRID_BAR() xcd_barrier(bar)
#endif
    const int lo = a.ph_lo, hi = a.ph_hi;
    unsigned long long pr_acc = 0ull, pr_t0 = 0ull;
#define IN(k) (lo <= (k) && (k) < hi && ((((PROBE_MASK) >> (k)) & 1u) ? (pr_t0 = __builtin_amdgcn_s_memrealtime(), true) : true))
#define SEAM(k) do { if (lo <= (k) + 1 && (k) + 1 < hi) GRID_BAR(); if (((PROBE_MASK) >> (k)) & 1u) pr_acc += __builtin_amdgcn_s_memrealtime() - pr_t0; } while (0)

    if (IN(PH_PRO)) { phase_prologue(a, F); SEAM(PH_PRO); }
#define RUN_LAYER(L) do { \
        constexpr int P = PH_L0 + (L) * PH_PER_LAYER; \
        constexpr int nM = NLAT / 256;        \
        if (IN(P + K_PRE)) { phase_pre(a, F, (L)); SEAM(P + K_PRE); } \
        if (DBG_STOP == 1) break; \
        if (IN(P + K_GIN)) { \
            if ((L) == 0) { pg8::Gemm g{(const bf16*)(ws + WS_A), (const bf16*)(ws + WS_WAB_IN), D}; pg8::StaticOrder S; S.init(nM, 24, F.G, F.blk); \
                pg8::EpiAB E{(bf16*)(ws + WS_R1), (const float*)(ws + WS_ROPE)}; pg8::gemm_phase<pg8::EpiAB, pg8::StaticOrder, true, true>(F.lds, F.wave, g, S, E); } \
            else { pg8::Gemm g{(const bf16*)(ws + WS_A), (const bf16*)(ws + WS_WCV_IN), D}; pg8::StaticOrder S; S.init(nM, 24, F.G, F.blk); \
                pg8::EpiCV E{(bf16*)(ws + WS_R1), (bf16*)(ws + WS_R1) + (size_t)NLAT * D}; pg8::gemm_phase<pg8::EpiCV, pg8::StaticOrder, true, true>(F.lds, F.wave, g, S, E); } \
            SEAM(P + K_GIN); \
        } \
        if (IN(P + K_MID1)) { \
            if ((L) == 0) { \
                { pg8::Gemm g{(const bf16*)(ws + WS_A), (const bf16*)(ws + WS_WAB_IN), D}; pg8::CtxKvOrder S; S.c = F.blk; \
                  pg8::EpiAB E{(bf16*)(ws + WS_R1), (const float*)(ws + WS_ROPE)}; pg8::gemm_phase<pg8::EpiAB, pg8::CtxKvOrder, true, true>(F.lds, F.wave, g, S, E); } \
                  \
                for (;;) { __syncthreads(); if (threadIdx.x == 0) F.MISC[4] = xb_add((unsigned*)(ws + WS_CTL) + CW_Q, 1u); __syncthreads(); const int v_ = (int)F.MISC[4]; if (v_ >= 2048) break; \
                    if (v_ < 1024) ret_u_unit(a, F, (v_ >> 5) * NSLOT + 2 + (v_ & 31)); else sgu_unit(a, F, ((v_ - 1024) >> 5) * NSLOT + 2 + (v_ & 31)); } \
            } else phase_conv(a, F); \
            SEAM(P + K_MID1); \
        } \
        if ((L) == 0) { \
            if (IN(P + K_MID1B)) { for (int i_ = F.blk; i_ < 64; i_ += F.G) ret_u_unit(a, F, (i_ >> 1) * NSLOT + (i_ & 1)); SEAM(P + K_MID1B); } \
            if (IN(P + K_MID2)) { phase_scan(a, F); SEAM(P + K_MID2); } \
            if (IN(P + K_MID3)) { for (int v_ = F.blk; v_ < 1024; v_ += F.G) ret_y_unit(a, F, (v_ >> 5) * NSLOT + 2 + (v_ & 31)); SEAM(P + K_MID3); } \
        } \
        if (IN(P + K_GOUT)) { \
            pg8::Gemm g{(const bf16*)(ws + WS_R3), (const bf16*)(ws + ((L) == 0 ? WS_WAB_OUT : WS_WCV_OUT)), D}; pg8::StaticOrder S; S.init(nM, 8, F.G, F.blk); \
            pg8::EpiRes E{(bf16*)(ws + WS_XB), (L) == 0 ? a.x : (const float*)nullptr, (const float*)(ws + WS_MOD) + (size_t)(L) * 5 * MODW + 2 * D}; \
            pg8::gemm_phase<pg8::EpiRes, pg8::StaticOrder, true, true>(F.lds, F.wave, g, S, E); \
            SEAM(P + K_GOUT); \
        } \
        if (DBG_STOP == 2 || (DBG_STOP == 4 && (L) == 1)) break; \
        if (IN(P + K_ROUTE)) { phase_route(a, F, (L)); SEAM(P + K_ROUTE); } \
        if (IN(P + K_MOE1)) { \
            const int TT = moe_tables(a, F, (L)); \
            pg8::Gemm g{(const bf16*)(ws + WS_A), (const bf16*)(ws + WS_W13 + (size_t)(L) * NE * D * D), D / 2}; \
            pg8::MoeOrder S; S.init(TT, 8, F.G, F.blk); S.texp = (const volatile LAS int*)(F.MISC + MI_TEXP); S.bstride = (long)D * D; \
            { FR_LANE_TID; LAS int* idxbuf = (LAS int*)(F.lds + 131072); const volatile LAS int* tb_ = (const volatile LAS int*)(F.MISC + MI_TB); const volatile LAS int* cn_ = (const volatile LAS int*)(F.MISC + MI_LCNT); \
              const int* GI = (const int*)(ws + WS_GIDX) + (size_t)(L) * NE * NTOK; \
              for (int i_ = 0; i_ < 16; ++i_) { pg8::Unit u_; if (!S.next(i_, u_)) break; const int e_ = S.texp[u_.pm]; const int idx_ = (u_.pm - tb_[e_]) * 256 + tid_; \
                  if (tid_ < 256) idxbuf[i_ * 256 + tid_] = idx_ < cn_[e_] ? GI[(size_t)e_ * NTOK + idx_] : 0; } \
              __syncthreads(); } \
            pg8::EpiMoe1 E{ws + WS_R3}; pg8::gemm_phase<pg8::EpiMoe1, pg8::MoeOrder, true, true, true, true>(F.lds, F.wave, g, S, E, (const LAS int*)(F.lds + 131072)); \
            SEAM(P + K_MOE1); \
        } \
        if (IN(P + K_MOE2)) { \
            const int TT = moe_tables(a, F, (L)); \
            pg8::Gemm g{(const bf16*)(ws + WS_R3), (const bf16*)(ws + WS_W2 + (size_t)(L) * NE * D * DE), DE / 2}; \
            pg8::MoeOrder S; S.init(TT, 8, F.G, F.blk); S.texp = (const volatile LAS int*)(F.MISC + MI_TEXP); S.bstride = (long)D * DE; \
            pg8::EpiMoe2 E{(bf16*)(ws + WS_R2)}; pg8::gemm_phase<pg8::EpiMoe2, pg8::MoeOrder, true, true, true>(F.lds, F.wave, g, S, E); \
            SEAM(P + K_MOE2); \
        } \
    } while (0)
    RUN_LAYER(0);
    if (DBG_STOP == 0 || DBG_STOP == 4) RUN_LAYER(1);
    if (IN(PH_FINAL)) phase_final(a, F, DBG_STOP == 0 ? 1 : (DBG_STOP == 3 ? 0 : -1));
#undef IN
#undef SEAM
    if ((PROBE_MASK) != 0u && F.blk == 0 && threadIdx.x == 0) { const unsigned long long t1 = __builtin_amdgcn_s_memrealtime(); while (__builtin_amdgcn_s_memrealtime() - t1 < (unsigned long long)(PROBE_MULT) * pr_acc) __builtin_amdgcn_s_sleep(8); }
}

extern "C" void kernel_launch(void* const* d_in, const int* in_sizes, int n_in, void* d_out, int out_size, void* d_ws, size_t ws_size, hipStream_t stream) {
    static int grid = 0;
    if (grid == 0) {
        if (n_in != 25 || in_sizes[0] != NLAT * D || out_size != NLAT * D || ws_size < WS_END) { fprintf(stderr, "kernel_launch: unexpected shapes (n_in %d, in0 %d, out %d, ws %zu)\n", n_in, n_in > 0 ? in_sizes[0] : -1, out_size, ws_size); grid = -1; return; }
        int dev = 0, cus = 0, per_cu = 0;
        if (hipGetDevice(&dev) != hipSuccess || hipDeviceGetAttribute(&cus, hipDeviceAttributeMultiprocessorCount, dev) != hipSuccess) { grid = -1; return; }
        if (hipFuncSetAttribute((const void*)fwd_kernel, hipFuncAttributeMaxDynamicSharedMemorySize, LDS_BYTES) != hipSuccess) { fprintf(stderr, "kernel_launch: hipFuncSetAttribute failed\n"); grid = -1; return; }
        if (hipOccupancyMaxActiveBlocksPerMultiprocessor(&per_cu, (const void*)fwd_kernel, 512, LDS_BYTES) != hipSuccess || per_cu < 1) fprintf(stderr, "kernel_launch: occupancy query reports %d\n", per_cu);
        (void)hipGetLastError();
        grid = cus;
    }
    if (grid < 0) return;
    (void)hipMemsetAsync((char*)d_ws + WS_CTL, 0, CTL_BYTES, stream);
    Args a{};
    const float** f = (const float**)&a;
    for (int i = 0; i < 25; ++i) f[i] = (const float*)d_in[i];
    a.out = (float*)d_out; a.ws = (unsigned char*)d_ws;
#if MK_SPLIT
    for (int ph = 0; ph < NPHASE; ++ph) { a.ph_lo = ph; a.ph_hi = ph + 1; hipLaunchKernelGGL(fwd_kernel, dim3(grid), dim3(512), LDS_BYTES, stream, a); }
#else
    a.ph_lo = 0; a.ph_hi = NPHASE; hipLaunchKernelGGL(fwd_kernel, dim3(grid), dim3(512), LDS_BYTES, stream, a);
#endif
}
```

```cpp
#include <hip/hip_runtime.h>
#include <cstdio>
#include <cstdint>

#ifndef MK_SPLIT
#define MK_SPLIT 0
#endif
#ifndef PROBE_MASK
#define PROBE_MASK 0u
#endif
#ifndef PROBE_MULT
#define PROBE_MULT 4
#endif
#ifndef DBG_STOP
#define DBG_STOP 0
#endif

#define LAS __attribute__((address_space(3)))
#define GAS __attribute__((address_space(1)))
typedef unsigned short bf16;
typedef short bf16x8 __attribute__((ext_vector_type(8)));
typedef short s16x4 __attribute__((ext_vector_type(4)));
typedef float f32x4 __attribute__((ext_vector_type(4)));
typedef float f32x2 __attribute__((ext_vector_type(2)));
typedef unsigned u32x4 __attribute__((ext_vector_type(4)));
typedef unsigned u32x2 __attribute__((ext_vector_type(2)));
typedef int i32x4 __attribute__((ext_vector_type(4)));
typedef int i32x8 __attribute__((ext_vector_type(8)));
typedef int i32x2 __attribute__((ext_vector_type(2)));

constexpr int D = 2048, NB = 4, TL = 4096, TCX = 256;
constexpr int NLAT = NB * TL;
constexpr int NCTX = NB * TCX;
constexpr int NTOK = NLAT + NCTX;
constexpr int HD = 128, NH = 8, RW = 1024;
constexpr int NSLOT = 34;
constexpr int NUNIT = NB * NH * NSLOT;
constexpr int DE = 1024, NE = 16;
constexpr int PCAP = 2 * NTOK + NE * 256;
constexpr float EPSN = 1e-6f;
constexpr float QK_SCALE = 0.08838834764831845f;
constexpr int MODW = 6 * D;

constexpr size_t MiB = 1u << 20;
constexpr size_t WS_CTL = 0, CTL_BYTES = 1 * MiB;
constexpr size_t WS_MOD = 1 * MiB;
constexpr size_t WS_ROPE = 1 * MiB + 512 * 1024;
constexpr size_t WS_WR = 2 * MiB;
constexpr size_t WS_RIDX = 3 * MiB;
constexpr size_t WS_RWT = 4 * MiB;
constexpr size_t WS_GIDX = 5 * MiB;
constexpr size_t WS_WAB_IN = 8 * MiB, WS_WAB_OUT = 32 * MiB, WS_WCV_IN = 40 * MiB, WS_WCV_OUT = 64 * MiB;
constexpr size_t WS_W13 = 72 * MiB;
constexpr size_t WS_W2 = 328 * MiB;
constexpr size_t WS_XB = 456 * MiB;
constexpr size_t WS_A = 592 * MiB;
constexpr size_t WS_R1 = 660 * MiB;
constexpr size_t WS_R2 = 864 * MiB;
constexpr size_t WS_R3 = 1016 * MiB;
constexpr size_t WS_END = 1092 * MiB;
constexpr size_t ZSEC = (size_t)NTOK * 1024;
constexpr int CW_BAR = 4096;
constexpr int CW_Q = 2048;
constexpr int CW_CNT = 8192;

constexpr int SCR_BYTES = 155648;
constexpr int MISC_OFF = SCR_BYTES;
constexpr int LDS_BYTES = SCR_BYTES + 4096;
constexpr int MI_LCNT = 16, MI_GBASE = 32, MI_TB = 64, MI_TEXP = 96, MI_RINFO = 256, MI_RW = 768;

__device__ __forceinline__ unsigned cvt_pk_bf16(float lo, float hi) { unsigned r; asm("v_cvt_pk_bf16_f32 %0, %1, %2" : "=v"(r) : "v"(lo), "v"(hi)); return r; }
__device__ __forceinline__ int lane_id() { int l; asm volatile("v_mbcnt_lo_u32_b32 %0, -1, 0\n\tv_mbcnt_hi_u32_b32 %0, -1, %0" : "=v"(l)); return l; }
__device__ __forceinline__ float bf2f(unsigned b) { return __uint_as_float(b << 16); }
template <int CTRL> __device__ __forceinline__ float dpp_mov(float v) { return __int_as_float(__builtin_amdgcn_update_dpp(0, __float_as_int(v), CTRL, 0xf, 0xf, false)); }
__device__ __forceinline__ float wave_sum(float v) {
    v += dpp_mov<0xB1>(v); v += dpp_mov<0x4E>(v); v += dpp_mov<0x141>(v); v += dpp_mov<0x140>(v);
    return ((__int_as_float(__builtin_amdgcn_readlane(__float_as_int(v), 0)) + __int_as_float(__builtin_amdgcn_readlane(__float_as_int(v), 16))) +
           (__int_as_float(__builtin_amdgcn_readlane(__float_as_int(v), 32)) + __int_as_float(__builtin_amdgcn_readlane(__float_as_int(v), 48))));
}
__device__ __forceinline__ float silu_f(float x) { return x / (1.0f + __expf(-x)); }
__device__ __forceinline__ float gelu_tanh_f(float x) { const float z = 1.5957691216057308f * (x + 0.044715f * x * x * x); return x / (1.0f + __expf(-z)); }
__device__ __forceinline__ u32x4 pack8(f32x4 a, f32x4 b) { u32x4 w; w.x = cvt_pk_bf16(a[0], a[1]); w.y = cvt_pk_bf16(a[2], a[3]); w.z = cvt_pk_bf16(b[0], b[1]); w.w = cvt_pk_bf16(b[2], b[3]); return w; }
__device__ __forceinline__ unsigned pk4_fp8(float a, float b, float c, float d) { int w = 0; w = __builtin_amdgcn_cvt_pk_fp8_f32(a, b, w, false); w = __builtin_amdgcn_cvt_pk_fp8_f32(c, d, w, true); return (unsigned)w; }
__device__ __forceinline__ u32x2 pack8_fp8(f32x4 a, f32x4 b) { u32x2 w; w.x = pk4_fp8(a[0], a[1], a[2], a[3]); w.y = pk4_fp8(b[0], b[1], b[2], b[3]); return w; }
#define W8_SCALE 64.0f
#define SCALE_W8 0x79797979
#define SCALE_ONE 0x7f7f7f7f
__device__ __forceinline__ f32x4 bf4_to_f32(u32x2 p) { return (f32x4){bf2f(p.x & 0xffffu), bf2f(p.x >> 16), bf2f(p.y & 0xffffu), bf2f(p.y >> 16)}; }
__device__ __forceinline__ u32x2 f32_to_bf4(f32x4 v) { u32x2 p; p.x = cvt_pk_bf16(v[0], v[1]); p.y = cvt_pk_bf16(v[2], v[3]); return p; }
__device__ __forceinline__ float logsig(float x) { return -log1pf(expf(-x)); }
#define LOG2E 1.4426950408889634f

namespace pg8 {
constexpr int BM = 256, BK = 64, HALF = 128, HTB = HALF * BK * 2, STAGE_BYTES = 8 * HTB, NXCD = 8, WGM = 8;
__host__ __device__ __forceinline__ int lds_byte(int r, int c) { const int st = (r >> 4) * 2 + (c >> 5), rr = r & 15, cc = c & 31, ob = rr * 64 + cc * 2; return st * 1024 + (ob ^ (((ob >> 9) & 1) << 5)); }
__host__ __device__ __forceinline__ void stage_rc(int b, int& R, int& C) { const int st = b / 1024, sb = b % 1024, swz = sb ^ (((sb >> 9) & 1) << 5); R = (st >> 1) * 16 + swz / 64; C = (st & 1) * 32 + (swz % 64) / 2; }

struct Unit { int pm, pn; long boff; };
struct Gemm { const bf16* A; const bf16* Bt; int K; };

struct StaticOrder {
    int nM, nN, nwg, G, c;
    __device__ __forceinline__ void init(int nM_, int nN_, int G_, int c_) { nM = nM_; nN = nN_; nwg = nM * nN; G = G_; c = c_; }
    __device__ __forceinline__ bool map(int i, int& pm, int& pn) const {
        const long L = (long)i * G + c; if (L >= nwg) return false;
        int wgid = (int)L; { const int q = nwg / NXCD, r = nwg % NXCD, xcd = wgid % NXCD, off = wgid / NXCD; wgid = (xcd < r ? xcd * (q + 1) : r * (q + 1) + (xcd - r) * q) + off; }
        const int nig = WGM * nN, gid = wgid / nig, fm = gid * WGM, gsz = (nM - fm) < WGM ? (nM - fm) : WGM;
        pm = fm + ((wgid % nig) % gsz); pn = (wgid % nig) / gsz; return true;
    }
    __device__ __forceinline__ bool next(int i, Unit& u) const { u.boff = 0; return map(i, u.pm, u.pn); }
};
struct CtxKvOrder {
    int c;
    __device__ __forceinline__ bool next(int i, Unit& u) const { if (i != 0 || c >= 32) return false; u.pm = 64 + (c >> 3); u.pn = 4 + (c & 7); u.boff = 0; return true; }
};
struct MoeOrder : StaticOrder {
    const volatile LAS int* texp; long bstride;
    __device__ __forceinline__ bool next(int i, Unit& u) const { if (!map(i, u.pm, u.pn)) return false; u.boff = (long)texp[u.pm] * bstride; return true; }
};

template <class Epi, class Sched, bool ALIGN_EPI, bool SP2, bool FP8 = false, bool GATHER = false>
__device__ __forceinline__ void gemm_phase(LAS unsigned char* lds, const int wid, const Gemm g, const Sched& S, const Epi& E, const LAS int* gidx = nullptr) {
    static_assert(!GATHER || SP2, "row-gathered A operand: SP2 loop only");
    const int lane = lane_id(), tid = wid * 64 + lane, wr = wid >> 2, wc = wid & 3, fr = lane & 15, fq = lane >> 4;
    const int K = g.K, nt = K / BK;
    unsigned voffA[2];
#pragma unroll
    for (int i = 0; i < 2; ++i) { int R, C; stage_rc(tid * 16 + i * 8192, R, C); voffA[i] = (unsigned)(R * K + C) * 2u; }
    const size_t kstep = (size_t)(BK * 2);
    const size_t hstep = (size_t)HALF * K * 2;
    const size_t tstep = 2 * hstep;
    const unsigned ldsw = (unsigned)wid * 1024u;
    const int aoff = lds_byte(wr * 64 + fr, fq * 8), boff = lds_byte(wc * 32 + fr, fq * 8);
#define PG8_SA(b, h) (((b) * 2 + (h)) * HTB)
#define PG8_SB(b, h) ((4 + (b) * 2 + (h)) * HTB)
#define PG8_STAGE(bufoff, gbase) do { _Pragma("unroll") for (int _i = 0; _i < 2; ++_i) \
        __builtin_amdgcn_global_load_lds((const unsigned*)((const char*)(gbase) + voffA[_i]), (LAS unsigned*)(lds + (bufoff) + ldsw + _i * 8192), 16, 0, 0); } while (0)
#define PG8_STAGEA(bufoff, ptr, kq, h, useN) do { if constexpr (GATHER) { _Pragma("unroll") for (int _i = 0; _i < 2; ++_i) \
        __builtin_amdgcn_global_load_lds((const unsigned*)(gA + (kq) + ((useN) ? oN[h][_i] : oC[h][_i])), (LAS unsigned*)(lds + (bufoff) + ldsw + _i * 8192), 16, 0, 0); } \
        else { PG8_STAGE(bufoff, ptr); } } while (0)
#define PG8_OFFS(o, uidx) do { _Pragma("unroll") for (int _h = 0; _h < 2; ++_h) _Pragma("unroll") for (int _i = 0; _i < 2; ++_i) { int R_, C_; stage_rc(tid * 16 + _i * 8192, R_, C_); \
        o[_h][_i] = (unsigned)gidx[(uidx) * 256 + _h * HALF + R_] * (unsigned)(K * 2) + (unsigned)(C_ * 2); } } while (0)
#define PG8_CAT(lo, hi) __builtin_shufflevector(lo, hi, 0, 1, 2, 3, 4, 5, 6, 7)
#define PG8_LDA(dst, b, h) do { _Pragma("unroll") for (int m = 0; m < 4; ++m) dst[m] = PG8_CAT(*(const LAS i32x4*)(lds + PG8_SA(b, h) + aoff + m * 2048), *(const LAS i32x4*)(lds + PG8_SA(b, h) + aoff + m * 2048 + 1024)); } while (0)
#define PG8_LDB(dst, b, h) do { _Pragma("unroll") for (int n = 0; n < 2; ++n) dst[n] = PG8_CAT(*(const LAS i32x4*)(lds + PG8_SB(b, h) + boff + n * 2048), *(const LAS i32x4*)(lds + PG8_SB(b, h) + boff + n * 2048 + 1024)); } while (0)
#define PG8_LO(x) __builtin_bit_cast(bf16x8, __builtin_shufflevector(x, x, 0, 1, 2, 3))
#define PG8_HI(x) __builtin_bit_cast(bf16x8, __builtin_shufflevector(x, x, 4, 5, 6, 7))
#define PG8_MMA(ai, bj, At, Bt) do { __builtin_amdgcn_s_setprio(1); \
        if constexpr (FP8) { _Pragma("unroll") for (int m = 0; m < 4; ++m) _Pragma("unroll") for (int n = 0; n < 2; ++n) \
            asm volatile("v_mfma_scale_f32_16x16x128_f8f6f4 %0, %1, %2, %0, %3, %4 op_sel_hi:[0,0,0]" : "+v"(acc[ai][bj][m][n]) : "v"(Bt[n]), "v"(At[m]), "v"(scw), "v"(sca)); } \
        else { _Pragma("unroll") for (int m = 0; m < 4; ++m) _Pragma("unroll") for (int n = 0; n < 2; ++n) { \
            acc[ai][bj][m][n] = __builtin_amdgcn_mfma_f32_16x16x32_bf16(PG8_LO(Bt[n]), PG8_LO(At[m]), acc[ai][bj][m][n], 0, 0, 0); \
            acc[ai][bj][m][n] = __builtin_amdgcn_mfma_f32_16x16x32_bf16(PG8_HI(Bt[n]), PG8_HI(At[m]), acc[ai][bj][m][n], 0, 0, 0); } } \
        __builtin_amdgcn_s_setprio(0); } while (0)
#define PG8_WAIT_V(n) asm volatile("s_waitcnt vmcnt(" #n ")" ::: "memory")
#define PG8_WAIT_L(n) asm volatile("s_waitcnt lgkmcnt(" #n ")" ::: "memory")
#define PG8_BAR __builtin_amdgcn_s_barrier()
#define PG8_SCHED __builtin_amdgcn_sched_barrier(0)
    Unit cur, nxt; int ui = 0;
    if (!S.next(0, cur)) return;
    int scw = SCALE_W8, sca = SCALE_ONE; if constexpr (FP8) asm volatile("" : "+v"(scw), "+v"(sca));
    f32x4 acc[2][2][4][2];
#pragma unroll
    for (int a = 0; a < 2; ++a)
#pragma unroll
        for (int b = 0; b < 2; ++b)
#pragma unroll
            for (int m = 0; m < 4; ++m)
#pragma unroll
                for (int n = 0; n < 2; ++n) acc[a][b][m][n] = (f32x4){0.f, 0.f, 0.f, 0.f};
    i32x8 At[4], B0[2], B1[2];
    const char* cA = (const char*)g.A + (size_t)cur.pm * tstep; const char* cB = (const char*)g.Bt + cur.boff + (size_t)cur.pn * tstep;
    const char* const gA = (const char*)g.A; unsigned oC[2][2], oN[2][2];
    if constexpr (GATHER) { PG8_OFFS(oC, 0);
#pragma unroll
        for (int h = 0; h < 2; ++h) { oN[h][0] = oC[h][0]; oN[h][1] = oC[h][1]; } }
    if constexpr (SP2) {
        PG8_STAGE(PG8_SB(0, 0), cB); PG8_STAGE(PG8_SB(0, 1), cB + hstep); PG8_STAGEA(PG8_SA(0, 0), cA, (size_t)0, 0, false); PG8_STAGEA(PG8_SA(0, 1), cA + hstep, (size_t)0, 1, false);
        if (wr == 1) PG8_BAR;
        PG8_WAIT_V(2); PG8_BAR;
        PG8_STAGE(PG8_SB(1, 0), cB + kstep); PG8_STAGEA(PG8_SA(1, 0), cA + kstep, kstep, 0, false); PG8_STAGE(PG8_SB(1, 1), cB + hstep + kstep);
        PG8_WAIT_V(6); PG8_BAR;
    } else {
        PG8_STAGE(PG8_SB(0, 0), cB); PG8_STAGE(PG8_SA(0, 0), cA); PG8_STAGE(PG8_SB(0, 1), cB + hstep); PG8_STAGE(PG8_SA(0, 1), cA + hstep);
        if (wr == 1) PG8_BAR;
        PG8_WAIT_V(4); PG8_BAR;
        PG8_STAGE(PG8_SB(1, 0), cB + kstep); PG8_STAGE(PG8_SA(1, 0), cA + kstep); PG8_STAGE(PG8_SB(1, 1), cB + hstep + kstep);
        PG8_WAIT_V(6); PG8_BAR;
    }
    for (;;) {
        const bool has_next = S.next(ui + 1, nxt);
        const char* nA = has_next ? (const char*)g.A + (size_t)nxt.pm * tstep : cA; const char* nB = has_next ? (const char*)g.Bt + nxt.boff + (size_t)nxt.pn * tstep : cB;
        if constexpr (GATHER) { if (has_next) PG8_OFFS(oN, ui + 1); }
#pragma unroll 1
        for (int t = 0; t < nt; t += 2) {
            const bool last = (t == nt - 2);
            const char* a1 = cA + (size_t)(t + 1) * kstep;
            const char* a2 = last ? nA : cA + (size_t)(t + 2) * kstep; const char* b2 = last ? nB : cB + (size_t)(t + 2) * kstep;
            const char* a3 = a2 + kstep; const char* b3 = b2 + kstep;
            const size_t kq1 = (size_t)(t + 1) * kstep, kq2 = last ? (size_t)0 : (size_t)(t + 2) * kstep, kq3 = kq2 + kstep;
            if constexpr (SP2) {
            PG8_LDB(B0, 0, 0); PG8_LDB(B1, 0, 1); PG8_SCHED; PG8_LDA(At, 0, 0); PG8_STAGEA(PG8_SA(1, 1), a1 + hstep, kq1, 1, false);
            PG8_WAIT_V(8); PG8_WAIT_L(0); PG8_BAR; PG8_MMA(0, 0, At, B0); PG8_MMA(0, 1, At, B1); PG8_BAR; PG8_SCHED;
            PG8_LDA(At, 0, 1); PG8_STAGE(PG8_SB(0, 0), b2); PG8_STAGE(PG8_SB(0, 1), b2 + hstep); PG8_STAGEA(PG8_SA(0, 0), a2, kq2, 0, last);
            PG8_WAIT_V(8); PG8_WAIT_L(0); PG8_BAR; PG8_MMA(1, 0, At, B0); PG8_MMA(1, 1, At, B1); PG8_BAR; PG8_SCHED;
            PG8_LDB(B0, 1, 0); PG8_LDB(B1, 1, 1); PG8_SCHED; PG8_LDA(At, 1, 0); PG8_STAGEA(PG8_SA(0, 1), a2 + hstep, kq2, 1, last);
            PG8_WAIT_V(8); PG8_WAIT_L(0); PG8_BAR; PG8_MMA(0, 0, At, B0); PG8_MMA(0, 1, At, B1); PG8_BAR; PG8_SCHED;
            PG8_LDA(At, 1, 1); PG8_STAGE(PG8_SB(1, 0), b3); PG8_STAGE(PG8_SB(1, 1), b3 + hstep); PG8_STAGEA(PG8_SA(1, 0), a3, kq3, 0, last);
            PG8_WAIT_V(8); PG8_WAIT_L(0); PG8_BAR; PG8_MMA(1, 0, At, B0); PG8_MMA(1, 1, At, B1); PG8_BAR; PG8_SCHED;
            } else {
            PG8_LDB(B0, 0, 0); PG8_SCHED; PG8_LDA(At, 0, 0); PG8_STAGE(PG8_SA(1, 1), a1 + hstep);
            PG8_WAIT_L(8); PG8_BAR; PG8_WAIT_L(0); PG8_MMA(0, 0, At, B0); PG8_BAR; PG8_SCHED;
            PG8_LDB(B1, 0, 1); PG8_STAGE(PG8_SB(0, 0), b2);
            PG8_BAR; PG8_WAIT_L(0); PG8_MMA(0, 1, At, B1); PG8_BAR;
            PG8_LDA(At, 0, 1); PG8_STAGE(PG8_SA(0, 0), a2);
            PG8_BAR; PG8_WAIT_L(0); PG8_MMA(1, 0, At, B0); PG8_BAR; PG8_SCHED;
            PG8_STAGE(PG8_SB(0, 1), b2 + hstep);
            PG8_WAIT_V(6); PG8_BAR; PG8_MMA(1, 1, At, B1); PG8_BAR;
            PG8_LDB(B0, 1, 0); PG8_SCHED; PG8_LDA(At, 1, 0); PG8_STAGE(PG8_SA(0, 1), a2 + hstep);
            PG8_WAIT_L(8); PG8_BAR; PG8_WAIT_L(0); PG8_MMA(0, 0, At, B0); PG8_BAR; PG8_SCHED;
            PG8_LDB(B1, 1, 1); PG8_STAGE(PG8_SB(1, 0), b3);
            PG8_BAR; PG8_WAIT_L(0); PG8_MMA(0, 1, At, B1); PG8_BAR;
            PG8_LDA(At, 1, 1); PG8_STAGE(PG8_SA(1, 0), a3);
            PG8_BAR; PG8_WAIT_L(0); PG8_MMA(1, 0, At, B0); PG8_BAR; PG8_SCHED;
            PG8_STAGE(PG8_SB(1, 1), b3 + hstep);
            PG8_WAIT_V(6); PG8_BAR; PG8_MMA(1, 1, At, B1); PG8_BAR;
            }
        }
        if constexpr (ALIGN_EPI) { if (wr == 0) PG8_BAR; }
        asm volatile("s_nop 15\n\ts_nop 15" ::: "memory");
        { int fr_ = fr, fq_ = fq; asm volatile("" : "+v"(fr_), "+v"(fq_)); E(acc, cur, wr, wc, fr_, fq_); }
        if (!has_next) break;
#pragma unroll
        for (int a = 0; a < 2; ++a)
#pragma unroll
            for (int b = 0; b < 2; ++b)
#pragma unroll
                for (int m = 0; m < 4; ++m)
#pragma unroll
                    for (int n = 0; n < 2; ++n) acc[a][b][m][n] = (f32x4){0.f, 0.f, 0.f, 0.f};
        cur = nxt; cA = nA; cB = nB; ++ui;
        if constexpr (GATHER) {
#pragma unroll
            for (int h = 0; h < 2; ++h) { oC[h][0] = oN[h][0]; oC[h][1] = oN[h][1]; } }
        if constexpr (ALIGN_EPI) { if (wr == 1) PG8_BAR; }
    }
    PG8_WAIT_V(0);
    if constexpr (!ALIGN_EPI) { if (wr == 0) PG8_BAR; }
    PG8_BAR;
#undef PG8_SA
#undef PG8_SB
#undef PG8_STAGE
#undef PG8_STAGEA
#undef PG8_OFFS
#undef PG8_LDA
#undef PG8_LDB
#undef PG8_CAT
#undef PG8_LO
#undef PG8_HI
#undef PG8_MMA
#undef PG8_WAIT_V
#undef PG8_WAIT_L
#undef PG8_BAR
#undef PG8_SCHED
}

typedef const f32x4 (&AccRef)[2][2][4][2];

struct EpiAB {
    bf16* Z; const float* cs;
    __device__ __forceinline__ void operator()(AccRef acc, const Unit& u, int wr, int wc, int fr, int fq) const {
        const int sec = u.pn >> 2, ct = u.pn & 3;
        bf16* base = Z + (size_t)sec * ZSEC;
#pragma unroll
        for (int ai = 0; ai < 2; ++ai)
#pragma unroll
            for (int m = 0; m < 4; ++m) {
                const int row = u.pm * BM + ai * HALF + wr * 64 + m * 16 + fr;
                if (sec < 2) {
                    const float sc = sec == 0 ? QK_SCALE : 1.0f;
                    const f32x4 x1a = acc[ai][0][m][0], x1b = acc[ai][0][m][1], x2a = acc[ai][1][m][0], x2b = acc[ai][1][m][1];
                    f32x4 o1a, o1b, o2a, o2b;
                    if (row < NLAT) {
                        const int t = row & (TL - 1); const int pos = (wc & 1) ? (t & 63) : (t >> 6);
                        const float* cp = cs + pos * 32 + 8 * fq;
                        const f32x4 c0 = *(const f32x4*)cp, c1 = *(const f32x4*)(cp + 4), s0 = *(const f32x4*)(cp + 2048), s1 = *(const f32x4*)(cp + 2052);
                        o1a = (x1a * c0 - x2a * s0) * sc; o1b = (x1b * c1 - x2b * s1) * sc; o2a = (x1a * s0 + x2a * c0) * sc; o2b = (x1b * s1 + x2b * c1) * sc;
                    } else { o1a = x1a * sc; o1b = x1b * sc; o2a = x2a * sc; o2b = x2b * sc; }
                    bf16* dst = base + (size_t)row * RW + (2 * ct + (wc >> 1)) * HD + 32 * (wc & 1) + 8 * fq;
                    *(u32x4*)dst = pack8(o1a, o1b); *(u32x4*)(dst + 64) = pack8(o2a, o2b);
                } else {
#pragma unroll
                    for (int bj = 0; bj < 2; ++bj) {
                        f32x4 v0 = acc[ai][bj][m][0], v1 = acc[ai][bj][m][1];
                        if (sec == 3) {
#pragma unroll
                            for (int j = 0; j < 4; ++j) { v0[j] = silu_f(v0[j]); v1[j] = silu_f(v1[j]); }
                        } else if (sec >= 4) {
#pragma unroll
                            for (int j = 0; j < 4; ++j) { v0[j] = gelu_tanh_f(v0[j]); v1[j] = gelu_tanh_f(v1[j]); }
                        }
                        *(u32x4*)(base + (size_t)row * RW + ct * 256 + bj * HALF + wc * 32 + 8 * fq) = pack8(v0, v1);
                    }
                }
            }
    }
};
struct EpiRes {
    bf16* X; const float* base_f32; const float* gate;
    __device__ __forceinline__ void operator()(AccRef acc, const Unit& u, int wr, int wc, int fr, int fq) const {
        const int r = u.pm >> 4; const int col0 = u.pn * BM + wc * 32 + 8 * fq;
        const float* gp = gate + (size_t)r * MODW + col0;
        const size_t ro = (size_t)(u.pm * BM + wr * 64 + fr) * D + col0;
#pragma unroll
        for (int bj = 0; bj < 2; ++bj) {
            const f32x4 g0 = *(const f32x4*)(gp + bj * HALF), g1 = *(const f32x4*)(gp + bj * HALF + 4);
            f32x4 x0[2][4], x1[2][4];
            if (base_f32) {
#pragma unroll
                for (int ai = 0; ai < 2; ++ai)
#pragma unroll
                    for (int m = 0; m < 4; ++m) { const float* bp = base_f32 + ro + (size_t)(ai * HALF + m * 16) * D + bj * HALF; x0[ai][m] = *(const f32x4*)bp; x1[ai][m] = *(const f32x4*)(bp + 4); }
            } else {
#pragma unroll
                for (int ai = 0; ai < 2; ++ai)
#pragma unroll
                    for (int m = 0; m < 4; ++m) { const u32x4 p = *(const u32x4*)(X + ro + (size_t)(ai * HALF + m * 16) * D + bj * HALF); u32x2 lo, hi; lo.x = p.x; lo.y = p.y; hi.x = p.z; hi.y = p.w; x0[ai][m] = bf4_to_f32(lo); x1[ai][m] = bf4_to_f32(hi); }
            }
#pragma unroll
            for (int ai = 0; ai < 2; ++ai)
#pragma unroll
                for (int m = 0; m < 4; ++m) *(u32x4*)(X + ro + (size_t)(ai * HALF + m * 16) * D + bj * HALF) = pack8(x0[ai][m] + g0 * acc[ai][bj][m][0], x1[ai][m] + g1 * acc[ai][bj][m][1]);
        }
    }
};
struct EpiCV {
    bf16* GB; bf16* XG;
    __device__ __forceinline__ void operator()(AccRef acc, const Unit& u, int wr, int wc, int fr, int fq) const {
#pragma unroll
        for (int ai = 0; ai < 2; ++ai)
#pragma unroll
            for (int m = 0; m < 4; ++m) { const size_t row = (size_t)(u.pm * BM + ai * HALF + wr * 64 + m * 16 + fr);
                if (u.pn < 8) {
#pragma unroll
                    for (int bj = 0; bj < 2; ++bj) *(u32x4*)(GB + row * D + u.pn * 256 + bj * HALF + wc * 32 + 8 * fq) = pack8(acc[ai][bj][m][0], acc[ai][bj][m][1]);
                } else {
                    *(u32x4*)(XG + row * D + (u.pn - 8) * HALF + wc * 32 + 8 * fq) = pack8(acc[ai][0][m][0] * acc[ai][1][m][0], acc[ai][0][m][1] * acc[ai][1][m][1]);
                } }
    }
};
struct EpiMoe1 {
    unsigned char* H;
    __device__ __forceinline__ void operator()(AccRef acc, const Unit& u, int wr, int wc, int fr, int fq) const {
#pragma unroll
        for (int ai = 0; ai < 2; ++ai)
#pragma unroll
            for (int m = 0; m < 4; ++m) { const size_t row = (size_t)(u.pm * BM + ai * HALF + wr * 64 + m * 16 + fr);
                f32x4 a0 = acc[ai][0][m][0], a1 = acc[ai][0][m][1];
#pragma unroll
                for (int j = 0; j < 4; ++j) { a0[j] = silu_f(a0[j]); a1[j] = silu_f(a1[j]); }
                *(u32x2*)(H + row * DE + u.pn * HALF + wc * 32 + 8 * fq) = pack8_fp8(a0 * acc[ai][1][m][0], a1 * acc[ai][1][m][1]); }
    }
};
struct EpiMoe2 {
    bf16* Y;
    __device__ __forceinline__ void operator()(AccRef acc, const Unit& u, int wr, int wc, int fr, int fq) const {
#pragma unroll
        for (int ai = 0; ai < 2; ++ai)
#pragma unroll
            for (int m = 0; m < 4; ++m) { const size_t row = (size_t)(u.pm * BM + ai * HALF + wr * 64 + m * 16 + fr);
#pragma unroll
                for (int bj = 0; bj < 2; ++bj) *(u32x4*)(Y + row * D + u.pn * 256 + bj * HALF + wc * 32 + 8 * fq) = pack8(acc[ai][bj][m][0], acc[ai][bj][m][1]); }
    }
};
}

#define XB_TMO      128
#define XB_XCNT(j)  (256  + 64 * (j))
#define XB_XSUB(j)  (1280 + 64 * (j))
#define XB_XGEN(j)  (2304 + 64 * (j))
#define XB_TOP      3328
#define XB_TOPGEN   3392
#define XCD_BAR_WORDS 3456
#define XB_SPIN_CAP (1u << 18)
__device__ __forceinline__ unsigned xb_ld(unsigned* p)              { return __hip_atomic_load(p, __ATOMIC_RELAXED, __HIP_MEMORY_SCOPE_AGENT); }
__device__ __forceinline__ unsigned xb_add(unsigned* p, unsigned v) { return __hip_atomic_fetch_add(p, v, __ATOMIC_RELAXED, __HIP_MEMORY_SCOPE_AGENT); }
__device__ __forceinline__ unsigned xb_xcc_id() { return (unsigned)__builtin_amdgcn_s_getreg((3 << 11) | 20) & 0xFu; }
#define XB_SPIN(cond, bar) do { unsigned _sp = 0; while (cond) { __builtin_amdgcn_s_sleep(1); \
    if ((++_sp & 255u) == 0u) { if (xb_ld(&(bar)[XB_TMO])) break; if (_sp > XB_SPIN_CAP) { atomicAdd(&(bar)[XB_TMO], 1u); break; } } } } while (0)
struct XcdBarrier { unsigned* bar; unsigned x; volatile LAS unsigned* st; };
__device__ __forceinline__ XcdBarrier xcd_barrier_post(unsigned* bar, volatile LAS unsigned* st) {
    XcdBarrier b; b.bar = bar; b.x = xb_xcc_id(); b.st = st;
    if (threadIdx.x == 0) (void)xb_add(&bar[XB_XCNT(b.x)], 1u);
    return b;
}
__device__ __forceinline__ void xcd_barrier_complete(unsigned* bar, unsigned x, unsigned& nloc, unsigned& nx) {
    const unsigned G = gridDim.x * gridDim.y * gridDim.z;
    unsigned sum, cnt, mine, sp = 0u;
    for (;;) {
        sum = 0u; cnt = 0u; mine = 0u;
#pragma unroll
        for (unsigned j = 0; j < 16; ++j) { const unsigned c = xb_ld(&bar[XB_XCNT(j)]); sum += c; cnt += (c > 0u) ? 1u : 0u; mine = (j == x) ? c : mine; }
        if (sum == G) break;
        __builtin_amdgcn_s_sleep(1);
        if ((++sp & 255u) == 0u) { if (xb_ld(&bar[XB_TMO])) break; if (sp > XB_SPIN_CAP) { atomicAdd(&bar[XB_TMO], 1u); break; } }
    }
    nloc = mine > 0u ? mine : 1u; nx = cnt > 0u ? cnt : 1u;
}
__device__ __forceinline__ void xcd_barrier(const XcdBarrier& b) {
    asm volatile("s_waitcnt vmcnt(0)" ::: "memory");
    __syncthreads();
    if (threadIdx.x == 0) {
        unsigned* bar = b.bar;
        __builtin_amdgcn_s_waitcnt(0);
        unsigned nloc = b.st[0], nx = b.st[1];
        if (nloc == 0u) { xcd_barrier_complete(bar, b.x, nloc, nx); b.st[0] = nloc; b.st[1] = nx; }
        const unsigned old = xb_add(&bar[XB_XSUB(b.x)], 1u);
        const unsigned gen = old / nloc;
        if (old + 1u == (gen + 1u) * nloc) {
            __builtin_amdgcn_fence(__ATOMIC_RELEASE, "agent");
            asm volatile("s_waitcnt vmcnt(0)" ::: "memory");
            const unsigned og = xb_add(&bar[XB_TOP], 1u);
            const unsigned tg = og / nx;
            if (og + 1u == (tg + 1u) * nx) xb_add(&bar[XB_TOPGEN], 1u);
            else XB_SPIN(xb_ld(&bar[XB_TOPGEN]) == tg, bar);
            __builtin_amdgcn_fence(__ATOMIC_ACQUIRE, "agent");
            xb_add(&bar[XB_XGEN(b.x)], 1u);
            asm volatile("s_waitcnt vmcnt(0)" ::: "memory");
        } else {
            XB_SPIN(xb_ld(&bar[XB_XGEN(b.x)]) == gen, bar);
            __builtin_amdgcn_fence(__ATOMIC_ACQUIRE, "agent");
            asm volatile("s_waitcnt vmcnt(0)" ::: "memory");
        }
    }
    __syncthreads();
}

struct Args {
    const float *x, *c, *ctx, *c_ctx, *w_mod, *b_mod, *g_mix, *g_ffn, *ab_w_in, *ab_w_out, *decay, *sgu_w, *sgu_b,
                *cv_w_in, *cv_cw, *cv_cb, *cv_w_out, *w_r1, *b_r1, *w_r2, *b_r2, *w1, *w3, *w2, *g_final;
    float* out; unsigned char* ws; int ph_lo, ph_hi;
};
struct Frame { LAS unsigned char* lds; volatile LAS unsigned* MISC; int wave, G, blk; };
#define FR_LANE_TID const int lane_ = lane_id(); const int tid_ = F.wave * 64 + lane_

enum { PH_PRO = 0, PH_L0 = 1, PH_PER_LAYER = 10, PH_FINAL = 21, NPHASE = 22 };
enum { K_PRE = 0, K_GIN = 1, K_MID1 = 2, K_MID1B = 3, K_MID2 = 4, K_MID3 = 5, K_GOUT = 6, K_ROUTE = 7, K_MOE1 = 8, K_MOE2 = 9 };

__device__ __forceinline__ int pos32(int x) { return 16 * ((x >> 2) & 1) + 4 * (x >> 3) + (x & 3); }
constexpr int I_IN = 32 * 192, I_OUT = 32 * 64, I_FIX = 2 * I_IN + 2 * I_OUT, I_EXP = 3072, I_MOE = 16 * I_EXP, NITEMS = I_FIX + 2 * I_MOE;
struct ItemDesc { const float* src; unsigned char* dst; int N, K, k0, dgrp, fp8; };
__device__ __forceinline__ ItemDesc decode_item(const Args& a, int it) {
    unsigned char* ws = a.ws; ItemDesc d; int kb, nb;
    if (it < I_IN) {
        kb = it / 192; nb = it % 192; const int n = nb * 32, sec = n >> 10;
        if (sec < 2) { const int h = (n & 1023) >> 7, dgi = (n & 127) >> 5; d.dgrp = (sec * 4 + (h >> 1)) * 8 + (dgi >> 1) * 4 + (h & 1) * 2 + (dgi & 1); } else d.dgrp = nb;
        d.src = a.ab_w_in; d.N = 6144; d.K = D; d.dst = ws + WS_WAB_IN; d.fp8 = 0;
    } else if (it < I_IN + I_OUT) { const int r = it - I_IN; kb = r / 64; nb = r % 64; d.dgrp = nb; d.src = a.ab_w_out; d.N = D; d.K = D; d.dst = ws + WS_WAB_OUT; d.fp8 = 0;
    } else if (it < 2 * I_IN + I_OUT) {
        const int r = it - I_IN - I_OUT; kb = r / 192; nb = r % 192; const int n = nb * 32;
        if (n < 2048) d.dgrp = nb; else if (n < 4096) { const int cc = n - 2048; d.dgrp = (8 + (cc >> 7)) * 8 + ((cc & 127) >> 5); } else { const int cc = n - 4096; d.dgrp = (8 + (cc >> 7)) * 8 + 4 + ((cc & 127) >> 5); }
        d.src = a.cv_w_in; d.N = 6144; d.K = D; d.dst = ws + WS_WCV_IN; d.fp8 = 0;
    } else if (it < I_FIX) { const int r = it - 2 * I_IN - I_OUT; kb = r / 64; nb = r % 64; d.dgrp = nb; d.src = a.cv_w_out; d.N = D; d.K = D; d.dst = ws + WS_WCV_OUT; d.fp8 = 0;
    } else {
        const int idx = it - I_FIX; const int le = idx / I_EXP, r = idx % I_EXP, which = r >> 10, item = r & 1023; d.fp8 = 1;
        if (which < 2) {
            kb = item >> 5; nb = item & 31; const int cc = nb * 32; d.dgrp = (cc >> 7) * 8 + which * 4 + ((cc & 127) >> 5);
            d.src = (which ? a.w3 : a.w1) + (size_t)le * D * DE; d.N = DE; d.K = D; d.dst = ws + WS_W13 + (size_t)le * D * D;
        } else {
            kb = item >> 6; nb = item & 63; d.dgrp = nb; d.src = a.w2 + (size_t)le * DE * D; d.N = D; d.K = DE; d.dst = ws + WS_W2 + (size_t)le * D * DE;
        }
    }
    d.k0 = 64 * kb; d.src += (size_t)d.k0 * d.N + 32 * nb;
    return d;
}
__device__ __forceinline__ void item_load(const ItemDesc& d, f32x4 (&v)[8], int lane) {
    const float* src = d.src + (size_t)(8 * (lane >> 3)) * d.N + 4 * (lane & 7);
#pragma unroll
    for (int i = 0; i < 8; ++i) v[i] = __builtin_nontemporal_load((const f32x4*)(src + (size_t)i * d.N));
}
__device__ __forceinline__ void item_finish(const ItemDesc& d, const f32x4 (&v)[8], LAS float* scr, int lane) {
    (void)scr;
    const int kq = 8 * (lane >> 3), nq = 4 * (lane & 7);
    if (d.fp8) {
#pragma unroll
        for (int j = 0; j < 4; ++j) { u32x2 o; o.x = pk4_fp8(v[0][j] * W8_SCALE, v[1][j] * W8_SCALE, v[2][j] * W8_SCALE, v[3][j] * W8_SCALE); o.y = pk4_fp8(v[4][j] * W8_SCALE, v[5][j] * W8_SCALE, v[6][j] * W8_SCALE, v[7][j] * W8_SCALE);
            *(u32x2*)(d.dst + (size_t)(d.dgrp * 32 + pos32(nq + j)) * d.K + d.k0 + kq) = o; }
    } else {
#pragma unroll
        for (int j = 0; j < 4; ++j) { u32x4 o; o.x = cvt_pk_bf16(v[0][j], v[1][j]); o.y = cvt_pk_bf16(v[2][j], v[3][j]); o.z = cvt_pk_bf16(v[4][j], v[5][j]); o.w = cvt_pk_bf16(v[6][j], v[7][j]);
            *(u32x4*)((bf16*)d.dst + (size_t)(d.dgrp * 32 + pos32(nq + j)) * d.K + d.k0 + kq) = o; }
    }
}
__device__ __forceinline__ void convert_items(const Args& a, Frame& F, int it0, int it1, int stride) {
    const int lane = lane_id(); LAS float* scr = (LAS float*)(F.lds + F.wave * 8448);
    if (it0 >= it1) return;
    f32x4 vc[8], vn[8]; ItemDesc cur = decode_item(a, it0); item_load(cur, vc, lane);
    for (int it = it0; it < it1; it += stride) {
        const bool hn = it + stride < it1; const ItemDesc nxt = decode_item(a, hn ? it + stride : it);
        if (hn) item_load(nxt, vn, lane);
        item_finish(cur, vc, scr, lane);
        cur.src = nxt.src; cur.dst = nxt.dst; cur.N = nxt.N; cur.K = nxt.K; cur.k0 = nxt.k0; cur.dgrp = nxt.dgrp; cur.fp8 = nxt.fp8;
#pragma unroll
        for (int i = 0; i < 8; ++i) vc[i] = vn[i];
    }
}
constexpr int TAIL_N1 = 0, TAIL_N2 = 0, TAIL_T1 = 160 * 8 * TAIL_N1, TAIL_T2 = 224 * 8 * TAIL_N2;
static_assert(TAIL_T1 + TAIL_T2 <= I_MOE, "tail shares");
__device__ __forceinline__ void phase_prologue(const Args& a, Frame& F) {
    FR_LANE_TID;
    unsigned char* ws = a.ws;
    {
        LAS float* S = (LAS float*)(F.lds + 69632);
        LAS float* red = (LAS float*)(F.lds + 110592);
        for (int i = tid_; i < 5 * D; i += 512) { const int r = i / D, k = i % D; const float v = r < 4 ? a.c[r * D + k] : a.c_ctx[k]; S[i] = silu_f(v); }
        __syncthreads();
        if (F.blk < 256) {
            const int Lm = F.blk >> 7, strip = F.blk & 127;
            const int rsub = lane_ / 24, c4 = lane_ % 24;
            float acc[5][4];
#pragma unroll
            for (int r = 0; r < 5; ++r) { acc[r][0] = 0.f; acc[r][1] = 0.f; acc[r][2] = 0.f; acc[r][3] = 0.f; }
            if (rsub < 2) {
                const float* wp = a.w_mod + (size_t)Lm * D * MODW + (size_t)(256 * F.wave + rsub) * MODW + 96 * strip + 4 * c4;
#pragma unroll 8
                for (int it = 0; it < 128; ++it) {
                    const f32x4 w = *(const f32x4*)(wp + (size_t)(2 * it) * MODW);
                    const int k = 256 * F.wave + 2 * it + rsub;
#pragma unroll
                    for (int r = 0; r < 5; ++r) { const float s = S[r * D + k]; acc[r][0] += s * w[0]; acc[r][1] += s * w[1]; acc[r][2] += s * w[2]; acc[r][3] += s * w[3]; }
                }
#pragma unroll
                for (int r = 0; r < 5; ++r)
#pragma unroll
                    for (int j = 0; j < 4; ++j) red[(F.wave * 2 + rsub) * 480 + r * 96 + 4 * c4 + j] = acc[r][j];
            }
            __syncthreads();
            if (tid_ < 480) { float s = 0.f;
#pragma unroll
                for (int p = 0; p < 16; ++p) s += red[p * 480 + tid_];
                const int r = tid_ / 96, cc = tid_ % 96; const int col = 96 * strip + cc;
                ((float*)(ws + WS_MOD))[(size_t)(Lm * 5 + r) * MODW + col] = s + a.b_mod[Lm * MODW + col]; }
        }
        __syncthreads();
    }
    {
        const int gt = F.blk * 512 + tid_, NT = F.G * 512;
        float* cs = (float*)(ws + WS_ROPE);
        for (int i = gt; i < 2048; i += NT) { const int pos = i >> 5, f = i & 31; const float inv = powf(10000.0f, -(float)f / 32.0f); const float ang = (float)pos * inv; cs[i] = cosf(ang); cs[2048 + i] = sinf(ang); }
        float* wr = (float*)(ws + WS_WR);
        for (int i = gt; i < 2 * 20 * D; i += NT) { const int L = i / (20 * D), r = (i / D) % 20, k = i % D;
            float v; if (r < 4) v = a.w_r1[((size_t)L * D + k) * 4 + r]; else { const int g = (r - 4) >> 2, e = (r - 4) & 3; v = a.w_r2[(((size_t)L * 4 + g) * D + k) * 4 + e]; }
            wr[i] = v; }
    }
    {
        const int gw = F.blk * 8 + F.wave, NGW = F.G * 8;
        constexpr int R0 = I_MOE - TAIL_T1 - TAIL_T2;
        constexpr int NPRO = I_FIX + R0 + I_MOE;
        int v0 = gw;
        if (v0 < I_FIX) { const int n = (I_FIX - v0 + NGW - 1) / NGW; convert_items(a, F, v0, I_FIX, NGW); v0 += n * NGW; }
        if (v0 < I_FIX + R0) { const int n = (I_FIX + R0 - v0 + NGW - 1) / NGW; convert_items(a, F, v0 + TAIL_T1 + TAIL_T2, I_FIX + I_MOE, NGW); v0 += n * NGW; }
        if (v0 < NPRO) convert_items(a, F, v0 - R0 + I_MOE, NITEMS, NGW);
    }
}

__device__ __forceinline__ int moe_tables(const Args& a, Frame& F, int L) {
    FR_LANE_TID;
    volatile LAS int* tb = (volatile LAS int*)(F.MISC + MI_TB); volatile LAS int* texp = (volatile LAS int*)(F.MISC + MI_TEXP); volatile LAS int* cn = (volatile LAS int*)(F.MISC + MI_LCNT);
    __syncthreads();
    if (tid_ == 0) { unsigned* cnt = (unsigned*)(a.ws + WS_CTL) + CW_CNT + L * 16 * 64; int acc = 0;
        for (int e = 0; e < NE; ++e) { tb[e] = acc; const int c = (int)xb_ld(cnt + e * 64); cn[e] = c; const int n = (c + 255) >> 8; for (int t = 0; t < n && acc + t < 160; ++t) texp[acc + t] = e; acc += n; }
        tb[NE] = acc; }
    __syncthreads();
    return tb[NE];
}
__device__ __forceinline__ float row_rstd(const f32x4 (&v)[8]) {
    float ss = 0.f;
#pragma unroll
    for (int j = 0; j < 8; ++j) ss += (v[j][0] * v[j][0] + v[j][1] * v[j][1]) + (v[j][2] * v[j][2] + v[j][3] * v[j][3]);
    return rsqrtf(wave_sum(ss) * (1.0f / D) + EPSN);
}
struct RowBuf { u32x2 xb[8], y0[8], y1[8]; f32x2 w; };
__device__ __forceinline__ void rowbuf_issue(RowBuf& b, const bf16* XB, const bf16* Y, const int* ridx, const float* rwt, const volatile LAS int* tb, int row, int ln4) {
    const i32x4 ri = *(const i32x4*)(ridx + 4 * (size_t)row); b.w = *(const f32x2*)(rwt + 2 * (size_t)row);
    const int d0 = tb[ri.x] * 256 + ri.y, d1 = tb[ri.z] * 256 + ri.w;
#pragma unroll
    for (int j = 0; j < 8; ++j) { b.xb[j] = *(const u32x2*)(XB + (size_t)row * D + ln4 + 256 * j); b.y0[j] = *(const u32x2*)(Y + (size_t)d0 * D + ln4 + 256 * j); b.y1[j] = *(const u32x2*)(Y + (size_t)d1 * D + ln4 + 256 * j); }
}
__device__ __forceinline__ void rowbuf_combine(const RowBuf& b, const f32x4 (&gate)[8], f32x4 (&v)[8]) {
#pragma unroll
    for (int j = 0; j < 8; ++j) v[j] = bf4_to_f32(b.xb[j]) + gate[j] * (bf4_to_f32(b.y0[j]) * b.w.x + bf4_to_f32(b.y1[j]) * b.w.y);
}
__device__ __forceinline__ void phase_pre(const Args& a, Frame& F, int L) {
    FR_LANE_TID;
    unsigned char* ws = a.ws; bf16* XB = (bf16*)(ws + WS_XB); bf16* A = (bf16*)(ws + WS_A);
    const float* MOD = (const float*)(ws + WS_MOD);
    if (L == 0) {
        const int nrows = NTOK; const int gw = F.blk * 8 + F.wave, NGW = F.G * 8;
        f32x4 vn[8];
        if (gw < nrows) { const float* src = gw < NLAT ? a.x + (size_t)gw * D : a.ctx + (size_t)(gw - NLAT) * D;
#pragma unroll
            for (int j = 0; j < 8; ++j) vn[j] = *(const f32x4*)(src + 4 * lane_ + 256 * j); }
        for (int row = gw; row < nrows; row += NGW) {
            const int r = row < NLAT ? row >> 12 : 4;
            int ln4 = 4 * lane_; asm volatile("" : "+v"(ln4));
            f32x4 v[8];
#pragma unroll
            for (int j = 0; j < 8; ++j) v[j] = vn[j];
            { const int rn = row + NGW; if (rn < nrows) { const float* src = rn < NLAT ? a.x + (size_t)rn * D : a.ctx + (size_t)(rn - NLAT) * D;
#pragma unroll
                for (int j = 0; j < 8; ++j) vn[j] = *(const f32x4*)(src + ln4 + 256 * j); } }
            const float rstd = row_rstd(v);
            const float* mp = MOD + (size_t)r * MODW; const float* gm = a.g_mix;
#pragma unroll
            for (int j = 0; j < 8; ++j) { const int c = ln4 + 256 * j; const f32x4 g = *(const f32x4*)(gm + c), sh = *(const f32x4*)(mp + c), sc = *(const f32x4*)(mp + D + c);
                *(u32x2*)(A + (size_t)row * D + c) = f32_to_bf4(v[j] * rstd * g * (sc + 1.0f) + sh); }
        }
    } else {
        (void)moe_tables(a, F, L - 1);
        const volatile LAS int* tb = (const volatile LAS int*)(F.MISC + MI_TB);
        const int RPB = NLAT / F.G, r = (F.blk * RPB) >> 12;
        const bf16* Y = (const bf16*)(ws + WS_R2); const int* ridx = (const int*)(ws + WS_RIDX) + (size_t)(L - 1) * NTOK * 4; const float* rwt = (const float*)(ws + WS_RWT) + (size_t)(L - 1) * NTOK * 2;
        const float* mp = MOD + (size_t)(L * 5 + r) * MODW;
        f32x4 gate[8], Gm[8];
#pragma unroll
        for (int j = 0; j < 8; ++j) { const int c = 4 * lane_ + 256 * j; gate[j] = *(const f32x4*)(MOD + (size_t)((L - 1) * 5 + r) * MODW + 5 * D + c); Gm[j] = *(const f32x4*)(a.g_mix + L * D + c) * (*(const f32x4*)(mp + D + c) + 1.0f); }
        RowBuf bA, bB;
        const int row0 = F.blk * RPB + F.wave;
        if (F.wave < RPB) rowbuf_issue(bA, XB, Y, ridx, rwt, tb, row0, 4 * lane_);
        for (int i = F.wave; i < RPB; i += 16) {
            int ln4 = 4 * lane_; asm volatile("" : "+v"(ln4));
            const int row = F.blk * RPB + i;
            if (i + 8 < RPB) rowbuf_issue(bB, XB, Y, ridx, rwt, tb, row + 8, ln4);
            { f32x4 v[8]; rowbuf_combine(bA, gate, v);
#pragma unroll
              for (int j = 0; j < 8; ++j) *(u32x2*)(XB + (size_t)row * D + ln4 + 256 * j) = f32_to_bf4(v[j]);
              const float rstd = row_rstd(v);
#pragma unroll
              for (int j = 0; j < 8; ++j) { const int c = ln4 + 256 * j; *(u32x2*)(A + (size_t)row * D + c) = f32_to_bf4(v[j] * rstd * Gm[j] + *(const f32x4*)(mp + c)); } }
            if (i + 8 >= RPB) break;
            if (i + 16 < RPB) rowbuf_issue(bA, XB, Y, ridx, rwt, tb, row + 16, ln4);
            { f32x4 v[8]; rowbuf_combine(bB, gate, v);
#pragma unroll
              for (int j = 0; j < 8; ++j) *(u32x2*)(XB + (size_t)(row + 8) * D + ln4 + 256 * j) = f32_to_bf4(v[j]);
              const float rstd = row_rstd(v);
#pragma unroll
              for (int j = 0; j < 8; ++j) { const int c = ln4 + 256 * j; *(u32x2*)(A + (size_t)(row + 8) * D + c) = f32_to_bf4(v[j] * rstd * Gm[j] + *(const f32x4*)(mp + c)); } }
        }
    }
}

constexpr int LDP = 136;
constexpr int IMG = 128 * LDP * 2;
__device__ __forceinline__ int swz_col(int r, int j) { return 8 * (((j >> 3) ^ (r >> 3)) & 15) + (j & 7); }
__device__ __forceinline__ int unit_row0(int b, int s) { return s < 2 ? NLAT + b * TCX + s * 128 : b * TL + (s - 2) * 128; }
__device__ __forceinline__ void piece_rc(int q, int& j, int& ch) { const int jr = q & 15, cq = (q >> 4) & 3, blk = q >> 6; j = 16 * (blk & 7) + jr; ch = 4 * (blk >> 3) + cq; }

__device__ __forceinline__ int unit_lat(int v) { return (v >> 5) * NSLOT + 2 + (v & 31); }
__device__ __forceinline__ int unit_ctx(int i) { return (i >> 1) * NSLOT + (i & 1); }
struct RU { u32x4 kv[4], vv[4]; };
__device__ __forceinline__ void ret_u_load(const Args& a, Frame& F, int u, RU& r) {
    FR_LANE_TID;
    const bf16* Z = (const bf16*)(a.ws + WS_R1);
    const int bh = u / NSLOT, s = u % NSLOT, b = bh >> 3, h = bh & 7; const int row0 = unit_row0(b, s);
    const int jq = 4 * F.wave + (lane_ >> 4), ch = lane_ & 15;
    const bf16* Kp = Z + 1 * ZSEC + (size_t)(row0 + 4 * jq) * RW + h * HD + 8 * ch; const bf16* Vp = Z + 2 * ZSEC + (size_t)(row0 + 4 * jq) * RW + h * HD + 8 * ch;
#pragma unroll
    for (int k = 0; k < 4; ++k) { r.kv[k] = *(const u32x4*)(Kp + (size_t)k * RW); r.vv[k] = *(const u32x4*)(Vp + (size_t)k * RW); }
}
template <bool CTX>
__device__ __forceinline__ int ret_u_body(const Args& a, Frame& F, int u, RU& r, const volatile LAS unsigned* nslot, int nlimit) {
    FR_LANE_TID;
    unsigned char* ws = a.ws;
    const int h = (u / NSLOT) & 7;
    const float lgf2 = logsig(a.decay[h]) * LOG2E, lgb2 = logsig(a.decay[NH + h]) * LOG2E;
    LAS bf16* KTf = (LAS bf16*)(F.lds); LAS bf16* KTb = (LAS bf16*)(F.lds + IMG); LAS bf16* VT = (LAS bf16*)(F.lds + 2 * IMG);
    { const int jq = 4 * F.wave + (lane_ >> 4), ch = lane_ & 15; const int col = 8 * (((jq >> 1) ^ ch) & 15) + 4 * (jq & 1);
      float ff[4], fb[4];
#pragma unroll
      for (int k = 0; k < 4; ++k) { const int j = 4 * jq + k; ff[k] = exp2f((float)(127 - j) * lgf2); fb[k] = exp2f((float)j * lgb2); }
#pragma unroll
      for (int i = 0; i < 8; ++i) { const unsigned sh = (i & 1) ? 16u : 0u; float kf[4]; unsigned vw[4];
#pragma unroll
          for (int k = 0; k < 4; ++k) { kf[k] = bf2f((r.kv[k][i >> 1] >> sh) & 0xffffu); vw[k] = (r.vv[k][i >> 1] >> sh) & 0xffffu; }
          u32x2 pf, pb, pv; pf.x = cvt_pk_bf16(kf[0] * ff[0], kf[1] * ff[1]); pf.y = cvt_pk_bf16(kf[2] * ff[2], kf[3] * ff[3]);
          pb.x = cvt_pk_bf16(kf[0] * fb[0], kf[1] * fb[1]); pb.y = cvt_pk_bf16(kf[2] * fb[2], kf[3] * fb[3]); pv.x = vw[0] | (vw[1] << 16); pv.y = vw[2] | (vw[3] << 16);
          const int o = (8 * ch + i) * LDP + col;
          *(LAS u32x2*)(KTf + o) = pf; *(LAS u32x2*)(KTb + o) = pb; *(LAS u32x2*)(VT + o) = pv; } }
    __syncthreads();
    const int nxt = (int)nslot[0];
    if (nxt < nlimit) ret_u_load(a, F, CTX ? unit_ctx(nxt) : unit_lat(nxt), r);
    const int fr = lane_ & 15, g = lane_ >> 4, dt = F.wave;
    f32x4 accf[8], accb[8];
#pragma unroll
    for (int e = 0; e < 8; ++e) { accf[e] = (f32x4){0.f, 0.f, 0.f, 0.f}; accb[e] = (f32x4){0.f, 0.f, 0.f, 0.f}; }
#pragma unroll
    for (int sI = 0; sI < 4; ++sI) {
        const int ad = (16 * dt + fr) * LDP + swz_col(16 * dt + fr, 32 * sI + 8 * g);
        const bf16x8 af = *(const LAS bf16x8*)(KTf + ad), ab = *(const LAS bf16x8*)(KTb + ad);
#pragma unroll
        for (int et = 0; et < 8; ++et) { const bf16x8 bv = *(const LAS bf16x8*)(VT + (16 * et + fr) * LDP + swz_col(16 * et + fr, 32 * sI + 8 * g));
            accf[et] = __builtin_amdgcn_mfma_f32_16x16x32_bf16(af, bv, accf[et], 0, 0, 0); accb[et] = __builtin_amdgcn_mfma_f32_16x16x32_bf16(ab, bv, accb[et], 0, 0, 0); }
    }
    bf16* ST = (bf16*)(ws + WS_R2) + (size_t)u * 2 * 16384;
    float one; asm volatile("v_mov_b32 %0, 1.0" : "=v"(one));
#pragma unroll
    for (int et = 0; et < 8; ++et) { *(u32x2*)(ST + (size_t)(16 * et + fr) * 128 + 16 * dt + 4 * g) = f32_to_bf4(accf[et] * one); *(u32x2*)(ST + 16384 + (size_t)(16 * et + fr) * 128 + 16 * dt + 4 * g) = f32_to_bf4(accb[et] * one); }
    __syncthreads();
    return nxt;
}
struct SU { f32x4 w[8]; u32x4 vv[4]; };
__device__ __forceinline__ void sgu_load(const Args& a, Frame& F, int u, SU& r) {
    FR_LANE_TID;
    const bf16* Z = (const bf16*)(a.ws + WS_R1);
    const int bg = u / NSLOT, s = u % NSLOT, b = bg >> 3, grp = bg & 7; const int row0 = unit_row0(b, s);
    const int qq = 4 * F.wave + (lane_ >> 4), cc = lane_ & 15;
    const bf16* Vp = Z + 5 * ZSEC + (size_t)(row0 + 4 * qq) * RW + grp * HD + 8 * cc; const float* wsrc = a.sgu_w + (size_t)grp * 16384;
#pragma unroll
    for (int k = 0; k < 8; ++k) { const int i4 = tid_ + 512 * k; r.w[k] = *(const f32x4*)(wsrc + (i4 >> 5) * 128 + (i4 & 31) * 4); }
#pragma unroll
    for (int k = 0; k < 4; ++k) r.vv[k] = *(const u32x4*)(Vp + (size_t)k * RW);
}
__device__ __forceinline__ int sgu_body(const Args& a, Frame& F, int u, SU& r, const volatile LAS unsigned* nslot, int nlimit) {
    FR_LANE_TID;
    unsigned char* ws = a.ws; const bf16* Z = (const bf16*)(ws + WS_R1); bf16* RS = (bf16*)(ws + WS_R3);
    const int bg = u / NSLOT, s = u % NSLOT, b = bg >> 3, grp = bg & 7; const int row0 = unit_row0(b, s);
    const bf16* Up = Z + 4 * ZSEC + (size_t)row0 * RW + grp * HD;
    LAS bf16* WS_ = (LAS bf16*)(F.lds); LAS bf16* VT = (LAS bf16*)(F.lds + IMG);
#pragma unroll
    for (int k = 0; k < 8; ++k) { const int i4 = tid_ + 512 * k; const int p = i4 >> 5, q4 = (i4 & 31) * 4; const f32x4 w = r.w[k];
        u32x2 o; o.x = cvt_pk_bf16(w[0], w[1]); o.y = cvt_pk_bf16(w[2], w[3]); *(LAS u32x2*)(WS_ + p * LDP + q4) = o; }
    { const int qq = 4 * F.wave + (lane_ >> 4), cc = lane_ & 15; const int col = 8 * (((qq >> 1) ^ cc) & 15) + 4 * (qq & 1);
      float x[4][8], mu[4], rstd[4];
#pragma unroll
      for (int k = 0; k < 4; ++k) { float sm = 0.f;
#pragma unroll
          for (int i = 0; i < 8; ++i) { x[k][i] = bf2f((r.vv[k][i >> 1] >> ((i & 1) ? 16u : 0u)) & 0xffffu); sm += x[k][i]; }
          sm += dpp_mov<0xB1>(sm); sm += dpp_mov<0x4E>(sm); sm += dpp_mov<0x141>(sm); sm += dpp_mov<0x140>(sm); mu[k] = sm * (1.0f / 128.0f); }
#pragma unroll
      for (int k = 0; k < 4; ++k) { float sq = 0.f;
#pragma unroll
          for (int i = 0; i < 8; ++i) { const float dl = x[k][i] - mu[k]; sq += dl * dl; }
          sq += dpp_mov<0xB1>(sq); sq += dpp_mov<0x4E>(sq); sq += dpp_mov<0x141>(sq); sq += dpp_mov<0x140>(sq); rstd[k] = rsqrtf(sq * (1.0f / 128.0f) + EPSN); }
#pragma unroll
      for (int i = 0; i < 8; ++i) { u32x2 pv; pv.x = cvt_pk_bf16((x[0][i] - mu[0]) * rstd[0], (x[1][i] - mu[1]) * rstd[1]); pv.y = cvt_pk_bf16((x[2][i] - mu[2]) * rstd[2], (x[3][i] - mu[3]) * rstd[3]);
          *(LAS u32x2*)(VT + (8 * cc + i) * LDP + col) = pv; } }
    __syncthreads();
    const int nxt = (int)nslot[0];
    if (nxt < nlimit) sgu_load(a, F, unit_lat(nxt), r);
    const int fr = lane_ & 15, g = lane_ >> 4, pt = F.wave;
    f32x4 acc[8];
#pragma unroll
    for (int c = 0; c < 8; ++c) acc[c] = (f32x4){0.f, 0.f, 0.f, 0.f};
#pragma unroll
    for (int sI = 0; sI < 4; ++sI) { const bf16x8 bw = *(const LAS bf16x8*)(WS_ + (16 * pt + fr) * LDP + 32 * sI + 8 * g);
#pragma unroll
        for (int ct = 0; ct < 8; ++ct) { const bf16x8 av = *(const LAS bf16x8*)(VT + (16 * ct + fr) * LDP + swz_col(16 * ct + fr, 32 * sI + 8 * g));
            acc[ct] = __builtin_amdgcn_mfma_f32_16x16x32_bf16(av, bw, acc[ct], 0, 0, 0); } }
    const int p = 16 * pt + fr; const float bs = a.sgu_b[grp * 128 + p];
#pragma unroll
    for (int ct = 0; ct < 8; ++ct) { const int c = 16 * ct + 4 * g; const u32x2 uu = *(const u32x2*)(Up + (size_t)p * RW + c);
        const float o0 = bf2f(uu.x & 0xffffu) * (acc[ct][0] + bs), o1 = bf2f(uu.x >> 16) * (acc[ct][1] + bs), o2 = bf2f(uu.y & 0xffffu) * (acc[ct][2] + bs), o3 = bf2f(uu.y >> 16) * (acc[ct][3] + bs);
        u32x2 o; o.x = cvt_pk_bf16(o0, o1); o.y = cvt_pk_bf16(o2, o3); *(u32x2*)(RS + (size_t)(row0 + p) * D + RW + grp * HD + c) = o; }
    __syncthreads();
    return nxt;
}
__device__ __forceinline__ void phase_scan(const Args& a, Frame& F) {
    FR_LANE_TID;
    bf16* ST = (bf16*)(a.ws + WS_R2);
    const int NT = F.G * 512;
    for (int it = F.blk * 512 + tid_; it < 32 * 2 * 2048; it += NT) {
        const int bh = it >> 12, dir = (it >> 11) & 1, e8 = it & 2047, h = bh & 7;
        const float cd = expf(128.0f * logsig(a.decay[dir * NH + h]));
        bf16* base = ST + ((size_t)bh * NSLOT * 2 + dir) * 16384 + (size_t)e8 * 8;
        float st[8];
#pragma unroll
        for (int i = 0; i < 8; ++i) st[i] = 0.f;
#pragma unroll 17
        for (int n = 0; n < NSLOT; ++n) { const int s_ = dir == 0 ? n : (n < 2 ? 1 - n : 35 - n);
            bf16* p = base + (size_t)s_ * 2 * 16384; const u32x4 t = *(const u32x4*)p;
            u32x4 o; o.x = cvt_pk_bf16(st[0], st[1]); o.y = cvt_pk_bf16(st[2], st[3]); o.z = cvt_pk_bf16(st[4], st[5]); o.w = cvt_pk_bf16(st[6], st[7]); *(u32x4*)p = o;
#pragma unroll
            for (int i = 0; i < 4; ++i) { st[2 * i] = st[2 * i] * cd + bf2f(t[i] & 0xffffu); st[2 * i + 1] = st[2 * i + 1] * cd + bf2f(t[i] >> 16); } }
    }
}
__device__ __forceinline__ void ret_y_unit(const Args& a, Frame& F, int u) {
    FR_LANE_TID;
    unsigned char* ws = a.ws; const bf16* Z = (const bf16*)(ws + WS_R1); bf16* RS = (bf16*)(ws + WS_R3);
    const int bh = u / NSLOT, s = u % NSLOT, b = bh >> 3, h = bh & 7; const int row0 = unit_row0(b, s);
    const bf16* Qp = Z + (size_t)row0 * RW + h * HD; const bf16* Kp = Z + 1 * ZSEC + (size_t)row0 * RW + h * HD; const bf16* Vp = Z + 2 * ZSEC + (size_t)row0 * RW + h * HD;
    const bf16* Gp = Z + 3 * ZSEC + (size_t)row0 * RW + h * HD;
    const float lgf2 = logsig(a.decay[h]) * LOG2E, lgb2 = logsig(a.decay[NH + h]) * LOG2E;
    LAS bf16* KN = (LAS bf16*)(F.lds); LAS bf16* VT = (LAS bf16*)(F.lds + IMG); LAS bf16* SF = (LAS bf16*)(F.lds + 2 * IMG); LAS bf16* SB = (LAS bf16*)(F.lds + 3 * IMG);
    { const int jq = 4 * F.wave + (lane_ >> 4), ch = lane_ & 15; const int col = 8 * (((jq >> 1) ^ ch) & 15) + 4 * (jq & 1);
      u32x4 vv[4];
#pragma unroll
      for (int k = 0; k < 4; ++k) { const int j = 4 * jq + k; *(LAS u32x4*)(KN + j * LDP + 8 * ch) = *(const u32x4*)(Kp + (size_t)j * RW + 8 * ch); vv[k] = *(const u32x4*)(Vp + (size_t)j * RW + 8 * ch); }
#pragma unroll
      for (int i = 0; i < 8; ++i) { const unsigned sh = (i & 1) ? 16u : 0u; unsigned vw[4];
#pragma unroll
          for (int k = 0; k < 4; ++k) vw[k] = (vv[k][i >> 1] >> sh) & 0xffffu;
          u32x2 pv; pv.x = vw[0] | (vw[1] << 16); pv.y = vw[2] | (vw[3] << 16); *(LAS u32x2*)(VT + (8 * ch + i) * LDP + col) = pv; } }
    { const bf16* ST = (const bf16*)(ws + WS_R2) + (size_t)u * 2 * 16384;
#pragma unroll
        for (int k = 0; k < 4; ++k) { const int i8 = tid_ + 512 * k; const int e = i8 >> 4, d8 = (i8 & 15) * 8;
            *(LAS u32x4*)(SF + e * LDP + d8) = *(const u32x4*)(ST + e * 128 + d8); *(LAS u32x4*)(SB + e * LDP + d8) = *(const u32x4*)(ST + 16384 + e * 128 + d8); } }
    const int fr = lane_ & 15, g = lane_ >> 4, it_ = F.wave; const int i_abs = 16 * it_ + fr;
    bf16x8 qf[4];
#pragma unroll
    for (int sI = 0; sI < 4; ++sI) qf[sI] = *(const bf16x8*)(Qp + (size_t)i_abs * RW + 32 * sI + 8 * g);
    __syncthreads();
    bf16x8 pf[4];
#pragma unroll
    for (int ks = 0; ks < 4; ++ks) { f32x4 s0 = (f32x4){0.f, 0.f, 0.f, 0.f}, s1 = s0;
#pragma unroll
        for (int sI = 0; sI < 4; ++sI) { const bf16x8 k0 = *(const LAS bf16x8*)(KN + (32 * ks + fr) * LDP + 32 * sI + 8 * g), k1 = *(const LAS bf16x8*)(KN + (32 * ks + 16 + fr) * LDP + 32 * sI + 8 * g);
            s0 = __builtin_amdgcn_mfma_f32_16x16x32_bf16(k0, qf[sI], s0, 0, 0, 0); s1 = __builtin_amdgcn_mfma_f32_16x16x32_bf16(k1, qf[sI], s1, 0, 0, 0); }
        unsigned w[4];
#pragma unroll
        for (int r = 0; r < 4; r += 2) {
            const int j0 = 32 * ks + 4 * g + r, j1 = j0 + 1, j2 = j0 + 16, j3 = j2 + 1;
            const float d0 = (float)(i_abs - j0), d1 = (float)(i_abs - j1), d2 = (float)(i_abs - j2), d3 = (float)(i_abs - j3);
            const float m0 = d0 >= 0.f ? exp2f(d0 * lgf2) : exp2f(-d0 * lgb2), m1 = d1 >= 0.f ? exp2f(d1 * lgf2) : exp2f(-d1 * lgb2);
            const float m2 = d2 >= 0.f ? exp2f(d2 * lgf2) : exp2f(-d2 * lgb2), m3 = d3 >= 0.f ? exp2f(d3 * lgf2) : exp2f(-d3 * lgb2);
            w[r >> 1] = cvt_pk_bf16(s0[r] * m0, s0[r + 1] * m1); w[2 + (r >> 1)] = cvt_pk_bf16(s1[r] * m2, s1[r + 1] * m3);
        }
        u32x4 ww; ww.x = w[0]; ww.y = w[1]; ww.z = w[2]; ww.w = w[3]; pf[ks] = __builtin_bit_cast(bf16x8, ww);
    }
    const float qdf = exp2f((float)(i_abs + 1) * lgf2), qdb = exp2f((float)(128 - i_abs) * lgb2);
    f32x4 y[8];
#pragma unroll
    for (int et = 0; et < 8; ++et) {
        f32x4 ai = (f32x4){0.f, 0.f, 0.f, 0.f}, cf = ai, cb = ai;
#pragma unroll
        for (int ks = 0; ks < 4; ++ks) { const LAS bf16* vr = VT + (16 * et + fr) * LDP; const u32x2 lo = *(const LAS u32x2*)(vr + swz_col(16 * et + fr, 32 * ks + 4 * g)), hi = *(const LAS u32x2*)(vr + swz_col(16 * et + fr, 32 * ks + 16 + 4 * g));
            u32x4 av; av.x = lo.x; av.y = lo.y; av.z = hi.x; av.w = hi.y;
            ai = __builtin_amdgcn_mfma_f32_16x16x32_bf16(__builtin_bit_cast(bf16x8, av), pf[ks], ai, 0, 0, 0); }
#pragma unroll
        for (int sI = 0; sI < 4; ++sI) { const bf16x8 sf = *(const LAS bf16x8*)(SF + (16 * et + fr) * LDP + 32 * sI + 8 * g), sb = *(const LAS bf16x8*)(SB + (16 * et + fr) * LDP + 32 * sI + 8 * g);
            cf = __builtin_amdgcn_mfma_f32_16x16x32_bf16(sf, qf[sI], cf, 0, 0, 0); cb = __builtin_amdgcn_mfma_f32_16x16x32_bf16(sb, qf[sI], cb, 0, 0, 0); }
        y[et] = ai + cf * qdf + cb * qdb; asm volatile("" ::: "memory");
    }
    float sm = 0.f;
#pragma unroll
    for (int et = 0; et < 8; ++et) sm += (y[et][0] + y[et][1]) + (y[et][2] + y[et][3]);
    sm += __shfl_xor(sm, 16); sm += __shfl_xor(sm, 32); const float mu = sm * (1.0f / 128.0f);
    float sq = 0.f;
#pragma unroll
    for (int et = 0; et < 8; ++et) { const f32x4 dl = y[et] - mu; sq += (dl[0] * dl[0] + dl[1] * dl[1]) + (dl[2] * dl[2] + dl[3] * dl[3]); }
    sq += __shfl_xor(sq, 16); sq += __shfl_xor(sq, 32); const float rstd = rsqrtf(sq * (1.0f / 128.0f) + EPSN);
#pragma unroll
    for (int et = 0; et < 8; ++et) { const int e = 16 * et + 4 * g; const u32x2 gg = *(const u32x2*)(Gp + (size_t)i_abs * RW + e);
        const f32x4 o = (y[et] - mu) * rstd; u32x2 w2; w2.x = cvt_pk_bf16(o[0] * bf2f(gg.x & 0xffffu), o[1] * bf2f(gg.x >> 16)); w2.y = cvt_pk_bf16(o[2] * bf2f(gg.y & 0xffffu), o[3] * bf2f(gg.y >> 16));
        *(u32x2*)(RS + (size_t)(row0 + i_abs) * D + h * HD + e) = w2; }
    __syncthreads();
}

__device__ __forceinline__ void phase_conv(const Args& a, Frame& F) {
    FR_LANE_TID;
    unsigned char* ws = a.ws; const bf16* GB = (const bf16*)(ws + WS_R1); const bf16* XG = GB + (size_t)NLAT * D; bf16* A1 = (bf16*)(ws + WS_R3);
    const int NT = F.G * 512;
#pragma unroll 4
    for (int it = F.blk * 512 + tid_; it < NLAT * 256; it += NT) {
        const int row = it >> 8, c = (it & 255) * 8; const int gc = row & 63;
        const u32x4 x1 = *(const u32x4*)(XG + (size_t)row * D + c), gb = *(const u32x4*)(GB + (size_t)row * D + c);
        u32x4 x0 = (u32x4){0u, 0u, 0u, 0u}, x2 = x0;
        if (gc > 0) x0 = *(const u32x4*)(XG + (size_t)(row - 1) * D + c);
        if (gc < 63) x2 = *(const u32x4*)(XG + (size_t)(row + 1) * D + c);
        float o[8];
#pragma unroll
        for (int i = 0; i < 8; ++i) { const int cc = c + i; const unsigned sh = (i & 1) ? 16u : 0u;
            const float f0 = bf2f((x0[i >> 1] >> sh) & 0xffffu), f1 = bf2f((x1[i >> 1] >> sh) & 0xffffu), f2 = bf2f((x2[i >> 1] >> sh) & 0xffffu), fg = bf2f((gb[i >> 1] >> sh) & 0xffffu);
            o[i] = fg * (a.cv_cb[cc] + a.cv_cw[cc] * f0 + a.cv_cw[D + cc] * f1 + a.cv_cw[2 * D + cc] * f2); }
        u32x4 w; w.x = cvt_pk_bf16(o[0], o[1]); w.y = cvt_pk_bf16(o[2], o[3]); w.z = cvt_pk_bf16(o[4], o[5]); w.w = cvt_pk_bf16(o[6], o[7]);
        *(u32x4*)(A1 + (size_t)row * D + c) = w;
    }
}

__device__ __forceinline__ void phase_route(const Args& a, Frame& F, int L) {
    FR_LANE_TID;
    unsigned char* ws = a.ws; const bf16* XB = (const bf16*)(ws + WS_XB); unsigned char* Fo = ws + WS_A;
    const float* MOD = (const float*)(ws + WS_MOD); const float* WR = (const float*)(ws + WS_WR) + (size_t)L * 20 * D;
    const int nrows = NLAT; const int RPB = (nrows + F.G - 1) / F.G;
    LAS int* rinfo = (LAS int*)(F.lds + MISC_OFF + 4 * MI_RINFO);
    LAS float* rw = (LAS float*)(F.lds + MISC_OFF + 4 * MI_RW);
    volatile LAS unsigned* lcnt = F.MISC + MI_LCNT; volatile LAS unsigned* gbase = F.MISC + MI_GBASE;
    LAS float* WL = (LAS float*)F.lds;
    if (tid_ < 16) lcnt[tid_] = 0u;
    { f32x4 t_[10];
#pragma unroll
      for (int k = 0; k < 10; ++k) t_[k] = *(const f32x4*)(WR + 4 * (size_t)(tid_ + 512 * k));
#pragma unroll
      for (int k = 0; k < 10; ++k) *(LAS f32x4*)(WL + 4 * (tid_ + 512 * k)) = t_[k];
      asm volatile("" ::: "memory");
#pragma unroll
      for (int k = 0; k < 9; ++k) t_[k] = *(const f32x4*)(WR + 4 * (size_t)(tid_ + 512 * (10 + k)));
#pragma unroll
      for (int k = 0; k < 9; ++k) *(LAS f32x4*)(WL + 4 * (tid_ + 512 * (10 + k))) = t_[k];
      asm volatile("" ::: "memory"); }
    __syncthreads();
    f32x4 Gm[8];
    const float* mp0 = MOD + (size_t)(L * 5 + ((F.blk * RPB) >> 12)) * MODW;
    { const float* gf = a.g_ffn + L * D;
#pragma unroll
      for (int j = 0; j < 8; ++j) { const int c = 4 * lane_ + 256 * j; const f32x4 g = *(const f32x4*)(gf + c), sc = *(const f32x4*)(mp0 + 4 * D + c); Gm[j] = g * (sc + 1.0f); } }
    f32x4 vn[8];
    { const int row = F.blk * RPB + F.wave; if (F.wave < RPB && row < nrows) {
#pragma unroll
        for (int j = 0; j < 8; ++j) vn[j] = bf4_to_f32(*(const u32x2*)(XB + (size_t)row * D + 4 * lane_ + 256 * j)); } }
    for (int i = F.wave; i < RPB; i += 8) {
        const int row = F.blk * RPB + i; if (row >= nrows) break;
        int ln4 = 4 * lane_; asm volatile("" : "+v"(ln4));
        f32x4 v[8];
#pragma unroll
        for (int j = 0; j < 8; ++j) v[j] = vn[j];
        if (i + 8 < RPB && row + 8 < nrows) {
#pragma unroll
            for (int j = 0; j < 8; ++j) vn[j] = bf4_to_f32(*(const u32x2*)(XB + (size_t)(row + 8) * D + ln4 + 256 * j)); }
        const float rstd = row_rstd(v);
#pragma unroll
        for (int j = 0; j < 8; ++j) { const int c = ln4 + 256 * j;
            v[j] = v[j] * rstd * Gm[j] + *(const f32x4*)(mp0 + 3 * D + c); *(unsigned*)(Fo + (size_t)row * D + c) = pk4_fp8(v[j][0], v[j][1], v[j][2], v[j][3]); }
        float l1[4] = {0.f, 0.f, 0.f, 0.f};
#pragma unroll
        for (int j = 0; j < 8; ++j)
#pragma unroll
            for (int g = 0; g < 4; ++g) { const f32x4 w = *(const LAS f32x4*)(WL + g * D + ln4 + 256 * j); l1[g] += (v[j][0] * w[0] + v[j][1] * w[1]) + (v[j][2] * w[2] + v[j][3] * w[3]); if (g == 3 && (j & 1)) asm volatile("" ::: "memory"); }
#pragma unroll
        for (int g = 0; g < 4; ++g) l1[g] = wave_sum(l1[g]) + a.b_r1[L * 4 + g];
        int grp = 0; float mx = l1[0];
#pragma unroll
        for (int g = 1; g < 4; ++g) if (l1[g] > mx) { mx = l1[g]; grp = g; }
        grp = __builtin_amdgcn_readfirstlane(grp);
        float den = 0.f;
#pragma unroll
        for (int g = 0; g < 4; ++g) den += expf(l1[g] - mx);
        const float pg = 1.0f / den;
        float l2[4] = {0.f, 0.f, 0.f, 0.f};
#pragma unroll
        for (int j = 0; j < 8; ++j)
#pragma unroll
            for (int e = 0; e < 3; ++e) { const f32x4 w = *(const LAS f32x4*)(WL + (4 + 4 * grp + e) * D + ln4 + 256 * j); l2[e] += (v[j][0] * w[0] + v[j][1] * w[1]) + (v[j][2] * w[2] + v[j][3] * w[3]); if (e == 2 && (j & 1)) asm volatile("" ::: "memory"); }
        if (grp < 3) {
#pragma unroll
            for (int j = 0; j < 8; ++j) { const f32x4 w = *(const LAS f32x4*)(WL + (7 + 4 * grp) * D + ln4 + 256 * j); l2[3] += (v[j][0] * w[0] + v[j][1] * w[1]) + (v[j][2] * w[2] + v[j][3] * w[3]); }
        } else {
#pragma unroll
            for (int j = 0; j < 8; ++j) { const f32x4 w = *(const f32x4*)(WR + (size_t)19 * D + ln4 + 256 * j); l2[3] += (v[j][0] * w[0] + v[j][1] * w[1]) + (v[j][2] * w[2] + v[j][3] * w[3]); }
        }
#pragma unroll
        for (int e = 0; e < 4; ++e) l2[e] = wave_sum(l2[e]) + a.b_r2[(L * 4 + grp) * 4 + e];
        int i0 = 0; float v0 = l2[0];
#pragma unroll
        for (int e = 1; e < 4; ++e) if (l2[e] > v0) { v0 = l2[e]; i0 = e; }
        int i1 = -1; float v1 = -3.0e38f;
#pragma unroll
        for (int e = 0; e < 4; ++e) if (e != i0 && l2[e] > v1) { v1 = l2[e]; i1 = e; }
        const float ex = expf(v1 - v0); const float w0 = pg / (1.0f + ex), w1 = pg * ex / (1.0f + ex);
        if (lane_ == 0) { const int e0 = grp * 4 + i0, e1 = grp * 4 + i1;
            const int li0 = (int)__hip_atomic_fetch_add((LAS unsigned*)&lcnt[e0], 1u, __ATOMIC_RELAXED, __HIP_MEMORY_SCOPE_WORKGROUP);
            const int li1 = (int)__hip_atomic_fetch_add((LAS unsigned*)&lcnt[e1], 1u, __ATOMIC_RELAXED, __HIP_MEMORY_SCOPE_WORKGROUP);
            rinfo[4 * i] = e0; rinfo[4 * i + 1] = li0; rinfo[4 * i + 2] = e1; rinfo[4 * i + 3] = li1; rw[2 * i] = w0; rw[2 * i + 1] = w1; }
    }
    __syncthreads();
    if (tid_ < 16) gbase[tid_] = xb_add((unsigned*)(ws + WS_CTL) + CW_CNT + (L * 16 + tid_) * 64, lcnt[tid_]);
    __syncthreads();
    int* RIDX = (int*)(ws + WS_RIDX) + (size_t)L * NTOK * 4; float* RWT = (float*)(ws + WS_RWT) + (size_t)L * NTOK * 2;
    for (int i = tid_; i < RPB; i += 512) { const int row = F.blk * RPB + i; if (row < nrows) {
        const int e0 = rinfo[4 * i], e1 = rinfo[4 * i + 2];
        i32x4 o; o.x = e0; o.y = (int)gbase[e0] + rinfo[4 * i + 1]; o.z = e1; o.w = (int)gbase[e1] + rinfo[4 * i + 3]; *(i32x4*)(RIDX + 4 * (size_t)row) = o;
        f32x2 w; w.x = rw[2 * i]; w.y = rw[2 * i + 1]; *(f32x2*)(RWT + 2 * (size_t)row) = w;
        int* GI = (int*)(ws + WS_GIDX) + (size_t)L * NE * NTOK; GI[(size_t)e0 * NTOK + o.y] = row; GI[(size_t)e1 * NTOK + o.w] = row; } }
    __syncthreads();
}
__device__ __forceinline__ void phase_final(const Args& a, Frame& F, int Lc  ) {
    FR_LANE_TID;
    unsigned char* ws = a.ws; const bf16* XB = (const bf16*)(ws + WS_XB); const float* MOD = (const float*)(ws + WS_MOD);
    if (Lc < 0) {
        const int gw = F.blk * 8 + F.wave, NGW = F.G * 8;
        for (int row = gw; row < NLAT; row += NGW) { f32x4 v[8];
#pragma unroll
            for (int j = 0; j < 8; ++j) v[j] = bf4_to_f32(*(const u32x2*)(XB + (size_t)row * D + 4 * lane_ + 256 * j));
            const float rstd = row_rstd(v);
#pragma unroll
            for (int j = 0; j < 8; ++j) { const int c = 4 * lane_ + 256 * j; *(f32x4*)(a.out + (size_t)row * D + c) = v[j] * rstd * *(const f32x4*)(a.g_final + c); } }
        return;
    }
    (void)moe_tables(a, F, Lc);
    const volatile LAS int* tb = (const volatile LAS int*)(F.MISC + MI_TB);
    const int RPB = NLAT / F.G, r = (F.blk * RPB) >> 12;
    const bf16* Y = (const bf16*)(ws + WS_R2); const int* ridx = (const int*)(ws + WS_RIDX) + (size_t)Lc * NTOK * 4; const float* rwt = (const float*)(ws + WS_RWT) + (size_t)Lc * NTOK * 2;
    f32x4 gate[8], Gf[8];
#pragma unroll
    for (int j = 0; j < 8; ++j) { const int c = 4 * lane_ + 256 * j; gate[j] = *(const f32x4*)(MOD + (size_t)(Lc * 5 + r) * MODW + 5 * D + c); Gf[j] = *(const f32x4*)(a.g_final + c); }
    RowBuf bA, bB;
    if (F.wave < RPB) rowbuf_issue(bA, XB, Y, ridx, rwt, tb, F.blk * RPB + F.wave, 4 * lane_);
    for (int i = F.wave; i < RPB; i += 16) {
        int ln4 = 4 * lane_; asm volatile("" : "+v"(ln4));
        const int row = F.blk * RPB + i;
        if (i + 8 < RPB) rowbuf_issue(bB, XB, Y, ridx, rwt, tb, row + 8, ln4);
        { f32x4 v[8]; rowbuf_combine(bA, gate, v); const float rstd = row_rstd(v);
#pragma unroll
          for (int j = 0; j < 8; ++j) *(f32x4*)(a.out + (size_t)row * D + ln4 + 256 * j) = v[j] * rstd * Gf[j]; }
        if (i + 8 >= RPB) break;
        if (i + 16 < RPB) rowbuf_issue(bA, XB, Y, ridx, rwt, tb, row + 16, ln4);
        { f32x4 v[8]; rowbuf_combine(bB, gate, v); const float rstd = row_rstd(v);
#pragma unroll
          for (int j = 0; j < 8; ++j) *(f32x4*)(a.out + (size_t)(row + 8) * D + ln4 + 256 * j) = v[j] * rstd * Gf[j]; }
    }
}

__global__ void __launch_bounds__(512, 2) fwd_kernel(Args a) {
    extern __shared__ __attribute__((aligned(16))) unsigned char lds_raw[];
    Frame F; F.lds = (LAS unsigned char*)lds_raw; F.MISC = (volatile LAS unsigned*)(F.lds + MISC_OFF);
    F.wave = __builtin_amdgcn_readfirstlane((int)threadIdx.x >> 6); F.G = gridDim.x; F.blk = blockIdx.x;
    unsigned char* ws = a.ws;
    F.MISC[threadIdx.x] = 0u; F.MISC[threadIdx.x + 512] = 0u;
    __syncthreads();
#if MK_SPLIT
    #define GRID_BAR() do { } while (0)
#else
    XcdBarrier bar = xcd_barrier_post((unsigned*)(ws + WS_CTL) + CW_BAR, F.MISC);
    #define GRID_BAR() xcd_barrier(bar)
#endif
    const int lo = a.ph_lo, hi = a.ph_hi;
    unsigned long long pr_acc = 0ull, pr_t0 = 0ull;
#define IN(k) (lo <= (k) && (k) < hi && ((((PROBE_MASK) >> (k)) & 1u) ? (pr_t0 = __builtin_amdgcn_s_memrealtime(), true) : true))
#define SEAM(k) do { if (lo <= (k) + 1 && (k) + 1 < hi) GRID_BAR(); if (((PROBE_MASK) >> (k)) & 1u) pr_acc += __builtin_amdgcn_s_memrealtime() - pr_t0; } while (0)

    if (IN(PH_PRO)) { phase_prologue(a, F); SEAM(PH_PRO); }
#define RUN_LAYER(L) do { \
        constexpr int P = PH_L0 + (L) * PH_PER_LAYER; \
        constexpr int nM = NLAT / 256;        \
        if (IN(P + K_PRE)) { phase_pre(a, F, (L)); SEAM(P + K_PRE); } \
        if (DBG_STOP == 1) break; \
        if (IN(P + K_GIN)) { \
            if ((L) == 0) { pg8::Gemm g{(const bf16*)(ws + WS_A), (const bf16*)(ws + WS_WAB_IN), D}; pg8::StaticOrder S; S.init(nM, 24, F.G, F.blk); \
                pg8::EpiAB E{(bf16*)(ws + WS_R1), (const float*)(ws + WS_ROPE)}; pg8::gemm_phase<pg8::EpiAB, pg8::StaticOrder, true, true>(F.lds, F.wave, g, S, E); } \
            else { pg8::Gemm g{(const bf16*)(ws + WS_A), (const bf16*)(ws + WS_WCV_IN), D}; pg8::StaticOrder S; S.init(nM, 24, F.G, F.blk); \
                pg8::EpiCV E{(bf16*)(ws + WS_R1), (bf16*)(ws + WS_R1) + (size_t)NLAT * D}; pg8::gemm_phase<pg8::EpiCV, pg8::StaticOrder, true, true>(F.lds, F.wave, g, S, E); } \
            SEAM(P + K_GIN); \
        } \
        if (IN(P + K_MID1)) { \
            if ((L) == 0) { \
                { pg8::Gemm g{(const bf16*)(ws + WS_A), (const bf16*)(ws + WS_WAB_IN), D}; pg8::CtxKvOrder S; S.c = F.blk; \
                  pg8::EpiAB E{(bf16*)(ws + WS_R1), (const float*)(ws + WS_ROPE)}; pg8::gemm_phase<pg8::EpiAB, pg8::CtxKvOrder, true, true>(F.lds, F.wave, g, S, E); } \
                  \
                  \
                { unsigned* q_ = (unsigned*)(ws + WS_CTL) + CW_Q; RU r_; \
                  __syncthreads(); if (threadIdx.x == 0) F.MISC[4] = xb_add(q_, 1u); __syncthreads(); int cur_ = (int)F.MISC[4]; \
                  if (cur_ < 1024) ret_u_load(a, F, unit_lat(cur_), r_); \
                  while (cur_ < 1024) { if (threadIdx.x == 0) F.MISC[5] = xb_add(q_, 1u); cur_ = ret_u_body<false>(a, F, unit_lat(cur_), r_, F.MISC + 5, 1024); } } \
                { unsigned* q_ = (unsigned*)(ws + WS_CTL) + CW_Q + 64; SU r_; \
                  __syncthreads(); if (threadIdx.x == 0) F.MISC[4] = xb_add(q_, 1u); __syncthreads(); int cur_ = (int)F.MISC[4]; \
                  if (cur_ < 1024) sgu_load(a, F, unit_lat(cur_), r_); \
                  while (cur_ < 1024) { if (threadIdx.x == 0) F.MISC[5] = xb_add(q_, 1u); cur_ = sgu_body(a, F, unit_lat(cur_), r_, F.MISC + 5, 1024); } } \
            } else phase_conv(a, F); \
            SEAM(P + K_MID1); \
        } \
        if ((L) == 0) { \
            if (IN(P + K_MID1B)) { if (F.blk < 64) { RU r_; __syncthreads(); if (threadIdx.x == 0) F.MISC[5] = 64u; ret_u_load(a, F, unit_ctx(F.blk), r_); (void)ret_u_body<true>(a, F, unit_ctx(F.blk), r_, F.MISC + 5, 64); } SEAM(P + K_MID1B); } \
            if (IN(P + K_MID2)) { phase_scan(a, F); SEAM(P + K_MID2); } \
            if (IN(P + K_MID3)) { for (int v_ = F.blk; v_ < 1024; v_ += F.G) ret_y_unit(a, F, (v_ >> 5) * NSLOT + 2 + (v_ & 31)); SEAM(P + K_MID3); } \
        } \
        if (IN(P + K_GOUT)) { \
            pg8::Gemm g{(const bf16*)(ws + WS_R3), (const bf16*)(ws + ((L) == 0 ? WS_WAB_OUT : WS_WCV_OUT)), D}; pg8::StaticOrder S; S.init(nM, 8, F.G, F.blk); \
            pg8::EpiRes E{(bf16*)(ws + WS_XB), (L) == 0 ? a.x : (const float*)nullptr, (const float*)(ws + WS_MOD) + (size_t)(L) * 5 * MODW + 2 * D}; \
            pg8::gemm_phase<pg8::EpiRes, pg8::StaticOrder, true, true>(F.lds, F.wave, g, S, E); \
            SEAM(P + K_GOUT); \
        } \
        if (DBG_STOP == 2 || (DBG_STOP == 4 && (L) == 1)) break; \
        if (IN(P + K_ROUTE)) { phase_route(a, F, (L)); SEAM(P + K_ROUTE); } \
        if (IN(P + K_MOE1)) { \
            const int TT = moe_tables(a, F, (L)); \
            pg8::Gemm g{(const bf16*)(ws + WS_A), (const bf16*)(ws + WS_W13 + (size_t)(L) * NE * D * D), D / 2}; \
            pg8::MoeOrder S; S.init(TT, 8, F.G, F.blk); S.texp = (const volatile LAS int*)(F.MISC + MI_TEXP); S.bstride = (long)D * D; \
            { FR_LANE_TID; LAS int* idxbuf = (LAS int*)(F.lds + 131072); const volatile LAS int* tb_ = (const volatile LAS int*)(F.MISC + MI_TB); const volatile LAS int* cn_ = (const volatile LAS int*)(F.MISC + MI_LCNT); \
              const int* GI = (const int*)(ws + WS_GIDX) + (size_t)(L) * NE * NTOK; \
              for (int i_ = 0; i_ < 16; ++i_) { pg8::Unit u_; if (!S.next(i_, u_)) break; const int e_ = S.texp[u_.pm]; const int idx_ = (u_.pm - tb_[e_]) * 256 + tid_; \
                  if (tid_ < 256) idxbuf[i_ * 256 + tid_] = idx_ < cn_[e_] ? GI[(size_t)e_ * NTOK + idx_] : 0; } \
              __syncthreads(); } \
            pg8::EpiMoe1 E{ws + WS_R3}; pg8::gemm_phase<pg8::EpiMoe1, pg8::MoeOrder, true, true, true, true>(F.lds, F.wave, g, S, E, (const LAS int*)(F.lds + 131072)); \
            SEAM(P + K_MOE1); \
        } \
        if (IN(P + K_MOE2)) { \
            const int TT = moe_tables(a, F, (L)); \
            pg8::Gemm g{(const bf16*)(ws + WS_R3), (const bf16*)(ws + WS_W2 + (size_t)(L) * NE * D * DE), DE / 2}; \
            pg8::MoeOrder S; S.init(TT, 8, F.G, F.blk); S.texp = (const volatile LAS int*)(F.MISC + MI_TEXP); S.bstride = (long)D * DE; \
            pg8::EpiMoe2 E{(bf16*)(ws + WS_R2)}; pg8::gemm_phase<pg8::EpiMoe2, pg8::MoeOrder, true, true, true>(F.lds, F.wave, g, S, E); \
            SEAM(P + K_MOE2); \
        } \
    } while (0)
    RUN_LAYER(0);
    if (DBG_STOP == 0 || DBG_STOP == 4) RUN_LAYER(1);
    if (IN(PH_FINAL)) phase_final(a, F, DBG_STOP == 0 ? 1 : (DBG_STOP == 3 ? 0 : -1));
#undef IN
#undef SEAM
    if ((PROBE_MASK) != 0u && F.blk == 0 && threadIdx.x == 0) { const unsigned long long t1 = __builtin_amdgcn_s_memrealtime(); while (__builtin_amdgcn_s_memrealtime() - t1 < (unsigned long long)(PROBE_MULT) * pr_acc) __builtin_amdgcn_s_sleep(8); }
}

extern "C" void kernel_launch(void* const* d_in, const int* in_sizes, int n_in, void* d_out, int out_size, void* d_ws, size_t ws_size, hipStream_t stream) {
    static int grid = 0;
    if (grid == 0) {
        if (n_in != 25 || in_sizes[0] != NLAT * D || out_size != NLAT * D || ws_size < WS_END) { fprintf(stderr, "kernel_launch: unexpected shapes (n_in %d, in0 %d, out %d, ws %zu)\n", n_in, n_in > 0 ? in_sizes[0] : -1, out_size, ws_size); grid = -1; return; }
        int dev = 0, cus = 0, per_cu = 0;
        if (hipGetDevice(&dev) != hipSuccess || hipDeviceGetAttribute(&cus, hipDeviceAttributeMultiprocessorCount, dev) != hipSuccess) { grid = -1; return; }
        if (hipFuncSetAttribute((const void*)fwd_kernel, hipFuncAttributeMaxDynamicSharedMemorySize, LDS_BYTES) != hipSuccess) { fprintf(stderr, "kernel_launch: hipFuncSetAttribute failed\n"); grid = -1; return; }
        if (hipOccupancyMaxActiveBlocksPerMultiprocessor(&per_cu, (const void*)fwd_kernel, 512, LDS_BYTES) != hipSuccess || per_cu < 1) fprintf(stderr, "kernel_launch: occupancy query reports %d\n", per_cu);
        (void)hipGetLastError();
        grid = cus;
    }
    if (grid < 0) return;
    (void)hipMemsetAsync((char*)d_ws + WS_CTL, 0, CTL_BYTES, stream);
    Args a{};
    const float** f = (const float**)&a;
    for (int i = 0; i < 25; ++i) f[i] = (const float*)d_in[i];
    a.out = (float*)d_out; a.ws = (unsigned char*)d_ws;
#if MK_SPLIT
    for (int ph = 0; ph < NPHASE; ++ph) { a.ph_lo = ph; a.ph_hi = ph + 1; hipLaunchKernelGGL(fwd_kernel, dim3(grid), dim3(512), LDS_BYTES, stream, a); }
#else
    a.ph_lo = 0; a.ph_hi = NPHASE; hipLaunchKernelGGL(fwd_kernel, dim3(grid), dim3(512), LDS_BYTES, stream, a);
#endif
}
```

```cpp
#include <hip/hip_runtime.h>
#include <cstdio>
#include <cstdint>

#ifndef MK_SPLIT
#define MK_SPLIT 0
#endif
#ifndef PROBE_MASK
#define PROBE_MASK 0u
#endif
#ifndef PROBE_MULT
#define PROBE_MULT 4
#endif
#ifndef DBG_STOP
#define DBG_STOP 0
#endif

#define LAS __attribute__((address_space(3)))
#define GAS __attribute__((address_space(1)))
typedef unsigned short bf16;
typedef short bf16x8 __attribute__((ext_vector_type(8)));
typedef short s16x4 __attribute__((ext_vector_type(4)));
typedef float f32x4 __attribute__((ext_vector_type(4)));
typedef float f32x2 __attribute__((ext_vector_type(2)));
typedef unsigned u32x4 __attribute__((ext_vector_type(4)));
typedef unsigned u32x2 __attribute__((ext_vector_type(2)));
typedef int i32x4 __attribute__((ext_vector_type(4)));
typedef int i32x8 __attribute__((ext_vector_type(8)));
typedef int i32x2 __attribute__((ext_vector_type(2)));

constexpr int D = 2048, NB = 4, TL = 4096, TCX = 256;
constexpr int NLAT = NB * TL;
constexpr int NCTX = NB * TCX;
constexpr int NTOK = NLAT + NCTX;
constexpr int HD = 128, NH = 8, RW = 1024;
constexpr int NSLOT = 34;
constexpr int NUNIT = NB * NH * NSLOT;
constexpr int DE = 1024, NE = 16;
constexpr int PCAP = 2 * NTOK + NE * 256;
constexpr float EPSN = 1e-6f;
constexpr float QK_SCALE = 0.08838834764831845f;
constexpr int MODW = 6 * D;

constexpr size_t MiB = 1u << 20;
constexpr size_t WS_CTL = 0, CTL_BYTES = 1 * MiB;
constexpr size_t WS_MOD = 1 * MiB;
constexpr size_t WS_ROPE = 1 * MiB + 512 * 1024;
constexpr size_t WS_WR = 2 * MiB;
constexpr size_t WS_RIDX = 3 * MiB;
constexpr size_t WS_RWT = 4 * MiB;
constexpr size_t WS_GIDX = 5 * MiB;
constexpr size_t WS_WAB_IN = 8 * MiB, WS_WAB_OUT = 32 * MiB, WS_WCV_IN = 40 * MiB, WS_WCV_OUT = 64 * MiB;
constexpr size_t WS_W13 = 72 * MiB;
constexpr size_t WS_W2 = 328 * MiB;
constexpr size_t WS_XB = 456 * MiB;
constexpr size_t WS_A = 592 * MiB;
constexpr size_t WS_R1 = 660 * MiB;
constexpr size_t WS_R2 = 864 * MiB;
constexpr size_t WS_R3 = 1016 * MiB;
constexpr size_t WS_END = 1092 * MiB;
constexpr size_t ZSEC = (size_t)NTOK * 1024;
constexpr int CW_BAR = 4096;
constexpr int CW_Q = 2048;
constexpr int CW_CNT = 8192;

constexpr int SCR_BYTES = 155648;
constexpr int MISC_OFF = SCR_BYTES;
constexpr int LDS_BYTES = SCR_BYTES + 4096;
constexpr int MI_LCNT = 16, MI_GBASE = 32, MI_TB = 64, MI_TEXP = 96, MI_RINFO = 256, MI_RW = 768;

__device__ __forceinline__ unsigned cvt_pk_bf16(float lo, float hi) { unsigned r; asm("v_cvt_pk_bf16_f32 %0, %1, %2" : "=v"(r) : "v"(lo), "v"(hi)); return r; }
__device__ __forceinline__ int lane_id() { int l; asm volatile("v_mbcnt_lo_u32_b32 %0, -1, 0\n\tv_mbcnt_hi_u32_b32 %0, -1, %0" : "=v"(l)); return l; }
__device__ __forceinline__ float bf2f(unsigned b) { return __uint_as_float(b << 16); }
template <int CTRL> __device__ __forceinline__ float dpp_mov(float v) { return __int_as_float(__builtin_amdgcn_update_dpp(0, __float_as_int(v), CTRL, 0xf, 0xf, false)); }
__device__ __forceinline__ float wave_sum(float v) {
    v += dpp_mov<0xB1>(v); v += dpp_mov<0x4E>(v); v += dpp_mov<0x141>(v); v += dpp_mov<0x140>(v);
    return ((__int_as_float(__builtin_amdgcn_readlane(__float_as_int(v), 0)) + __int_as_float(__builtin_amdgcn_readlane(__float_as_int(v), 16))) +
           (__int_as_float(__builtin_amdgcn_readlane(__float_as_int(v), 32)) + __int_as_float(__builtin_amdgcn_readlane(__float_as_int(v), 48))));
}
__device__ __forceinline__ float silu_f(float x) { return x * __builtin_amdgcn_rcpf(1.0f + __expf(-x)); }
__device__ __forceinline__ float gelu_tanh_f(float x) { const float z = 1.5957691216057308f * (x + 0.044715f * x * x * x); return x * __builtin_amdgcn_rcpf(1.0f + __expf(-z)); }
__device__ __forceinline__ u32x4 pack8(f32x4 a, f32x4 b) { u32x4 w; w.x = cvt_pk_bf16(a[0], a[1]); w.y = cvt_pk_bf16(a[2], a[3]); w.z = cvt_pk_bf16(b[0], b[1]); w.w = cvt_pk_bf16(b[2], b[3]); return w; }
__device__ __forceinline__ unsigned pk4_fp8(float a, float b, float c, float d) { int w = 0; w = __builtin_amdgcn_cvt_pk_fp8_f32(a, b, w, false); w = __builtin_amdgcn_cvt_pk_fp8_f32(c, d, w, true); return (unsigned)w; }
__device__ __forceinline__ u32x2 pack8_fp8(f32x4 a, f32x4 b) { u32x2 w; w.x = pk4_fp8(a[0], a[1], a[2], a[3]); w.y = pk4_fp8(b[0], b[1], b[2], b[3]); return w; }
#define W8_SCALE 64.0f
#define SCALE_W8 0x79797979
#define SCALE_ONE 0x7f7f7f7f
__device__ __forceinline__ f32x4 bf4_to_f32(u32x2 p) { return (f32x4){bf2f(p.x & 0xffffu), bf2f(p.x >> 16), bf2f(p.y & 0xffffu), bf2f(p.y >> 16)}; }
__device__ __forceinline__ u32x2 f32_to_bf4(f32x4 v) { u32x2 p; p.x = cvt_pk_bf16(v[0], v[1]); p.y = cvt_pk_bf16(v[2], v[3]); return p; }
__device__ __forceinline__ float logsig(float x) { return -log1pf(expf(-x)); }
#define LOG2E 1.4426950408889634f

namespace pg8 {
constexpr int BM = 256, BK = 64, HALF = 128, HTB = HALF * BK * 2, STAGE_BYTES = 8 * HTB, NXCD = 8, WGM = 8;
__host__ __device__ __forceinline__ int lds_byte(int r, int c) { const int st = (r >> 4) * 2 + (c >> 5), rr = r & 15, cc = c & 31, ob = rr * 64 + cc * 2; return st * 1024 + (ob ^ (((ob >> 9) & 1) << 5)); }
__host__ __device__ __forceinline__ void stage_rc(int b, int& R, int& C) { const int st = b / 1024, sb = b % 1024, swz = sb ^ (((sb >> 9) & 1) << 5); R = (st >> 1) * 16 + swz / 64; C = (st & 1) * 32 + (swz % 64) / 2; }

struct Unit { int pm, pn; long boff; };
struct Gemm { const bf16* A; const bf16* Bt; int K; };

struct StaticOrder {
    int nM, nN, nwg, G, c;
    __device__ __forceinline__ void init(int nM_, int nN_, int G_, int c_) { nM = nM_; nN = nN_; nwg = nM * nN; G = G_; c = c_; }
    __device__ __forceinline__ bool map(int i, int& pm, int& pn) const {
        const long L = (long)i * G + c; if (L >= nwg) return false;
        int wgid = (int)L; { const int q = nwg / NXCD, r = nwg % NXCD, xcd = wgid % NXCD, off = wgid / NXCD; wgid = (xcd < r ? xcd * (q + 1) : r * (q + 1) + (xcd - r) * q) + off; }
        const int nig = WGM * nN, gid = wgid / nig, fm = gid * WGM, gsz = (nM - fm) < WGM ? (nM - fm) : WGM;
        pm = fm + ((wgid % nig) % gsz); pn = (wgid % nig) / gsz; return true;
    }
    __device__ __forceinline__ bool next(int i, Unit& u) const { u.boff = 0; return map(i, u.pm, u.pn); }
};
struct CtxKvOrder {
    int c;
    __device__ __forceinline__ bool next(int i, Unit& u) const { if (i != 0 || c >= 32) return false; u.pm = 64 + (c >> 3); u.pn = 4 + (c & 7); u.boff = 0; return true; }
};
struct MoeOrder : StaticOrder {
    const volatile LAS int* texp; long bstride;
    __device__ __forceinline__ bool next(int i, Unit& u) const { if (!map(i, u.pm, u.pn)) return false; u.boff = (long)texp[u.pm] * bstride; return true; }
};

template <class Epi, class Sched, bool ALIGN_EPI, bool SP2, bool FP8 = false, bool GATHER = false>
__device__ __forceinline__ void gemm_phase(LAS unsigned char* lds, const int wid, const Gemm g, const Sched& S, const Epi& E, const LAS int* gidx = nullptr) {
    static_assert(!GATHER || SP2, "row-gathered A operand: SP2 loop only");
    const int lane = lane_id(), tid = wid * 64 + lane, wr = wid >> 2, wc = wid & 3, fr = lane & 15, fq = lane >> 4;
    const int K = g.K, nt = K / BK;
    unsigned voffA[2];
#pragma unroll
    for (int i = 0; i < 2; ++i) { int R, C; stage_rc(tid * 16 + i * 8192, R, C); voffA[i] = (unsigned)(R * K + C) * 2u; }
    const size_t kstep = (size_t)(BK * 2);
    const size_t hstep = (size_t)HALF * K * 2;
    const size_t tstep = 2 * hstep;
    const unsigned ldsw = (unsigned)wid * 1024u;
    const int aoff = lds_byte(wr * 64 + fr, fq * 8), boff = lds_byte(wc * 32 + fr, fq * 8);
#define PG8_SA(b, h) (((b) * 2 + (h)) * HTB)
#define PG8_SB(b, h) ((4 + (b) * 2 + (h)) * HTB)
#define PG8_STAGE(bufoff, gbase) do { _Pragma("unroll") for (int _i = 0; _i < 2; ++_i) \
        __builtin_amdgcn_global_load_lds((const unsigned*)((const char*)(gbase) + voffA[_i]), (LAS unsigned*)(lds + (bufoff) + ldsw + _i * 8192), 16, 0, 0); } while (0)
#define PG8_STAGEA(bufoff, ptr, kq, h, useN) do { if constexpr (GATHER) { _Pragma("unroll") for (int _i = 0; _i < 2; ++_i) \
        __builtin_amdgcn_global_load_lds((const unsigned*)(gA + (kq) + ((useN) ? oN[h][_i] : oC[h][_i])), (LAS unsigned*)(lds + (bufoff) + ldsw + _i * 8192), 16, 0, 0); } \
        else { PG8_STAGE(bufoff, ptr); } } while (0)
#define PG8_OFFS(o, uidx) do { _Pragma("unroll") for (int _h = 0; _h < 2; ++_h) _Pragma("unroll") for (int _i = 0; _i < 2; ++_i) { int R_, C_; stage_rc(tid * 16 + _i * 8192, R_, C_); \
        o[_h][_i] = (unsigned)gidx[(uidx) * 256 + _h * HALF + R_] * (unsigned)(K * 2) + (unsigned)(C_ * 2); } } while (0)
#define PG8_CAT(lo, hi) __builtin_shufflevector(lo, hi, 0, 1, 2, 3, 4, 5, 6, 7)
#define PG8_LDA(dst, b, h) do { _Pragma("unroll") for (int m = 0; m < 4; ++m) dst[m] = PG8_CAT(*(const LAS i32x4*)(lds + PG8_SA(b, h) + aoff + m * 2048), *(const LAS i32x4*)(lds + PG8_SA(b, h) + aoff + m * 2048 + 1024)); } while (0)
#define PG8_LDB(dst, b, h) do { _Pragma("unroll") for (int n = 0; n < 2; ++n) dst[n] = PG8_CAT(*(const LAS i32x4*)(lds + PG8_SB(b, h) + boff + n * 2048), *(const LAS i32x4*)(lds + PG8_SB(b, h) + boff + n * 2048 + 1024)); } while (0)
#define PG8_LO(x) __builtin_bit_cast(bf16x8, __builtin_shufflevector(x, x, 0, 1, 2, 3))
#define PG8_HI(x) __builtin_bit_cast(bf16x8, __builtin_shufflevector(x, x, 4, 5, 6, 7))
#define PG8_MMA(ai, bj, At, Bt) do { __builtin_amdgcn_s_setprio(1); \
        if constexpr (FP8) { _Pragma("unroll") for (int m = 0; m < 4; ++m) _Pragma("unroll") for (int n = 0; n < 2; ++n) \
            asm volatile("v_mfma_scale_f32_16x16x128_f8f6f4 %0, %1, %2, %0, %3, %4 op_sel_hi:[0,0,0]" : "+v"(acc[ai][bj][m][n]) : "v"(Bt[n]), "v"(At[m]), "v"(scw), "v"(sca)); } \
        else { _Pragma("unroll") for (int m = 0; m < 4; ++m) _Pragma("unroll") for (int n = 0; n < 2; ++n) { \
            acc[ai][bj][m][n] = __builtin_amdgcn_mfma_f32_16x16x32_bf16(PG8_LO(Bt[n]), PG8_LO(At[m]), acc[ai][bj][m][n], 0, 0, 0); \
            acc[ai][bj][m][n] = __builtin_amdgcn_mfma_f32_16x16x32_bf16(PG8_HI(Bt[n]), PG8_HI(At[m]), acc[ai][bj][m][n], 0, 0, 0); } } \
        __builtin_amdgcn_s_setprio(0); } while (0)
#define PG8_WAIT_V(n) asm volatile("s_waitcnt vmcnt(" #n ")" ::: "memory")
#define PG8_WAIT_L(n) asm volatile("s_waitcnt lgkmcnt(" #n ")" ::: "memory")
#define PG8_BAR __builtin_amdgcn_s_barrier()
#define PG8_SCHED __builtin_amdgcn_sched_barrier(0)
    Unit cur, nxt; int ui = 0;
    if (!S.next(0, cur)) return;
    int scw = SCALE_W8, sca = SCALE_ONE; if constexpr (FP8) asm volatile("" : "+v"(scw), "+v"(sca));
    f32x4 acc[2][2][4][2];
#pragma unroll
    for (int a = 0; a < 2; ++a)
#pragma unroll
        for (int b = 0; b < 2; ++b)
#pragma unroll
            for (int m = 0; m < 4; ++m)
#pragma unroll
                for (int n = 0; n < 2; ++n) acc[a][b][m][n] = (f32x4){0.f, 0.f, 0.f, 0.f};
    i32x8 At[4], B0[2], B1[2];
    const char* cA = (const char*)g.A + (size_t)cur.pm * tstep; const char* cB = (const char*)g.Bt + cur.boff + (size_t)cur.pn * tstep;
    const char* const gA = (const char*)g.A; unsigned oC[2][2], oN[2][2];
    if constexpr (GATHER) { PG8_OFFS(oC, 0);
#pragma unroll
        for (int h = 0; h < 2; ++h) { oN[h][0] = oC[h][0]; oN[h][1] = oC[h][1]; } }
    if constexpr (SP2) {
        PG8_STAGE(PG8_SB(0, 0), cB); PG8_STAGE(PG8_SB(0, 1), cB + hstep); PG8_STAGEA(PG8_SA(0, 0), cA, (size_t)0, 0, false); PG8_STAGEA(PG8_SA(0, 1), cA + hstep, (size_t)0, 1, false);
        if (wr == 1) PG8_BAR;
        PG8_WAIT_V(2); PG8_BAR;
        PG8_STAGE(PG8_SB(1, 0), cB + kstep); PG8_STAGEA(PG8_SA(1, 0), cA + kstep, kstep, 0, false); PG8_STAGE(PG8_SB(1, 1), cB + hstep + kstep);
        PG8_WAIT_V(6); PG8_BAR;
    } else {
        PG8_STAGE(PG8_SB(0, 0), cB); PG8_STAGE(PG8_SA(0, 0), cA); PG8_STAGE(PG8_SB(0, 1), cB + hstep); PG8_STAGE(PG8_SA(0, 1), cA + hstep);
        if (wr == 1) PG8_BAR;
        PG8_WAIT_V(4); PG8_BAR;
        PG8_STAGE(PG8_SB(1, 0), cB + kstep); PG8_STAGE(PG8_SA(1, 0), cA + kstep); PG8_STAGE(PG8_SB(1, 1), cB + hstep + kstep);
        PG8_WAIT_V(6); PG8_BAR;
    }
    for (;;) {
        const bool has_next = S.next(ui + 1, nxt);
        const char* nA = has_next ? (const char*)g.A + (size_t)nxt.pm * tstep : cA; const char* nB = has_next ? (const char*)g.Bt + nxt.boff + (size_t)nxt.pn * tstep : cB;
        if constexpr (GATHER) { if (has_next) PG8_OFFS(oN, ui + 1); }
#pragma unroll 1
        for (int t = 0; t < nt; t += 2) {
            const bool last = (t == nt - 2);
            const char* a1 = cA + (size_t)(t + 1) * kstep;
            const char* a2 = last ? nA : cA + (size_t)(t + 2) * kstep; const char* b2 = last ? nB : cB + (size_t)(t + 2) * kstep;
            const char* a3 = a2 + kstep; const char* b3 = b2 + kstep;
            const size_t kq1 = (size_t)(t + 1) * kstep, kq2 = last ? (size_t)0 : (size_t)(t + 2) * kstep, kq3 = kq2 + kstep;
            if constexpr (SP2) {
            PG8_LDB(B0, 0, 0); PG8_LDB(B1, 0, 1); PG8_SCHED; PG8_LDA(At, 0, 0); PG8_STAGEA(PG8_SA(1, 1), a1 + hstep, kq1, 1, false);
            PG8_WAIT_V(8); PG8_WAIT_L(0); PG8_BAR; PG8_MMA(0, 0, At, B0); PG8_MMA(0, 1, At, B1); PG8_BAR; PG8_SCHED;
            PG8_LDA(At, 0, 1); PG8_STAGE(PG8_SB(0, 0), b2); PG8_STAGE(PG8_SB(0, 1), b2 + hstep); PG8_STAGEA(PG8_SA(0, 0), a2, kq2, 0, last);
            PG8_WAIT_V(8); PG8_WAIT_L(0); PG8_BAR; PG8_MMA(1, 0, At, B0); PG8_MMA(1, 1, At, B1); PG8_BAR; PG8_SCHED;
            PG8_LDB(B0, 1, 0); PG8_LDB(B1, 1, 1); PG8_SCHED; PG8_LDA(At, 1, 0); PG8_STAGEA(PG8_SA(0, 1), a2 + hstep, kq2, 1, last);
            PG8_WAIT_V(8); PG8_WAIT_L(0); PG8_BAR; PG8_MMA(0, 0, At, B0); PG8_MMA(0, 1, At, B1); PG8_BAR; PG8_SCHED;
            PG8_LDA(At, 1, 1); PG8_STAGE(PG8_SB(1, 0), b3); PG8_STAGE(PG8_SB(1, 1), b3 + hstep); PG8_STAGEA(PG8_SA(1, 0), a3, kq3, 0, last);
            PG8_WAIT_V(8); PG8_WAIT_L(0); PG8_BAR; PG8_MMA(1, 0, At, B0); PG8_MMA(1, 1, At, B1); PG8_BAR; PG8_SCHED;
            } else {
            PG8_LDB(B0, 0, 0); PG8_SCHED; PG8_LDA(At, 0, 0); PG8_STAGE(PG8_SA(1, 1), a1 + hstep);
            PG8_WAIT_L(8); PG8_BAR; PG8_WAIT_L(0); PG8_MMA(0, 0, At, B0); PG8_BAR; PG8_SCHED;
            PG8_LDB(B1, 0, 1); PG8_STAGE(PG8_SB(0, 0), b2);
            PG8_BAR; PG8_WAIT_L(0); PG8_MMA(0, 1, At, B1); PG8_BAR;
            PG8_LDA(At, 0, 1); PG8_STAGE(PG8_SA(0, 0), a2);
            PG8_BAR; PG8_WAIT_L(0); PG8_MMA(1, 0, At, B0); PG8_BAR; PG8_SCHED;
            PG8_STAGE(PG8_SB(0, 1), b2 + hstep);
            PG8_WAIT_V(6); PG8_BAR; PG8_MMA(1, 1, At, B1); PG8_BAR;
            PG8_LDB(B0, 1, 0); PG8_SCHED; PG8_LDA(At, 1, 0); PG8_STAGE(PG8_SA(0, 1), a2 + hstep);
            PG8_WAIT_L(8); PG8_BAR; PG8_WAIT_L(0); PG8_MMA(0, 0, At, B0); PG8_BAR; PG8_SCHED;
            PG8_LDB(B1, 1, 1); PG8_STAGE(PG8_SB(1, 0), b3);
            PG8_BAR; PG8_WAIT_L(0); PG8_MMA(0, 1, At, B1); PG8_BAR;
            PG8_LDA(At, 1, 1); PG8_STAGE(PG8_SA(1, 0), a3);
            PG8_BAR; PG8_WAIT_L(0); PG8_MMA(1, 0, At, B0); PG8_BAR; PG8_SCHED;
            PG8_STAGE(PG8_SB(1, 1), b3 + hstep);
            PG8_WAIT_V(6); PG8_BAR; PG8_MMA(1, 1, At, B1); PG8_BAR;
            }
        }
        if constexpr (ALIGN_EPI) { if (wr == 0) PG8_BAR; }
        asm volatile("s_nop 15\n\ts_nop 15" ::: "memory");
        { int fr_ = fr, fq_ = fq; asm volatile("" : "+v"(fr_), "+v"(fq_)); E(acc, cur, wr, wc, fr_, fq_); }
        if (!has_next) break;
#pragma unroll
        for (int a = 0; a < 2; ++a)
#pragma unroll
            for (int b = 0; b < 2; ++b)
#pragma unroll
                for (int m = 0; m < 4; ++m)
#pragma unroll
                    for (int n = 0; n < 2; ++n) acc[a][b][m][n] = (f32x4){0.f, 0.f, 0.f, 0.f};
        cur = nxt; cA = nA; cB = nB; ++ui;
        if constexpr (GATHER) {
#pragma unroll
            for (int h = 0; h < 2; ++h) { oC[h][0] = oN[h][0]; oC[h][1] = oN[h][1]; } }
        if constexpr (ALIGN_EPI) { if (wr == 1) PG8_BAR; }
    }
    PG8_WAIT_V(0);
    if constexpr (!ALIGN_EPI) { if (wr == 0) PG8_BAR; }
    PG8_BAR;
#undef PG8_SA
#undef PG8_SB
#undef PG8_STAGE
#undef PG8_STAGEA
#undef PG8_OFFS
#undef PG8_LDA
#undef PG8_LDB
#undef PG8_CAT
#undef PG8_LO
#undef PG8_HI
#undef PG8_MMA
#undef PG8_WAIT_V
#undef PG8_WAIT_L
#undef PG8_BAR
#undef PG8_SCHED
}

typedef const f32x4 (&AccRef)[2][2][4][2];

struct EpiAB {
    bf16* Z; const LAS float* cs;
    __device__ __forceinline__ void operator()(AccRef acc, const Unit& u, int wr, int wc, int fr, int fq) const {
        const int sec = u.pn >> 2, ct = u.pn & 3;
        bf16* base = Z + (size_t)sec * ZSEC;
#pragma unroll
        for (int ai = 0; ai < 2; ++ai)
#pragma unroll
            for (int m = 0; m < 4; ++m) {
                const int row = u.pm * BM + ai * HALF + wr * 64 + m * 16 + fr;
                if (sec < 2) {
                    const float sc = sec == 0 ? QK_SCALE : 1.0f;
                    const f32x4 x1a = acc[ai][0][m][0], x1b = acc[ai][0][m][1], x2a = acc[ai][1][m][0], x2b = acc[ai][1][m][1];
                    f32x4 o1a, o1b, o2a, o2b;
                    if (row < NLAT) {
                        const int t = row & (TL - 1); const int pos = (wc & 1) ? (t & 63) : (t >> 6);
                        const LAS float* cp = cs + pos * 32 + 8 * fq;
                        const f32x4 c0 = *(const LAS f32x4*)cp, c1 = *(const LAS f32x4*)(cp + 4), s0 = *(const LAS f32x4*)(cp + 2048), s1 = *(const LAS f32x4*)(cp + 2052);
                        o1a = (x1a * c0 - x2a * s0) * sc; o1b = (x1b * c1 - x2b * s1) * sc; o2a = (x1a * s0 + x2a * c0) * sc; o2b = (x1b * s1 + x2b * c1) * sc;
                    } else { o1a = x1a * sc; o1b = x1b * sc; o2a = x2a * sc; o2b = x2b * sc; }
                    bf16* dst = base + (size_t)row * RW + (2 * ct + (wc >> 1)) * HD + 32 * (wc & 1) + 8 * fq;
                    *(u32x4*)dst = pack8(o1a, o1b); *(u32x4*)(dst + 64) = pack8(o2a, o2b);
                } else {
#pragma unroll
                    for (int bj = 0; bj < 2; ++bj) {
                        f32x4 v0 = acc[ai][bj][m][0], v1 = acc[ai][bj][m][1];
                        if (sec == 3) {
#pragma unroll
                            for (int j = 0; j < 4; ++j) { v0[j] = silu_f(v0[j]); v1[j] = silu_f(v1[j]); }
                        } else if (sec >= 4) {
#pragma unroll
                            for (int j = 0; j < 4; ++j) { v0[j] = gelu_tanh_f(v0[j]); v1[j] = gelu_tanh_f(v1[j]); }
                        }
                        *(u32x4*)(base + (size_t)row * RW + ct * 256 + bj * HALF + wc * 32 + 8 * fq) = pack8(v0, v1);
                    }
                }
            }
    }
};
struct EpiRes {
    bf16* X; const float* base_f32; const float* gate;
    __device__ __forceinline__ void operator()(AccRef acc, const Unit& u, int wr, int wc, int fr, int fq) const {
        const int r = u.pm >> 4; const int col0 = u.pn * BM + wc * 32 + 8 * fq;
        const float* gp = gate + (size_t)r * MODW + col0;
        const size_t ro = (size_t)(u.pm * BM + wr * 64 + fr) * D + col0;
#pragma unroll
        for (int bj = 0; bj < 2; ++bj) {
            const f32x4 g0 = *(const f32x4*)(gp + bj * HALF), g1 = *(const f32x4*)(gp + bj * HALF + 4);
            f32x4 x0[2][4], x1[2][4];
            if (base_f32) {
#pragma unroll
                for (int ai = 0; ai < 2; ++ai)
#pragma unroll
                    for (int m = 0; m < 4; ++m) { const float* bp = base_f32 + ro + (size_t)(ai * HALF + m * 16) * D + bj * HALF; x0[ai][m] = *(const f32x4*)bp; x1[ai][m] = *(const f32x4*)(bp + 4); }
            } else {
#pragma unroll
                for (int ai = 0; ai < 2; ++ai)
#pragma unroll
                    for (int m = 0; m < 4; ++m) { const u32x4 p = *(const u32x4*)(X + ro + (size_t)(ai * HALF + m * 16) * D + bj * HALF); u32x2 lo, hi; lo.x = p.x; lo.y = p.y; hi.x = p.z; hi.y = p.w; x0[ai][m] = bf4_to_f32(lo); x1[ai][m] = bf4_to_f32(hi); }
            }
#pragma unroll
            for (int ai = 0; ai < 2; ++ai)
#pragma unroll
                for (int m = 0; m < 4; ++m) *(u32x4*)(X + ro + (size_t)(ai * HALF + m * 16) * D + bj * HALF) = pack8(x0[ai][m] + g0 * acc[ai][bj][m][0], x1[ai][m] + g1 * acc[ai][bj][m][1]);
        }
    }
};
struct EpiCV {
    bf16* GB; bf16* XG;
    __device__ __forceinline__ void operator()(AccRef acc, const Unit& u, int wr, int wc, int fr, int fq) const {
#pragma unroll
        for (int ai = 0; ai < 2; ++ai)
#pragma unroll
            for (int m = 0; m < 4; ++m) { const size_t row = (size_t)(u.pm * BM + ai * HALF + wr * 64 + m * 16 + fr);
                if (u.pn < 8) {
#pragma unroll
                    for (int bj = 0; bj < 2; ++bj) *(u32x4*)(GB + row * D + u.pn * 256 + bj * HALF + wc * 32 + 8 * fq) = pack8(acc[ai][bj][m][0], acc[ai][bj][m][1]);
                } else {
                    *(u32x4*)(XG + row * D + (u.pn - 8) * HALF + wc * 32 + 8 * fq) = pack8(acc[ai][0][m][0] * acc[ai][1][m][0], acc[ai][0][m][1] * acc[ai][1][m][1]);
                } }
    }
};
struct EpiMoe1 {
    unsigned char* H;
    __device__ __forceinline__ void operator()(AccRef acc, const Unit& u, int wr, int wc, int fr, int fq) const {
#pragma unroll
        for (int ai = 0; ai < 2; ++ai)
#pragma unroll
            for (int m = 0; m < 4; ++m) { const size_t row = (size_t)(u.pm * BM + ai * HALF + wr * 64 + m * 16 + fr);
                f32x4 a0 = acc[ai][0][m][0], a1 = acc[ai][0][m][1];
#pragma unroll
                for (int j = 0; j < 4; ++j) { a0[j] = silu_f(a0[j]); a1[j] = silu_f(a1[j]); }
                *(u32x2*)(H + row * DE + u.pn * HALF + wc * 32 + 8 * fq) = pack8_fp8(a0 * acc[ai][1][m][0], a1 * acc[ai][1][m][1]); }
    }
};
struct EpiMoe2 {
    bf16* Y;
    __device__ __forceinline__ void operator()(AccRef acc, const Unit& u, int wr, int wc, int fr, int fq) const {
#pragma unroll
        for (int ai = 0; ai < 2; ++ai)
#pragma unroll
            for (int m = 0; m < 4; ++m) { const size_t row = (size_t)(u.pm * BM + ai * HALF + wr * 64 + m * 16 + fr);
#pragma unroll
                for (int bj = 0; bj < 2; ++bj) *(u32x4*)(Y + row * D + u.pn * 256 + bj * HALF + wc * 32 + 8 * fq) = pack8(acc[ai][bj][m][0], acc[ai][bj][m][1]); }
    }
};
}

#define XB_TMO      128
#define XB_XCNT(j)  (256  + 64 * (j))
#define XB_XSUB(j)  (1280 + 64 * (j))
#define XB_XGEN(j)  (2304 + 64 * (j))
#define XB_TOP      3328
#define XB_TOPGEN   3392
#define XCD_BAR_WORDS 3456
#define XB_SPIN_CAP (1u << 18)
__device__ __forceinline__ unsigned xb_ld(unsigned* p)              { return __hip_atomic_load(p, __ATOMIC_RELAXED, __HIP_MEMORY_SCOPE_AGENT); }
__device__ __forceinline__ unsigned xb_add(unsigned* p, unsigned v) { return __hip_atomic_fetch_add(p, v, __ATOMIC_RELAXED, __HIP_MEMORY_SCOPE_AGENT); }
__device__ __forceinline__ unsigned xb_xcc_id() { return (unsigned)__builtin_amdgcn_s_getreg((3 << 11) | 20) & 0xFu; }
#define XB_SPIN(cond, bar) do { unsigned _sp = 0; while (cond) { __builtin_amdgcn_s_sleep(1); \
    if ((++_sp & 255u) == 0u) { if (xb_ld(&(bar)[XB_TMO])) break; if (_sp > XB_SPIN_CAP) { atomicAdd(&(bar)[XB_TMO], 1u); break; } } } } while (0)
struct XcdBarrier { unsigned* bar; unsigned x; volatile LAS unsigned* st; };
__device__ __forceinline__ XcdBarrier xcd_barrier_post(unsigned* bar, volatile LAS unsigned* st) {
    XcdBarrier b; b.bar = bar; b.x = xb_xcc_id(); b.st = st;
    if (threadIdx.x == 0) (void)xb_add(&bar[XB_XCNT(b.x)], 1u);
    return b;
}
__device__ __forceinline__ void xcd_barrier_complete(unsigned* bar, unsigned x, unsigned& nloc, unsigned& nx) {
    const unsigned G = gridDim.x * gridDim.y * gridDim.z;
    unsigned sum, cnt, mine, sp = 0u;
    for (;;) {
        sum = 0u; cnt = 0u; mine = 0u;
#pragma unroll
        for (unsigned j = 0; j < 16; ++j) { const unsigned c = xb_ld(&bar[XB_XCNT(j)]); sum += c; cnt += (c > 0u) ? 1u : 0u; mine = (j == x) ? c : mine; }
        if (sum == G) break;
        __builtin_amdgcn_s_sleep(1);
        if ((++sp & 255u) == 0u) { if (xb_ld(&bar[XB_TMO])) break; if (sp > XB_SPIN_CAP) { atomicAdd(&bar[XB_TMO], 1u); break; } }
    }
    nloc = mine > 0u ? mine : 1u; nx = cnt > 0u ? cnt : 1u;
}
__device__ __forceinline__ void xcd_barrier(const XcdBarrier& b) {
    asm volatile("s_waitcnt vmcnt(0)" ::: "memory");
    __syncthreads();
    if (threadIdx.x == 0) {
        unsigned* bar = b.bar;
        __builtin_amdgcn_s_waitcnt(0);
        unsigned nloc = b.st[0], nx = b.st[1];
        if (nloc == 0u) { xcd_barrier_complete(bar, b.x, nloc, nx); b.st[0] = nloc; b.st[1] = nx; }
        const unsigned old = xb_add(&bar[XB_XSUB(b.x)], 1u);
        const unsigned gen = old / nloc;
        if (old + 1u == (gen + 1u) * nloc) {
            __builtin_amdgcn_fence(__ATOMIC_RELEASE, "agent");
            asm volatile("s_waitcnt vmcnt(0)" ::: "memory");
            const unsigned og = xb_add(&bar[XB_TOP], 1u);
            const unsigned tg = og / nx;
            if (og + 1u == (tg + 1u) * nx) xb_add(&bar[XB_TOPGEN], 1u);
            else XB_SPIN(xb_ld(&bar[XB_TOPGEN]) == tg, bar);
            __builtin_amdgcn_fence(__ATOMIC_ACQUIRE, "agent");
            xb_add(&bar[XB_XGEN(b.x)], 1u);
            asm volatile("s_waitcnt vmcnt(0)" ::: "memory");
        } else {
            XB_SPIN(xb_ld(&bar[XB_XGEN(b.x)]) == gen, bar);
            __builtin_amdgcn_fence(__ATOMIC_ACQUIRE, "agent");
            asm volatile("s_waitcnt vmcnt(0)" ::: "memory");
        }
    }
    __syncthreads();
}

struct Args {
    const float *x, *c, *ctx, *c_ctx, *w_mod, *b_mod, *g_mix, *g_ffn, *ab_w_in, *ab_w_out, *decay, *sgu_w, *sgu_b,
                *cv_w_in, *cv_cw, *cv_cb, *cv_w_out, *w_r1, *b_r1, *w_r2, *b_r2, *w1, *w3, *w2, *g_final;
    float* out; unsigned char* ws; int ph_lo, ph_hi;
};
struct Frame { LAS unsigned char* lds; volatile LAS unsigned* MISC; int wave, G, blk; };
#define FR_LANE_TID const int lane_ = lane_id(); const int tid_ = F.wave * 64 + lane_

enum { PH_PRO = 0, PH_L0 = 1, PH_PER_LAYER = 10, PH_FINAL = 21, NPHASE = 22 };
enum { K_PRE = 0, K_GIN = 1, K_MID1 = 2, K_MID1B = 3, K_MID2 = 4, K_MID3 = 5, K_GOUT = 6, K_ROUTE = 7, K_MOE1 = 8, K_MOE2 = 9 };

__device__ __forceinline__ int pos32(int x) { return 16 * ((x >> 2) & 1) + 4 * (x >> 3) + (x & 3); }
constexpr int I_IN = 32 * 192, I_OUT = 32 * 64, I_FIX = 2 * I_IN + 2 * I_OUT, I_EXP = 3072, I_MOE = 16 * I_EXP, NITEMS = I_FIX + 2 * I_MOE;
struct ItemDesc { const float* src; unsigned char* dst; int N, K, k0, dgrp, fp8; };
__device__ __forceinline__ ItemDesc decode_item(const Args& a, int it) {
    unsigned char* ws = a.ws; ItemDesc d; int kb, nb;
    if (it < I_IN) {
        kb = it / 192; nb = it % 192; const int n = nb * 32, sec = n >> 10;
        if (sec < 2) { const int h = (n & 1023) >> 7, dgi = (n & 127) >> 5; d.dgrp = (sec * 4 + (h >> 1)) * 8 + (dgi >> 1) * 4 + (h & 1) * 2 + (dgi & 1); } else d.dgrp = nb;
        d.src = a.ab_w_in; d.N = 6144; d.K = D; d.dst = ws + WS_WAB_IN; d.fp8 = 0;
    } else if (it < I_IN + I_OUT) { const int r = it - I_IN; kb = r / 64; nb = r % 64; d.dgrp = nb; d.src = a.ab_w_out; d.N = D; d.K = D; d.dst = ws + WS_WAB_OUT; d.fp8 = 0;
    } else if (it < 2 * I_IN + I_OUT) {
        const int r = it - I_IN - I_OUT; kb = r / 192; nb = r % 192; const int n = nb * 32;
        if (n < 2048) d.dgrp = nb; else if (n < 4096) { const int cc = n - 2048; d.dgrp = (8 + (cc >> 7)) * 8 + ((cc & 127) >> 5); } else { const int cc = n - 4096; d.dgrp = (8 + (cc >> 7)) * 8 + 4 + ((cc & 127) >> 5); }
        d.src = a.cv_w_in; d.N = 6144; d.K = D; d.dst = ws + WS_WCV_IN; d.fp8 = 0;
    } else if (it < I_FIX) { const int r = it - 2 * I_IN - I_OUT; kb = r / 64; nb = r % 64; d.dgrp = nb; d.src = a.cv_w_out; d.N = D; d.K = D; d.dst = ws + WS_WCV_OUT; d.fp8 = 0;
    } else {
        const int idx = it - I_FIX; const int le = idx / I_EXP, r = idx % I_EXP, which = r >> 10, item = r & 1023; d.fp8 = 1;
        if (which < 2) {
            kb = item >> 5; nb = item & 31; const int cc = nb * 32; d.dgrp = (cc >> 7) * 8 + which * 4 + ((cc & 127) >> 5);
            d.src = (which ? a.w3 : a.w1) + (size_t)le * D * DE; d.N = DE; d.K = D; d.dst = ws + WS_W13 + (size_t)le * D * D;
        } else {
            kb = item >> 6; nb = item & 63; d.dgrp = nb; d.src = a.w2 + (size_t)le * DE * D; d.N = D; d.K = DE; d.dst = ws + WS_W2 + (size_t)le * D * DE;
        }
    }
    d.k0 = 64 * kb; d.src += (size_t)d.k0 * d.N + 32 * nb;
    return d;
}
__device__ __forceinline__ void item_load(const ItemDesc& d, f32x4 (&v)[8], int lane) {
    const float* src = d.src + (size_t)(8 * (lane >> 3)) * d.N + 4 * (lane & 7);
#pragma unroll
    for (int i = 0; i < 8; ++i) v[i] = __builtin_nontemporal_load((const f32x4*)(src + (size_t)i * d.N));
}
__device__ __forceinline__ void item_finish(const ItemDesc& d, const f32x4 (&v)[8], LAS float* scr, int lane) {
    (void)scr;
    const int kq = 8 * (lane >> 3), nq = 4 * (lane & 7);
    if (d.fp8) {
#pragma unroll
        for (int j = 0; j < 4; ++j) { u32x2 o; o.x = pk4_fp8(v[0][j] * W8_SCALE, v[1][j] * W8_SCALE, v[2][j] * W8_SCALE, v[3][j] * W8_SCALE); o.y = pk4_fp8(v[4][j] * W8_SCALE, v[5][j] * W8_SCALE, v[6][j] * W8_SCALE, v[7][j] * W8_SCALE);
            __builtin_nontemporal_store(o, (u32x2*)(d.dst + (size_t)(d.dgrp * 32 + pos32(nq + j)) * d.K + d.k0 + kq)); }
    } else {
#pragma unroll
        for (int j = 0; j < 4; ++j) { u32x4 o; o.x = cvt_pk_bf16(v[0][j], v[1][j]); o.y = cvt_pk_bf16(v[2][j], v[3][j]); o.z = cvt_pk_bf16(v[4][j], v[5][j]); o.w = cvt_pk_bf16(v[6][j], v[7][j]);
            __builtin_nontemporal_store(o, (u32x4*)((bf16*)d.dst + (size_t)(d.dgrp * 32 + pos32(nq + j)) * d.K + d.k0 + kq)); }
    }
}
__device__ __forceinline__ void convert_items(const Args& a, Frame& F, int it0, int it1, int stride) {
    const int lane = lane_id(); LAS float* scr = (LAS float*)(F.lds + F.wave * 8448);
    if (it0 >= it1) return;
    f32x4 vc[8], vn[8]; ItemDesc cur = decode_item(a, it0); item_load(cur, vc, lane);
    for (int it = it0; it < it1; it += stride) {
        const bool hn = it + stride < it1; const ItemDesc nxt = decode_item(a, hn ? it + stride : it);
        if (hn) item_load(nxt, vn, lane);
        item_finish(cur, vc, scr, lane);
        cur.src = nxt.src; cur.dst = nxt.dst; cur.N = nxt.N; cur.K = nxt.K; cur.k0 = nxt.k0; cur.dgrp = nxt.dgrp; cur.fp8 = nxt.fp8;
#pragma unroll
        for (int i = 0; i < 8; ++i) vc[i] = vn[i];
    }
}
constexpr int TAIL_N1 = 0, TAIL_N2 = 0, TAIL_T1 = 160 * 8 * TAIL_N1, TAIL_T2 = 224 * 8 * TAIL_N2;
static_assert(TAIL_T1 + TAIL_T2 <= I_MOE, "tail shares");
__device__ __forceinline__ void phase_prologue(const Args& a, Frame& F) {
    FR_LANE_TID;
    unsigned char* ws = a.ws;
    {
        LAS float* S = (LAS float*)(F.lds + 69632);
        LAS float* red = (LAS float*)(F.lds + 110592);
        for (int i = tid_; i < 5 * D; i += 512) { const int r = i / D, k = i % D; const float v = r < 4 ? a.c[r * D + k] : a.c_ctx[k]; S[i] = silu_f(v); }
        __syncthreads();
        if (F.blk < 256) {
            const int Lm = F.blk >> 7, strip = F.blk & 127;
            const int rsub = lane_ / 24, c4 = lane_ % 24;
            float acc[5][4];
#pragma unroll
            for (int r = 0; r < 5; ++r) { acc[r][0] = 0.f; acc[r][1] = 0.f; acc[r][2] = 0.f; acc[r][3] = 0.f; }
            if (rsub < 2) {
                const float* wp = a.w_mod + (size_t)Lm * D * MODW + (size_t)(256 * F.wave + rsub) * MODW + 96 * strip + 4 * c4;
#pragma unroll 8
                for (int it = 0; it < 128; ++it) {
                    const f32x4 w = __builtin_nontemporal_load((const f32x4*)(wp + (size_t)(2 * it) * MODW));
                    const int k = 256 * F.wave + 2 * it + rsub;
#pragma unroll
                    for (int r = 0; r < 5; ++r) { const float s = S[r * D + k]; acc[r][0] += s * w[0]; acc[r][1] += s * w[1]; acc[r][2] += s * w[2]; acc[r][3] += s * w[3]; }
                }
#pragma unroll
                for (int r = 0; r < 5; ++r)
#pragma unroll
                    for (int j = 0; j < 4; ++j) red[(F.wave * 2 + rsub) * 480 + r * 96 + 4 * c4 + j] = acc[r][j];
            }
            __syncthreads();
            if (tid_ < 480) { float s = 0.f;
#pragma unroll
                for (int p = 0; p < 16; ++p) s += red[p * 480 + tid_];
                const int r = tid_ / 96, cc = tid_ % 96; const int col = 96 * strip + cc;
                ((float*)(ws + WS_MOD))[(size_t)(Lm * 5 + r) * MODW + col] = s + a.b_mod[Lm * MODW + col]; }
        }
        __syncthreads();
    }
    {
        const int gt = F.blk * 512 + tid_, NT = F.G * 512;
        float* cs = (float*)(ws + WS_ROPE);
        for (int i = gt; i < 2048; i += NT) { const int pos = i >> 5, f = i & 31; const float inv = powf(10000.0f, -(float)f / 32.0f); const float ang = (float)pos * inv; cs[i] = cosf(ang); cs[2048 + i] = sinf(ang); }
        float* wr = (float*)(ws + WS_WR);
        for (int i = gt; i < 2 * 20 * D; i += NT) { const int L = i / (20 * D), r = (i / D) % 20, k = i % D;
            float v; if (r < 4) v = a.w_r1[((size_t)L * D + k) * 4 + r]; else { const int g = (r - 4) >> 2, e = (r - 4) & 3; v = a.w_r2[(((size_t)L * 4 + g) * D + k) * 4 + e]; }
            wr[i] = v; }
    }
    {
        const int gw = F.blk * 8 + F.wave, NGW = F.G * 8;
        constexpr int R0 = I_MOE - TAIL_T1 - TAIL_T2;
        constexpr int NPRO = I_FIX + R0 + I_MOE;
        int v0 = gw;
        if (v0 < I_FIX) { const int n = (I_FIX - v0 + NGW - 1) / NGW; convert_items(a, F, v0, I_FIX, NGW); v0 += n * NGW; }
        if (v0 < I_FIX + R0) { const int n = (I_FIX + R0 - v0 + NGW - 1) / NGW; convert_items(a, F, v0 + TAIL_T1 + TAIL_T2, I_FIX + I_MOE, NGW); v0 += n * NGW; }
        if (v0 < NPRO) convert_items(a, F, v0 - R0 + I_MOE, NITEMS, NGW);
    }
}

__device__ __forceinline__ int moe_tables(const Args& a, Frame& F, int L) {
    FR_LANE_TID;
    volatile LAS int* tb = (volatile LAS int*)(F.MISC + MI_TB); volatile LAS int* texp = (volatile LAS int*)(F.MISC + MI_TEXP); volatile LAS int* cn = (volatile LAS int*)(F.MISC + MI_LCNT);
    __syncthreads();
    if (tid_ == 0) { unsigned* cnt = (unsigned*)(a.ws + WS_CTL) + CW_CNT + L * 16 * 64; int acc = 0;
        for (int e = 0; e < NE; ++e) { tb[e] = acc; const int c = (int)xb_ld(cnt + e * 64); cn[e] = c; const int n = (c + 255) >> 8; for (int t = 0; t < n && acc + t < 160; ++t) texp[acc + t] = e; acc += n; }
        tb[NE] = acc; }
    __syncthreads();
    return tb[NE];
}
__device__ __forceinline__ float row_rstd(const f32x4 (&v)[8]) {
    float ss = 0.f;
#pragma unroll
    for (int j = 0; j < 8; ++j) ss += (v[j][0] * v[j][0] + v[j][1] * v[j][1]) + (v[j][2] * v[j][2] + v[j][3] * v[j][3]);
    return rsqrtf(wave_sum(ss) * (1.0f / D) + EPSN);
}
struct RowBuf { u32x2 xb[8], y0[8], y1[8]; f32x2 w; };
__device__ __forceinline__ void rowbuf_issue(RowBuf& b, const bf16* XB, const bf16* Y, const int* ridx, const float* rwt, const volatile LAS int* tb, int row, int ln4) {
    const i32x4 ri = *(const i32x4*)(ridx + 4 * (size_t)row); b.w = *(const f32x2*)(rwt + 2 * (size_t)row);
    const int d0 = tb[ri.x] * 256 + ri.y, d1 = tb[ri.z] * 256 + ri.w;
#pragma unroll
    for (int j = 0; j < 8; ++j) { b.xb[j] = *(const u32x2*)(XB + (size_t)row * D + ln4 + 256 * j); b.y0[j] = *(const u32x2*)(Y + (size_t)d0 * D + ln4 + 256 * j); b.y1[j] = *(const u32x2*)(Y + (size_t)d1 * D + ln4 + 256 * j); }
}
__device__ __forceinline__ void rowbuf_combine(const RowBuf& b, const f32x4 (&gate)[8], f32x4 (&v)[8]) {
#pragma unroll
    for (int j = 0; j < 8; ++j) v[j] = bf4_to_f32(b.xb[j]) + gate[j] * (bf4_to_f32(b.y0[j]) * b.w.x + bf4_to_f32(b.y1[j]) * b.w.y);
}
__device__ __forceinline__ void phase_pre(const Args& a, Frame& F, int L) {
    FR_LANE_TID;
    unsigned char* ws = a.ws; bf16* XB = (bf16*)(ws + WS_XB); bf16* A = (bf16*)(ws + WS_A);
    const float* MOD = (const float*)(ws + WS_MOD);
    if (L == 0) {
        const int nrows = NTOK; const int gw = F.blk * 8 + F.wave, NGW = F.G * 8;
        f32x4 vn[8];
        if (gw < nrows) { const float* src = gw < NLAT ? a.x + (size_t)gw * D : a.ctx + (size_t)(gw - NLAT) * D;
#pragma unroll
            for (int j = 0; j < 8; ++j) vn[j] = *(const f32x4*)(src + 4 * lane_ + 256 * j); }
        for (int row = gw; row < nrows; row += NGW) {
            const int r = row < NLAT ? row >> 12 : 4;
            int ln4 = 4 * lane_; asm volatile("" : "+v"(ln4));
            f32x4 v[8];
#pragma unroll
            for (int j = 0; j < 8; ++j) v[j] = vn[j];
            { const int rn = row + NGW; if (rn < nrows) { const float* src = rn < NLAT ? a.x + (size_t)rn * D : a.ctx + (size_t)(rn - NLAT) * D;
#pragma unroll
                for (int j = 0; j < 8; ++j) vn[j] = *(const f32x4*)(src + ln4 + 256 * j); } }
            const float rstd = row_rstd(v);
            const float* mp = MOD + (size_t)r * MODW; const float* gm = a.g_mix;
#pragma unroll
            for (int j = 0; j < 8; ++j) { const int c = ln4 + 256 * j; const f32x4 g = *(const f32x4*)(gm + c), sh = *(const f32x4*)(mp + c), sc = *(const f32x4*)(mp + D + c);
                *(u32x2*)(A + (size_t)row * D + c) = f32_to_bf4(v[j] * rstd * g * (sc + 1.0f) + sh); }
        }
    } else {
        (void)moe_tables(a, F, L - 1);
        const volatile LAS int* tb = (const volatile LAS int*)(F.MISC + MI_TB);
        const int RPB = NLAT / F.G, r = (F.blk * RPB) >> 12;
        const bf16* Y = (const bf16*)(ws + WS_R2); const int* ridx = (const int*)(ws + WS_RIDX) + (size_t)(L - 1) * NTOK * 4; const float* rwt = (const float*)(ws + WS_RWT) + (size_t)(L - 1) * NTOK * 2;
        const float* mp = MOD + (size_t)(L * 5 + r) * MODW;
        f32x4 gate[8], Gm[8];
#pragma unroll
        for (int j = 0; j < 8; ++j) { const int c = 4 * lane_ + 256 * j; gate[j] = *(const f32x4*)(MOD + (size_t)((L - 1) * 5 + r) * MODW + 5 * D + c); Gm[j] = *(const f32x4*)(a.g_mix + L * D + c) * (*(const f32x4*)(mp + D + c) + 1.0f); }
        RowBuf bA, bB;
        const int row0 = F.blk * RPB + F.wave;
        if (F.wave < RPB) rowbuf_issue(bA, XB, Y, ridx, rwt, tb, row0, 4 * lane_);
        for (int i = F.wave; i < RPB; i += 16) {
            int ln4 = 4 * lane_; asm volatile("" : "+v"(ln4));
            const int row = F.blk * RPB + i;
            if (i + 8 < RPB) rowbuf_issue(bB, XB, Y, ridx, rwt, tb, row + 8, ln4);
            { f32x4 v[8]; rowbuf_combine(bA, gate, v);
#pragma unroll
              for (int j = 0; j < 8; ++j) *(u32x2*)(XB + (size_t)row * D + ln4 + 256 * j) = f32_to_bf4(v[j]);
              const float rstd = row_rstd(v);
#pragma unroll
              for (int j = 0; j < 8; ++j) { const int c = ln4 + 256 * j; *(u32x2*)(A + (size_t)row * D + c) = f32_to_bf4(v[j] * rstd * Gm[j] + *(const f32x4*)(mp + c)); } }
            if (i + 8 >= RPB) break;
            if (i + 16 < RPB) rowbuf_issue(bA, XB, Y, ridx, rwt, tb, row + 16, ln4);
            { f32x4 v[8]; rowbuf_combine(bB, gate, v);
#pragma unroll
              for (int j = 0; j < 8; ++j) *(u32x2*)(XB + (size_t)(row + 8) * D + ln4 + 256 * j) = f32_to_bf4(v[j]);
              const float rstd = row_rstd(v);
#pragma unroll
              for (int j = 0; j < 8; ++j) { const int c = ln4 + 256 * j; *(u32x2*)(A + (size_t)(row + 8) * D + c) = f32_to_bf4(v[j] * rstd * Gm[j] + *(const f32x4*)(mp + c)); } }
        }
    }
}

constexpr int LDP = 136;
constexpr int IMG = 128 * LDP * 2;
__device__ __forceinline__ int swz_col(int r, int j) { return 8 * (((j >> 3) ^ (r >> 3)) & 15) + (j & 7); }
__device__ __forceinline__ int unit_row0(int b, int s) { return s < 2 ? NLAT + b * TCX + s * 128 : b * TL + (s - 2) * 128; }
__device__ __forceinline__ void piece_rc(int q, int& j, int& ch) { const int jr = q & 15, cq = (q >> 4) & 3, blk = q >> 6; j = 16 * (blk & 7) + jr; ch = 4 * (blk >> 3) + cq; }

__device__ __forceinline__ int unit_lat(int v) { return (v >> 5) * NSLOT + 2 + (v & 31); }
__device__ __forceinline__ int unit_ctx(int i) { return (i >> 1) * NSLOT + (i & 1); }
struct RU { u32x4 kv[4], vv[4]; };
__device__ __forceinline__ void ret_u_load(const Args& a, Frame& F, int u, RU& r) {
    FR_LANE_TID;
    const bf16* Z = (const bf16*)(a.ws + WS_R1);
    const int bh = u / NSLOT, s = u % NSLOT, b = bh >> 3, h = bh & 7; const int row0 = unit_row0(b, s);
    const int jq = 4 * F.wave + (lane_ >> 4), ch = lane_ & 15;
    const bf16* Kp = Z + 1 * ZSEC + (size_t)(row0 + 4 * jq) * RW + h * HD + 8 * ch; const bf16* Vp = Z + 2 * ZSEC + (size_t)(row0 + 4 * jq) * RW + h * HD + 8 * ch;
#pragma unroll
    for (int k = 0; k < 4; ++k) { r.kv[k] = *(const u32x4*)(Kp + (size_t)k * RW); r.vv[k] = *(const u32x4*)(Vp + (size_t)k * RW); }
}
template <bool CTX>
__device__ __forceinline__ int ret_u_body(const Args& a, Frame& F, int u, RU& r, const volatile LAS unsigned* nslot, int nlimit) {
    FR_LANE_TID;
    unsigned char* ws = a.ws;
    const int h = (u / NSLOT) & 7;
    const float lgf2 = logsig(a.decay[h]) * LOG2E, lgb2 = logsig(a.decay[NH + h]) * LOG2E;
    LAS bf16* KTf = (LAS bf16*)(F.lds); LAS bf16* KTb = (LAS bf16*)(F.lds + IMG); LAS bf16* VT = (LAS bf16*)(F.lds + 2 * IMG);
    { const int jq = 4 * F.wave + (lane_ >> 4), ch = lane_ & 15; const int col = 8 * (((jq >> 1) ^ ch) & 15) + 4 * (jq & 1);
      float ff[4], fb[4];
#pragma unroll
      for (int k = 0; k < 4; ++k) { const int j = 4 * jq + k; ff[k] = exp2f((float)(127 - j) * lgf2); fb[k] = exp2f((float)j * lgb2); }
#pragma unroll
      for (int i = 0; i < 8; ++i) { const unsigned sh = (i & 1) ? 16u : 0u; float kf[4]; unsigned vw[4];
#pragma unroll
          for (int k = 0; k < 4; ++k) { kf[k] = bf2f((r.kv[k][i >> 1] >> sh) & 0xffffu); vw[k] = (r.vv[k][i >> 1] >> sh) & 0xffffu; }
          u32x2 pf, pb, pv; pf.x = cvt_pk_bf16(kf[0] * ff[0], kf[1] * ff[1]); pf.y = cvt_pk_bf16(kf[2] * ff[2], kf[3] * ff[3]);
          pb.x = cvt_pk_bf16(kf[0] * fb[0], kf[1] * fb[1]); pb.y = cvt_pk_bf16(kf[2] * fb[2], kf[3] * fb[3]); pv.x = vw[0] | (vw[1] << 16); pv.y = vw[2] | (vw[3] << 16);
          const int o = (8 * ch + i) * LDP + col;
          *(LAS u32x2*)(KTf + o) = pf; *(LAS u32x2*)(KTb + o) = pb; *(LAS u32x2*)(VT + o) = pv; } }
    __syncthreads();
    const int nxt = (int)nslot[0];
    if (nxt < nlimit) ret_u_load(a, F, CTX ? unit_ctx(nxt) : unit_lat(nxt), r);
    const int fr = lane_ & 15, g = lane_ >> 4, dt = F.wave;
    f32x4 accf[8], accb[8];
#pragma unroll
    for (int e = 0; e < 8; ++e) { accf[e] = (f32x4){0.f, 0.f, 0.f, 0.f}; accb[e] = (f32x4){0.f, 0.f, 0.f, 0.f}; }
#pragma unroll
    for (int sI = 0; sI < 4; ++sI) {
        const int ad = (16 * dt + fr) * LDP + swz_col(16 * dt + fr, 32 * sI + 8 * g);
        const bf16x8 af = *(const LAS bf16x8*)(KTf + ad), ab = *(const LAS bf16x8*)(KTb + ad);
#pragma unroll
        for (int et = 0; et < 8; ++et) { const bf16x8 bv = *(const LAS bf16x8*)(VT + (16 * et + fr) * LDP + swz_col(16 * et + fr, 32 * sI + 8 * g));
            accf[et] = __builtin_amdgcn_mfma_f32_16x16x32_bf16(af, bv, accf[et], 0, 0, 0); accb[et] = __builtin_amdgcn_mfma_f32_16x16x32_bf16(ab, bv, accb[et], 0, 0, 0); }
    }
    bf16* ST = (bf16*)(ws + WS_R2) + (size_t)u * 2 * 16384;
    float one; asm volatile("v_mov_b32 %0, 1.0" : "=v"(one));
#pragma unroll
    for (int et = 0; et < 8; ++et) { *(u32x2*)(ST + (size_t)(16 * et + fr) * 128 + 16 * dt + 4 * g) = f32_to_bf4(accf[et] * one); *(u32x2*)(ST + 16384 + (size_t)(16 * et + fr) * 128 + 16 * dt + 4 * g) = f32_to_bf4(accb[et] * one); }
    __syncthreads();
    return nxt;
}
struct SU { f32x4 w[8]; u32x4 vv[4]; };
__device__ __forceinline__ void sgu_load(const Args& a, Frame& F, int u, SU& r) {
    FR_LANE_TID;
    const bf16* Z = (const bf16*)(a.ws + WS_R1);
    const int bg = u / NSLOT, s = u % NSLOT, b = bg >> 3, grp = bg & 7; const int row0 = unit_row0(b, s);
    const int qq = 4 * F.wave + (lane_ >> 4), cc = lane_ & 15;
    const bf16* Vp = Z + 5 * ZSEC + (size_t)(row0 + 4 * qq) * RW + grp * HD + 8 * cc; const float* wsrc = a.sgu_w + (size_t)grp * 16384;
#pragma unroll
    for (int k = 0; k < 8; ++k) { const int i4 = tid_ + 512 * k; r.w[k] = *(const f32x4*)(wsrc + (i4 >> 5) * 128 + (i4 & 31) * 4); }
#pragma unroll
    for (int k = 0; k < 4; ++k) r.vv[k] = *(const u32x4*)(Vp + (size_t)k * RW);
}
__device__ __forceinline__ int sgu_body(const Args& a, Frame& F, int u, SU& r, const volatile LAS unsigned* nslot, int nlimit) {
    FR_LANE_TID;
    unsigned char* ws = a.ws; const bf16* Z = (const bf16*)(ws + WS_R1); bf16* RS = (bf16*)(ws + WS_R3);
    const int bg = u / NSLOT, s = u % NSLOT, b = bg >> 3, grp = bg & 7; const int row0 = unit_row0(b, s);
    const bf16* Up = Z + 4 * ZSEC + (size_t)row0 * RW + grp * HD;
    LAS bf16* WS_ = (LAS bf16*)(F.lds); LAS bf16* VT = (LAS bf16*)(F.lds + IMG);
#pragma unroll
    for (int k = 0; k < 8; ++k) { const int i4 = tid_ + 512 * k; const int p = i4 >> 5, q4 = (i4 & 31) * 4; const f32x4 w = r.w[k];
        u32x2 o; o.x = cvt_pk_bf16(w[0], w[1]); o.y = cvt_pk_bf16(w[2], w[3]); *(LAS u32x2*)(WS_ + p * LDP + q4) = o; }
    { const int qq = 4 * F.wave + (lane_ >> 4), cc = lane_ & 15; const int col = 8 * (((qq >> 1) ^ cc) & 15) + 4 * (qq & 1);
      float x[4][8], mu[4], rstd[4];
#pragma unroll
      for (int k = 0; k < 4; ++k) { float sm = 0.f;
#pragma unroll
          for (int i = 0; i < 8; ++i) { x[k][i] = bf2f((r.vv[k][i >> 1] >> ((i & 1) ? 16u : 0u)) & 0xffffu); sm += x[k][i]; }
          sm += dpp_mov<0xB1>(sm); sm += dpp_mov<0x4E>(sm); sm += dpp_mov<0x141>(sm); sm += dpp_mov<0x140>(sm); mu[k] = sm * (1.0f / 128.0f); }
#pragma unroll
      for (int k = 0; k < 4; ++k) { float sq = 0.f;
#pragma unroll
          for (int i = 0; i < 8; ++i) { const float dl = x[k][i] - mu[k]; sq += dl * dl; }
          sq += dpp_mov<0xB1>(sq); sq += dpp_mov<0x4E>(sq); sq += dpp_mov<0x141>(sq); sq += dpp_mov<0x140>(sq); rstd[k] = rsqrtf(sq * (1.0f / 128.0f) + EPSN); }
#pragma unroll
      for (int i = 0; i < 8; ++i) { u32x2 pv; pv.x = cvt_pk_bf16((x[0][i] - mu[0]) * rstd[0], (x[1][i] - mu[1]) * rstd[1]); pv.y = cvt_pk_bf16((x[2][i] - mu[2]) * rstd[2], (x[3][i] - mu[3]) * rstd[3]);
          *(LAS u32x2*)(VT + (8 * cc + i) * LDP + col) = pv; } }
    __syncthreads();
    const int nxt = (int)nslot[0];
    if (nxt < nlimit) sgu_load(a, F, unit_lat(nxt), r);
    const int fr = lane_ & 15, g = lane_ >> 4, pt = F.wave;
    f32x4 acc[8];
#pragma unroll
    for (int c = 0; c < 8; ++c) acc[c] = (f32x4){0.f, 0.f, 0.f, 0.f};
#pragma unroll
    for (int sI = 0; sI < 4; ++sI) { const bf16x8 bw = *(const LAS bf16x8*)(WS_ + (16 * pt + fr) * LDP + 32 * sI + 8 * g);
#pragma unroll
        for (int ct = 0; ct < 8; ++ct) { const bf16x8 av = *(const LAS bf16x8*)(VT + (16 * ct + fr) * LDP + swz_col(16 * ct + fr, 32 * sI + 8 * g));
            acc[ct] = __builtin_amdgcn_mfma_f32_16x16x32_bf16(av, bw, acc[ct], 0, 0, 0); } }
    const int p = 16 * pt + fr; const float bs = a.sgu_b[grp * 128 + p];
#pragma unroll
    for (int ct = 0; ct < 8; ++ct) { const int c = 16 * ct + 4 * g; const u32x2 uu = *(const u32x2*)(Up + (size_t)p * RW + c);
        const float o0 = bf2f(uu.x & 0xffffu) * (acc[ct][0] + bs), o1 = bf2f(uu.x >> 16) * (acc[ct][1] + bs), o2 = bf2f(uu.y & 0xffffu) * (acc[ct][2] + bs), o3 = bf2f(uu.y >> 16) * (acc[ct][3] + bs);
        u32x2 o; o.x = cvt_pk_bf16(o0, o1); o.y = cvt_pk_bf16(o2, o3); *(u32x2*)(RS + (size_t)(row0 + p) * D + RW + grp * HD + c) = o; }
    __syncthreads();
    return nxt;
}
__device__ __forceinline__ void phase_scan(const Args& a, Frame& F) {
    FR_LANE_TID;
    bf16* ST = (bf16*)(a.ws + WS_R2);
    const int NT = F.G * 512;
    for (int it = F.blk * 512 + tid_; it < 32 * 2 * 2048; it += NT) {
        const int bh = it >> 12, dir = (it >> 11) & 1, e8 = it & 2047, h = bh & 7;
        const float cd = expf(128.0f * logsig(a.decay[dir * NH + h]));
        bf16* base = ST + ((size_t)bh * NSLOT * 2 + dir) * 16384 + (size_t)e8 * 8;
        float st[8];
#pragma unroll
        for (int i = 0; i < 8; ++i) st[i] = 0.f;
#pragma unroll 17
        for (int n = 0; n < NSLOT; ++n) { const int s_ = dir == 0 ? n : (n < 2 ? 1 - n : 35 - n);
            bf16* p = base + (size_t)s_ * 2 * 16384; const u32x4 t = *(const u32x4*)p;
            u32x4 o; o.x = cvt_pk_bf16(st[0], st[1]); o.y = cvt_pk_bf16(st[2], st[3]); o.z = cvt_pk_bf16(st[4], st[5]); o.w = cvt_pk_bf16(st[6], st[7]); *(u32x4*)p = o;
#pragma unroll
            for (int i = 0; i < 4; ++i) { st[2 * i] = st[2 * i] * cd + bf2f(t[i] & 0xffffu); st[2 * i + 1] = st[2 * i + 1] * cd + bf2f(t[i] >> 16); } }
    }
}
__device__ __forceinline__ void ret_y_unit(const Args& a, Frame& F, int u) {
    FR_LANE_TID;
    unsigned char* ws = a.ws; const bf16* Z = (const bf16*)(ws + WS_R1); bf16* RS = (bf16*)(ws + WS_R3);
    const int bh = u / NSLOT, s = u % NSLOT, b = bh >> 3, h = bh & 7; const int row0 = unit_row0(b, s);
    const bf16* Qp = Z + (size_t)row0 * RW + h * HD; const bf16* Kp = Z + 1 * ZSEC + (size_t)row0 * RW + h * HD; const bf16* Vp = Z + 2 * ZSEC + (size_t)row0 * RW + h * HD;
    const bf16* Gp = Z + 3 * ZSEC + (size_t)row0 * RW + h * HD;
    const float lgf2 = logsig(a.decay[h]) * LOG2E, lgb2 = logsig(a.decay[NH + h]) * LOG2E;
    LAS bf16* KN = (LAS bf16*)(F.lds); LAS bf16* VT = (LAS bf16*)(F.lds + IMG); LAS bf16* SF = (LAS bf16*)(F.lds + 2 * IMG); LAS bf16* SB = (LAS bf16*)(F.lds + 3 * IMG);
    { const int jq = 4 * F.wave + (lane_ >> 4), ch = lane_ & 15; const int col = 8 * (((jq >> 1) ^ ch) & 15) + 4 * (jq & 1);
      u32x4 vv[4];
#pragma unroll
      for (int k = 0; k < 4; ++k) { const int j = 4 * jq + k; *(LAS u32x4*)(KN + j * LDP + 8 * ch) = *(const u32x4*)(Kp + (size_t)j * RW + 8 * ch); vv[k] = *(const u32x4*)(Vp + (size_t)j * RW + 8 * ch); }
#pragma unroll
      for (int i = 0; i < 8; ++i) { const unsigned sh = (i & 1) ? 16u : 0u; unsigned vw[4];
#pragma unroll
          for (int k = 0; k < 4; ++k) vw[k] = (vv[k][i >> 1] >> sh) & 0xffffu;
          u32x2 pv; pv.x = vw[0] | (vw[1] << 16); pv.y = vw[2] | (vw[3] << 16); *(LAS u32x2*)(VT + (8 * ch + i) * LDP + col) = pv; } }
    { const bf16* ST = (const bf16*)(ws + WS_R2) + (size_t)u * 2 * 16384;
#pragma unroll
        for (int k = 0; k < 4; ++k) { const int i8 = tid_ + 512 * k; const int e = i8 >> 4, d8 = (i8 & 15) * 8;
            *(LAS u32x4*)(SF + e * LDP + d8) = *(const u32x4*)(ST + e * 128 + d8); *(LAS u32x4*)(SB + e * LDP + d8) = *(const u32x4*)(ST + 16384 + e * 128 + d8); } }
    const int fr = lane_ & 15, g = lane_ >> 4, it_ = F.wave; const int i_abs = 16 * it_ + fr;
    bf16x8 qf[4];
#pragma unroll
    for (int sI = 0; sI < 4; ++sI) qf[sI] = *(const bf16x8*)(Qp + (size_t)i_abs * RW + 32 * sI + 8 * g);
    __syncthreads();
    bf16x8 pf[4];
#pragma unroll
    for (int ks = 0; ks < 4; ++ks) { f32x4 s0 = (f32x4){0.f, 0.f, 0.f, 0.f}, s1 = s0;
#pragma unroll
        for (int sI = 0; sI < 4; ++sI) { const bf16x8 k0 = *(const LAS bf16x8*)(KN + (32 * ks + fr) * LDP + 32 * sI + 8 * g), k1 = *(const LAS bf16x8*)(KN + (32 * ks + 16 + fr) * LDP + 32 * sI + 8 * g);
            s0 = __builtin_amdgcn_mfma_f32_16x16x32_bf16(k0, qf[sI], s0, 0, 0, 0); s1 = __builtin_amdgcn_mfma_f32_16x16x32_bf16(k1, qf[sI], s1, 0, 0, 0); }
        unsigned w[4];
#pragma unroll
        for (int r = 0; r < 4; r += 2) {
            const int j0 = 32 * ks + 4 * g + r, j1 = j0 + 1, j2 = j0 + 16, j3 = j2 + 1;
            const float d0 = (float)(i_abs - j0), d1 = (float)(i_abs - j1), d2 = (float)(i_abs - j2), d3 = (float)(i_abs - j3);
            const float m0 = d0 >= 0.f ? exp2f(d0 * lgf2) : exp2f(-d0 * lgb2), m1 = d1 >= 0.f ? exp2f(d1 * lgf2) : exp2f(-d1 * lgb2);
            const float m2 = d2 >= 0.f ? exp2f(d2 * lgf2) : exp2f(-d2 * lgb2), m3 = d3 >= 0.f ? exp2f(d3 * lgf2) : exp2f(-d3 * lgb2);
            w[r >> 1] = cvt_pk_bf16(s0[r] * m0, s0[r + 1] * m1); w[2 + (r >> 1)] = cvt_pk_bf16(s1[r] * m2, s1[r + 1] * m3);
        }
        u32x4 ww; ww.x = w[0]; ww.y = w[1]; ww.z = w[2]; ww.w = w[3]; pf[ks] = __builtin_bit_cast(bf16x8, ww);
    }
    const float qdf = exp2f((float)(i_abs + 1) * lgf2), qdb = exp2f((float)(128 - i_abs) * lgb2);
    f32x4 y[8];
#pragma unroll
    for (int et = 0; et < 8; ++et) {
        f32x4 ai = (f32x4){0.f, 0.f, 0.f, 0.f}, cf = ai, cb = ai;
#pragma unroll
        for (int ks = 0; ks < 4; ++ks) { const LAS bf16* vr = VT + (16 * et + fr) * LDP; const u32x2 lo = *(const LAS u32x2*)(vr + swz_col(16 * et + fr, 32 * ks + 4 * g)), hi = *(const LAS u32x2*)(vr + swz_col(16 * et + fr, 32 * ks + 16 + 4 * g));
            u32x4 av; av.x = lo.x; av.y = lo.y; av.z = hi.x; av.w = hi.y;
            ai = __builtin_amdgcn_mfma_f32_16x16x32_bf16(__builtin_bit_cast(bf16x8, av), pf[ks], ai, 0, 0, 0); }
#pragma unroll
        for (int sI = 0; sI < 4; ++sI) { const bf16x8 sf = *(const LAS bf16x8*)(SF + (16 * et + fr) * LDP + 32 * sI + 8 * g), sb = *(const LAS bf16x8*)(SB + (16 * et + fr) * LDP + 32 * sI + 8 * g);
            cf = __builtin_amdgcn_mfma_f32_16x16x32_bf16(sf, qf[sI], cf, 0, 0, 0); cb = __builtin_amdgcn_mfma_f32_16x16x32_bf16(sb, qf[sI], cb, 0, 0, 0); }
        y[et] = ai + cf * qdf + cb * qdb; asm volatile("" ::: "memory");
    }
    float sm = 0.f;
#pragma unroll
    for (int et = 0; et < 8; ++et) sm += (y[et][0] + y[et][1]) + (y[et][2] + y[et][3]);
    sm += __shfl_xor(sm, 16); sm += __shfl_xor(sm, 32); const float mu = sm * (1.0f / 128.0f);
    float sq = 0.f;
#pragma unroll
    for (int et = 0; et < 8; ++et) { const f32x4 dl = y[et] - mu; sq += (dl[0] * dl[0] + dl[1] * dl[1]) + (dl[2] * dl[2] + dl[3] * dl[3]); }
    sq += __shfl_xor(sq, 16); sq += __shfl_xor(sq, 32); const float rstd = rsqrtf(sq * (1.0f / 128.0f) + EPSN);
#pragma unroll
    for (int et = 0; et < 8; ++et) { const int e = 16 * et + 4 * g; const u32x2 gg = *(const u32x2*)(Gp + (size_t)i_abs * RW + e);
        const f32x4 o = (y[et] - mu) * rstd; u32x2 w2; w2.x = cvt_pk_bf16(o[0] * bf2f(gg.x & 0xffffu), o[1] * bf2f(gg.x >> 16)); w2.y = cvt_pk_bf16(o[2] * bf2f(gg.y & 0xffffu), o[3] * bf2f(gg.y >> 16));
        *(u32x2*)(RS + (size_t)(row0 + i_abs) * D + h * HD + e) = w2; }
    __syncthreads();
}

__device__ __forceinline__ void phase_conv(const Args& a, Frame& F) {
    FR_LANE_TID;
    unsigned char* ws = a.ws; const bf16* GB = (const bf16*)(ws + WS_R1); const bf16* XG = GB + (size_t)NLAT * D; bf16* A1 = (bf16*)(ws + WS_R3);
    const int NT = F.G * 512;
#pragma unroll 4
    for (int it = F.blk * 512 + tid_; it < NLAT * 256; it += NT) {
        const int row = it >> 8, c = (it & 255) * 8; const int gc = row & 63;
        const u32x4 x1 = *(const u32x4*)(XG + (size_t)row * D + c), gb = *(const u32x4*)(GB + (size_t)row * D + c);
        u32x4 x0 = (u32x4){0u, 0u, 0u, 0u}, x2 = x0;
        if (gc > 0) x0 = *(const u32x4*)(XG + (size_t)(row - 1) * D + c);
        if (gc < 63) x2 = *(const u32x4*)(XG + (size_t)(row + 1) * D + c);
        float o[8];
#pragma unroll
        for (int i = 0; i < 8; ++i) { const int cc = c + i; const unsigned sh = (i & 1) ? 16u : 0u;
            const float f0 = bf2f((x0[i >> 1] >> sh) & 0xffffu), f1 = bf2f((x1[i >> 1] >> sh) & 0xffffu), f2 = bf2f((x2[i >> 1] >> sh) & 0xffffu), fg = bf2f((gb[i >> 1] >> sh) & 0xffffu);
            o[i] = fg * (a.cv_cb[cc] + a.cv_cw[cc] * f0 + a.cv_cw[D + cc] * f1 + a.cv_cw[2 * D + cc] * f2); }
        u32x4 w; w.x = cvt_pk_bf16(o[0], o[1]); w.y = cvt_pk_bf16(o[2], o[3]); w.z = cvt_pk_bf16(o[4], o[5]); w.w = cvt_pk_bf16(o[6], o[7]);
        *(u32x4*)(A1 + (size_t)row * D + c) = w;
    }
}

__device__ __forceinline__ void phase_route(const Args& a, Frame& F, int L) {
    FR_LANE_TID;
    unsigned char* ws = a.ws; const bf16* XB = (const bf16*)(ws + WS_XB); unsigned char* Fo = ws + WS_A;
    const float* MOD = (const float*)(ws + WS_MOD); const float* WR = (const float*)(ws + WS_WR) + (size_t)L * 20 * D;
    const int nrows = NLAT; const int RPB = (nrows + F.G - 1) / F.G;
    LAS int* rinfo = (LAS int*)(F.lds + MISC_OFF + 4 * MI_RINFO);
    LAS float* rw = (LAS float*)(F.lds + MISC_OFF + 4 * MI_RW);
    volatile LAS unsigned* lcnt = F.MISC + MI_LCNT; volatile LAS unsigned* gbase = F.MISC + MI_GBASE;
    LAS float* WL = (LAS float*)F.lds;
    if (tid_ < 16) lcnt[tid_] = 0u;
    { f32x4 t_[10];
#pragma unroll
      for (int k = 0; k < 10; ++k) t_[k] = *(const f32x4*)(WR + 4 * (size_t)(tid_ + 512 * k));
#pragma unroll
      for (int k = 0; k < 10; ++k) *(LAS f32x4*)(WL + 4 * (tid_ + 512 * k)) = t_[k];
      asm volatile("" ::: "memory");
#pragma unroll
      for (int k = 0; k < 9; ++k) t_[k] = *(const f32x4*)(WR + 4 * (size_t)(tid_ + 512 * (10 + k)));
#pragma unroll
      for (int k = 0; k < 9; ++k) *(LAS f32x4*)(WL + 4 * (tid_ + 512 * (10 + k))) = t_[k];
      asm volatile("" ::: "memory"); }
    __syncthreads();
    f32x4 Gm[8];
    const float* mp0 = MOD + (size_t)(L * 5 + ((F.blk * RPB) >> 12)) * MODW;
    { const float* gf = a.g_ffn + L * D;
#pragma unroll
      for (int j = 0; j < 8; ++j) { const int c = 4 * lane_ + 256 * j; const f32x4 g = *(const f32x4*)(gf + c), sc = *(const f32x4*)(mp0 + 4 * D + c); Gm[j] = g * (sc + 1.0f); } }
    f32x4 vn[8];
    { const int row = F.blk * RPB + F.wave; if (F.wave < RPB && row < nrows) {
#pragma unroll
        for (int j = 0; j < 8; ++j) vn[j] = bf4_to_f32(*(const u32x2*)(XB + (size_t)row * D + 4 * lane_ + 256 * j)); } }
    for (int i = F.wave; i < RPB; i += 8) {
        const int row = F.blk * RPB + i; if (row >= nrows) break;
        int ln4 = 4 * lane_; asm volatile("" : "+v"(ln4));
        f32x4 v[8];
#pragma unroll
        for (int j = 0; j < 8; ++j) v[j] = vn[j];
        if (i + 8 < RPB && row + 8 < nrows) {
#pragma unroll
            for (int j = 0; j < 8; ++j) vn[j] = bf4_to_f32(*(const u32x2*)(XB + (size_t)(row + 8) * D + ln4 + 256 * j)); }
        const float rstd = row_rstd(v);
#pragma unroll
        for (int j = 0; j < 8; ++j) { const int c = ln4 + 256 * j;
            v[j] = v[j] * rstd * Gm[j] + *(const f32x4*)(mp0 + 3 * D + c); *(unsigned*)(Fo + (size_t)row * D + c) = pk4_fp8(v[j][0], v[j][1], v[j][2], v[j][3]); }
        float l1[4] = {0.f, 0.f, 0.f, 0.f};
#pragma unroll
        for (int j = 0; j < 8; ++j)
#pragma unroll
            for (int g = 0; g < 4; ++g) { const f32x4 w = *(const LAS f32x4*)(WL + g * D + ln4 + 256 * j); l1[g] += (v[j][0] * w[0] + v[j][1] * w[1]) + (v[j][2] * w[2] + v[j][3] * w[3]); if (g == 3 && (j & 1)) asm volatile("" ::: "memory"); }
#pragma unroll
        for (int g = 0; g < 4; ++g) l1[g] = wave_sum(l1[g]) + a.b_r1[L * 4 + g];
        int grp = 0; float mx = l1[0];
#pragma unroll
        for (int g = 1; g < 4; ++g) if (l1[g] > mx) { mx = l1[g]; grp = g; }
        grp = __builtin_amdgcn_readfirstlane(grp);
        float den = 0.f;
#pragma unroll
        for (int g = 0; g < 4; ++g) den += expf(l1[g] - mx);
        const float pg = 1.0f / den;
        float l2[4] = {0.f, 0.f, 0.f, 0.f};
#pragma unroll
        for (int j = 0; j < 8; ++j)
#pragma unroll
            for (int e = 0; e < 3; ++e) { const f32x4 w = *(const LAS f32x4*)(WL + (4 + 4 * grp + e) * D + ln4 + 256 * j); l2[e] += (v[j][0] * w[0] + v[j][1] * w[1]) + (v[j][2] * w[2] + v[j][3] * w[3]); if (e == 2 && (j & 1)) asm volatile("" ::: "memory"); }
        if (grp < 3) {
#pragma unroll
            for (int j = 0; j < 8; ++j) { const f32x4 w = *(const LAS f32x4*)(WL + (7 + 4 * grp) * D + ln4 + 256 * j); l2[3] += (v[j][0] * w[0] + v[j][1] * w[1]) + (v[j][2] * w[2] + v[j][3] * w[3]); }
        } else {
#pragma unroll
            for (int j = 0; j < 8; ++j) { const f32x4 w = *(const f32x4*)(WR + (size_t)19 * D + ln4 + 256 * j); l2[3] += (v[j][0] * w[0] + v[j][1] * w[1]) + (v[j][2] * w[2] + v[j][3] * w[3]); }
        }
#pragma unroll
        for (int e = 0; e < 4; ++e) l2[e] = wave_sum(l2[e]) + a.b_r2[(L * 4 + grp) * 4 + e];
        int i0 = 0; float v0 = l2[0];
#pragma unroll
        for (int e = 1; e < 4; ++e) if (l2[e] > v0) { v0 = l2[e]; i0 = e; }
        int i1 = -1; float v1 = -3.0e38f;
#pragma unroll
        for (int e = 0; e < 4; ++e) if (e != i0 && l2[e] > v1) { v1 = l2[e]; i1 = e; }
        const float ex = expf(v1 - v0); const float w0 = pg / (1.0f + ex), w1 = pg * ex / (1.0f + ex);
        if (lane_ == 0) { const int e0 = grp * 4 + i0, e1 = grp * 4 + i1;
            const int li0 = (int)__hip_atomic_fetch_add((LAS unsigned*)&lcnt[e0], 1u, __ATOMIC_RELAXED, __HIP_MEMORY_SCOPE_WORKGROUP);
            const int li1 = (int)__hip_atomic_fetch_add((LAS unsigned*)&lcnt[e1], 1u, __ATOMIC_RELAXED, __HIP_MEMORY_SCOPE_WORKGROUP);
            rinfo[4 * i] = e0; rinfo[4 * i + 1] = li0; rinfo[4 * i + 2] = e1; rinfo[4 * i + 3] = li1; rw[2 * i] = w0; rw[2 * i + 1] = w1; }
    }
    __syncthreads();
    if (tid_ < 16) gbase[tid_] = xb_add((unsigned*)(ws + WS_CTL) + CW_CNT + (L * 16 + tid_) * 64, lcnt[tid_]);
    __syncthreads();
    int* RIDX = (int*)(ws + WS_RIDX) + (size_t)L * NTOK * 4; float* RWT = (float*)(ws + WS_RWT) + (size_t)L * NTOK * 2;
    for (int i = tid_; i < RPB; i += 512) { const int row = F.blk * RPB + i; if (row < nrows) {
        const int e0 = rinfo[4 * i], e1 = rinfo[4 * i + 2];
        i32x4 o; o.x = e0; o.y = (int)gbase[e0] + rinfo[4 * i + 1]; o.z = e1; o.w = (int)gbase[e1] + rinfo[4 * i + 3]; *(i32x4*)(RIDX + 4 * (size_t)row) = o;
        f32x2 w; w.x = rw[2 * i]; w.y = rw[2 * i + 1]; *(f32x2*)(RWT + 2 * (size_t)row) = w;
        int* GI = (int*)(ws + WS_GIDX) + (size_t)L * NE * NTOK; GI[(size_t)e0 * NTOK + o.y] = row; GI[(size_t)e1 * NTOK + o.w] = row; } }
    __syncthreads();
}
__device__ __forceinline__ void phase_final(const Args& a, Frame& F, int Lc  ) {
    FR_LANE_TID;
    unsigned char* ws = a.ws; const bf16* XB = (const bf16*)(ws + WS_XB); const float* MOD = (const float*)(ws + WS_MOD);
    if (Lc < 0) {
        const int gw = F.blk * 8 + F.wave, NGW = F.G * 8;
        for (int row = gw; row < NLAT; row += NGW) { f32x4 v[8];
#pragma unroll
            for (int j = 0; j < 8; ++j) v[j] = bf4_to_f32(*(const u32x2*)(XB + (size_t)row * D + 4 * lane_ + 256 * j));
            const float rstd = row_rstd(v);
#pragma unroll
            for (int j = 0; j < 8; ++j) { const int c = 4 * lane_ + 256 * j; *(f32x4*)(a.out + (size_t)row * D + c) = v[j] * rstd * *(const f32x4*)(a.g_final + c); } }
        return;
    }
    (void)moe_tables(a, F, Lc);
    const volatile LAS int* tb = (const volatile LAS int*)(F.MISC + MI_TB);
    const int RPB = NLAT / F.G, r = (F.blk * RPB) >> 12;
    const bf16* Y = (const bf16*)(ws + WS_R2); const int* ridx = (const int*)(ws + WS_RIDX) + (size_t)Lc * NTOK * 4; const float* rwt = (const float*)(ws + WS_RWT) + (size_t)Lc * NTOK * 2;
    f32x4 gate[8], Gf[8];
#pragma unroll
    for (int j = 0; j < 8; ++j) { const int c = 4 * lane_ + 256 * j; gate[j] = *(const f32x4*)(MOD + (size_t)(Lc * 5 + r) * MODW + 5 * D + c); Gf[j] = *(const f32x4*)(a.g_final + c); }
    RowBuf bA, bB;
    if (F.wave < RPB) rowbuf_issue(bA, XB, Y, ridx, rwt, tb, F.blk * RPB + F.wave, 4 * lane_);
    for (int i = F.wave; i < RPB; i += 16) {
        int ln4 = 4 * lane_; asm volatile("" : "+v"(ln4));
        const int row = F.blk * RPB + i;
        if (i + 8 < RPB) rowbuf_issue(bB, XB, Y, ridx, rwt, tb, row + 8, ln4);
        { f32x4 v[8]; rowbuf_combine(bA, gate, v); const float rstd = row_rstd(v);
#pragma unroll
          for (int j = 0; j < 8; ++j) *(f32x4*)(a.out + (size_t)row * D + ln4 + 256 * j) = v[j] * rstd * Gf[j]; }
        if (i + 8 >= RPB) break;
        if (i + 16 < RPB) rowbuf_issue(bA, XB, Y, ridx, rwt, tb, row + 16, ln4);
        { f32x4 v[8]; rowbuf_combine(bB, gate, v); const float rstd = row_rstd(v);
#pragma unroll
          for (int j = 0; j < 8; ++j) *(f32x4*)(a.out + (size_t)(row + 8) * D + ln4 + 256 * j) = v[j] * rstd * Gf[j]; }
    }
}

__global__ void __launch_bounds__(512, 2) fwd_kernel(Args a) {
    extern __shared__ __attribute__((aligned(16))) unsigned char lds_raw[];
    Frame F; F.lds = (LAS unsigned char*)lds_raw; F.MISC = (volatile LAS unsigned*)(F.lds + MISC_OFF);
    F.wave = __builtin_amdgcn_readfirstlane((int)threadIdx.x >> 6); F.G = gridDim.x; F.blk = blockIdx.x;
    unsigned char* ws = a.ws;
    F.MISC[threadIdx.x] = 0u; F.MISC[threadIdx.x + 512] = 0u;
    __syncthreads();
#if MK_SPLIT
    #define GRID_BAR() do { } while (0)
#else
    XcdBarrier bar = xcd_barrier_post((unsigned*)(ws + WS_CTL) + CW_BAR, F.MISC);
    #define GRID_BAR() xcd_barrier(bar)
#endif
    const int lo = a.ph_lo, hi = a.ph_hi;
    unsigned long long pr_acc = 0ull, pr_t0 = 0ull;
#define IN(k) (lo <= (k) && (k) < hi && ((((PROBE_MASK) >> (k)) & 1u) ? (pr_t0 = __builtin_amdgcn_s_memrealtime(), true) : true))
#define SEAM(k) do { if (lo <= (k) + 1 && (k) + 1 < hi) GRID_BAR(); if (((PROBE_MASK) >> (k)) & 1u) pr_acc += __builtin_amdgcn_s_memrealtime() - pr_t0; } while (0)

    if (IN(PH_PRO)) { phase_prologue(a, F); SEAM(PH_PRO); }
#define RUN_LAYER(L) do { \
        constexpr int P = PH_L0 + (L) * PH_PER_LAYER; \
        constexpr int nM = NLAT / 256;        \
        if (IN(P + K_PRE)) { phase_pre(a, F, (L)); SEAM(P + K_PRE); } \
        if (DBG_STOP == 1) break; \
        if (IN(P + K_GIN)) { \
            if ((L) == 0) { pg8::Gemm g{(const bf16*)(ws + WS_A), (const bf16*)(ws + WS_WAB_IN), D}; pg8::StaticOrder S; S.init(nM, 24, F.G, F.blk); \
                { const int t_ = F.wave * 64 + lane_id(); LAS float* cl_ = (LAS float*)(F.lds + 131072); const float* cg_ = (const float*)(ws + WS_ROPE); \
                  for (int k_ = 0; k_ < 2; ++k_) *(LAS f32x4*)(cl_ + 4 * (t_ + 512 * k_)) = *(const f32x4*)(cg_ + 4 * (t_ + 512 * k_)); __syncthreads(); } \
                pg8::EpiAB E{(bf16*)(ws + WS_R1), (const LAS float*)(F.lds + 131072)}; pg8::gemm_phase<pg8::EpiAB, pg8::StaticOrder, true, true>(F.lds, F.wave, g, S, E); } \
            else { pg8::Gemm g{(const bf16*)(ws + WS_A), (const bf16*)(ws + WS_WCV_IN), D}; pg8::StaticOrder S; S.init(nM, 24, F.G, F.blk); \
                pg8::EpiCV E{(bf16*)(ws + WS_R1), (bf16*)(ws + WS_R1) + (size_t)NLAT * D}; pg8::gemm_phase<pg8::EpiCV, pg8::StaticOrder, true, true>(F.lds, F.wave, g, S, E); } \
            SEAM(P + K_GIN); \
        } \
        if (IN(P + K_MID1)) { \
            if ((L) == 0) { \
                { pg8::Gemm g{(const bf16*)(ws + WS_A), (const bf16*)(ws + WS_WAB_IN), D}; pg8::CtxKvOrder S; S.c = F.blk; \
                  pg8::EpiAB E{(bf16*)(ws + WS_R1), (const LAS float*)(F.lds + 131072)}; pg8::gemm_phase<pg8::EpiAB, pg8::CtxKvOrder, true, true>(F.lds, F.wave, g, S, E); } \
                  \
                  \
                { unsigned* q_ = (unsigned*)(ws + WS_CTL) + CW_Q; RU r_; \
                  __syncthreads(); if (threadIdx.x == 0) F.MISC[4] = xb_add(q_, 1u); __syncthreads(); int cur_ = (int)F.MISC[4]; \
                  if (cur_ < 1024) ret_u_load(a, F, unit_lat(cur_), r_); \
                  while (cur_ < 1024) { if (threadIdx.x == 0) F.MISC[5] = xb_add(q_, 1u); cur_ = ret_u_body<false>(a, F, unit_lat(cur_), r_, F.MISC + 5, 1024); } } \
                { unsigned* q_ = (unsigned*)(ws + WS_CTL) + CW_Q + 64; SU r_; \
                  __syncthreads(); if (threadIdx.x == 0) F.MISC[4] = xb_add(q_, 1u); __syncthreads(); int cur_ = (int)F.MISC[4]; \
                  if (cur_ < 1024) sgu_load(a, F, unit_lat(cur_), r_); \
                  while (cur_ < 1024) { if (threadIdx.x == 0) F.MISC[5] = xb_add(q_, 1u); cur_ = sgu_body(a, F, unit_lat(cur_), r_, F.MISC + 5, 1024); } } \
            } else phase_conv(a, F); \
            SEAM(P + K_MID1); \
        } \
        if ((L) == 0) { \
            if (IN(P + K_MID1B)) { if (F.blk < 64) { RU r_; __syncthreads(); if (threadIdx.x == 0) F.MISC[5] = 64u; ret_u_load(a, F, unit_ctx(F.blk), r_); (void)ret_u_body<true>(a, F, unit_ctx(F.blk), r_, F.MISC + 5, 64); } SEAM(P + K_MID1B); } \
            if (IN(P + K_MID2)) { phase_scan(a, F); SEAM(P + K_MID2); } \
            if (IN(P + K_MID3)) { for (int v_ = F.blk; v_ < 1024; v_ += F.G) ret_y_unit(a, F, (v_ >> 5) * NSLOT + 2 + (v_ & 31)); SEAM(P + K_MID3); } \
        } \
        if (IN(P + K_GOUT)) { \
            pg8::Gemm g{(const bf16*)(ws + WS_R3), (const bf16*)(ws + ((L) == 0 ? WS_WAB_OUT : WS_WCV_OUT)), D}; pg8::StaticOrder S; S.init(nM, 8, F.G, F.blk); \
            pg8::EpiRes E{(bf16*)(ws + WS_XB), (L) == 0 ? a.x : (const float*)nullptr, (const float*)(ws + WS_MOD) + (size_t)(L) * 5 * MODW + 2 * D}; \
            pg8::gemm_phase<pg8::EpiRes, pg8::StaticOrder, true, true>(F.lds, F.wave, g, S, E); \
            SEAM(P + K_GOUT); \
        } \
        if (DBG_STOP == 2 || (DBG_STOP == 4 && (L) == 1)) break; \
        if (IN(P + K_ROUTE)) { phase_route(a, F, (L)); SEAM(P + K_ROUTE); } \
        if (IN(P + K_MOE1)) { \
            const int TT = moe_tables(a, F, (L)); \
            pg8::Gemm g{(const bf16*)(ws + WS_A), (const bf16*)(ws + WS_W13 + (size_t)(L) * NE * D * D), D / 2}; \
            pg8::MoeOrder S; S.init(TT, 8, F.G, F.blk); S.texp = (const volatile LAS int*)(F.MISC + MI_TEXP); S.bstride = (long)D * D; \
            { FR_LANE_TID; LAS int* idxbuf = (LAS int*)(F.lds + 131072); const volatile LAS int* tb_ = (const volatile LAS int*)(F.MISC + MI_TB); const volatile LAS int* cn_ = (const volatile LAS int*)(F.MISC + MI_LCNT); \
              const int* GI = (const int*)(ws + WS_GIDX) + (size_t)(L) * NE * NTOK; \
              for (int i_ = 0; i_ < 16; ++i_) { pg8::Unit u_; if (!S.next(i_, u_)) break; const int e_ = S.texp[u_.pm]; const int idx_ = (u_.pm - tb_[e_]) * 256 + tid_; \
                  if (tid_ < 256) idxbuf[i_ * 256 + tid_] = idx_ < cn_[e_] ? GI[(size_t)e_ * NTOK + idx_] : 0; } \
              __syncthreads(); } \
            pg8::EpiMoe1 E{ws + WS_R3}; pg8::gemm_phase<pg8::EpiMoe1, pg8::MoeOrder, true, true, true, true>(F.lds, F.wave, g, S, E, (const LAS int*)(F.lds + 131072)); \
            SEAM(P + K_MOE1); \
        } \
        if (IN(P + K_MOE2)) { \
            const int TT = moe_tables(a, F, (L)); \
            pg8::Gemm g{(const bf16*)(ws + WS_R3), (const bf16*)(ws + WS_W2 + (size_t)(L) * NE * D * DE), DE / 2}; \
            pg8::MoeOrder S; S.init(TT, 8, F.G, F.blk); S.texp = (const volatile LAS int*)(F.MISC + MI_TEXP); S.bstride = (long)D * DE; \
            pg8::EpiMoe2 E{(bf16*)(ws + WS_R2)}; pg8::gemm_phase<pg8::EpiMoe2, pg8::MoeOrder, true, true, true>(F.lds, F.wave, g, S, E); \
            SEAM(P + K_MOE2); \
        } \
    } while (0)
    RUN_LAYER(0);
    if (DBG_STOP == 0 || DBG_STOP == 4) RUN_LAYER(1);
    if (IN(PH_FINAL)) phase_final(a, F, DBG_STOP == 0 ? 1 : (DBG_STOP == 3 ? 0 : -1));
#undef IN
#undef SEAM
    if ((PROBE_MASK) != 0u && F.blk == 0 && threadIdx.x == 0) { const unsigned long long t1 = __builtin_amdgcn_s_memrealtime(); while (__builtin_amdgcn_s_memrealtime() - t1 < (unsigned long long)(PROBE_MULT) * pr_acc) __builtin_amdgcn_s_sleep(8); }
}

extern "C" void kernel_launch(void* const* d_in, const int* in_sizes, int n_in, void* d_out, int out_size, void* d_ws, size_t ws_size, hipStream_t stream) {
    static int grid = 0;
    if (grid == 0) {
        if (n_in != 25 || in_sizes[0] != NLAT * D || out_size != NLAT * D || ws_size < WS_END) { fprintf(stderr, "kernel_launch: unexpected shapes (n_in %d, in0 %d, out %d, ws %zu)\n", n_in, n_in > 0 ? in_sizes[0] : -1, out_size, ws_size); grid = -1; return; }
        int dev = 0, cus = 0, per_cu = 0;
        if (hipGetDevice(&dev) != hipSuccess || hipDeviceGetAttribute(&cus, hipDeviceAttributeMultiprocessorCount, dev) != hipSuccess) { grid = -1; return; }
        if (hipFuncSetAttribute((const void*)fwd_kernel, hipFuncAttributeMaxDynamicSharedMemorySize, LDS_BYTES) != hipSuccess) { fprintf(stderr, "kernel_launch: hipFuncSetAttribute failed\n"); grid = -1; return; }
        if (hipOccupancyMaxActiveBlocksPerMultiprocessor(&per_cu, (const void*)fwd_kernel, 512, LDS_BYTES) != hipSuccess || per_cu < 1) fprintf(stderr, "kernel_launch: occupancy query reports %d\n", per_cu);
        (void)hipGetLastError();
        grid = cus;
    }
    if (grid < 0) return;
    (void)hipMemsetAsync((char*)d_ws + WS_CTL, 0, CTL_BYTES, stream);
    Args a{};
    const float** f = (const float**)&a;
    for (int i = 0; i < 25; ++i) f[i] = (const float*)d_in[i];
    a.out = (float*)d_out; a.ws = (unsigned char*)d_ws;
#if MK_SPLIT
    for (int ph = 0; ph < NPHASE; ++ph) { a.ph_lo = ph; a.ph_hi = ph + 1; hipLaunchKernelGGL(fwd_kernel, dim3(grid), dim3(512), LDS_BYTES, stream, a); }
#else
    a.ph_lo = 0; a.ph_hi = NPHASE; hipLaunchKernelGGL(fwd_kernel, dim3(grid), dim3(512), LDS_BYTES, stream, a);
#endif
}
```
